# Optimizing an MI355X kernel written in HIP

```python
import math
import jax, jax.numpy as jnp
from jax import lax
import numpy as np

D_MODEL = 2048
BATCH = 1
SEQ = 16384
DEPTH = 2

N_MEM = 256
N_MIXERS = 2
HEAD_DIM = 128
EPS = 1e-6
X_HEADS = 4
X_WIDTH = X_HEADS * HEAD_DIM
BRANCH_WIDTH = D_MODEL - X_WIDTH
MIX_WIDTH = BRANCH_WIDTH + X_WIDTH
GLA_HEADS = 4
GLA_DV = BRANCH_WIDTH // GLA_HEADS
GLA_DK = GLA_DV // 2
GLA_KEY_WIDTH = GLA_HEADS * GLA_DK
GLA_GATE_RANK = 16
GLA_GATE_TEMP = 16.0
GLA_CHUNK = 64
NSA_HEADS = BRANCH_WIDTH // HEAD_DIM
NSA_GROUPS = 2
NSA_HPG = NSA_HEADS // NSA_GROUPS
NSA_KV_WIDTH = NSA_GROUPS * HEAD_DIM
N_BRANCH = 3
CMP_LEN = 32
CMP_STRIDE = 16
CMP_HIDDEN = 256
SLC_LEN = 64
SLC_TOPN = 16
WINDOW = 512
Q_BLOCK = 128
FORCED = 1e4

GLA_SIZES = [GLA_KEY_WIDTH, GLA_KEY_WIDTH, BRANCH_WIDTH, GLA_GATE_RANK, BRANCH_WIDTH, X_WIDTH, X_WIDTH]
NSA_SIZES = [BRANCH_WIDTH] + [NSA_KV_WIDTH] * 6 + [NSA_HEADS * N_BRANCH, BRANCH_WIDTH, X_WIDTH, X_WIDTH]
GLA_IN = sum(GLA_SIZES)
NSA_IN = sum(NSA_SIZES)
N_GLA_LAYERS = (DEPTH + 1) // 2
N_NSA_LAYERS = DEPTH // 2

kernel_name = 'hybrid_gla_nsa_memxattn'


def rmsnorm(x, g):
    xf = x.astype(jnp.float32)
    y = xf * lax.rsqrt(jnp.mean(xf * xf, axis=-1, keepdims=True) + EPS)
    return (y * g.astype(jnp.float32)).astype(x.dtype)


def split_cols(a, sizes):
    return jnp.split(a, np.cumsum(sizes)[:-1].tolist(), axis=-1)


def masked_softmax(s, mask):
    p = jax.nn.softmax(jnp.where(mask, s, -1e30), axis=-1)
    return jnp.where(mask, p, 0.0)


def mem_cross_attention(xq, mem_n, w_kv):
    B, T, _ = xq.shape
    M = mem_n.shape[1]
    k, v = jnp.split(mem_n @ w_kv, 2, axis=-1)
    q = xq.reshape(B, T, X_HEADS, HEAD_DIM)
    k = k.reshape(B, M, X_HEADS, HEAD_DIM)
    v = v.reshape(B, M, X_HEADS, HEAD_DIM)
    s = jnp.einsum('bthd,bmhd->bhtm', q, k).astype(jnp.float32) * HEAD_DIM ** -0.5
    p = jax.nn.softmax(s, axis=-1).astype(v.dtype)
    return jnp.einsum('bhtm,bmhd->bthd', p, v).reshape(B, T, X_WIDTH)


def gla_chunk_scan(q, k, v, logg):
    B, T, H, DK = q.shape
    DV = v.shape[-1]
    C = GLA_CHUNK
    N = T // C

    def to_chunks(a):
        return a.reshape(B, N, C, H, a.shape[-1]).transpose(1, 0, 3, 2, 4)

    qc, kc, vc, gc = to_chunks(q), to_chunks(k), to_chunks(v), to_chunks(logg)
    causal = jnp.tril(jnp.ones((C, C), dtype=bool))[:, :, None]

    def step(S, inp):
        qi, ki, vi, gi = inp
        b = jnp.cumsum(gi, axis=2)
        b_last = b[:, :, -1:, :]
        diff = b[:, :, :, None, :] - b[:, :, None, :, :]
        decay = jnp.exp(jnp.where(causal, diff, -jnp.inf))
        attn = jnp.einsum('bhcd,bhsd,bhcsd->bhcs', qi, ki, decay)
        o = jnp.einsum('bhcd,bhde->bhce', qi * jnp.exp(b), S) + jnp.einsum('bhcs,bhse->bhce', attn, vi)
        S = jnp.exp(b_last[:, :, 0, :])[..., None] * S + jnp.einsum('bhsd,bhse->bhde', ki * jnp.exp(b_last - b), vi)
        return S, o

    S0 = jnp.zeros((B, H, DK, DV), jnp.float32)
    _, o = lax.scan(step, S0, (qc, kc, vc, gc))
    return o.transpose(1, 0, 3, 2, 4).reshape(B, T, H, DV)


def gla_mixer(h, mem_n, w_in, w_gate_lr, b_gate, g_norm, w_kv, w_out):
    B, T, _ = h.shape
    f32 = jnp.float32
    q, k, v, glr, r, xq, xg = split_cols(h @ w_in, GLA_SIZES)
    q = q.reshape(B, T, GLA_HEADS, GLA_DK).astype(f32) * GLA_DK ** -0.5
    k = k.reshape(B, T, GLA_HEADS, GLA_DK).astype(f32)
    v = v.reshape(B, T, GLA_HEADS, GLA_DV).astype(f32)
    logg = jax.nn.log_sigmoid((glr @ w_gate_lr + b_gate).astype(f32)) / GLA_GATE_TEMP
    logg = logg.reshape(B, T, GLA_HEADS, GLA_DK)
    o = gla_chunk_scan(q, k, v, logg)
    o = rmsnorm(o, g_norm).reshape(B, T, BRANCH_WIDTH).astype(h.dtype)
    y_seq = o * jax.nn.silu(r)
    y_mem = mem_cross_attention(xq, mem_n, w_kv) * jax.nn.silu(xg)
    return jnp.concatenate([y_seq, y_mem], axis=-1) @ w_out


def nsa_mixer(h, mem_n, w_in, pe_k, pe_v, wk1, wk2, wv1, wv2, w_kv, w_out):
    B, T, _ = h.shape
    dt = h.dtype
    f32 = jnp.float32
    G, HPG, HD = NSA_GROUPS, NSA_HPG, HEAD_DIM
    scale = HD ** -0.5
    q, kc, vc, ks, vs, kw, vw, gl, r, xq, xg = split_cols(h @ w_in, NSA_SIZES)
    q = q.reshape(B, T, G, HPG, HD)
    gates = jax.nn.sigmoid(gl.astype(f32)).reshape(B, T, G, HPG, N_BRANCH)
    kc, vc, ks, vs, kw, vw = [a.reshape(B, T, G, HD) for a in (kc, vc, ks, vs, kw, vw)]

    n_cmp = (T - CMP_LEN) // CMP_STRIDE + 1
    cidx = np.arange(n_cmp)[:, None] * CMP_STRIDE + np.arange(CMP_LEN)[None, :]

    def compress(a, pe, w1, w2):
        blocks = a[:, cidx] + pe[None, None, :, None, :]
        blocks = blocks.transpose(0, 1, 3, 2, 4).reshape(B, n_cmp, G, CMP_LEN * HD)
        return jax.nn.silu(blocks @ w1) @ w2

    k_cmp = compress(kc, pe_k, wk1, wk2)
    v_cmp = compress(vc, pe_v, wv1, wv2)
    cmp_end = jnp.asarray(cidx[:, -1])

    n_slc = T // SLC_LEN
    top_n = min(SLC_TOPN, n_slc)
    cstart = np.arange(n_cmp) * CMP_STRIDE
    sstart = np.arange(n_slc) * SLC_LEN
    overlap = jnp.asarray(((cstart[:, None] < sstart[None, :] + SLC_LEN) &
                           (cstart[:, None] + CMP_LEN > sstart[None, :])).astype(np.float32))
    k_sb = ks.reshape(B, n_slc, SLC_LEN, G, HD).transpose(0, 3, 1, 2, 4)
    v_sb = vs.reshape(B, n_slc, SLC_LEN, G, HD).transpose(0, 3, 1, 2, 4)

    kw_pad = jnp.pad(kw, ((0, 0), (WINDOW, 0), (0, 0), (0, 0)))
    vw_pad = jnp.pad(vw, ((0, 0), (WINDOW, 0), (0, 0), (0, 0)))

    n_qb = T // Q_BLOCK
    q_blocks = q.reshape(B, n_qb, Q_BLOCK, G, HPG, HD).transpose(1, 0, 2, 3, 4, 5)
    g_blocks = gates.reshape(B, n_qb, Q_BLOCK, G, HPG, N_BRANCH).transpose(1, 0, 2, 3, 4, 5)
    bi = jnp.arange(B)[:, None, None, None]
    gi = jnp.arange(G)[None, :, None, None]
    jblk = jnp.arange(n_slc)

    def block_fn(args):
        qb_idx, qb, gb = args
        start = qb_idx * Q_BLOCK
        t = start + jnp.arange(Q_BLOCK)
        s = jnp.einsum('bqghd,bngd->bghqn', qb, k_cmp).astype(f32) * scale
        p_cmp = masked_softmax(s, cmp_end[None, :] <= t[:, None])
        o_cmp = jnp.einsum('bghqn,bngd->bqghd', p_cmp.astype(dt), v_cmp)
        imp = jnp.einsum('bghqn,nj->bgqj', p_cmp, overlap)
        cur = t // SLC_LEN
        forced = (jblk[None, :] == 0) | (jblk[None, :] == cur[:, None]) | (jblk[None, :] == cur[:, None] - 1)
        imp = jnp.where(forced, FORCED, imp)
        imp = jnp.where(jblk[None, :] > cur[:, None], -FORCED, imp)
        _, sel = lax.top_k(imp, top_n)
        ksel = k_sb[bi, gi, sel].reshape(B, G, Q_BLOCK, top_n * SLC_LEN, HD)
        vsel = v_sb[bi, gi, sel].reshape(B, G, Q_BLOCK, top_n * SLC_LEN, HD)
        pos = (sel[..., None] * SLC_LEN + jnp.arange(SLC_LEN)).reshape(B, G, Q_BLOCK, top_n * SLC_LEN)
        s = jnp.einsum('bqghd,bgqkd->bghqk', qb, ksel).astype(f32) * scale
        p = masked_softmax(s, (pos <= t[None, None, :, None])[:, :, None])
        o_slc = jnp.einsum('bghqk,bgqkd->bqghd', p.astype(dt), vsel)
        kwin = lax.dynamic_slice_in_dim(kw_pad, start, Q_BLOCK + WINDOW, axis=1)
        vwin = lax.dynamic_slice_in_dim(vw_pad, start, Q_BLOCK + WINDOW, axis=1)
        wpos = start - WINDOW + jnp.arange(Q_BLOCK + WINDOW)
        m_win = (wpos[None, :] <= t[:, None]) & (wpos[None, :] > t[:, None] - WINDOW) & (wpos[None, :] >= 0)
        s = jnp.einsum('bqghd,bkgd->bghqk', qb, kwin).astype(f32) * scale
        p = masked_softmax(s, m_win)
        o_win = jnp.einsum('bghqk,bkgd->bqghd', p.astype(dt), vwin)
        o = gb[..., 0:1] * o_cmp + gb[..., 1:2] * o_slc + gb[..., 2:3] * o_win
        return o.astype(dt)

    o = lax.map(block_fn, (jnp.arange(n_qb), q_blocks, g_blocks))
    o = o.transpose(1, 0, 2, 3, 4, 5).reshape(B, T, BRANCH_WIDTH)
    y_seq = o * jax.nn.silu(r)
    y_mem = mem_cross_attention(xq, mem_n, w_kv) * jax.nn.silu(xg)
    return jnp.concatenate([y_seq, y_mem], axis=-1) @ w_out


def setup_inputs(seed: int = 0) -> dict:
    key = jax.random.key(seed)
    ks = jax.random.split(key, 20)
    f32 = jnp.float32

    def nrm(k, shape, scale):
        return jax.random.normal(k, shape, f32) * scale

    nA, nB = N_GLA_LAYERS, N_NSA_LAYERS
    return {
        'x': nrm(ks[0], (BATCH, SEQ, D_MODEL), 1.0),
        'mem': nrm(ks[1], (BATCH, N_MEM, D_MODEL), 1.0),
        'ln_pre': 1.0 + nrm(ks[2], (DEPTH, D_MODEL), 0.02),
        'ln_post': 1.0 + nrm(ks[3], (DEPTH, D_MODEL), 0.02),
        'ln_mem': 1.0 + nrm(ks[4], (DEPTH, D_MODEL), 0.02),
        'w_mem_kv': nrm(ks[5], (DEPTH, D_MODEL, 2 * X_WIDTH), D_MODEL ** -0.5),
        'gla_w_in': nrm(ks[6], (nA, D_MODEL, GLA_IN), D_MODEL ** -0.5),
        'gla_w_gate_lr': nrm(ks[7], (nA, GLA_GATE_RANK, GLA_KEY_WIDTH), GLA_GATE_RANK ** -0.5),
        'gla_b_gate': nrm(ks[8], (nA, GLA_KEY_WIDTH), 0.1),
        'gla_norm': 1.0 + nrm(ks[9], (nA, GLA_DV), 0.02),
        'gla_w_out': nrm(ks[10], (nA, MIX_WIDTH, D_MODEL), MIX_WIDTH ** -0.5),
        'nsa_w_in': nrm(ks[11], (nB, D_MODEL, NSA_IN), D_MODEL ** -0.5),
        'nsa_pe_k': nrm(ks[12], (nB, CMP_LEN, HEAD_DIM), 0.1),
        'nsa_pe_v': nrm(ks[13], (nB, CMP_LEN, HEAD_DIM), 0.1),
        'nsa_wk1': nrm(ks[14], (nB, CMP_LEN * HEAD_DIM, CMP_HIDDEN), (CMP_LEN * HEAD_DIM) ** -0.5),
        'nsa_wk2': nrm(ks[15], (nB, CMP_HIDDEN, HEAD_DIM), CMP_HIDDEN ** -0.5),
        'nsa_wv1': nrm(ks[16], (nB, CMP_LEN * HEAD_DIM, CMP_HIDDEN), (CMP_LEN * HEAD_DIM) ** -0.5),
        'nsa_wv2': nrm(ks[17], (nB, CMP_HIDDEN, HEAD_DIM), CMP_HIDDEN ** -0.5),
        'nsa_w_out': nrm(ks[18], (nB, MIX_WIDTH, D_MODEL), MIX_WIDTH ** -0.5),
    }


def reference(x, mem, ln_pre, ln_post, ln_mem, w_mem_kv, gla_w_in, gla_w_gate_lr, gla_b_gate, gla_norm, gla_w_out,
              nsa_w_in, nsa_pe_k, nsa_pe_v, nsa_wk1, nsa_wk2, nsa_wv1, nsa_wv2, nsa_w_out):
    h = x
    for i in range(DEPTH):
        xn = rmsnorm(h, ln_pre[i])
        mem_n = rmsnorm(mem, ln_mem[i])
        a = i // N_MIXERS
        if i % N_MIXERS == 0:
            y = gla_mixer(xn, mem_n, gla_w_in[a], gla_w_gate_lr[a], gla_b_gate[a], gla_norm[a], w_mem_kv[i], gla_w_out[a])
        else:
            y = nsa_mixer(xn, mem_n, nsa_w_in[a], nsa_pe_k[a], nsa_pe_v[a], nsa_wk1[a], nsa_wk2[a], nsa_wv1[a], nsa_wv2[a],
                          w_mem_kv[i], nsa_w_out[a])
        h = h + rmsnorm(y, ln_post[i])
    return h
```

```cpp
#include <hip/hip_runtime.h>
#include <cstdio>
#include <cstdint>
namespace pg8 {
#define PG8_LAS __attribute__((address_space(3)))
typedef unsigned short bf16_t;
typedef short bf16x8 __attribute__((ext_vector_type(8)));
typedef float f32x4 __attribute__((ext_vector_type(4)));
typedef unsigned u32x4 __attribute__((ext_vector_type(4)));
constexpr int BM = 256, BK = 64, HALF = 128, HTB = HALF * BK * 2  , STAGE_BYTES = 8 * HTB, NXCD = 8, WGM = 8;

__host__ __device__ __forceinline__ int lds_byte(int r, int c) { const int st = (r >> 4) * 2 + (c >> 5), rr = r & 15, cc = c & 31, ob = rr * 64 + cc * 2; return st * 1024 + (ob ^ (((ob >> 9) & 1) << 5)); }
__host__ __device__ __forceinline__ void stage_rc(int b, int& R, int& C) { const int st = b / 1024, sb = b % 1024, swz = sb ^ (((sb >> 9) & 1) << 5); R = (st >> 1) * 16 + swz / 64; C = (st & 1) * 32 + (swz % 64) / 2; }
__host__ __device__ __forceinline__ int perm32(int rho) { const int n = rho >> 4, i = rho & 15; return 8 * (i >> 2) + 4 * n + (i & 3); }

struct Unit { int pm, pn; };
struct Gemm { const bf16_t* A; const bf16_t* Bt; int M, N, K; };

struct StaticOrder {
    int nM, nN, nwg, G, c;
    __host__ __device__ void init(int M, int N, int G_, int c_) { nM = M / BM; nN = N / BM; nwg = nM * nN; G = G_; c = c_; }
    __host__ __device__ bool next(int i, Unit& u) const {
        const long L = (long)i * G + c; if (L >= nwg) return false;
        int wgid = (int)L; { const int q = nwg / NXCD, r = nwg % NXCD, xcd = wgid % NXCD, off = wgid / NXCD; wgid = (xcd < r ? xcd * (q + 1) : r * (q + 1) + (xcd - r) * q) + off; }
        const int nig = WGM * nN, gid = wgid / nig, fm = gid * WGM, gsz = (nM - fm) < WGM ? (nM - fm) : WGM;
        u.pm = fm + ((wgid % nig) % gsz); u.pn = (wgid % nig) / gsz; return true;
    }
    __device__ __forceinline__ void a_ready(const Unit&) const {}
    __device__ __forceinline__ void done(const Unit&) const {}
};

__device__ __forceinline__ unsigned cvt_pk_bf16(float lo, float hi) { unsigned r; asm volatile("v_cvt_pk_bf16_f32 %0, %1, %2" : "=v"(r) : "v"(lo), "v"(hi)); return r; }
typedef float f32x2 __attribute__((ext_vector_type(2)));
__device__ __forceinline__ f32x2 gelu_pk(f32x2 v) {
    const f32x2 av = __builtin_elementwise_abs(v), d = av * 0.2316418882f + 1.0f;
    f32x2 t; t.x = __builtin_amdgcn_rcpf(d.x); t.y = __builtin_amdgcn_rcpf(d.y);
    f32x2 q = t * 0.5307027145f + (-0.7265760135f); q = q * t + 0.7107068705f; q = q * t + (-0.142248368f); q = q * t + 0.127414796f; q = q * t;
    const f32x2 s = (v * v) * (-0.72134752044f);
    f32x2 e; e.x = __builtin_amdgcn_exp2f(s.x); e.y = __builtin_amdgcn_exp2f(s.y);
    const f32x2 m = v * (q * e), r = v - m;
    f32x2 o; o.x = v.x < 0.f ? m.x : r.x; o.y = v.y < 0.f ? m.y : r.y; return o;
}

template <int ACT  > struct EpiBf16 {
    static constexpr bool PERM = true, AFTER_DRAIN = false; static_assert(ACT == 0 || ACT == 1, "EpiBf16: ACT is 0 (none) or 1 (gelu_pk)");
    bf16_t* O; int ldc; const float* bias; int split_cols; size_t split_stride; float scale0;
    __device__ __forceinline__ void operator()(const f32x4 (&acc)[2][2][4][2], const Unit& u, int wr, int wc, int fr, int fq) const {
        const int row0 = u.pm * BM + wr * 64 + fr; int colt = u.pn * BM; bf16_t* base = O;
        float sc = 1.f; if (split_cols) { const int t = colt / split_cols; base += (size_t)t * split_stride; colt -= t * split_cols; if (t == 0) sc = scale0; }
        const int col0 = colt + wc * 32 + 8 * fq, bcol0 = u.pn * BM + wc * 32 + 8 * fq;
        f32x4 bv[2][2];
#pragma unroll
        for (int bj = 0; bj < 2; ++bj)
#pragma unroll
            for (int n = 0; n < 2; ++n) bv[bj][n] = bias ? *(const f32x4*)(bias + bcol0 + bj * HALF + 4 * n) : (f32x4){0.f, 0.f, 0.f, 0.f};
#pragma unroll
        for (int ai = 0; ai < 2; ++ai)
#pragma unroll
            for (int m = 0; m < 4; ++m) { bf16_t* rowp = base + (size_t)(row0 + ai * HALF + m * 16) * ldc + col0;
#pragma unroll
                for (int bj = 0; bj < 2; ++bj) { f32x4 v0 = acc[ai][bj][m][0] + bv[bj][0], v1 = acc[ai][bj][m][1] + bv[bj][1];
                    if (ACT == 1) { f32x2 a = gelu_pk((f32x2){v0[0], v0[1]}), b = gelu_pk((f32x2){v0[2], v0[3]}), c = gelu_pk((f32x2){v1[0], v1[1]}), d = gelu_pk((f32x2){v1[2], v1[3]});
                        v0 = (f32x4){a.x, a.y, b.x, b.y}; v1 = (f32x4){c.x, c.y, d.x, d.y}; }
                    v0 = v0 * sc; v1 = v1 * sc; u32x4 w; w.x = cvt_pk_bf16(v0[0], v0[1]); w.y = cvt_pk_bf16(v0[2], v0[3]); w.z = cvt_pk_bf16(v1[0], v1[1]); w.w = cvt_pk_bf16(v1[2], v1[3]);
                    *(u32x4*)(rowp + bj * HALF) = w; } }
    }
};

template <class Epi, class Sched, bool ALIGN_EPI = false, bool SP2 = false>
__device__ __forceinline__ void gemm_phase(PG8_LAS unsigned char* lds, const Gemm g, const Sched& S, const Epi& E) {
    const int tid = threadIdx.x, wid = __builtin_amdgcn_readfirstlane(tid >> 6), lane = tid & 63, wr = wid >> 2, wc = wid & 3, fr = lane & 15, fq = lane >> 4;
    const int K = g.K, nt = K / BK;
    unsigned voffA[2], voffB[2];
#pragma unroll
    for (int i = 0; i < 2; ++i) { int R, C; stage_rc(tid * 16 + i * 8192, R, C); const int Rb = Epi::PERM ? ((R & ~31) + perm32(R & 31)) : R;
        voffA[i] = (unsigned)(R * K + C) * 2u; voffB[i] = (unsigned)(Rb * K + C) * 2u; }
    const size_t kstep = (size_t)(BK * 2);
    const size_t hstep = (size_t)HALF * K * 2;
    const size_t tstep = 2 * hstep;
    const unsigned ldsw = (unsigned)wid * 1024u;
    const int aoff = lds_byte(wr * 64 + fr, fq * 8), boff = lds_byte(wc * 32 + fr, fq * 8);
#define PG8_SA(b, h) (((b) * 2 + (h)) * HTB)
#define PG8_SB(b, h) ((4 + (b) * 2 + (h)) * HTB)
#define PG8_STAGE(bufoff, gbase, voff) do { _Pragma("unroll") for (int _i = 0; _i < 2; ++_i) \
        __builtin_amdgcn_global_load_lds((const unsigned*)((const char*)(gbase) + (voff)[_i]), (PG8_LAS unsigned*)(lds + (bufoff) + ldsw + _i * 8192), 16, 0, 0); } while (0)
#define PG8_LDA(dst, b, h) do { _Pragma("unroll") for (int m = 0; m < 4; ++m) _Pragma("unroll") for (int k = 0; k < 2; ++k) dst[m][k] = *(const PG8_LAS bf16x8*)(lds + PG8_SA(b, h) + aoff + m * 2048 + k * 1024); } while (0)
#define PG8_LDB(dst, b, h) do { _Pragma("unroll") for (int n = 0; n < 2; ++n) _Pragma("unroll") for (int k = 0; k < 2; ++k) dst[n][k] = *(const PG8_LAS bf16x8*)(lds + PG8_SB(b, h) + boff + n * 2048 + k * 1024); } while (0)
#define PG8_MMA(ai, bj, At, Bt) do { __builtin_amdgcn_s_setprio(1); _Pragma("unroll") for (int m = 0; m < 4; ++m) _Pragma("unroll") for (int n = 0; n < 2; ++n) _Pragma("unroll") for (int k = 0; k < 2; ++k) \
        acc[ai][bj][m][n] = __builtin_amdgcn_mfma_f32_16x16x32_bf16(Bt[n][k], At[m][k], acc[ai][bj][m][n], 0, 0, 0); __builtin_amdgcn_s_setprio(0); } while (0)
#define PG8_WAIT_V(n) asm volatile("s_waitcnt vmcnt(" #n ")" ::: "memory")
#define PG8_WAIT_L(n) asm volatile("s_waitcnt lgkmcnt(" #n ")" ::: "memory")
#define PG8_BAR __builtin_amdgcn_s_barrier()
#define PG8_SCHED __builtin_amdgcn_sched_barrier(0)
    Unit cur, nxt; int ui = 0;
    if (!S.next(0, cur)) return;
    f32x4 acc[2][2][4][2];
#pragma unroll
    for (int a = 0; a < 2; ++a)
#pragma unroll
        for (int b = 0; b < 2; ++b)
#pragma unroll
            for (int m = 0; m < 4; ++m)
#pragma unroll
                for (int n = 0; n < 2; ++n) acc[a][b][m][n] = (f32x4){0.f, 0.f, 0.f, 0.f};
    bf16x8 At[4][2], B0[2][2], B1[2][2];
    const char* cA = (const char*)g.A + (size_t)cur.pm * tstep; const char* cB = (const char*)g.Bt + (size_t)cur.pn * tstep;
    S.a_ready(cur);
    if constexpr (SP2) {
        PG8_STAGE(PG8_SB(0, 0), cB, voffB); PG8_STAGE(PG8_SB(0, 1), cB + hstep, voffB); PG8_STAGE(PG8_SA(0, 0), cA, voffA); PG8_STAGE(PG8_SA(0, 1), cA + hstep, voffA);
        if (wr == 1) PG8_BAR;
        PG8_WAIT_V(2); PG8_BAR;
        PG8_STAGE(PG8_SB(1, 0), cB + kstep, voffB); PG8_STAGE(PG8_SA(1, 0), cA + kstep, voffA); PG8_STAGE(PG8_SB(1, 1), cB + hstep + kstep, voffB);
        PG8_WAIT_V(6); PG8_BAR;
    } else {
        PG8_STAGE(PG8_SB(0, 0), cB, voffB); PG8_STAGE(PG8_SA(0, 0), cA, voffA); PG8_STAGE(PG8_SB(0, 1), cB + hstep, voffB); PG8_STAGE(PG8_SA(0, 1), cA + hstep, voffA);
        if (wr == 1) PG8_BAR;
        PG8_WAIT_V(4); PG8_BAR;
        PG8_STAGE(PG8_SB(1, 0), cB + kstep, voffB); PG8_STAGE(PG8_SA(1, 0), cA + kstep, voffA); PG8_STAGE(PG8_SB(1, 1), cB + hstep + kstep, voffB);
        PG8_WAIT_V(6); PG8_BAR;
    }
    for (;;) {
        const bool has_next = S.next(ui + 1, nxt);
        const char* nA = has_next ? (const char*)g.A + (size_t)nxt.pm * tstep : cA; const char* nB = has_next ? (const char*)g.Bt + (size_t)nxt.pn * tstep : cB;
        for (int t = 0; t < nt; t += 2) {
            const bool last = (t == nt - 2);
            const char* a1 = cA + (size_t)(t + 1) * kstep;
            const char* a2 = last ? nA : cA + (size_t)(t + 2) * kstep; const char* b2 = last ? nB : cB + (size_t)(t + 2) * kstep;
            const char* a3 = a2 + kstep; const char* b3 = b2 + kstep;
            if (last && has_next) S.a_ready(nxt);
            if constexpr (SP2) {
            PG8_LDB(B0, 0, 0); PG8_LDB(B1, 0, 1); PG8_SCHED; PG8_LDA(At, 0, 0); PG8_STAGE(PG8_SA(1, 1), a1 + hstep, voffA);
            PG8_WAIT_V(8); PG8_WAIT_L(0); PG8_BAR; PG8_MMA(0, 0, At, B0); PG8_MMA(0, 1, At, B1); PG8_BAR; PG8_SCHED;
            PG8_LDA(At, 0, 1); PG8_STAGE(PG8_SB(0, 0), b2, voffB); PG8_STAGE(PG8_SB(0, 1), b2 + hstep, voffB); PG8_STAGE(PG8_SA(0, 0), a2, voffA);
            PG8_WAIT_V(8); PG8_WAIT_L(0); PG8_BAR; PG8_MMA(1, 0, At, B0); PG8_MMA(1, 1, At, B1); PG8_BAR; PG8_SCHED;
            PG8_LDB(B0, 1, 0); PG8_LDB(B1, 1, 1); PG8_SCHED; PG8_LDA(At, 1, 0); PG8_STAGE(PG8_SA(0, 1), a2 + hstep, voffA);
            PG8_WAIT_V(8); PG8_WAIT_L(0); PG8_BAR; PG8_MMA(0, 0, At, B0); PG8_MMA(0, 1, At, B1); PG8_BAR; PG8_SCHED;
            PG8_LDA(At, 1, 1); PG8_STAGE(PG8_SB(1, 0), b3, voffB); PG8_STAGE(PG8_SB(1, 1), b3 + hstep, voffB); PG8_STAGE(PG8_SA(1, 0), a3, voffA);
            PG8_WAIT_V(8); PG8_WAIT_L(0); PG8_BAR; PG8_MMA(1, 0, At, B0); PG8_MMA(1, 1, At, B1); PG8_BAR; PG8_SCHED;
            } else {
            PG8_LDB(B0, 0, 0); PG8_SCHED; PG8_LDA(At, 0, 0); PG8_STAGE(PG8_SA(1, 1), a1 + hstep, voffA);
            PG8_WAIT_L(8); PG8_BAR; PG8_WAIT_L(0); PG8_MMA(0, 0, At, B0); PG8_BAR; PG8_SCHED;
            PG8_LDB(B1, 0, 1); PG8_STAGE(PG8_SB(0, 0), b2, voffB);
            PG8_BAR; PG8_WAIT_L(0); PG8_MMA(0, 1, At, B1); PG8_BAR;
            PG8_LDA(At, 0, 1); PG8_STAGE(PG8_SA(0, 0), a2, voffA);
            PG8_BAR; PG8_WAIT_L(0); PG8_MMA(1, 0, At, B0); PG8_BAR; PG8_SCHED;
            PG8_STAGE(PG8_SB(0, 1), b2 + hstep, voffB);
            PG8_WAIT_V(6); PG8_BAR; PG8_MMA(1, 1, At, B1); PG8_BAR;
            PG8_LDB(B0, 1, 0); PG8_SCHED; PG8_LDA(At, 1, 0); PG8_STAGE(PG8_SA(0, 1), a2 + hstep, voffA);
            PG8_WAIT_L(8); PG8_BAR; PG8_WAIT_L(0); PG8_MMA(0, 0, At, B0); PG8_BAR; PG8_SCHED;
            PG8_LDB(B1, 1, 1); PG8_STAGE(PG8_SB(1, 0), b3, voffB);
            PG8_BAR; PG8_WAIT_L(0); PG8_MMA(0, 1, At, B1); PG8_BAR;
            PG8_LDA(At, 1, 1); PG8_STAGE(PG8_SA(1, 0), a3, voffA);
            PG8_BAR; PG8_WAIT_L(0); PG8_MMA(1, 0, At, B0); PG8_BAR; PG8_SCHED;
            PG8_STAGE(PG8_SB(1, 1), b3 + hstep, voffB);
            PG8_WAIT_V(6); PG8_BAR; PG8_MMA(1, 1, At, B1); PG8_BAR;
            }
        }
        if constexpr (ALIGN_EPI) { if (wr == 0) PG8_BAR; }
        if constexpr (!Epi::AFTER_DRAIN) { E(acc, cur, wr, wc, fr, fq); S.done(cur); }
        if (!has_next) break;
#pragma unroll
        for (int a = 0; a < 2; ++a)
#pragma unroll
            for (int b = 0; b < 2; ++b)
#pragma unroll
                for (int m = 0; m < 4; ++m)
#pragma unroll
                    for (int n = 0; n < 2; ++n) acc[a][b][m][n] = (f32x4){0.f, 0.f, 0.f, 0.f};
        cur = nxt; cA = nA; cB = nB; ++ui;
        if constexpr (ALIGN_EPI) { if (wr == 1) PG8_BAR; }
    }
    PG8_WAIT_V(0);
    if constexpr (!ALIGN_EPI) { if (wr == 0) PG8_BAR; }
    PG8_BAR;
    if constexpr (Epi::AFTER_DRAIN) { E.fused(acc, cur, wr, wc, fr, fq, lds, wid, lane); S.done(cur); }
#undef PG8_SA
#undef PG8_SB
#undef PG8_STAGE
#undef PG8_LDA
#undef PG8_LDB
#undef PG8_MMA
#undef PG8_WAIT_V
#undef PG8_WAIT_L
#undef PG8_BAR
#undef PG8_SCHED
}
}
#define GAS __attribute__((address_space(1)))
#define LAS __attribute__((address_space(3)))
typedef unsigned short bf16;
typedef unsigned v4u __attribute__((ext_vector_type(4)));
typedef float f32x4 __attribute__((ext_vector_type(4)));
typedef short bf16x8 __attribute__((ext_vector_type(8)));
typedef GAS unsigned gu32;
typedef GAS unsigned long long gu64;
#define RLX_AGENT __ATOMIC_RELAXED, __HIP_MEMORY_SCOPE_AGENT
#define LDS_WAIT() asm volatile("s_waitcnt lgkmcnt(0)" ::: "memory")
#define VM_WAIT() asm volatile("s_waitcnt vmcnt(0)" ::: "memory")
__device__ __forceinline__ unsigned long long rt() { return __builtin_amdgcn_s_memrealtime(); }
__device__ __forceinline__ unsigned f2bf(float f) { unsigned u = __builtin_bit_cast(unsigned, f); return (u + 0x7fffu + ((u >> 16) & 1u)) >> 16; }
__device__ __forceinline__ unsigned pk2(float lo, float hi) { return f2bf(lo) | (f2bf(hi) << 16); }

#define XB_TMO      128
#define XB_XCNT(j)  (256  + 64 * (j))
#define XB_XSUB(j)  (1280 + 64 * (j))
#define XB_XGEN(j)  (2304 + 64 * (j))
#define XB_TOP      3328
#define XB_TOPGEN   3392
#define XCD_BAR_WORDS 3456
#define XB_SPIN_CAP (1u << 18)

__device__ __forceinline__ unsigned xb_ld(unsigned* p)              { return __hip_atomic_load(p, __ATOMIC_RELAXED, __HIP_MEMORY_SCOPE_AGENT); }
__device__ __forceinline__ unsigned xb_add(unsigned* p, unsigned v) { return __hip_atomic_fetch_add(p, v, __ATOMIC_RELAXED, __HIP_MEMORY_SCOPE_AGENT); }
__device__ __forceinline__ unsigned xb_xcc_id() { return (unsigned)__builtin_amdgcn_s_getreg((3 << 11) | 20) & 0xFu; }
#define XB_SPIN(cond, bar) do { unsigned _sp = 0; while (cond) { __builtin_amdgcn_s_sleep(1); \
    if ((++_sp & 255u) == 0u) { if (xb_ld(&(bar)[XB_TMO])) break; if (_sp > XB_SPIN_CAP) { atomicAdd(&(bar)[XB_TMO], 1u); break; } } } } while (0)

struct XcdBarrier {
    unsigned* bar; unsigned x;
    volatile LAS unsigned* st;
};

__device__ __forceinline__ XcdBarrier xcd_barrier_post(unsigned* bar, volatile LAS unsigned* st) {
    XcdBarrier b; b.bar = bar; b.x = xb_xcc_id(); b.st = st;
    if (threadIdx.x == 0) (void)xb_add(&bar[XB_XCNT(b.x)], 1u);
    return b;
}
__device__ __forceinline__ void xcd_barrier_complete(unsigned* bar, unsigned x, unsigned& nloc, unsigned& nx) {
    const unsigned G = gridDim.x * gridDim.y * gridDim.z;
    unsigned sum, cnt, mine, sp = 0u;
    for (;;) {
        sum = 0u; cnt = 0u; mine = 0u;
#pragma unroll
        for (unsigned j = 0; j < 16; ++j) { const unsigned c = xb_ld(&bar[XB_XCNT(j)]); sum += c; cnt += (c > 0u) ? 1u : 0u; mine = (j == x) ? c : mine; }
        if (sum == G) break;
        __builtin_amdgcn_s_sleep(1);
        if ((++sp & 255u) == 0u) { if (xb_ld(&bar[XB_TMO])) break; if (sp > XB_SPIN_CAP) { atomicAdd(&bar[XB_TMO], 1u); break; } }
    }
    nloc = mine > 0u ? mine : 1u; nx = cnt > 0u ? cnt : 1u;
}

__device__ __forceinline__ void xcd_barrier(const XcdBarrier& b) {
    asm volatile("s_waitcnt vmcnt(0)" ::: "memory");
    __syncthreads();
    if (threadIdx.x == 0) {
        unsigned* bar = b.bar;
        __builtin_amdgcn_s_waitcnt(0);
        unsigned nloc = b.st[0], nx = b.st[1];
        if (nloc == 0u) { xcd_barrier_complete(bar, b.x, nloc, nx); b.st[0] = nloc; b.st[1] = nx; }
        const unsigned old = xb_add(&bar[XB_XSUB(b.x)], 1u);
        const unsigned gen = old / nloc;
        if (old + 1u == (gen + 1u) * nloc) {
            __builtin_amdgcn_fence(__ATOMIC_RELEASE, "agent");
            asm volatile("s_waitcnt vmcnt(0)" ::: "memory");
            const unsigned og = xb_add(&bar[XB_TOP], 1u);
            const unsigned tg = og / nx;
            if (og + 1u == (tg + 1u) * nx) xb_add(&bar[XB_TOPGEN], 1u);
            else XB_SPIN(xb_ld(&bar[XB_TOPGEN]) == tg, bar);
            __builtin_amdgcn_fence(__ATOMIC_ACQUIRE, "agent");
            xb_add(&bar[XB_XGEN(b.x)], 1u);
            asm volatile("s_waitcnt vmcnt(0)" ::: "memory");
        } else {
            XB_SPIN(xb_ld(&bar[XB_XGEN(b.x)]) == gen, bar);
            __builtin_amdgcn_fence(__ATOMIC_ACQUIRE, "agent");
            asm volatile("s_waitcnt vmcnt(0)" ::: "memory");
        }
    }
    __syncthreads();
}

constexpr int T = 16384, DM = 2048, NP = 5888, NMEM = 256;
constexpr int NWAVES = 8, NTHR = 512;
constexpr float EPS = 1e-6f;
constexpr size_t MiB = 1u << 20;
constexpr size_t WS_CTL = 0, CTL_ZERO_BYTES = 65536;
constexpr size_t WS_WIN0 = 1 * MiB, WS_WIN1 = 24 * MiB, WS_WOUT0 = 47 * MiB, WS_WOUT1 = 55 * MiB, WS_WMKV = 63 * MiB, WS_WK1T = 71 * MiB, WS_WV1T = 73 * MiB;
constexpr size_t WS_MEMKV = 75 * MiB, WS_DEC = 76 * MiB, WS_KCMP = 77 * MiB, WS_VCMP = 77 * MiB + 512 * 1024, WS_SEL = 78 * MiB;
constexpr size_t WS_XN = 80 * MiB, WS_P = 144 * MiB, WS_STATE = 328 * MiB, WS_END = 472 * MiB;
constexpr size_t WS_MIX1 = WS_STATE;
constexpr size_t DO_MIX0 = 0, DO_OI = 64 * MiB;
constexpr int CR = 3072, CXQ = 4608, CXG = 5120, CGL = 5632;
constexpr int GQ = 0, GK = 768, GV = 1536;
constexpr int NQ = 0, NKC = 1536, NVC = 1792, NKS = 2048, NVS = 2304, NKW = 2560, NVW = 2816;
constexpr int RING_BYTES = 131072, LDSCTL_OFF = RING_BYTES, MISC_OFF = LDSCTL_OFF + 320, LDS_BYTES = 147456;
constexpr int N_PHASES = 12;

__device__ __forceinline__ float bf2f(bf16 v) { return __builtin_bit_cast(float, (unsigned)v << 16); }
__device__ __forceinline__ bf16 f2b(float f) { return (bf16)f2bf(f); }
__device__ __forceinline__ float wave_sum(float v) {
#pragma unroll
    for (int o = 1; o < 64; o <<= 1) v += __shfl_xor(v, o);
    return v;
}
__device__ __forceinline__ float silu_f(float x) { return x / (1.f + __expf(-x)); }
__device__ __forceinline__ float sigmoid_f(float x) { return 1.f / (1.f + __expf(-x)); }
__device__ __forceinline__ float logsigmoid_f(float x) { return fminf(x, 0.f) - log1pf(__expf(-fabsf(x))); }

__device__ __forceinline__ int win_src_col(int layer, int c) {
    const int ex = layer ? 36 : 16;
    if (c < 3072) return c;
    if (c < 5632) return c + ex;
    if (c < 5632 + ex) return c - 5632 + 3072;
    return -1;
}

__device__ __forceinline__ void transpose_item(const float* W, int ldw, int K, bf16* WT, int n0, int k0, int srcc, LAS float* scr, int lane) {
#pragma unroll 8
    for (int i = 0; i < 32; ++i) { const int kk = 2 * i + (lane >> 5); scr[kk * 33 + (lane & 31)] = (srcc >= 0) ? W[(size_t)(k0 + kk) * ldw + srcc] : 0.f; }
    LDS_WAIT(); asm volatile("" ::: "memory");
    const int c = lane & 7;
#pragma unroll
    for (int j = 0; j < 4; ++j) { const int n = (lane >> 3) + 8 * j; const LAS float* s = scr + (8 * c) * 33 + n;
        v4u o; o.x = pk2(s[0 * 33], s[1 * 33]); o.y = pk2(s[2 * 33], s[3 * 33]); o.z = pk2(s[4 * 33], s[5 * 33]); o.w = pk2(s[6 * 33], s[7 * 33]);
        *(v4u*)(WT + (size_t)(n0 + n) * K + k0 + 8 * c) = o; }
    LDS_WAIT(); asm volatile("" ::: "memory");
}

__device__ __forceinline__ void rms_row_to_bf16(const float* xrow, const float* g, bf16* orow, int lane) {
    const f32x4* xr = (const f32x4*)xrow + lane; const f32x4* gr = (const f32x4*)g + lane;
    f32x4 v[8]; float s = 0.f;
#pragma unroll
    for (int j = 0; j < 8; ++j) { v[j] = xr[64 * j]; s += (v[j].x * v[j].x + v[j].y * v[j].y) + (v[j].z * v[j].z + v[j].w * v[j].w); }
    const float rstd = rsqrtf(wave_sum(s) * (1.f / DM) + EPS);
    unsigned long long* o8 = (unsigned long long*)orow + lane;
#pragma unroll
    for (int j = 0; j < 8; ++j) { const f32x4 gg = gr[64 * j];
        o8[64 * j] = (unsigned long long)pk2(v[j].x * rstd * gg.x, v[j].y * rstd * gg.y) | ((unsigned long long)pk2(v[j].z * rstd * gg.z, v[j].w * rstd * gg.w) << 32); }
}

struct Args { const float* in[19]; float* out; unsigned char* ws; int ph_lo, ph_hi; };

struct Ctx {
    LAS unsigned char* lds;
    int tid, lane, wave, G, gw, NGW;
    const float *x, *mem, *ln_pre, *ln_post, *ln_mem, *w_mem_kv, *gla_w_in, *gla_w_gate, *gla_b_gate, *gla_norm, *gla_w_out;
    const float *nsa_w_in, *pe_k, *pe_v, *wk1, *wk2, *wv1, *wv2, *nsa_w_out;
    float* out; unsigned char* ws;
    bf16 *WIN0, *WIN1, *WOUT0, *WOUT1, *WMKV, *MEMKV, *KCMP, *VCMP, *XN, *P, *STATE, *MIX0, *MIX1, *OI;
    float* DEC;
};

__device__ __forceinline__ void phase_prep(Ctx& F) {
    LAS float* scr = (LAS float*)(F.lds + F.wave * 16384);
    constexpr int I_WIN = 32 * 184, I_WOUT = 32 * 64, I_MKV = 32 * 32;
    constexpr int NITEMS = 2 * I_WIN + 2 * I_WOUT + 2 * I_MKV;
    for (int it = F.gw; it < NITEMS; it += F.NGW) {
        int r = it;
        if (r < 2 * I_WIN) { const int layer = r / I_WIN; r -= layer * I_WIN; const int kb = r / 184, nb = r % 184;
            const int srcc = win_src_col(layer, nb * 32 + (F.lane & 31));
            transpose_item(layer ? F.nsa_w_in : F.gla_w_in, layer ? 5668 : 5648, DM, layer ? F.WIN1 : F.WIN0, nb * 32, kb * 64, srcc, scr, F.lane); continue; }
        r -= 2 * I_WIN;
        if (r < 2 * I_WOUT) { const int layer = r / I_WOUT; r -= layer * I_WOUT; const int kb = r / 64, nb = r % 64;
            transpose_item(layer ? F.nsa_w_out : F.gla_w_out, DM, DM, layer ? F.WOUT1 : F.WOUT0, nb * 32, kb * 64, nb * 32 + (F.lane & 31), scr, F.lane); continue; }
        r -= 2 * I_WOUT;
        { const int layer = r / I_MKV; r -= layer * I_MKV; const int kb = r / 32, nb = r % 32;
            transpose_item(F.w_mem_kv + (size_t)layer * DM * 1024, 1024, DM, F.WMKV + (size_t)layer * 1024 * DM, nb * 32, kb * 64, nb * 32 + (F.lane & 31), scr, F.lane); }
    }
    for (int m = F.gw; m < T; m += F.NGW) rms_row_to_bf16(F.x + (size_t)m * DM, F.ln_pre, F.XN + (size_t)m * DM, F.lane);
}

__device__ __forceinline__ void memkv_naive(Ctx& F) {
    const int gt = blockIdx.x * NTHR + F.tid, NT = F.G * NTHR;
    for (int o = gt; o < 2 * NMEM * 1024; o += NT) {
        const int layer = o >> 18, m = (o >> 10) & 255, n = o & 1023;
        const float* mr = F.mem + (size_t)m * DM; const float* g = F.ln_mem + layer * DM; const float* W = F.w_mem_kv + (size_t)layer * DM * 1024 + n;
        float ss = 0.f, acc = 0.f;
        for (int k = 0; k < DM; ++k) { const float a = mr[k]; ss += a * a; acc += a * g[k] * W[(size_t)k * 1024]; }
        const float v = acc * rsqrtf(ss * (1.f / DM) + EPS);
        const int kv = n >> 9, h = (n >> 7) & 3, d = n & 127;
        F.MEMKV[((((size_t)layer * 2 + kv) * 4 + h) * NMEM + m) * 128 + d] = f2b(v);
    }
}

__device__ __forceinline__ void cross_naive(Ctx& F, int layer, bf16* MIX) {
    const float scale = 0.08838834764831845f;
    for (int u = F.gw; u < T * 4; u += F.NGW) {
        const int t = u >> 2, h = u & 3;
        const bf16* pr = F.P + (size_t)t * NP;
        const unsigned qq = *(const unsigned*)(pr + CXQ + h * 128 + 2 * F.lane);
        const float q0 = bf2f((bf16)(qq & 0xffff)) * scale, q1 = bf2f((bf16)(qq >> 16)) * scale;
        const bf16* Kb = F.MEMKV + (((size_t)layer * 2 + 0) * 4 + h) * NMEM * 128;
        const bf16* Vb = F.MEMKV + (((size_t)layer * 2 + 1) * 4 + h) * NMEM * 128;
        float m = -1e30f, l = 0.f, o0 = 0.f, o1 = 0.f;
        for (int j = 0; j < NMEM; ++j) {
            const unsigned kk = *(const unsigned*)(Kb + j * 128 + 2 * F.lane), vv = *(const unsigned*)(Vb + j * 128 + 2 * F.lane);
            const float s = wave_sum(q0 * bf2f((bf16)(kk & 0xffff)) + q1 * bf2f((bf16)(kk >> 16)));
            const float mn = fmaxf(m, s), a = __expf(m - mn), p = __expf(s - mn);
            l = l * a + p; o0 = o0 * a + p * bf2f((bf16)(vv & 0xffff)); o1 = o1 * a + p * bf2f((bf16)(vv >> 16)); m = mn;
        }
        const unsigned gg = *(const unsigned*)(pr + CXG + h * 128 + 2 * F.lane);
        const float r0 = o0 / l * silu_f(bf2f((bf16)(gg & 0xffff))), r1 = o1 / l * silu_f(bf2f((bf16)(gg >> 16)));
        *(unsigned*)(MIX + (size_t)t * DM + 1536 + h * 128 + 2 * F.lane) = pk2(r0, r1);
    }
}

__device__ __forceinline__ void gla_g1_naive(Ctx& F) {
    LAS float* bcum = (LAS float*)(F.lds);
    LAS float* Aat = (LAS float*)(F.lds + 49152);
    LAS float* glr = (LAS float*)(F.lds + 65536);
    LAS float* blast = (LAS float*)(F.lds + 69632);
    const float qscale = 0.07216878364870323f;
    for (int u = blockIdx.x; u < 1024; u += F.G) {
        const int n = u >> 2, h = u & 3; const size_t row0 = (size_t)n * 64;
        for (int i = F.tid; i < 1024; i += NTHR) glr[i] = bf2f(F.P[(row0 + (i >> 4)) * NP + CGL + (i & 15)]);
        __syncthreads();
        if (F.tid < 192) {
            const int d = F.tid, col = h * 192 + d; float wg[16];
#pragma unroll
            for (int j = 0; j < 16; ++j) wg[j] = F.gla_w_gate[j * 768 + col];
            const float bias = F.gla_b_gate[col]; float b = 0.f;
            for (int c = 0; c < 64; ++c) { float gl = bias;
#pragma unroll
                for (int j = 0; j < 16; ++j) gl += glr[c * 16 + j] * wg[j];
                b += logsigmoid_f(gl) * (1.f / 16.f); bcum[c * 192 + d] = b; }
            blast[d] = b; F.DEC[n * 768 + col] = __expf(b);
        }
        __syncthreads();
        for (int i = 0; i < 8; ++i) { const int idx = F.tid + NTHR * i, c = idx >> 6, s = idx & 63; float a = 0.f;
            if (s <= c) { const bf16* qp = F.P + (row0 + c) * NP + GQ + h * 192; const bf16* kp = F.P + (row0 + s) * NP + GK + h * 192;
                for (int d = 0; d < 192; ++d) a += bf2f(qp[d]) * bf2f(kp[d]) * __expf(bcum[c * 192 + d] - bcum[s * 192 + d]);
                a *= qscale; }
            Aat[idx] = a; }
        __syncthreads();
        for (int i = 0; i < 48; ++i) { const int idx = F.tid + NTHR * i, c = idx / 384, e = idx % 384; float a = 0.f;
            for (int s = 0; s <= c; ++s) a += Aat[c * 64 + s] * bf2f(F.P[(row0 + s) * NP + GV + h * 384 + e]);
            F.OI[(row0 + c) * 1536 + h * 384 + e] = f2b(a); }
        for (int i = 0; i < 144; ++i) { const int idx = F.tid + NTHR * i, e = idx / 192, d = idx % 192; float a = 0.f; const float bl = blast[d];
            for (int c = 0; c < 64; ++c) a += bf2f(F.P[(row0 + c) * NP + GK + h * 192 + d]) * __expf(bl - bcum[c * 192 + d]) * bf2f(F.P[(row0 + c) * NP + GV + h * 384 + e]);
            F.STATE[((size_t)u * 384 + e) * 192 + d] = f2b(a); }
        __syncthreads();
        for (int i = 0; i < 24; ++i) { const int idx = F.tid + NTHR * i, c = idx / 192, d = idx % 192;
            bf16* qp = F.P + (row0 + c) * NP + GQ + h * 192 + d; *qp = f2b(bf2f(*qp) * qscale * __expf(bcum[c * 192 + d])); }
        __syncthreads();
    }
}

__device__ __forceinline__ void gla_scan(Ctx& F) {
    const int gt = blockIdx.x * NTHR + F.tid, NT = F.G * NTHR;
    constexpr int PER = 4 * 384 * 192;
    for (int item = gt; item < PER / 4; item += NT) {
        const int idx = item * 4, h = idx / (384 * 192), d0 = idx % 192;
        bf16* sp = F.STATE + idx; const float* dp = F.DEC + h * 192 + d0;
        float s0 = 0.f, s1 = 0.f, s2 = 0.f, s3 = 0.f;
        for (int n0 = 0; n0 < 256; n0 += 8) {
            unsigned long long u[8]; f32x4 dc[8];
#pragma unroll
            for (int j = 0; j < 8; ++j) { u[j] = *(const unsigned long long*)(sp + (size_t)(n0 + j) * PER); dc[j] = *(const f32x4*)(dp + (n0 + j) * 768); }
#pragma unroll
            for (int j = 0; j < 8; ++j) {
                const unsigned lo = (unsigned)u[j], hi = (unsigned)(u[j] >> 32);
                s0 = dc[j].x * s0 + bf2f((bf16)(lo & 0xffff)); s1 = dc[j].y * s1 + bf2f((bf16)(lo >> 16));
                s2 = dc[j].z * s2 + bf2f((bf16)(hi & 0xffff)); s3 = dc[j].w * s3 + bf2f((bf16)(hi >> 16));
                *(unsigned long long*)(sp + (size_t)(n0 + j) * PER) = (unsigned long long)pk2(s0, s1) | ((unsigned long long)pk2(s2, s3) << 32);
            }
        }
    }
}

__device__ __forceinline__ void gla_g3_naive(Ctx& F) {
    LAS float* o = (LAS float*)(F.lds);
    LAS float* rs = (LAS float*)(F.lds + 98304);
    for (int u = blockIdx.x; u < 1024; u += F.G) {
        const int n = u >> 2, h = u & 3; const size_t row0 = (size_t)n * 64;
        for (int i = 0; i < 48; ++i) { const int idx = F.tid + NTHR * i, c = idx / 384, e = idx % 384;
            float a = bf2f(F.OI[(row0 + c) * 1536 + h * 384 + e]);
            if (n > 0) { const bf16* sp = F.STATE + ((size_t)(u - 4) * 384 + e) * 192; const bf16* qp = F.P + (row0 + c) * NP + GQ + h * 192;
                for (int d = 0; d < 192; ++d) a += bf2f(qp[d]) * bf2f(sp[d]); }
            o[idx] = a; }
        __syncthreads();
        for (int c = F.wave; c < 64; c += NWAVES) { float ss = 0.f;
            for (int e = F.lane; e < 384; e += 64) { const float v = o[c * 384 + e]; ss += v * v; }
            ss = wave_sum(ss); if (F.lane == 0) rs[c] = rsqrtf(ss * (1.f / 384.f) + EPS); }
        __syncthreads();
        for (int i = 0; i < 48; ++i) { const int idx = F.tid + NTHR * i, c = idx / 384, e = idx % 384;
            const float v = o[idx] * rs[c] * F.gla_norm[e]; const float r = bf2f(F.P[(row0 + c) * NP + CR + h * 384 + e]);
            F.MIX0[(row0 + c) * DM + h * 384 + e] = f2b(v * silu_f(r)); }
        __syncthreads();
    }
}

__device__ __forceinline__ void post_rows(Ctx& F, const float* hin, const bf16* Y, const float* gpost, float* hout, const float* gpre, bf16* XNo) {
    for (int m = F.gw; m < T; m += F.NGW) {
        const v4u* yr = (const v4u*)(Y + (size_t)m * DM) + F.lane;
        float y[32]; float ss = 0.f;
#pragma unroll
        for (int j = 0; j < 4; ++j) { const v4u w = yr[64 * j];
            const unsigned ww[4] = {w.x, w.y, w.z, w.w};
#pragma unroll
            for (int q = 0; q < 4; ++q) { y[j * 8 + 2 * q] = bf2f((bf16)(ww[q] & 0xffff)); y[j * 8 + 2 * q + 1] = bf2f((bf16)(ww[q] >> 16)); } }
#pragma unroll
        for (int i = 0; i < 32; ++i) ss += y[i] * y[i];
        const float rstd = rsqrtf(wave_sum(ss) * (1.f / DM) + EPS);
        float hn[32]; float s2 = 0.f;
#pragma unroll
        for (int j = 0; j < 4; ++j) {
#pragma unroll
            for (int q = 0; q < 2; ++q) { const int col = j * 512 + F.lane * 8 + q * 4;
                const f32x4 hv = *(const f32x4*)(hin + (size_t)m * DM + col); const f32x4 gp = *(const f32x4*)(gpost + col);
                f32x4 r; r.x = hv.x + y[j * 8 + q * 4 + 0] * rstd * gp.x; r.y = hv.y + y[j * 8 + q * 4 + 1] * rstd * gp.y; r.z = hv.z + y[j * 8 + q * 4 + 2] * rstd * gp.z; r.w = hv.w + y[j * 8 + q * 4 + 3] * rstd * gp.w;
                *(f32x4*)(hout + (size_t)m * DM + col) = r;
                hn[j * 8 + q * 4 + 0] = r.x; hn[j * 8 + q * 4 + 1] = r.y; hn[j * 8 + q * 4 + 2] = r.z; hn[j * 8 + q * 4 + 3] = r.w;
                s2 += (r.x * r.x + r.y * r.y) + (r.z * r.z + r.w * r.w); } }
        if (gpre) {
            const float rstd2 = rsqrtf(wave_sum(s2) * (1.f / DM) + EPS);
#pragma unroll
            for (int j = 0; j < 4; ++j) { const int col = j * 512 + F.lane * 8;
                const f32x4 g0 = *(const f32x4*)(gpre + col), g1 = *(const f32x4*)(gpre + col + 4);
                v4u w; w.x = pk2(hn[j * 8 + 0] * rstd2 * g0.x, hn[j * 8 + 1] * rstd2 * g0.y); w.y = pk2(hn[j * 8 + 2] * rstd2 * g0.z, hn[j * 8 + 3] * rstd2 * g0.w);
                w.z = pk2(hn[j * 8 + 4] * rstd2 * g1.x, hn[j * 8 + 5] * rstd2 * g1.y); w.w = pk2(hn[j * 8 + 6] * rstd2 * g1.z, hn[j * 8 + 7] * rstd2 * g1.w);
                *((v4u*)(XNo + (size_t)m * DM) + F.lane + 64 * j) = w; }
        }
    }
}

__device__ __forceinline__ void nsa_compress_naive(Ctx& F) {
    LAS float* blk = (LAS float*)(F.lds);
    LAS float* part = (LAS float*)(F.lds + 65536);
    LAS float* hid = (LAS float*)(F.lds + 73728);
    for (int u = blockIdx.x; u < 1024; u += F.G) {
        const int kv = u & 1, g = (u >> 1) & 1, nq = u >> 2;
        const float* pe = kv ? F.pe_v : F.pe_k; const float* w1 = kv ? F.wv1 : F.wk1; const float* w2 = kv ? F.wv2 : F.wk2;
        const int colb = (kv ? NVC : NKC) + g * 128;
        for (int i = 0; i < 32; ++i) { const int idx = F.tid + NTHR * i, r = idx >> 12, i4 = idx & 4095, l = i4 >> 7, d = i4 & 127; const int n = nq * 4 + r;
            float v = 0.f; if (n < 1023) v = bf2f(F.P[(size_t)(16 * n + l) * NP + colb + d]) + pe[l * 128 + d];
            blk[idx] = v; }
        __syncthreads();
        { const int j = F.tid & 255, ih = F.tid >> 8; float a0 = 0.f, a1 = 0.f, a2 = 0.f, a3 = 0.f;
            for (int i = ih * 2048; i < ih * 2048 + 2048; ++i) { const float w = w1[(size_t)i * 256 + j];
                a0 += blk[i] * w; a1 += blk[4096 + i] * w; a2 += blk[8192 + i] * w; a3 += blk[12288 + i] * w; }
            part[(ih * 4 + 0) * 256 + j] = a0; part[(ih * 4 + 1) * 256 + j] = a1; part[(ih * 4 + 2) * 256 + j] = a2; part[(ih * 4 + 3) * 256 + j] = a3; }
        __syncthreads();
        for (int i = F.tid; i < 1024; i += NTHR) hid[i] = silu_f(part[i] + part[1024 + i]);
        __syncthreads();
        { const int d = F.tid & 127, r = F.tid >> 7; const int n = nq * 4 + r; float a = 0.f;
            for (int j = 0; j < 256; ++j) a += hid[r * 256 + j] * w2[j * 128 + d];
            if (n < 1023) (kv ? F.VCMP : F.KCMP)[((size_t)g * 1024 + n) * 128 + d] = f2b(a); }
        __syncthreads();
    }
}

__device__ __forceinline__ void nsa_main_naive(Ctx& F) {
    const float scale = 0.08838834764831845f;
    LAS float* ocs = (LAS float*)(F.lds + F.wave * 4096);
    const int lane = F.lane;
    for (int u = F.gw; u < T * 2; u += F.NGW) {
        const int t = u >> 1, g = u & 1; const bf16* pr = F.P + (size_t)t * NP;
        const int ncv = (t >= 31) ? min((t - 31) / 16 + 1, 1023) : 0;
        const bf16* Kc = F.KCMP + (size_t)g * 1024 * 128; const bf16* Vc = F.VCMP + (size_t)g * 1024 * 128;
        float imp0 = 0.f, imp1 = 0.f, imp2 = 0.f, imp3 = 0.f;
        for (int h = 0; h < 6; ++h) {
            const unsigned qq = *(const unsigned*)(pr + NQ + (g * 6 + h) * 128 + 2 * lane);
            const float q0 = bf2f((bf16)(qq & 0xffff)) * scale, q1 = bf2f((bf16)(qq >> 16)) * scale;
            float m = -1e30f, l = 0.f, o0 = 0.f, o1 = 0.f;
            for (int c = 0; c < ncv; ++c) {
                const unsigned kk = *(const unsigned*)(Kc + c * 128 + 2 * lane), vv = *(const unsigned*)(Vc + c * 128 + 2 * lane);
                const float s = wave_sum(q0 * bf2f((bf16)(kk & 0xffff)) + q1 * bf2f((bf16)(kk >> 16)));
                const float mn = fmaxf(m, s), a = __expf(m - mn), p = __expf(s - mn);
                l = l * a + p; o0 = o0 * a + p * bf2f((bf16)(vv & 0xffff)); o1 = o1 * a + p * bf2f((bf16)(vv >> 16)); m = mn;
            }
            const float gate = sigmoid_f(bf2f(pr[CGL + g * 18 + h * 3 + 0]));
            const float il = (ncv > 0) ? 1.f / l : 0.f;
            ocs[h * 128 + 2 * lane] = gate * o0 * il; ocs[h * 128 + 2 * lane + 1] = gate * o1 * il;
            for (int c = 0; c < ncv; ++c) {
                const unsigned kk = *(const unsigned*)(Kc + c * 128 + 2 * lane);
                const float s = wave_sum(q0 * bf2f((bf16)(kk & 0xffff)) + q1 * bf2f((bf16)(kk >> 16)));
                const float p = __expf(s - m) * il;
                const int ja = c >> 2, jb = (c + 1) >> 2;
                { const int jj = lane;       if (jj == ja || jj == jb) imp0 += p; }
                { const int jj = lane + 64;  if (jj == ja || jj == jb) imp1 += p; }
                { const int jj = lane + 128; if (jj == ja || jj == jb) imp2 += p; }
                { const int jj = lane + 192; if (jj == ja || jj == jb) imp3 += p; }
            }
        }
        const int cur = t >> 6;
        float iv[4] = {imp0, imp1, imp2, imp3};
#pragma unroll
        for (int i = 0; i < 4; ++i) { const int jj = lane + 64 * i; if (jj == 0 || jj == cur || jj == cur - 1) iv[i] = 1e4f; if (jj > cur) iv[i] = -1e4f; }
        int mysel = 0;
#pragma unroll
        for (int r = 0; r < 16; ++r) {
            float bv = iv[0]; int bi = lane;
#pragma unroll
            for (int i = 1; i < 4; ++i) { if (iv[i] > bv) { bv = iv[i]; bi = lane + 64 * i; } }
#pragma unroll
            for (int o = 1; o < 64; o <<= 1) { const float ov = __shfl_xor(bv, o); const int oi = __shfl_xor(bi, o); if (ov > bv || (ov == bv && oi < bi)) { bv = ov; bi = oi; } }
            mysel = (lane == r) ? bi : mysel;
#pragma unroll
            for (int i = 0; i < 4; ++i) if (lane + 64 * i == bi) iv[i] = -3e38f;
        }
        for (int h = 0; h < 6; ++h) {
            const unsigned qq = *(const unsigned*)(pr + NQ + (g * 6 + h) * 128 + 2 * lane);
            const float q0 = bf2f((bf16)(qq & 0xffff)) * scale, q1 = bf2f((bf16)(qq >> 16)) * scale;
            float m = -1e30f, l = 0.f, o0 = 0.f, o1 = 0.f;
            for (int r = 0; r < 16; ++r) { const int j = __shfl(mysel, r); if (j > cur) continue;
                const int kend = min(64, t - 64 * j + 1);
                for (int i = 0; i < kend; ++i) { const bf16* kr = F.P + (size_t)(64 * j + i) * NP;
                    const unsigned kk = *(const unsigned*)(kr + NKS + g * 128 + 2 * lane), vv = *(const unsigned*)(kr + NVS + g * 128 + 2 * lane);
                    const float s = wave_sum(q0 * bf2f((bf16)(kk & 0xffff)) + q1 * bf2f((bf16)(kk >> 16)));
                    const float mn = fmaxf(m, s), a = __expf(m - mn), p = __expf(s - mn);
                    l = l * a + p; o0 = o0 * a + p * bf2f((bf16)(vv & 0xffff)); o1 = o1 * a + p * bf2f((bf16)(vv >> 16)); m = mn; } }
            const float gs = sigmoid_f(bf2f(pr[CGL + g * 18 + h * 3 + 1]));
            float r0 = ocs[h * 128 + 2 * lane] + gs * o0 / l, r1 = ocs[h * 128 + 2 * lane + 1] + gs * o1 / l;
            m = -1e30f; l = 0.f; o0 = 0.f; o1 = 0.f;
            for (int p0 = max(0, t - 511); p0 <= t; ++p0) { const bf16* kr = F.P + (size_t)p0 * NP;
                const unsigned kk = *(const unsigned*)(kr + NKW + g * 128 + 2 * lane), vv = *(const unsigned*)(kr + NVW + g * 128 + 2 * lane);
                const float s = wave_sum(q0 * bf2f((bf16)(kk & 0xffff)) + q1 * bf2f((bf16)(kk >> 16)));
                const float mn = fmaxf(m, s), a = __expf(m - mn), p = __expf(s - mn);
                l = l * a + p; o0 = o0 * a + p * bf2f((bf16)(vv & 0xffff)); o1 = o1 * a + p * bf2f((bf16)(vv >> 16)); m = mn; }
            const float gw_ = sigmoid_f(bf2f(pr[CGL + g * 18 + h * 3 + 2]));
            r0 += gw_ * o0 / l; r1 += gw_ * o1 / l;
            const unsigned rr = *(const unsigned*)(pr + CR + (g * 6 + h) * 128 + 2 * lane);
            r0 *= silu_f(bf2f((bf16)(rr & 0xffff))); r1 *= silu_f(bf2f((bf16)(rr >> 16)));
            *(unsigned*)(F.MIX1 + (size_t)t * DM + (g * 6 + h) * 128 + 2 * lane) = pk2(r0, r1);
        }
    }
}

__global__ void __launch_bounds__(NTHR, 2) fwd_kernel(Args args) {
    extern __shared__ __attribute__((aligned(16))) unsigned char lds_raw[];
    Ctx F;
    F.lds = (LAS unsigned char*)lds_raw;
    F.tid = threadIdx.x; F.lane = F.tid & 63; F.wave = __builtin_amdgcn_readfirstlane(F.tid >> 6);
    F.G = gridDim.x; F.gw = blockIdx.x * NWAVES + F.wave; F.NGW = F.G * NWAVES;
    F.x = args.in[0]; F.mem = args.in[1]; F.ln_pre = args.in[2]; F.ln_post = args.in[3]; F.ln_mem = args.in[4]; F.w_mem_kv = args.in[5];
    F.gla_w_in = args.in[6]; F.gla_w_gate = args.in[7]; F.gla_b_gate = args.in[8]; F.gla_norm = args.in[9]; F.gla_w_out = args.in[10];
    F.nsa_w_in = args.in[11]; F.pe_k = args.in[12]; F.pe_v = args.in[13]; F.wk1 = args.in[14]; F.wk2 = args.in[15]; F.wv1 = args.in[16]; F.wv2 = args.in[17]; F.nsa_w_out = args.in[18];
    F.out = args.out; F.ws = args.ws;
    unsigned char* ws = args.ws;
    F.WIN0 = (bf16*)(ws + WS_WIN0); F.WIN1 = (bf16*)(ws + WS_WIN1); F.WOUT0 = (bf16*)(ws + WS_WOUT0); F.WOUT1 = (bf16*)(ws + WS_WOUT1); F.WMKV = (bf16*)(ws + WS_WMKV);
    F.MEMKV = (bf16*)(ws + WS_MEMKV); F.DEC = (float*)(ws + WS_DEC); F.KCMP = (bf16*)(ws + WS_KCMP); F.VCMP = (bf16*)(ws + WS_VCMP);
    F.XN = (bf16*)(ws + WS_XN); F.P = (bf16*)(ws + WS_P); F.STATE = (bf16*)(ws + WS_STATE); F.MIX1 = (bf16*)(ws + WS_MIX1);
    F.MIX0 = (bf16*)((unsigned char*)args.out + DO_MIX0); F.OI = (bf16*)((unsigned char*)args.out + DO_OI);

    volatile LAS unsigned* MISC = (volatile LAS unsigned*)(F.lds + MISC_OFF);
    for (int u = F.tid; u < (LDS_BYTES - LDSCTL_OFF) / 4; u += NTHR) ((LAS unsigned*)(F.lds + LDSCTL_OFF))[u] = 0u;
    __syncthreads();
    const int lo = args.ph_lo, hi = args.ph_hi;
    XcdBarrier bar; bar.bar = (unsigned*)(ws + WS_CTL); bar.x = 0; bar.st = nullptr;
    if (hi - lo > 1) bar = xcd_barrier_post((unsigned*)(ws + WS_CTL), MISC + 8);
#define IN(k) (lo <= (k) && (k) < hi)
#define SEAM(k) do { if (IN(k) && IN((k) + 1)) xcd_barrier(bar); } while (0)

    if (IN(0)) { phase_prep(F); } SEAM(0);
    if (IN(1)) { memkv_naive(F);
        pg8::Gemm g{F.XN, F.WIN0, T, NP, DM}; pg8::StaticOrder S; S.init(T, NP, F.G, (int)blockIdx.x);
        pg8::EpiBf16<0> E{F.P, NP, nullptr, 0, 0, 1.f};
        pg8::gemm_phase<pg8::EpiBf16<0>, pg8::StaticOrder, true, true>(F.lds, g, S, E); } SEAM(1);
    if (IN(2)) { gla_g1_naive(F); cross_naive(F, 0, F.MIX0); } SEAM(2);
    if (IN(3)) { gla_scan(F); } SEAM(3);
    if (IN(4)) { gla_g3_naive(F); } SEAM(4);
    if (IN(5)) { pg8::Gemm g{F.MIX0, F.WOUT0, T, DM, DM}; pg8::StaticOrder S; S.init(T, DM, F.G, (int)blockIdx.x);
        pg8::EpiBf16<0> E{F.XN, DM, nullptr, 0, 0, 1.f};
        pg8::gemm_phase<pg8::EpiBf16<0>, pg8::StaticOrder, true, true>(F.lds, g, S, E); } SEAM(5);
    if (IN(6)) { post_rows(F, F.x, F.XN, F.ln_post, F.out, F.ln_pre + DM, F.XN); } SEAM(6);
    if (IN(7)) { pg8::Gemm g{F.XN, F.WIN1, T, NP, DM}; pg8::StaticOrder S; S.init(T, NP, F.G, (int)blockIdx.x);
        pg8::EpiBf16<0> E{F.P, NP, nullptr, 0, 0, 1.f};
        pg8::gemm_phase<pg8::EpiBf16<0>, pg8::StaticOrder, true, true>(F.lds, g, S, E); } SEAM(7);
    if (IN(8)) { nsa_compress_naive(F); } SEAM(8);
    if (IN(9)) { nsa_main_naive(F); cross_naive(F, 1, F.MIX1); } SEAM(9);
    if (IN(10)) { pg8::Gemm g{F.MIX1, F.WOUT1, T, DM, DM}; pg8::StaticOrder S; S.init(T, DM, F.G, (int)blockIdx.x);
        pg8::EpiBf16<0> E{F.XN, DM, nullptr, 0, 0, 1.f};
        pg8::gemm_phase<pg8::EpiBf16<0>, pg8::StaticOrder, true, true>(F.lds, g, S, E); } SEAM(10);
    if (IN(11)) { post_rows(F, F.out, F.XN, F.ln_post + DM, F.out, nullptr, nullptr); }
#undef IN
#undef SEAM
}

#ifndef N_LAUNCHES
#define N_LAUNCHES 12
#endif
extern "C" void kernel_launch(void* const* d_in, const int* in_sizes, int n_in, void* d_out, int out_size, void* d_ws, size_t ws_size, hipStream_t stream) {
    static int grid = 0;
    if (grid == 0) {
        if (n_in != 19 || out_size != T * DM || ws_size < WS_END) { fprintf(stderr, "kernel_launch: unexpected shapes (n_in %d out %d ws %zu)\n", n_in, out_size, ws_size); grid = -1; return; }
        int dev = 0, cus = 0, per_cu = 0;
        if (hipGetDevice(&dev) != hipSuccess || hipDeviceGetAttribute(&cus, hipDeviceAttributeMultiprocessorCount, dev) != hipSuccess) { grid = -1; return; }
        if (hipFuncSetAttribute((const void*)fwd_kernel, hipFuncAttributeMaxDynamicSharedMemorySize, LDS_BYTES) != hipSuccess) { fprintf(stderr, "kernel_launch: hipFuncSetAttribute failed\n"); grid = -1; return; }
        if (hipOccupancyMaxActiveBlocksPerMultiprocessor(&per_cu, (const void*)fwd_kernel, NTHR, LDS_BYTES) != hipSuccess || per_cu < 1) fprintf(stderr, "kernel_launch: occupancy query reports %d\n", per_cu);
        (void)hipGetLastError();
        grid = cus;
    }
    if (grid < 0) return;
    if (hipMemsetAsync((char*)d_ws + WS_CTL, 0, CTL_ZERO_BYTES, stream) != hipSuccess) return;
    Args a{};
    for (int i = 0; i < 19; ++i) a.in[i] = (const float*)d_in[i];
    a.out = (float*)d_out; a.ws = (unsigned char*)d_ws;
    for (int li = 0; li < N_LAUNCHES; ++li) {
        a.ph_lo = li * N_PHASES / N_LAUNCHES; a.ph_hi = (li + 1) * N_PHASES / N_LAUNCHES;
        hipLaunchKernelGGL(fwd_kernel, dim3(grid), dim3(NTHR), LDS_BYTES, stream, a);
    }
}
```

```cpp
#include <hip/hip_runtime.h>
#include <cstdio>
#include <cstdint>
namespace pg8 {
#define PG8_LAS __attribute__((address_space(3)))
typedef unsigned short bf16_t;
typedef short bf16x8 __attribute__((ext_vector_type(8)));
typedef float f32x4 __attribute__((ext_vector_type(4)));
typedef unsigned u32x4 __attribute__((ext_vector_type(4)));
constexpr int BM = 256, BK = 64, HALF = 128, HTB = HALF * BK * 2  , STAGE_BYTES = 8 * HTB, NXCD = 8, WGM = 8;

__host__ __device__ __forceinline__ int lds_byte(int r, int c) { const int st = (r >> 4) * 2 + (c >> 5), rr = r & 15, cc = c & 31, ob = rr * 64 + cc * 2; return st * 1024 + (ob ^ (((ob >> 9) & 1) << 5)); }
__host__ __device__ __forceinline__ void stage_rc(int b, int& R, int& C) { const int st = b / 1024, sb = b % 1024, swz = sb ^ (((sb >> 9) & 1) << 5); R = (st >> 1) * 16 + swz / 64; C = (st & 1) * 32 + (swz % 64) / 2; }
__host__ __device__ __forceinline__ int perm32(int rho) { const int n = rho >> 4, i = rho & 15; return 8 * (i >> 2) + 4 * n + (i & 3); }

struct Unit { int pm, pn; };
struct Gemm { const bf16_t* A; const bf16_t* Bt; int M, N, K; };

struct StaticOrder {
    int nM, nN, nwg, G, c;
    __host__ __device__ void init(int M, int N, int G_, int c_) { nM = M / BM; nN = N / BM; nwg = nM * nN; G = G_; c = c_; }
    __host__ __device__ bool next(int i, Unit& u) const {
        const long L = (long)i * G + c; if (L >= nwg) return false;
        int wgid = (int)L; { const int q = nwg / NXCD, r = nwg % NXCD, xcd = wgid % NXCD, off = wgid / NXCD; wgid = (xcd < r ? xcd * (q + 1) : r * (q + 1) + (xcd - r) * q) + off; }
        const int nig = WGM * nN, gid = wgid / nig, fm = gid * WGM, gsz = (nM - fm) < WGM ? (nM - fm) : WGM;
        u.pm = fm + ((wgid % nig) % gsz); u.pn = (wgid % nig) / gsz; return true;
    }
    __device__ __forceinline__ void a_ready(const Unit&) const {}
    __device__ __forceinline__ void done(const Unit&) const {}
};

__device__ __forceinline__ unsigned cvt_pk_bf16(float lo, float hi) { unsigned r; asm volatile("v_cvt_pk_bf16_f32 %0, %1, %2" : "=v"(r) : "v"(lo), "v"(hi)); return r; }
typedef float f32x2 __attribute__((ext_vector_type(2)));
__device__ __forceinline__ f32x2 gelu_pk(f32x2 v) {
    const f32x2 av = __builtin_elementwise_abs(v), d = av * 0.2316418882f + 1.0f;
    f32x2 t; t.x = __builtin_amdgcn_rcpf(d.x); t.y = __builtin_amdgcn_rcpf(d.y);
    f32x2 q = t * 0.5307027145f + (-0.7265760135f); q = q * t + 0.7107068705f; q = q * t + (-0.142248368f); q = q * t + 0.127414796f; q = q * t;
    const f32x2 s = (v * v) * (-0.72134752044f);
    f32x2 e; e.x = __builtin_amdgcn_exp2f(s.x); e.y = __builtin_amdgcn_exp2f(s.y);
    const f32x2 m = v * (q * e), r = v - m;
    f32x2 o; o.x = v.x < 0.f ? m.x : r.x; o.y = v.y < 0.f ? m.y : r.y; return o;
}

template <int ACT  > struct EpiBf16 {
    static constexpr bool PERM = true, AFTER_DRAIN = false; static_assert(ACT == 0 || ACT == 1, "EpiBf16: ACT is 0 (none) or 1 (gelu_pk)");
    bf16_t* O; int ldc; const float* bias; int split_cols; size_t split_stride; float scale0;
    __device__ __forceinline__ void operator()(const f32x4 (&acc)[2][2][4][2], const Unit& u, int wr, int wc, int fr, int fq) const {
        const int row0 = u.pm * BM + wr * 64 + fr; int colt = u.pn * BM; bf16_t* base = O;
        float sc = 1.f; if (split_cols) { const int t = colt / split_cols; base += (size_t)t * split_stride; colt -= t * split_cols; if (t == 0) sc = scale0; }
        const int col0 = colt + wc * 32 + 8 * fq, bcol0 = u.pn * BM + wc * 32 + 8 * fq;
        f32x4 bv[2][2];
#pragma unroll
        for (int bj = 0; bj < 2; ++bj)
#pragma unroll
            for (int n = 0; n < 2; ++n) bv[bj][n] = bias ? *(const f32x4*)(bias + bcol0 + bj * HALF + 4 * n) : (f32x4){0.f, 0.f, 0.f, 0.f};
#pragma unroll
        for (int ai = 0; ai < 2; ++ai)
#pragma unroll
            for (int m = 0; m < 4; ++m) { bf16_t* rowp = base + (size_t)(row0 + ai * HALF + m * 16) * ldc + col0;
#pragma unroll
                for (int bj = 0; bj < 2; ++bj) { f32x4 v0 = acc[ai][bj][m][0] + bv[bj][0], v1 = acc[ai][bj][m][1] + bv[bj][1];
                    if (ACT == 1) { f32x2 a = gelu_pk((f32x2){v0[0], v0[1]}), b = gelu_pk((f32x2){v0[2], v0[3]}), c = gelu_pk((f32x2){v1[0], v1[1]}), d = gelu_pk((f32x2){v1[2], v1[3]});
                        v0 = (f32x4){a.x, a.y, b.x, b.y}; v1 = (f32x4){c.x, c.y, d.x, d.y}; }
                    v0 = v0 * sc; v1 = v1 * sc; u32x4 w; w.x = cvt_pk_bf16(v0[0], v0[1]); w.y = cvt_pk_bf16(v0[2], v0[3]); w.z = cvt_pk_bf16(v1[0], v1[1]); w.w = cvt_pk_bf16(v1[2], v1[3]);
                    *(u32x4*)(rowp + bj * HALF) = w; } }
    }
};

template <class Epi, class Sched, bool ALIGN_EPI = false, bool SP2 = false>
__device__ __forceinline__ void gemm_phase(PG8_LAS unsigned char* lds, const Gemm g, const Sched& S, const Epi& E) {
    const int tid = threadIdx.x, wid = __builtin_amdgcn_readfirstlane(tid >> 6), lane = tid & 63, wr = wid >> 2, wc = wid & 3, fr = lane & 15, fq = lane >> 4;
    const int K = g.K, nt = K / BK;
    unsigned voffA[2], voffB[2];
#pragma unroll
    for (int i = 0; i < 2; ++i) { int R, C; stage_rc(tid * 16 + i * 8192, R, C); const int Rb = Epi::PERM ? ((R & ~31) + perm32(R & 31)) : R;
        voffA[i] = (unsigned)(R * K + C) * 2u; voffB[i] = (unsigned)(Rb * K + C) * 2u; }
    const size_t kstep = (size_t)(BK * 2);
    const size_t hstep = (size_t)HALF * K * 2;
    const size_t tstep = 2 * hstep;
    const unsigned ldsw = (unsigned)wid * 1024u;
    const int aoff = lds_byte(wr * 64 + fr, fq * 8), boff = lds_byte(wc * 32 + fr, fq * 8);
#define PG8_SA(b, h) (((b) * 2 + (h)) * HTB)
#define PG8_SB(b, h) ((4 + (b) * 2 + (h)) * HTB)
#define PG8_STAGE(bufoff, gbase, voff) do { _Pragma("unroll") for (int _i = 0; _i < 2; ++_i) \
        __builtin_amdgcn_global_load_lds((const unsigned*)((const char*)(gbase) + (voff)[_i]), (PG8_LAS unsigned*)(lds + (bufoff) + ldsw + _i * 8192), 16, 0, 0); } while (0)
#define PG8_LDA(dst, b, h) do { _Pragma("unroll") for (int m = 0; m < 4; ++m) _Pragma("unroll") for (int k = 0; k < 2; ++k) dst[m][k] = *(const PG8_LAS bf16x8*)(lds + PG8_SA(b, h) + aoff + m * 2048 + k * 1024); } while (0)
#define PG8_LDB(dst, b, h) do { _Pragma("unroll") for (int n = 0; n < 2; ++n) _Pragma("unroll") for (int k = 0; k < 2; ++k) dst[n][k] = *(const PG8_LAS bf16x8*)(lds + PG8_SB(b, h) + boff + n * 2048 + k * 1024); } while (0)
#define PG8_MMA(ai, bj, At, Bt) do { __builtin_amdgcn_s_setprio(1); _Pragma("unroll") for (int m = 0; m < 4; ++m) _Pragma("unroll") for (int n = 0; n < 2; ++n) _Pragma("unroll") for (int k = 0; k < 2; ++k) \
        acc[ai][bj][m][n] = __builtin_amdgcn_mfma_f32_16x16x32_bf16(Bt[n][k], At[m][k], acc[ai][bj][m][n], 0, 0, 0); __builtin_amdgcn_s_setprio(0); } while (0)
#define PG8_WAIT_V(n) asm volatile("s_waitcnt vmcnt(" #n ")" ::: "memory")
#define PG8_WAIT_L(n) asm volatile("s_waitcnt lgkmcnt(" #n ")" ::: "memory")
#define PG8_BAR __builtin_amdgcn_s_barrier()
#define PG8_SCHED __builtin_amdgcn_sched_barrier(0)
    Unit cur, nxt; int ui = 0;
    if (!S.next(0, cur)) return;
    f32x4 acc[2][2][4][2];
#pragma unroll
    for (int a = 0; a < 2; ++a)
#pragma unroll
        for (int b = 0; b < 2; ++b)
#pragma unroll
            for (int m = 0; m < 4; ++m)
#pragma unroll
                for (int n = 0; n < 2; ++n) acc[a][b][m][n] = (f32x4){0.f, 0.f, 0.f, 0.f};
    bf16x8 At[4][2], B0[2][2], B1[2][2];
    const char* cA = (const char*)g.A + (size_t)cur.pm * tstep; const char* cB = (const char*)g.Bt + (size_t)cur.pn * tstep;
    S.a_ready(cur);
    if constexpr (SP2) {
        PG8_STAGE(PG8_SB(0, 0), cB, voffB); PG8_STAGE(PG8_SB(0, 1), cB + hstep, voffB); PG8_STAGE(PG8_SA(0, 0), cA, voffA); PG8_STAGE(PG8_SA(0, 1), cA + hstep, voffA);
        if (wr == 1) PG8_BAR;
        PG8_WAIT_V(2); PG8_BAR;
        PG8_STAGE(PG8_SB(1, 0), cB + kstep, voffB); PG8_STAGE(PG8_SA(1, 0), cA + kstep, voffA); PG8_STAGE(PG8_SB(1, 1), cB + hstep + kstep, voffB);
        PG8_WAIT_V(6); PG8_BAR;
    } else {
        PG8_STAGE(PG8_SB(0, 0), cB, voffB); PG8_STAGE(PG8_SA(0, 0), cA, voffA); PG8_STAGE(PG8_SB(0, 1), cB + hstep, voffB); PG8_STAGE(PG8_SA(0, 1), cA + hstep, voffA);
        if (wr == 1) PG8_BAR;
        PG8_WAIT_V(4); PG8_BAR;
        PG8_STAGE(PG8_SB(1, 0), cB + kstep, voffB); PG8_STAGE(PG8_SA(1, 0), cA + kstep, voffA); PG8_STAGE(PG8_SB(1, 1), cB + hstep + kstep, voffB);
        PG8_WAIT_V(6); PG8_BAR;
    }
    for (;;) {
        const bool has_next = S.next(ui + 1, nxt);
        const char* nA = has_next ? (const char*)g.A + (size_t)nxt.pm * tstep : cA; const char* nB = has_next ? (const char*)g.Bt + (size_t)nxt.pn * tstep : cB;
        for (int t = 0; t < nt; t += 2) {
            const bool last = (t == nt - 2);
            const char* a1 = cA + (size_t)(t + 1) * kstep;
            const char* a2 = last ? nA : cA + (size_t)(t + 2) * kstep; const char* b2 = last ? nB : cB + (size_t)(t + 2) * kstep;
            const char* a3 = a2 + kstep; const char* b3 = b2 + kstep;
            if (last && has_next) S.a_ready(nxt);
            if constexpr (SP2) {
            PG8_LDB(B0, 0, 0); PG8_LDB(B1, 0, 1); PG8_SCHED; PG8_LDA(At, 0, 0); PG8_STAGE(PG8_SA(1, 1), a1 + hstep, voffA);
            PG8_WAIT_V(8); PG8_WAIT_L(0); PG8_BAR; PG8_MMA(0, 0, At, B0); PG8_MMA(0, 1, At, B1); PG8_BAR; PG8_SCHED;
            PG8_LDA(At, 0, 1); PG8_STAGE(PG8_SB(0, 0), b2, voffB); PG8_STAGE(PG8_SB(0, 1), b2 + hstep, voffB); PG8_STAGE(PG8_SA(0, 0), a2, voffA);
            PG8_WAIT_V(8); PG8_WAIT_L(0); PG8_BAR; PG8_MMA(1, 0, At, B0); PG8_MMA(1, 1, At, B1); PG8_BAR; PG8_SCHED;
            PG8_LDB(B0, 1, 0); PG8_LDB(B1, 1, 1); PG8_SCHED; PG8_LDA(At, 1, 0); PG8_STAGE(PG8_SA(0, 1), a2 + hstep, voffA);
            PG8_WAIT_V(8); PG8_WAIT_L(0); PG8_BAR; PG8_MMA(0, 0, At, B0); PG8_MMA(0, 1, At, B1); PG8_BAR; PG8_SCHED;
            PG8_LDA(At, 1, 1); PG8_STAGE(PG8_SB(1, 0), b3, voffB); PG8_STAGE(PG8_SB(1, 1), b3 + hstep, voffB); PG8_STAGE(PG8_SA(1, 0), a3, voffA);
            PG8_WAIT_V(8); PG8_WAIT_L(0); PG8_BAR; PG8_MMA(1, 0, At, B0); PG8_MMA(1, 1, At, B1); PG8_BAR; PG8_SCHED;
            } else {
            PG8_LDB(B0, 0, 0); PG8_SCHED; PG8_LDA(At, 0, 0); PG8_STAGE(PG8_SA(1, 1), a1 + hstep, voffA);
            PG8_WAIT_L(8); PG8_BAR; PG8_WAIT_L(0); PG8_MMA(0, 0, At, B0); PG8_BAR; PG8_SCHED;
            PG8_LDB(B1, 0, 1); PG8_STAGE(PG8_SB(0, 0), b2, voffB);
            PG8_BAR; PG8_WAIT_L(0); PG8_MMA(0, 1, At, B1); PG8_BAR;
            PG8_LDA(At, 0, 1); PG8_STAGE(PG8_SA(0, 0), a2, voffA);
            PG8_BAR; PG8_WAIT_L(0); PG8_MMA(1, 0, At, B0); PG8_BAR; PG8_SCHED;
            PG8_STAGE(PG8_SB(0, 1), b2 + hstep, voffB);
            PG8_WAIT_V(6); PG8_BAR; PG8_MMA(1, 1, At, B1); PG8_BAR;
            PG8_LDB(B0, 1, 0); PG8_SCHED; PG8_LDA(At, 1, 0); PG8_STAGE(PG8_SA(0, 1), a2 + hstep, voffA);
            PG8_WAIT_L(8); PG8_BAR; PG8_WAIT_L(0); PG8_MMA(0, 0, At, B0); PG8_BAR; PG8_SCHED;
            PG8_LDB(B1, 1, 1); PG8_STAGE(PG8_SB(1, 0), b3, voffB);
            PG8_BAR; PG8_WAIT_L(0); PG8_MMA(0, 1, At, B1); PG8_BAR;
            PG8_LDA(At, 1, 1); PG8_STAGE(PG8_SA(1, 0), a3, voffA);
            PG8_BAR; PG8_WAIT_L(0); PG8_MMA(1, 0, At, B0); PG8_BAR; PG8_SCHED;
            PG8_STAGE(PG8_SB(1, 1), b3 + hstep, voffB);
            PG8_WAIT_V(6); PG8_BAR; PG8_MMA(1, 1, At, B1); PG8_BAR;
            }
        }
        if constexpr (ALIGN_EPI) { if (wr == 0) PG8_BAR; }
        if constexpr (!Epi::AFTER_DRAIN) { E(acc, cur, wr, wc, fr, fq); S.done(cur); }
        if (!has_next) break;
#pragma unroll
        for (int a = 0; a < 2; ++a)
#pragma unroll
            for (int b = 0; b < 2; ++b)
#pragma unroll
                for (int m = 0; m < 4; ++m)
#pragma unroll
                    for (int n = 0; n < 2; ++n) acc[a][b][m][n] = (f32x4){0.f, 0.f, 0.f, 0.f};
        cur = nxt; cA = nA; cB = nB; ++ui;
        if constexpr (ALIGN_EPI) { if (wr == 1) PG8_BAR; }
    }
    PG8_WAIT_V(0);
    if constexpr (!ALIGN_EPI) { if (wr == 0) PG8_BAR; }
    PG8_BAR;
    if constexpr (Epi::AFTER_DRAIN) { E.fused(acc, cur, wr, wc, fr, fq, lds, wid, lane); S.done(cur); }
#undef PG8_SA
#undef PG8_SB
#undef PG8_STAGE
#undef PG8_LDA
#undef PG8_LDB
#undef PG8_MMA
#undef PG8_WAIT_V
#undef PG8_WAIT_L
#undef PG8_BAR
#undef PG8_SCHED
}
}
#define GAS __attribute__((address_space(1)))
#define LAS __attribute__((address_space(3)))
typedef unsigned short bf16;
typedef unsigned v4u __attribute__((ext_vector_type(4)));
typedef float f32x4 __attribute__((ext_vector_type(4)));
typedef short bf16x8 __attribute__((ext_vector_type(8)));
typedef GAS unsigned gu32;
typedef GAS unsigned long long gu64;
#define RLX_AGENT __ATOMIC_RELAXED, __HIP_MEMORY_SCOPE_AGENT
#define LDS_WAIT() asm volatile("s_waitcnt lgkmcnt(0)" ::: "memory")
#define VM_WAIT() asm volatile("s_waitcnt vmcnt(0)" ::: "memory")
__device__ __forceinline__ unsigned long long rt() { return __builtin_amdgcn_s_memrealtime(); }
__device__ __forceinline__ unsigned f2bf(float f) { unsigned u = __builtin_bit_cast(unsigned, f); return (u + 0x7fffu + ((u >> 16) & 1u)) >> 16; }
__device__ __forceinline__ unsigned pk2(float lo, float hi) { return f2bf(lo) | (f2bf(hi) << 16); }

#define XB_TMO      128
#define XB_XCNT(j)  (256  + 64 * (j))
#define XB_XSUB(j)  (1280 + 64 * (j))
#define XB_XGEN(j)  (2304 + 64 * (j))
#define XB_TOP      3328
#define XB_TOPGEN   3392
#define XCD_BAR_WORDS 3456
#define XB_SPIN_CAP (1u << 18)

__device__ __forceinline__ unsigned xb_ld(unsigned* p)              { return __hip_atomic_load(p, __ATOMIC_RELAXED, __HIP_MEMORY_SCOPE_AGENT); }
__device__ __forceinline__ unsigned xb_add(unsigned* p, unsigned v) { return __hip_atomic_fetch_add(p, v, __ATOMIC_RELAXED, __HIP_MEMORY_SCOPE_AGENT); }
__device__ __forceinline__ unsigned xb_xcc_id() { return (unsigned)__builtin_amdgcn_s_getreg((3 << 11) | 20) & 0xFu; }
#define XB_SPIN(cond, bar) do { unsigned _sp = 0; while (cond) { __builtin_amdgcn_s_sleep(1); \
    if ((++_sp & 255u) == 0u) { if (xb_ld(&(bar)[XB_TMO])) break; if (_sp > XB_SPIN_CAP) { atomicAdd(&(bar)[XB_TMO], 1u); break; } } } } while (0)

struct XcdBarrier {
    unsigned* bar; unsigned x;
    volatile LAS unsigned* st;
};

__device__ __forceinline__ XcdBarrier xcd_barrier_post(unsigned* bar, volatile LAS unsigned* st) {
    XcdBarrier b; b.bar = bar; b.x = xb_xcc_id(); b.st = st;
    if (threadIdx.x == 0) (void)xb_add(&bar[XB_XCNT(b.x)], 1u);
    return b;
}
__device__ __forceinline__ void xcd_barrier_complete(unsigned* bar, unsigned x, unsigned& nloc, unsigned& nx) {
    const unsigned G = gridDim.x * gridDim.y * gridDim.z;
    unsigned sum, cnt, mine, sp = 0u;
    for (;;) {
        sum = 0u; cnt = 0u; mine = 0u;
#pragma unroll
        for (unsigned j = 0; j < 16; ++j) { const unsigned c = xb_ld(&bar[XB_XCNT(j)]); sum += c; cnt += (c > 0u) ? 1u : 0u; mine = (j == x) ? c : mine; }
        if (sum == G) break;
        __builtin_amdgcn_s_sleep(1);
        if ((++sp & 255u) == 0u) { if (xb_ld(&bar[XB_TMO])) break; if (sp > XB_SPIN_CAP) { atomicAdd(&bar[XB_TMO], 1u); break; } }
    }
    nloc = mine > 0u ? mine : 1u; nx = cnt > 0u ? cnt : 1u;
}

__device__ __forceinline__ void xcd_barrier(const XcdBarrier& b) {
    asm volatile("s_waitcnt vmcnt(0)" ::: "memory");
    __syncthreads();
    if (threadIdx.x == 0) {
        unsigned* bar = b.bar;
        __builtin_amdgcn_s_waitcnt(0);
        unsigned nloc = b.st[0], nx = b.st[1];
        if (nloc == 0u) { xcd_barrier_complete(bar, b.x, nloc, nx); b.st[0] = nloc; b.st[1] = nx; }
        const unsigned old = xb_add(&bar[XB_XSUB(b.x)], 1u);
        const unsigned gen = old / nloc;
        if (old + 1u == (gen + 1u) * nloc) {
            __builtin_amdgcn_fence(__ATOMIC_RELEASE, "agent");
            asm volatile("s_waitcnt vmcnt(0)" ::: "memory");
            const unsigned og = xb_add(&bar[XB_TOP], 1u);
            const unsigned tg = og / nx;
            if (og + 1u == (tg + 1u) * nx) xb_add(&bar[XB_TOPGEN], 1u);
            else XB_SPIN(xb_ld(&bar[XB_TOPGEN]) == tg, bar);
            __builtin_amdgcn_fence(__ATOMIC_ACQUIRE, "agent");
            xb_add(&bar[XB_XGEN(b.x)], 1u);
            asm volatile("s_waitcnt vmcnt(0)" ::: "memory");
        } else {
            XB_SPIN(xb_ld(&bar[XB_XGEN(b.x)]) == gen, bar);
            __builtin_amdgcn_fence(__ATOMIC_ACQUIRE, "agent");
            asm volatile("s_waitcnt vmcnt(0)" ::: "memory");
        }
    }
    __syncthreads();
}

constexpr int T = 16384, DM = 2048, NP = 5888, NMEM = 256;
constexpr int NWAVES = 8, NTHR = 512;
constexpr float EPS = 1e-6f;
constexpr size_t MiB = 1u << 20;
constexpr size_t WS_CTL = 0, CTL_ZERO_BYTES = 65536;
constexpr size_t WS_WIN0 = 1 * MiB, WS_WIN1 = 24 * MiB, WS_WOUT0 = 47 * MiB, WS_WOUT1 = 55 * MiB, WS_WMKV = 63 * MiB, WS_WK1T = 71 * MiB, WS_WV1T = 73 * MiB;
constexpr size_t WS_MEMKV = 75 * MiB, WS_DEC = 76 * MiB, WS_KCMP = 77 * MiB, WS_VCMP = 77 * MiB + 512 * 1024, WS_SEL = 78 * MiB;
constexpr size_t WS_XN = 80 * MiB, WS_P = 144 * MiB, WS_STATE = 328 * MiB, WS_END = 472 * MiB;
constexpr size_t WS_MIX1 = WS_STATE;
constexpr size_t DO_MIX0 = 0, DO_OI = 64 * MiB;
constexpr int CR = 3072, CXQ = 4608, CXG = 5120, CGL = 5632;
constexpr int GQ = 0, GK = 768, GV = 1536;
constexpr int NQ = 0, NKC = 1536, NVC = 1792, NKS = 2048, NVS = 2304, NKW = 2560, NVW = 2816;
constexpr int RING_BYTES = 131072, LDSCTL_OFF = RING_BYTES, MISC_OFF = LDSCTL_OFF + 320, LDS_BYTES = 147456;
constexpr int N_PHASES = 12;

__device__ __forceinline__ float bf2f(bf16 v) { return __builtin_bit_cast(float, (unsigned)v << 16); }
__device__ __forceinline__ bf16 f2b(float f) { return (bf16)f2bf(f); }
__device__ __forceinline__ float wave_sum(float v) {
#pragma unroll
    for (int o = 1; o < 64; o <<= 1) v += __shfl_xor(v, o);
    return v;
}
__device__ __forceinline__ float silu_f(float x) { return x / (1.f + __expf(-x)); }
__device__ __forceinline__ float sigmoid_f(float x) { return 1.f / (1.f + __expf(-x)); }
__device__ __forceinline__ float logsigmoid_f(float x) { return fminf(x, 0.f) - log1pf(__expf(-fabsf(x))); }

__device__ __forceinline__ int win_src_col(int layer, int c) {
    const int ex = layer ? 36 : 16;
    if (c < 3072) return c;
    if (c < 5632) return c + ex;
    if (c < 5632 + ex) return c - 5632 + 3072;
    return -1;
}

__device__ __forceinline__ void transpose_item(const float* W, int ldw, int K, bf16* WT, int n0, int k0, int srcc, LAS float* scr, int lane) {
#pragma unroll 8
    for (int i = 0; i < 32; ++i) { const int kk = 2 * i + (lane >> 5); scr[kk * 33 + (lane & 31)] = (srcc >= 0) ? W[(size_t)(k0 + kk) * ldw + srcc] : 0.f; }
    LDS_WAIT(); asm volatile("" ::: "memory");
    const int c = lane & 7;
#pragma unroll
    for (int j = 0; j < 4; ++j) { const int n = (lane >> 3) + 8 * j; const LAS float* s = scr + (8 * c) * 33 + n;
        v4u o; o.x = pk2(s[0 * 33], s[1 * 33]); o.y = pk2(s[2 * 33], s[3 * 33]); o.z = pk2(s[4 * 33], s[5 * 33]); o.w = pk2(s[6 * 33], s[7 * 33]);
        *(v4u*)(WT + (size_t)(n0 + n) * K + k0 + 8 * c) = o; }
    LDS_WAIT(); asm volatile("" ::: "memory");
}

__device__ __forceinline__ void rms_row_to_bf16(const float* xrow, const float* g, bf16* orow, int lane) {
    const f32x4* xr = (const f32x4*)xrow + lane; const f32x4* gr = (const f32x4*)g + lane;
    f32x4 v[8]; float s = 0.f;
#pragma unroll
    for (int j = 0; j < 8; ++j) { v[j] = xr[64 * j]; s += (v[j].x * v[j].x + v[j].y * v[j].y) + (v[j].z * v[j].z + v[j].w * v[j].w); }
    const float rstd = rsqrtf(wave_sum(s) * (1.f / DM) + EPS);
    unsigned long long* o8 = (unsigned long long*)orow + lane;
#pragma unroll
    for (int j = 0; j < 8; ++j) { const f32x4 gg = gr[64 * j];
        o8[64 * j] = (unsigned long long)pk2(v[j].x * rstd * gg.x, v[j].y * rstd * gg.y) | ((unsigned long long)pk2(v[j].z * rstd * gg.z, v[j].w * rstd * gg.w) << 32); }
}

struct Args { const float* in[19]; float* out; unsigned char* ws; int ph_lo, ph_hi; };

struct Ctx {
    LAS unsigned char* lds;
    int tid, lane, wave, G, gw, NGW;
    const float *x, *mem, *ln_pre, *ln_post, *ln_mem, *w_mem_kv, *gla_w_in, *gla_w_gate, *gla_b_gate, *gla_norm, *gla_w_out;
    const float *nsa_w_in, *pe_k, *pe_v, *wk1, *wk2, *wv1, *wv2, *nsa_w_out;
    float* out; unsigned char* ws;
    bf16 *WIN0, *WIN1, *WOUT0, *WOUT1, *WMKV, *MEMKV, *KCMP, *VCMP, *XN, *P, *STATE, *MIX0, *MIX1, *OI;
    float* DEC;
};

__device__ __forceinline__ void phase_prep(Ctx& F) {
    LAS float* scr = (LAS float*)(F.lds + F.wave * 16384);
    constexpr int I_WIN = 32 * 184, I_WOUT = 32 * 64, I_MKV = 32 * 32;
    constexpr int NITEMS = 2 * I_WIN + 2 * I_WOUT + 2 * I_MKV;
    for (int it = F.gw; it < NITEMS; it += F.NGW) {
        int r = it;
        if (r < 2 * I_WIN) { const int layer = r / I_WIN; r -= layer * I_WIN; const int kb = r / 184, nb = r % 184;
            const int srcc = win_src_col(layer, nb * 32 + (F.lane & 31));
            transpose_item(layer ? F.nsa_w_in : F.gla_w_in, layer ? 5668 : 5648, DM, layer ? F.WIN1 : F.WIN0, nb * 32, kb * 64, srcc, scr, F.lane); continue; }
        r -= 2 * I_WIN;
        if (r < 2 * I_WOUT) { const int layer = r / I_WOUT; r -= layer * I_WOUT; const int kb = r / 64, nb = r % 64;
            transpose_item(layer ? F.nsa_w_out : F.gla_w_out, DM, DM, layer ? F.WOUT1 : F.WOUT0, nb * 32, kb * 64, nb * 32 + (F.lane & 31), scr, F.lane); continue; }
        r -= 2 * I_WOUT;
        { const int layer = r / I_MKV; r -= layer * I_MKV; const int kb = r / 32, nb = r % 32;
            transpose_item(F.w_mem_kv + (size_t)layer * DM * 1024, 1024, DM, F.WMKV + (size_t)layer * 1024 * DM, nb * 32, kb * 64, nb * 32 + (F.lane & 31), scr, F.lane); }
    }
    for (int m = F.gw; m < T; m += F.NGW) rms_row_to_bf16(F.x + (size_t)m * DM, F.ln_pre, F.XN + (size_t)m * DM, F.lane);
}

__device__ __forceinline__ void memkv_naive(Ctx& F) {
    const int gt = blockIdx.x * NTHR + F.tid, NT = F.G * NTHR;
    for (int o = gt; o < 2 * NMEM * 1024; o += NT) {
        const int layer = o >> 18, m = (o >> 10) & 255, n = o & 1023;
        const float* mr = F.mem + (size_t)m * DM; const float* g = F.ln_mem + layer * DM; const float* W = F.w_mem_kv + (size_t)layer * DM * 1024 + n;
        float ss = 0.f, acc = 0.f;
        for (int k = 0; k < DM; ++k) { const float a = mr[k]; ss += a * a; acc += a * g[k] * W[(size_t)k * 1024]; }
        const float v = acc * rsqrtf(ss * (1.f / DM) + EPS);
        const int kv = n >> 9, h = (n >> 7) & 3, d = n & 127;
        F.MEMKV[((((size_t)layer * 2 + kv) * 4 + h) * NMEM + m) * 128 + d] = f2b(v);
    }
}

__device__ __forceinline__ void cross_naive(Ctx& F, int layer, bf16* MIX) {
    const float scale = 0.08838834764831845f;
    for (int u = F.gw; u < T * 4; u += F.NGW) {
        const int t = u >> 2, h = u & 3;
        const bf16* pr = F.P + (size_t)t * NP;
        const unsigned qq = *(const unsigned*)(pr + CXQ + h * 128 + 2 * F.lane);
        const float q0 = bf2f((bf16)(qq & 0xffff)) * scale, q1 = bf2f((bf16)(qq >> 16)) * scale;
        const bf16* Kb = F.MEMKV + (((size_t)layer * 2 + 0) * 4 + h) * NMEM * 128;
        const bf16* Vb = F.MEMKV + (((size_t)layer * 2 + 1) * 4 + h) * NMEM * 128;
        float m = -1e30f, l = 0.f, o0 = 0.f, o1 = 0.f;
        for (int j = 0; j < NMEM; ++j) {
            const unsigned kk = *(const unsigned*)(Kb + j * 128 + 2 * F.lane), vv = *(const unsigned*)(Vb + j * 128 + 2 * F.lane);
            const float s = wave_sum(q0 * bf2f((bf16)(kk & 0xffff)) + q1 * bf2f((bf16)(kk >> 16)));
            const float mn = fmaxf(m, s), a = __expf(m - mn), p = __expf(s - mn);
            l = l * a + p; o0 = o0 * a + p * bf2f((bf16)(vv & 0xffff)); o1 = o1 * a + p * bf2f((bf16)(vv >> 16)); m = mn;
        }
        const unsigned gg = *(const unsigned*)(pr + CXG + h * 128 + 2 * F.lane);
        const float r0 = o0 / l * silu_f(bf2f((bf16)(gg & 0xffff))), r1 = o1 / l * silu_f(bf2f((bf16)(gg >> 16)));
        *(unsigned*)(MIX + (size_t)t * DM + 1536 + h * 128 + 2 * F.lane) = pk2(r0, r1);
    }
}

__device__ __forceinline__ void gla_g1_naive(Ctx& F) {
    LAS float* bcum = (LAS float*)(F.lds);
    LAS float* Aat = (LAS float*)(F.lds + 49152);
    LAS float* glr = (LAS float*)(F.lds + 65536);
    LAS float* blast = (LAS float*)(F.lds + 69632);
    const float qscale = 0.07216878364870323f;
    for (int u = blockIdx.x; u < 1024; u += F.G) {
        const int n = u >> 2, h = u & 3; const size_t row0 = (size_t)n * 64;
        for (int i = F.tid; i < 1024; i += NTHR) glr[i] = bf2f(F.P[(row0 + (i >> 4)) * NP + CGL + (i & 15)]);
        __syncthreads();
        if (F.tid < 192) {
            const int d = F.tid, col = h * 192 + d; float wg[16];
#pragma unroll
            for (int j = 0; j < 16; ++j) wg[j] = F.gla_w_gate[j * 768 + col];
            const float bias = F.gla_b_gate[col]; float b = 0.f;
            for (int c = 0; c < 64; ++c) { float gl = bias;
#pragma unroll
                for (int j = 0; j < 16; ++j) gl += glr[c * 16 + j] * wg[j];
                b += logsigmoid_f(gl) * (1.f / 16.f); bcum[c * 192 + d] = b; }
            blast[d] = b; F.DEC[n * 768 + col] = __expf(b);
        }
        __syncthreads();
        for (int i = 0; i < 8; ++i) { const int idx = F.tid + NTHR * i, c = idx >> 6, s = idx & 63; float a = 0.f;
            if (s <= c) { const bf16* qp = F.P + (row0 + c) * NP + GQ + h * 192; const bf16* kp = F.P + (row0 + s) * NP + GK + h * 192;
                for (int d = 0; d < 192; ++d) a += bf2f(qp[d]) * bf2f(kp[d]) * __expf(bcum[c * 192 + d] - bcum[s * 192 + d]);
                a *= qscale; }
            Aat[idx] = a; }
        __syncthreads();
        for (int i = 0; i < 48; ++i) { const int idx = F.tid + NTHR * i, c = idx / 384, e = idx % 384; float a = 0.f;
            for (int s = 0; s <= c; ++s) a += Aat[c * 64 + s] * bf2f(F.P[(row0 + s) * NP + GV + h * 384 + e]);
            F.OI[(row0 + c) * 1536 + h * 384 + e] = f2b(a); }
        for (int i = 0; i < 144; ++i) { const int idx = F.tid + NTHR * i, e = idx / 192, d = idx % 192; float a = 0.f; const float bl = blast[d];
            for (int c = 0; c < 64; ++c) a += bf2f(F.P[(row0 + c) * NP + GK + h * 192 + d]) * __expf(bl - bcum[c * 192 + d]) * bf2f(F.P[(row0 + c) * NP + GV + h * 384 + e]);
            F.STATE[((size_t)u * 384 + e) * 192 + d] = f2b(a); }
        __syncthreads();
        for (int i = 0; i < 24; ++i) { const int idx = F.tid + NTHR * i, c = idx / 192, d = idx % 192;
            bf16* qp = F.P + (row0 + c) * NP + GQ + h * 192 + d; *qp = f2b(bf2f(*qp) * qscale * __expf(bcum[c * 192 + d])); }
        __syncthreads();
    }
}

__device__ __forceinline__ void gla_scan(Ctx& F) {
    const int gt = blockIdx.x * NTHR + F.tid, NT = F.G * NTHR;
    constexpr int PER = 4 * 384 * 192;
    for (int item = gt; item < PER / 4; item += NT) {
        const int idx = item * 4, h = idx / (384 * 192), d0 = idx % 192;
        bf16* sp = F.STATE + idx; const float* dp = F.DEC + h * 192 + d0;
        float s0 = 0.f, s1 = 0.f, s2 = 0.f, s3 = 0.f;
        for (int n0 = 0; n0 < 256; n0 += 8) {
            unsigned long long u[8]; f32x4 dc[8];
#pragma unroll
            for (int j = 0; j < 8; ++j) { u[j] = *(const unsigned long long*)(sp + (size_t)(n0 + j) * PER); dc[j] = *(const f32x4*)(dp + (n0 + j) * 768); }
#pragma unroll
            for (int j = 0; j < 8; ++j) {
                const unsigned lo = (unsigned)u[j], hi = (unsigned)(u[j] >> 32);
                s0 = dc[j].x * s0 + bf2f((bf16)(lo & 0xffff)); s1 = dc[j].y * s1 + bf2f((bf16)(lo >> 16));
                s2 = dc[j].z * s2 + bf2f((bf16)(hi & 0xffff)); s3 = dc[j].w * s3 + bf2f((bf16)(hi >> 16));
                *(unsigned long long*)(sp + (size_t)(n0 + j) * PER) = (unsigned long long)pk2(s0, s1) | ((unsigned long long)pk2(s2, s3) << 32);
            }
        }
    }
}

__device__ __forceinline__ void gla_g3_naive(Ctx& F) {
    LAS float* o = (LAS float*)(F.lds);
    LAS float* rs = (LAS float*)(F.lds + 98304);
    for (int u = blockIdx.x; u < 1024; u += F.G) {
        const int n = u >> 2, h = u & 3; const size_t row0 = (size_t)n * 64;
        for (int i = 0; i < 48; ++i) { const int idx = F.tid + NTHR * i, c = idx / 384, e = idx % 384;
            float a = bf2f(F.OI[(row0 + c) * 1536 + h * 384 + e]);
            if (n > 0) { const bf16* sp = F.STATE + ((size_t)(u - 4) * 384 + e) * 192; const bf16* qp = F.P + (row0 + c) * NP + GQ + h * 192;
                for (int d = 0; d < 192; ++d) a += bf2f(qp[d]) * bf2f(sp[d]); }
            o[idx] = a; }
        __syncthreads();
        for (int c = F.wave; c < 64; c += NWAVES) { float ss = 0.f;
            for (int e = F.lane; e < 384; e += 64) { const float v = o[c * 384 + e]; ss += v * v; }
            ss = wave_sum(ss); if (F.lane == 0) rs[c] = rsqrtf(ss * (1.f / 384.f) + EPS); }
        __syncthreads();
        for (int i = 0; i < 48; ++i) { const int idx = F.tid + NTHR * i, c = idx / 384, e = idx % 384;
            const float v = o[idx] * rs[c] * F.gla_norm[e]; const float r = bf2f(F.P[(row0 + c) * NP + CR + h * 384 + e]);
            F.MIX0[(row0 + c) * DM + h * 384 + e] = f2b(v * silu_f(r)); }
        __syncthreads();
    }
}

__device__ __forceinline__ void post_rows(Ctx& F, const float* hin, const bf16* Y, const float* gpost, float* hout, const float* gpre, bf16* XNo) {
    for (int m = F.gw; m < T; m += F.NGW) {
        const v4u* yr = (const v4u*)(Y + (size_t)m * DM) + F.lane;
        float y[32]; float ss = 0.f;
#pragma unroll
        for (int j = 0; j < 4; ++j) { const v4u w = yr[64 * j];
            const unsigned ww[4] = {w.x, w.y, w.z, w.w};
#pragma unroll
            for (int q = 0; q < 4; ++q) { y[j * 8 + 2 * q] = bf2f((bf16)(ww[q] & 0xffff)); y[j * 8 + 2 * q + 1] = bf2f((bf16)(ww[q] >> 16)); } }
#pragma unroll
        for (int i = 0; i < 32; ++i) ss += y[i] * y[i];
        const float rstd = rsqrtf(wave_sum(ss) * (1.f / DM) + EPS);
        float hn[32]; float s2 = 0.f;
#pragma unroll
        for (int j = 0; j < 4; ++j) {
#pragma unroll
            for (int q = 0; q < 2; ++q) { const int col = j * 512 + F.lane * 8 + q * 4;
                const f32x4 hv = *(const f32x4*)(hin + (size_t)m * DM + col); const f32x4 gp = *(const f32x4*)(gpost + col);
                f32x4 r; r.x = hv.x + y[j * 8 + q * 4 + 0] * rstd * gp.x; r.y = hv.y + y[j * 8 + q * 4 + 1] * rstd * gp.y; r.z = hv.z + y[j * 8 + q * 4 + 2] * rstd * gp.z; r.w = hv.w + y[j * 8 + q * 4 + 3] * rstd * gp.w;
                *(f32x4*)(hout + (size_t)m * DM + col) = r;
                hn[j * 8 + q * 4 + 0] = r.x; hn[j * 8 + q * 4 + 1] = r.y; hn[j * 8 + q * 4 + 2] = r.z; hn[j * 8 + q * 4 + 3] = r.w;
                s2 += (r.x * r.x + r.y * r.y) + (r.z * r.z + r.w * r.w); } }
        if (gpre) {
            const float rstd2 = rsqrtf(wave_sum(s2) * (1.f / DM) + EPS);
#pragma unroll
            for (int j = 0; j < 4; ++j) { const int col = j * 512 + F.lane * 8;
                const f32x4 g0 = *(const f32x4*)(gpre + col), g1 = *(const f32x4*)(gpre + col + 4);
                v4u w; w.x = pk2(hn[j * 8 + 0] * rstd2 * g0.x, hn[j * 8 + 1] * rstd2 * g0.y); w.y = pk2(hn[j * 8 + 2] * rstd2 * g0.z, hn[j * 8 + 3] * rstd2 * g0.w);
                w.z = pk2(hn[j * 8 + 4] * rstd2 * g1.x, hn[j * 8 + 5] * rstd2 * g1.y); w.w = pk2(hn[j * 8 + 6] * rstd2 * g1.z, hn[j * 8 + 7] * rstd2 * g1.w);
                *((v4u*)(XNo + (size_t)m * DM) + F.lane + 64 * j) = w; }
        }
    }
}

__device__ __forceinline__ void nsa_compress_naive(Ctx& F) {
    LAS float* blk = (LAS float*)(F.lds);
    LAS float* part = (LAS float*)(F.lds + 65536);
    LAS float* hid = (LAS float*)(F.lds + 73728);
    for (int u = blockIdx.x; u < 1024; u += F.G) {
        const int kv = u & 1, g = (u >> 1) & 1, nq = u >> 2;
        const float* pe = kv ? F.pe_v : F.pe_k; const float* w1 = kv ? F.wv1 : F.wk1; const float* w2 = kv ? F.wv2 : F.wk2;
        const int colb = (kv ? NVC : NKC) + g * 128;
        for (int i = 0; i < 32; ++i) { const int idx = F.tid + NTHR * i, r = idx >> 12, i4 = idx & 4095, l = i4 >> 7, d = i4 & 127; const int n = nq * 4 + r;
            float v = 0.f; if (n < 1023) v = bf2f(F.P[(size_t)(16 * n + l) * NP + colb + d]) + pe[l * 128 + d];
            blk[idx] = v; }
        __syncthreads();
        { const int j = F.tid & 255, ih = F.tid >> 8; float a0 = 0.f, a1 = 0.f, a2 = 0.f, a3 = 0.f;
            for (int i = ih * 2048; i < ih * 2048 + 2048; ++i) { const float w = w1[(size_t)i * 256 + j];
                a0 += blk[i] * w; a1 += blk[4096 + i] * w; a2 += blk[8192 + i] * w; a3 += blk[12288 + i] * w; }
            part[(ih * 4 + 0) * 256 + j] = a0; part[(ih * 4 + 1) * 256 + j] = a1; part[(ih * 4 + 2) * 256 + j] = a2; part[(ih * 4 + 3) * 256 + j] = a3; }
        __syncthreads();
        for (int i = F.tid; i < 1024; i += NTHR) hid[i] = silu_f(part[i] + part[1024 + i]);
        __syncthreads();
        { const int d = F.tid & 127, r = F.tid >> 7; const int n = nq * 4 + r; float a = 0.f;
            for (int j = 0; j < 256; ++j) a += hid[r * 256 + j] * w2[j * 128 + d];
            if (n < 1023) (kv ? F.VCMP : F.KCMP)[((size_t)g * 1024 + n) * 128 + d] = f2b(a); }
        __syncthreads();
    }
}

__device__ __forceinline__ void nsa_main_naive(Ctx& F) {
    const float scale = 0.08838834764831845f;
    LAS float* ocs = (LAS float*)(F.lds + F.wave * 4096);
    const int lane = F.lane;
    for (int u = F.gw; u < T * 2; u += F.NGW) {
        const int t = u >> 1, g = u & 1; const bf16* pr = F.P + (size_t)t * NP;
        const int ncv = (t >= 31) ? min((t - 31) / 16 + 1, 1023) : 0;
        const bf16* Kc = F.KCMP + (size_t)g * 1024 * 128; const bf16* Vc = F.VCMP + (size_t)g * 1024 * 128;
        float imp0 = 0.f, imp1 = 0.f, imp2 = 0.f, imp3 = 0.f;
        for (int h = 0; h < 6; ++h) {
            const unsigned qq = *(const unsigned*)(pr + NQ + (g * 6 + h) * 128 + 2 * lane);
            const float q0 = bf2f((bf16)(qq & 0xffff)) * scale, q1 = bf2f((bf16)(qq >> 16)) * scale;
            float m = -1e30f, l = 0.f, o0 = 0.f, o1 = 0.f;
            for (int c = 0; c < ncv; ++c) {
                const unsigned kk = *(const unsigned*)(Kc + c * 128 + 2 * lane), vv = *(const unsigned*)(Vc + c * 128 + 2 * lane);
                const float s = wave_sum(q0 * bf2f((bf16)(kk & 0xffff)) + q1 * bf2f((bf16)(kk >> 16)));
                const float mn = fmaxf(m, s), a = __expf(m - mn), p = __expf(s - mn);
                l = l * a + p; o0 = o0 * a + p * bf2f((bf16)(vv & 0xffff)); o1 = o1 * a + p * bf2f((bf16)(vv >> 16)); m = mn;
            }
            const float gate = sigmoid_f(bf2f(pr[CGL + g * 18 + h * 3 + 0]));
            const float il = (ncv > 0) ? 1.f / l : 0.f;
            ocs[h * 128 + 2 * lane] = gate * o0 * il; ocs[h * 128 + 2 * lane + 1] = gate * o1 * il;
            for (int c = 0; c < ncv; ++c) {
                const unsigned kk = *(const unsigned*)(Kc + c * 128 + 2 * lane);
                const float s = wave_sum(q0 * bf2f((bf16)(kk & 0xffff)) + q1 * bf2f((bf16)(kk >> 16)));
                const float p = __expf(s - m) * il;
                const int ja = c >> 2, jb = (c + 1) >> 2;
                { const int jj = lane;       if (jj == ja || jj == jb) imp0 += p; }
                { const int jj = lane + 64;  if (jj == ja || jj == jb) imp1 += p; }
                { const int jj = lane + 128; if (jj == ja || jj == jb) imp2 += p; }
                { const int jj = lane + 192; if (jj == ja || jj == jb) imp3 += p; }
            }
        }
        const int cur = t >> 6;
        float iv[4] = {imp0, imp1, imp2, imp3};
#pragma unroll
        for (int i = 0; i < 4; ++i) { const int jj = lane + 64 * i; if (jj == 0 || jj == cur || jj == cur - 1) iv[i] = 1e4f; if (jj > cur) iv[i] = -1e4f; }
        int mysel = 0;
#pragma unroll
        for (int r = 0; r < 16; ++r) {
            float bv = iv[0]; int bi = lane;
#pragma unroll
            for (int i = 1; i < 4; ++i) { if (iv[i] > bv) { bv = iv[i]; bi = lane + 64 * i; } }
#pragma unroll
            for (int o = 1; o < 64; o <<= 1) { const float ov = __shfl_xor(bv, o); const int oi = __shfl_xor(bi, o); if (ov > bv || (ov == bv && oi < bi)) { bv = ov; bi = oi; } }
            mysel = (lane == r) ? bi : mysel;
#pragma unroll
            for (int i = 0; i < 4; ++i) if (lane + 64 * i == bi) iv[i] = -3e38f;
        }
        for (int h = 0; h < 6; ++h) {
            const unsigned qq = *(const unsigned*)(pr + NQ + (g * 6 + h) * 128 + 2 * lane);
            const float q0 = bf2f((bf16)(qq & 0xffff)) * scale, q1 = bf2f((bf16)(qq >> 16)) * scale;
            float m = -1e30f, l = 0.f, o0 = 0.f, o1 = 0.f;
            for (int r = 0; r < 16; ++r) { const int j = __shfl(mysel, r); if (j > cur) continue;
                const int kend = min(64, t - 64 * j + 1);
                for (int i = 0; i < kend; ++i) { const bf16* kr = F.P + (size_t)(64 * j + i) * NP;
                    const unsigned kk = *(const unsigned*)(kr + NKS + g * 128 + 2 * lane), vv = *(const unsigned*)(kr + NVS + g * 128 + 2 * lane);
                    const float s = wave_sum(q0 * bf2f((bf16)(kk & 0xffff)) + q1 * bf2f((bf16)(kk >> 16)));
                    const float mn = fmaxf(m, s), a = __expf(m - mn), p = __expf(s - mn);
                    l = l * a + p; o0 = o0 * a + p * bf2f((bf16)(vv & 0xffff)); o1 = o1 * a + p * bf2f((bf16)(vv >> 16)); m = mn; } }
            const float gs = sigmoid_f(bf2f(pr[CGL + g * 18 + h * 3 + 1]));
            float r0 = ocs[h * 128 + 2 * lane] + gs * o0 / l, r1 = ocs[h * 128 + 2 * lane + 1] + gs * o1 / l;
            m = -1e30f; l = 0.f; o0 = 0.f; o1 = 0.f;
            for (int p0 = max(0, t - 511); p0 <= t; ++p0) { const bf16* kr = F.P + (size_t)p0 * NP;
                const unsigned kk = *(const unsigned*)(kr + NKW + g * 128 + 2 * lane), vv = *(const unsigned*)(kr + NVW + g * 128 + 2 * lane);
                const float s = wave_sum(q0 * bf2f((bf16)(kk & 0xffff)) + q1 * bf2f((bf16)(kk >> 16)));
                const float mn = fmaxf(m, s), a = __expf(m - mn), p = __expf(s - mn);
                l = l * a + p; o0 = o0 * a + p * bf2f((bf16)(vv & 0xffff)); o1 = o1 * a + p * bf2f((bf16)(vv >> 16)); m = mn; }
            const float gw_ = sigmoid_f(bf2f(pr[CGL + g * 18 + h * 3 + 2]));
            r0 += gw_ * o0 / l; r1 += gw_ * o1 / l;
            const unsigned rr = *(const unsigned*)(pr + CR + (g * 6 + h) * 128 + 2 * lane);
            r0 *= silu_f(bf2f((bf16)(rr & 0xffff))); r1 *= silu_f(bf2f((bf16)(rr >> 16)));
            *(unsigned*)(F.MIX1 + (size_t)t * DM + (g * 6 + h) * 128 + 2 * lane) = pk2(r0, r1);
        }
    }
}

__global__ void __launch_bounds__(NTHR, 2) fwd_kernel(Args args) {
    extern __shared__ __attribute__((aligned(16))) unsigned char lds_raw[];
    Ctx F;
    F.lds = (LAS unsigned char*)lds_raw;
    F.tid = threadIdx.x; F.lane = F.tid & 63; F.wave = __builtin_amdgcn_readfirstlane(F.tid >> 6);
    F.G = gridDim.x; F.gw = blockIdx.x * NWAVES + F.wave; F.NGW = F.G * NWAVES;
    F.x = args.in[0]; F.mem = args.in[1]; F.ln_pre = args.in[2]; F.ln_post = args.in[3]; F.ln_mem = args.in[4]; F.w_mem_kv = args.in[5];
    F.gla_w_in = args.in[6]; F.gla_w_gate = args.in[7]; F.gla_b_gate = args.in[8]; F.gla_norm = args.in[9]; F.gla_w_out = args.in[10];
    F.nsa_w_in = args.in[11]; F.pe_k = args.in[12]; F.pe_v = args.in[13]; F.wk1 = args.in[14]; F.wk2 = args.in[15]; F.wv1 = args.in[16]; F.wv2 = args.in[17]; F.nsa_w_out = args.in[18];
    F.out = args.out; F.ws = args.ws;
    unsigned char* ws = args.ws;
    F.WIN0 = (bf16*)(ws + WS_WIN0); F.WIN1 = (bf16*)(ws + WS_WIN1); F.WOUT0 = (bf16*)(ws + WS_WOUT0); F.WOUT1 = (bf16*)(ws + WS_WOUT1); F.WMKV = (bf16*)(ws + WS_WMKV);
    F.MEMKV = (bf16*)(ws + WS_MEMKV); F.DEC = (float*)(ws + WS_DEC); F.KCMP = (bf16*)(ws + WS_KCMP); F.VCMP = (bf16*)(ws + WS_VCMP);
    F.XN = (bf16*)(ws + WS_XN); F.P = (bf16*)(ws + WS_P); F.STATE = (bf16*)(ws + WS_STATE); F.MIX1 = (bf16*)(ws + WS_MIX1);
    F.MIX0 = (bf16*)((unsigned char*)args.out + DO_MIX0); F.OI = (bf16*)((unsigned char*)args.out + DO_OI);

    volatile LAS unsigned* MISC = (volatile LAS unsigned*)(F.lds + MISC_OFF);
    for (int u = F.tid; u < (LDS_BYTES - LDSCTL_OFF) / 4; u += NTHR) ((LAS unsigned*)(F.lds + LDSCTL_OFF))[u] = 0u;
    __syncthreads();
    const int lo = args.ph_lo, hi = args.ph_hi;
    XcdBarrier bar; bar.bar = (unsigned*)(ws + WS_CTL); bar.x = 0; bar.st = nullptr;
    if (hi - lo > 1) bar = xcd_barrier_post((unsigned*)(ws + WS_CTL), MISC + 8);
#define IN(k) (lo <= (k) && (k) < hi)
#define SEAM(k) do { if (IN(k) && IN((k) + 1)) xcd_barrier(bar); } while (0)

    if (IN(0)) { phase_prep(F); } SEAM(0);
    if (IN(1)) { memkv_naive(F);
        pg8::Gemm g{F.XN, F.WIN0, T, NP, DM}; pg8::StaticOrder S; S.init(T, NP, F.G, (int)blockIdx.x);
        pg8::EpiBf16<0> E{F.P, NP, nullptr, 0, 0, 1.f};
        pg8::gemm_phase<pg8::EpiBf16<0>, pg8::StaticOrder, true, true>(F.lds, g, S, E); } SEAM(1);
    if (IN(2)) { gla_g1_naive(F); cross_naive(F, 0, F.MIX0); } SEAM(2);
    if (IN(3)) { gla_scan(F); } SEAM(3);
    if (IN(4)) { gla_g3_naive(F); } SEAM(4);
    if (IN(5)) { pg8::Gemm g{F.MIX0, F.WOUT0, T, DM, DM}; pg8::StaticOrder S; S.init(T, DM, F.G, (int)blockIdx.x);
        pg8::EpiBf16<0> E{F.XN, DM, nullptr, 0, 0, 1.f};
        pg8::gemm_phase<pg8::EpiBf16<0>, pg8::StaticOrder, true, true>(F.lds, g, S, E); } SEAM(5);
    if (IN(6)) { post_rows(F, F.x, F.XN, F.ln_post, F.out, F.ln_pre + DM, F.XN); } SEAM(6);
    if (IN(7)) { pg8::Gemm g{F.XN, F.WIN1, T, NP, DM}; pg8::StaticOrder S; S.init(T, NP, F.G, (int)blockIdx.x);
        pg8::EpiBf16<0> E{F.P, NP, nullptr, 0, 0, 1.f};
        pg8::gemm_phase<pg8::EpiBf16<0>, pg8::StaticOrder, true, true>(F.lds, g, S, E); } SEAM(7);
    if (IN(8)) { nsa_compress_naive(F); } SEAM(8);
    if (IN(9)) { nsa_main_naive(F); cross_naive(F, 1, F.MIX1); } SEAM(9);
    if (IN(10)) { pg8::Gemm g{F.MIX1, F.WOUT1, T, DM, DM}; pg8::StaticOrder S; S.init(T, DM, F.G, (int)blockIdx.x);
        pg8::EpiBf16<0> E{F.XN, DM, nullptr, 0, 0, 1.f};
        pg8::gemm_phase<pg8::EpiBf16<0>, pg8::StaticOrder, true, true>(F.lds, g, S, E); } SEAM(10);
    if (IN(11)) { post_rows(F, F.out, F.XN, F.ln_post + DM, F.out, nullptr, nullptr); }
#undef IN
#undef SEAM
}

#ifndef N_LAUNCHES
#define N_LAUNCHES 1
#endif
extern "C" void kernel_launch(void* const* d_in, const int* in_sizes, int n_in, void* d_out, int out_size, void* d_ws, size_t ws_size, hipStream_t stream) {
    static int grid = 0;
    if (grid == 0) {
        if (n_in != 19 || out_size != T * DM || ws_size < WS_END) { fprintf(stderr, "kernel_launch: unexpected shapes (n_in %d out %d ws %zu)\n", n_in, out_size, ws_size); grid = -1; return; }
        int dev = 0, cus = 0, per_cu = 0;
        if (hipGetDevice(&dev) != hipSuccess || hipDeviceGetAttribute(&cus, hipDeviceAttributeMultiprocessorCount, dev) != hipSuccess) { grid = -1; return; }
        if (hipFuncSetAttribute((const void*)fwd_kernel, hipFuncAttributeMaxDynamicSharedMemorySize, LDS_BYTES) != hipSuccess) { fprintf(stderr, "kernel_launch: hipFuncSetAttribute failed\n"); grid = -1; return; }
        if (hipOccupancyMaxActiveBlocksPerMultiprocessor(&per_cu, (const void*)fwd_kernel, NTHR, LDS_BYTES) != hipSuccess || per_cu < 1) fprintf(stderr, "kernel_launch: occupancy query reports %d\n", per_cu);
        (void)hipGetLastError();
        grid = cus;
    }
    if (grid < 0) return;
    if (hipMemsetAsync((char*)d_ws + WS_CTL, 0, CTL_ZERO_BYTES, stream) != hipSuccess) return;
    Args a{};
    for (int i = 0; i < 19; ++i) a.in[i] = (const float*)d_in[i];
    a.out = (float*)d_out; a.ws = (unsigned char*)d_ws;
    for (int li = 0; li < N_LAUNCHES; ++li) {
        a.ph_lo = li * N_PHASES / N_LAUNCHES; a.ph_hi = (li + 1) * N_PHASES / N_LAUNCHES;
        hipLaunchKernelGGL(fwd_kernel, dim3(grid), dim3(NTHR), LDS_BYTES, stream, a);
    }
}
```

```cpp
#include <hip/hip_runtime.h>
#include <cstdio>
#include <cstdint>
namespace pg8 {
#define PG8_LAS __attribute__((address_space(3)))
typedef unsigned short bf16_t;
typedef short bf16x8 __attribute__((ext_vector_type(8)));
typedef float f32x4 __attribute__((ext_vector_type(4)));
typedef unsigned u32x4 __attribute__((ext_vector_type(4)));
constexpr int BM = 256, BK = 64, HALF = 128, HTB = HALF * BK * 2  , STAGE_BYTES = 8 * HTB, NXCD = 8, WGM = 8;

__host__ __device__ __forceinline__ int lds_byte(int r, int c) { const int st = (r >> 4) * 2 + (c >> 5), rr = r & 15, cc = c & 31, ob = rr * 64 + cc * 2; return st * 1024 + (ob ^ (((ob >> 9) & 1) << 5)); }
__host__ __device__ __forceinline__ void stage_rc(int b, int& R, int& C) { const int st = b / 1024, sb = b % 1024, swz = sb ^ (((sb >> 9) & 1) << 5); R = (st >> 1) * 16 + swz / 64; C = (st & 1) * 32 + (swz % 64) / 2; }
__host__ __device__ __forceinline__ int perm32(int rho) { const int n = rho >> 4, i = rho & 15; return 8 * (i >> 2) + 4 * n + (i & 3); }

struct Unit { int pm, pn; };
struct Gemm { const bf16_t* A; const bf16_t* Bt; int M, N, K; };

struct StaticOrder {
    int nM, nN, nwg, G, c;
    __host__ __device__ void init(int M, int N, int G_, int c_) { nM = M / BM; nN = N / BM; nwg = nM * nN; G = G_; c = c_; }
    __host__ __device__ bool next(int i, Unit& u) const {
        const long L = (long)i * G + c; if (L >= nwg) return false;
        int wgid = (int)L; { const int q = nwg / NXCD, r = nwg % NXCD, xcd = wgid % NXCD, off = wgid / NXCD; wgid = (xcd < r ? xcd * (q + 1) : r * (q + 1) + (xcd - r) * q) + off; }
        const int nig = WGM * nN, gid = wgid / nig, fm = gid * WGM, gsz = (nM - fm) < WGM ? (nM - fm) : WGM;
        u.pm = fm + ((wgid % nig) % gsz); u.pn = (wgid % nig) / gsz; return true;
    }
    __device__ __forceinline__ void a_ready(const Unit&) const {}
    __device__ __forceinline__ void done(const Unit&) const {}
};

__device__ __forceinline__ unsigned cvt_pk_bf16(float lo, float hi) { unsigned r; asm volatile("v_cvt_pk_bf16_f32 %0, %1, %2" : "=v"(r) : "v"(lo), "v"(hi)); return r; }
typedef float f32x2 __attribute__((ext_vector_type(2)));
__device__ __forceinline__ f32x2 gelu_pk(f32x2 v) {
    const f32x2 av = __builtin_elementwise_abs(v), d = av * 0.2316418882f + 1.0f;
    f32x2 t; t.x = __builtin_amdgcn_rcpf(d.x); t.y = __builtin_amdgcn_rcpf(d.y);
    f32x2 q = t * 0.5307027145f + (-0.7265760135f); q = q * t + 0.7107068705f; q = q * t + (-0.142248368f); q = q * t + 0.127414796f; q = q * t;
    const f32x2 s = (v * v) * (-0.72134752044f);
    f32x2 e; e.x = __builtin_amdgcn_exp2f(s.x); e.y = __builtin_amdgcn_exp2f(s.y);
    const f32x2 m = v * (q * e), r = v - m;
    f32x2 o; o.x = v.x < 0.f ? m.x : r.x; o.y = v.y < 0.f ? m.y : r.y; return o;
}

template <int ACT  > struct EpiBf16 {
    static constexpr bool PERM = true, AFTER_DRAIN = false; static_assert(ACT == 0 || ACT == 1, "EpiBf16: ACT is 0 (none) or 1 (gelu_pk)");
    bf16_t* O; int ldc; const float* bias; int split_cols; size_t split_stride; float scale0;
    __device__ __forceinline__ void operator()(const f32x4 (&acc)[2][2][4][2], const Unit& u, int wr, int wc, int fr, int fq) const {
        const int row0 = u.pm * BM + wr * 64 + fr; int colt = u.pn * BM; bf16_t* base = O;
        float sc = 1.f; if (split_cols) { const int t = colt / split_cols; base += (size_t)t * split_stride; colt -= t * split_cols; if (t == 0) sc = scale0; }
        const int col0 = colt + wc * 32 + 8 * fq, bcol0 = u.pn * BM + wc * 32 + 8 * fq;
        f32x4 bv[2][2];
#pragma unroll
        for (int bj = 0; bj < 2; ++bj)
#pragma unroll
            for (int n = 0; n < 2; ++n) bv[bj][n] = bias ? *(const f32x4*)(bias + bcol0 + bj * HALF + 4 * n) : (f32x4){0.f, 0.f, 0.f, 0.f};
#pragma unroll
        for (int ai = 0; ai < 2; ++ai)
#pragma unroll
            for (int m = 0; m < 4; ++m) { bf16_t* rowp = base + (size_t)(row0 + ai * HALF + m * 16) * ldc + col0;
#pragma unroll
                for (int bj = 0; bj < 2; ++bj) { f32x4 v0 = acc[ai][bj][m][0] + bv[bj][0], v1 = acc[ai][bj][m][1] + bv[bj][1];
                    if (ACT == 1) { f32x2 a = gelu_pk((f32x2){v0[0], v0[1]}), b = gelu_pk((f32x2){v0[2], v0[3]}), c = gelu_pk((f32x2){v1[0], v1[1]}), d = gelu_pk((f32x2){v1[2], v1[3]});
                        v0 = (f32x4){a.x, a.y, b.x, b.y}; v1 = (f32x4){c.x, c.y, d.x, d.y}; }
                    v0 = v0 * sc; v1 = v1 * sc; u32x4 w; w.x = cvt_pk_bf16(v0[0], v0[1]); w.y = cvt_pk_bf16(v0[2], v0[3]); w.z = cvt_pk_bf16(v1[0], v1[1]); w.w = cvt_pk_bf16(v1[2], v1[3]);
                    *(u32x4*)(rowp + bj * HALF) = w; } }
    }
};

template <class Epi, class Sched, bool ALIGN_EPI = false, bool SP2 = false>
__device__ __forceinline__ void gemm_phase(PG8_LAS unsigned char* lds, const Gemm g, const Sched& S, const Epi& E) {
    const int tid = threadIdx.x, wid = __builtin_amdgcn_readfirstlane(tid >> 6), lane = tid & 63, wr = wid >> 2, wc = wid & 3, fr = lane & 15, fq = lane >> 4;
    const int K = g.K, nt = K / BK;
    unsigned voffA[2], voffB[2];
#pragma unroll
    for (int i = 0; i < 2; ++i) { int R, C; stage_rc(tid * 16 + i * 8192, R, C); const int Rb = Epi::PERM ? ((R & ~31) + perm32(R & 31)) : R;
        voffA[i] = (unsigned)(R * K + C) * 2u; voffB[i] = (unsigned)(Rb * K + C) * 2u; }
    const size_t kstep = (size_t)(BK * 2);
    const size_t hstep = (size_t)HALF * K * 2;
    const size_t tstep = 2 * hstep;
    const unsigned ldsw = (unsigned)wid * 1024u;
    const int aoff = lds_byte(wr * 64 + fr, fq * 8), boff = lds_byte(wc * 32 + fr, fq * 8);
#define PG8_SA(b, h) (((b) * 2 + (h)) * HTB)
#define PG8_SB(b, h) ((4 + (b) * 2 + (h)) * HTB)
#define PG8_STAGE(bufoff, gbase, voff) do { _Pragma("unroll") for (int _i = 0; _i < 2; ++_i) \
        __builtin_amdgcn_global_load_lds((const unsigned*)((const char*)(gbase) + (voff)[_i]), (PG8_LAS unsigned*)(lds + (bufoff) + ldsw + _i * 8192), 16, 0, 0); } while (0)
#define PG8_LDA(dst, b, h) do { _Pragma("unroll") for (int m = 0; m < 4; ++m) _Pragma("unroll") for (int k = 0; k < 2; ++k) dst[m][k] = *(const PG8_LAS bf16x8*)(lds + PG8_SA(b, h) + aoff + m * 2048 + k * 1024); } while (0)
#define PG8_LDB(dst, b, h) do { _Pragma("unroll") for (int n = 0; n < 2; ++n) _Pragma("unroll") for (int k = 0; k < 2; ++k) dst[n][k] = *(const PG8_LAS bf16x8*)(lds + PG8_SB(b, h) + boff + n * 2048 + k * 1024); } while (0)
#define PG8_MMA(ai, bj, At, Bt) do { __builtin_amdgcn_s_setprio(1); _Pragma("unroll") for (int m = 0; m < 4; ++m) _Pragma("unroll") for (int n = 0; n < 2; ++n) _Pragma("unroll") for (int k = 0; k < 2; ++k) \
        acc[ai][bj][m][n] = __builtin_amdgcn_mfma_f32_16x16x32_bf16(Bt[n][k], At[m][k], acc[ai][bj][m][n], 0, 0, 0); __builtin_amdgcn_s_setprio(0); } while (0)
#define PG8_WAIT_V(n) asm volatile("s_waitcnt vmcnt(" #n ")" ::: "memory")
#define PG8_WAIT_L(n) asm volatile("s_waitcnt lgkmcnt(" #n ")" ::: "memory")
#define PG8_BAR __builtin_amdgcn_s_barrier()
#define PG8_SCHED __builtin_amdgcn_sched_barrier(0)
    Unit cur, nxt; int ui = 0;
    if (!S.next(0, cur)) return;
    f32x4 acc[2][2][4][2];
#pragma unroll
    for (int a = 0; a < 2; ++a)
#pragma unroll
        for (int b = 0; b < 2; ++b)
#pragma unroll
            for (int m = 0; m < 4; ++m)
#pragma unroll
                for (int n = 0; n < 2; ++n) acc[a][b][m][n] = (f32x4){0.f, 0.f, 0.f, 0.f};
    bf16x8 At[4][2], B0[2][2], B1[2][2];
    const char* cA = (const char*)g.A + (size_t)cur.pm * tstep; const char* cB = (const char*)g.Bt + (size_t)cur.pn * tstep;
    S.a_ready(cur);
    if constexpr (SP2) {
        PG8_STAGE(PG8_SB(0, 0), cB, voffB); PG8_STAGE(PG8_SB(0, 1), cB + hstep, voffB); PG8_STAGE(PG8_SA(0, 0), cA, voffA); PG8_STAGE(PG8_SA(0, 1), cA + hstep, voffA);
        if (wr == 1) PG8_BAR;
        PG8_WAIT_V(2); PG8_BAR;
        PG8_STAGE(PG8_SB(1, 0), cB + kstep, voffB); PG8_STAGE(PG8_SA(1, 0), cA + kstep, voffA); PG8_STAGE(PG8_SB(1, 1), cB + hstep + kstep, voffB);
        PG8_WAIT_V(6); PG8_BAR;
    } else {
        PG8_STAGE(PG8_SB(0, 0), cB, voffB); PG8_STAGE(PG8_SA(0, 0), cA, voffA); PG8_STAGE(PG8_SB(0, 1), cB + hstep, voffB); PG8_STAGE(PG8_SA(0, 1), cA + hstep, voffA);
        if (wr == 1) PG8_BAR;
        PG8_WAIT_V(4); PG8_BAR;
        PG8_STAGE(PG8_SB(1, 0), cB + kstep, voffB); PG8_STAGE(PG8_SA(1, 0), cA + kstep, voffA); PG8_STAGE(PG8_SB(1, 1), cB + hstep + kstep, voffB);
        PG8_WAIT_V(6); PG8_BAR;
    }
    for (;;) {
        const bool has_next = S.next(ui + 1, nxt);
        const char* nA = has_next ? (const char*)g.A + (size_t)nxt.pm * tstep : cA; const char* nB = has_next ? (const char*)g.Bt + (size_t)nxt.pn * tstep : cB;
        for (int t = 0; t < nt; t += 2) {
            const bool last = (t == nt - 2);
            const char* a1 = cA + (size_t)(t + 1) * kstep;
            const char* a2 = last ? nA : cA + (size_t)(t + 2) * kstep; const char* b2 = last ? nB : cB + (size_t)(t + 2) * kstep;
            const char* a3 = a2 + kstep; const char* b3 = b2 + kstep;
            if (last && has_next) S.a_ready(nxt);
            if constexpr (SP2) {
            PG8_LDB(B0, 0, 0); PG8_LDB(B1, 0, 1); PG8_SCHED; PG8_LDA(At, 0, 0); PG8_STAGE(PG8_SA(1, 1), a1 + hstep, voffA);
            PG8_WAIT_V(8); PG8_WAIT_L(0); PG8_BAR; PG8_MMA(0, 0, At, B0); PG8_MMA(0, 1, At, B1); PG8_BAR; PG8_SCHED;
            PG8_LDA(At, 0, 1); PG8_STAGE(PG8_SB(0, 0), b2, voffB); PG8_STAGE(PG8_SB(0, 1), b2 + hstep, voffB); PG8_STAGE(PG8_SA(0, 0), a2, voffA);
            PG8_WAIT_V(8); PG8_WAIT_L(0); PG8_BAR; PG8_MMA(1, 0, At, B0); PG8_MMA(1, 1, At, B1); PG8_BAR; PG8_SCHED;
            PG8_LDB(B0, 1, 0); PG8_LDB(B1, 1, 1); PG8_SCHED; PG8_LDA(At, 1, 0); PG8_STAGE(PG8_SA(0, 1), a2 + hstep, voffA);
            PG8_WAIT_V(8); PG8_WAIT_L(0); PG8_BAR; PG8_MMA(0, 0, At, B0); PG8_MMA(0, 1, At, B1); PG8_BAR; PG8_SCHED;
            PG8_LDA(At, 1, 1); PG8_STAGE(PG8_SB(1, 0), b3, voffB); PG8_STAGE(PG8_SB(1, 1), b3 + hstep, voffB); PG8_STAGE(PG8_SA(1, 0), a3, voffA);
            PG8_WAIT_V(8); PG8_WAIT_L(0); PG8_BAR; PG8_MMA(1, 0, At, B0); PG8_MMA(1, 1, At, B1); PG8_BAR; PG8_SCHED;
            } else {
            PG8_LDB(B0, 0, 0); PG8_SCHED; PG8_LDA(At, 0, 0); PG8_STAGE(PG8_SA(1, 1), a1 + hstep, voffA);
            PG8_WAIT_L(8); PG8_BAR; PG8_WAIT_L(0); PG8_MMA(0, 0, At, B0); PG8_BAR; PG8_SCHED;
            PG8_LDB(B1, 0, 1); PG8_STAGE(PG8_SB(0, 0), b2, voffB);
            PG8_BAR; PG8_WAIT_L(0); PG8_MMA(0, 1, At, B1); PG8_BAR;
            PG8_LDA(At, 0, 1); PG8_STAGE(PG8_SA(0, 0), a2, voffA);
            PG8_BAR; PG8_WAIT_L(0); PG8_MMA(1, 0, At, B0); PG8_BAR; PG8_SCHED;
            PG8_STAGE(PG8_SB(0, 1), b2 + hstep, voffB);
            PG8_WAIT_V(6); PG8_BAR; PG8_MMA(1, 1, At, B1); PG8_BAR;
            PG8_LDB(B0, 1, 0); PG8_SCHED; PG8_LDA(At, 1, 0); PG8_STAGE(PG8_SA(0, 1), a2 + hstep, voffA);
            PG8_WAIT_L(8); PG8_BAR; PG8_WAIT_L(0); PG8_MMA(0, 0, At, B0); PG8_BAR; PG8_SCHED;
            PG8_LDB(B1, 1, 1); PG8_STAGE(PG8_SB(1, 0), b3, voffB);
            PG8_BAR; PG8_WAIT_L(0); PG8_MMA(0, 1, At, B1); PG8_BAR;
            PG8_LDA(At, 1, 1); PG8_STAGE(PG8_SA(1, 0), a3, voffA);
            PG8_BAR; PG8_WAIT_L(0); PG8_MMA(1, 0, At, B0); PG8_BAR; PG8_SCHED;
            PG8_STAGE(PG8_SB(1, 1), b3 + hstep, voffB);
            PG8_WAIT_V(6); PG8_BAR; PG8_MMA(1, 1, At, B1); PG8_BAR;
            }
        }
        if constexpr (ALIGN_EPI) { if (wr == 0) PG8_BAR; }
        if constexpr (!Epi::AFTER_DRAIN) { E(acc, cur, wr, wc, fr, fq); S.done(cur); }
        if (!has_next) break;
#pragma unroll
        for (int a = 0; a < 2; ++a)
#pragma unroll
            for (int b = 0; b < 2; ++b)
#pragma unroll
                for (int m = 0; m < 4; ++m)
#pragma unroll
                    for (int n = 0; n < 2; ++n) acc[a][b][m][n] = (f32x4){0.f, 0.f, 0.f, 0.f};
        cur = nxt; cA = nA; cB = nB; ++ui;
        if constexpr (ALIGN_EPI) { if (wr == 1) PG8_BAR; }
    }
    PG8_WAIT_V(0);
    if constexpr (!ALIGN_EPI) { if (wr == 0) PG8_BAR; }
    PG8_BAR;
    if constexpr (Epi::AFTER_DRAIN) { E.fused(acc, cur, wr, wc, fr, fq, lds, wid, lane); S.done(cur); }
#undef PG8_SA
#undef PG8_SB
#undef PG8_STAGE
#undef PG8_LDA
#undef PG8_LDB
#undef PG8_MMA
#undef PG8_WAIT_V
#undef PG8_WAIT_L
#undef PG8_BAR
#undef PG8_SCHED
}
}
#define GAS __attribute__((address_space(1)))
#define LAS __attribute__((address_space(3)))
typedef unsigned short bf16;
typedef unsigned v4u __attribute__((ext_vector_type(4)));
typedef float f32x4 __attribute__((ext_vector_type(4)));
typedef short bf16x8 __attribute__((ext_vector_type(8)));
typedef GAS unsigned gu32;
typedef GAS unsigned long long gu64;
#define RLX_AGENT __ATOMIC_RELAXED, __HIP_MEMORY_SCOPE_AGENT
#define LDS_WAIT() asm volatile("s_waitcnt lgkmcnt(0)" ::: "memory")
#define VM_WAIT() asm volatile("s_waitcnt vmcnt(0)" ::: "memory")
__device__ __forceinline__ unsigned long long rt() { return __builtin_amdgcn_s_memrealtime(); }
__device__ __forceinline__ unsigned f2bf(float f) { unsigned u = __builtin_bit_cast(unsigned, f); return (u + 0x7fffu + ((u >> 16) & 1u)) >> 16; }
__device__ __forceinline__ unsigned pk2(float lo, float hi) { return f2bf(lo) | (f2bf(hi) << 16); }

#define XB_TMO      128
#define XB_XCNT(j)  (256  + 64 * (j))
#define XB_XSUB(j)  (1280 + 64 * (j))
#define XB_XGEN(j)  (2304 + 64 * (j))
#define XB_TOP      3328
#define XB_TOPGEN   3392
#define XCD_BAR_WORDS 3456
#define XB_SPIN_CAP (1u << 18)

__device__ __forceinline__ unsigned xb_ld(unsigned* p)              { return __hip_atomic_load(p, __ATOMIC_RELAXED, __HIP_MEMORY_SCOPE_AGENT); }
__device__ __forceinline__ unsigned xb_add(unsigned* p, unsigned v) { return __hip_atomic_fetch_add(p, v, __ATOMIC_RELAXED, __HIP_MEMORY_SCOPE_AGENT); }
__device__ __forceinline__ unsigned xb_xcc_id() { return (unsigned)__builtin_amdgcn_s_getreg((3 << 11) | 20) & 0xFu; }
#define XB_SPIN(cond, bar) do { unsigned _sp = 0; while (cond) { __builtin_amdgcn_s_sleep(1); \
    if ((++_sp & 255u) == 0u) { if (xb_ld(&(bar)[XB_TMO])) break; if (_sp > XB_SPIN_CAP) { atomicAdd(&(bar)[XB_TMO], 1u); break; } } } } while (0)

struct XcdBarrier {
    unsigned* bar; unsigned x;
    volatile LAS unsigned* st;
};

__device__ __forceinline__ XcdBarrier xcd_barrier_post(unsigned* bar, volatile LAS unsigned* st) {
    XcdBarrier b; b.bar = bar; b.x = xb_xcc_id(); b.st = st;
    if (threadIdx.x == 0) (void)xb_add(&bar[XB_XCNT(b.x)], 1u);
    return b;
}
__device__ __forceinline__ void xcd_barrier_complete(unsigned* bar, unsigned x, unsigned& nloc, unsigned& nx) {
    const unsigned G = gridDim.x * gridDim.y * gridDim.z;
    unsigned sum, cnt, mine, sp = 0u;
    for (;;) {
        sum = 0u; cnt = 0u; mine = 0u;
#pragma unroll
        for (unsigned j = 0; j < 16; ++j) { const unsigned c = xb_ld(&bar[XB_XCNT(j)]); sum += c; cnt += (c > 0u) ? 1u : 0u; mine = (j == x) ? c : mine; }
        if (sum == G) break;
        __builtin_amdgcn_s_sleep(1);
        if ((++sp & 255u) == 0u) { if (xb_ld(&bar[XB_TMO])) break; if (sp > XB_SPIN_CAP) { atomicAdd(&bar[XB_TMO], 1u); break; } }
    }
    nloc = mine > 0u ? mine : 1u; nx = cnt > 0u ? cnt : 1u;
}

__device__ __forceinline__ void xcd_barrier(const XcdBarrier& b) {
    asm volatile("s_waitcnt vmcnt(0)" ::: "memory");
    __syncthreads();
    if (threadIdx.x == 0) {
        unsigned* bar = b.bar;
        __builtin_amdgcn_s_waitcnt(0);
        unsigned nloc = b.st[0], nx = b.st[1];
        if (nloc == 0u) { xcd_barrier_complete(bar, b.x, nloc, nx); b.st[0] = nloc; b.st[1] = nx; }
        const unsigned old = xb_add(&bar[XB_XSUB(b.x)], 1u);
        const unsigned gen = old / nloc;
        if (old + 1u == (gen + 1u) * nloc) {
            __builtin_amdgcn_fence(__ATOMIC_RELEASE, "agent");
            asm volatile("s_waitcnt vmcnt(0)" ::: "memory");
            const unsigned og = xb_add(&bar[XB_TOP], 1u);
            const unsigned tg = og / nx;
            if (og + 1u == (tg + 1u) * nx) xb_add(&bar[XB_TOPGEN], 1u);
            else XB_SPIN(xb_ld(&bar[XB_TOPGEN]) == tg, bar);
            __builtin_amdgcn_fence(__ATOMIC_ACQUIRE, "agent");
            xb_add(&bar[XB_XGEN(b.x)], 1u);
            asm volatile("s_waitcnt vmcnt(0)" ::: "memory");
        } else {
            XB_SPIN(xb_ld(&bar[XB_XGEN(b.x)]) == gen, bar);
            __builtin_amdgcn_fence(__ATOMIC_ACQUIRE, "agent");
            asm volatile("s_waitcnt vmcnt(0)" ::: "memory");
        }
    }
    __syncthreads();
}

constexpr int T = 16384, DM = 2048, NP = 5888, NMEM = 256;
constexpr int NWAVES = 8, NTHR = 512;
constexpr float EPS = 1e-6f;
constexpr size_t MiB = 1u << 20;
constexpr size_t WS_CTL = 0, CTL_ZERO_BYTES = 65536;
constexpr size_t WS_WIN0 = 1 * MiB, WS_WIN1 = 24 * MiB, WS_WOUT0 = 47 * MiB, WS_WOUT1 = 55 * MiB, WS_WMKV = 63 * MiB, WS_WK1T = 71 * MiB, WS_WV1T = 73 * MiB;
constexpr size_t WS_MEMKV = 75 * MiB, WS_DEC = 76 * MiB, WS_KCMP = 77 * MiB, WS_VCMP = 77 * MiB + 512 * 1024, WS_SEL = 78 * MiB;
constexpr size_t WS_XN = 80 * MiB, WS_P = 144 * MiB, WS_STATE = 328 * MiB, WS_END = 472 * MiB;
constexpr size_t WS_MIX1 = WS_STATE;
constexpr size_t DO_MIX0 = 0, DO_OI = 64 * MiB;
constexpr int CR = 3072, CXQ = 4608, CXG = 5120, CGL = 5632;
constexpr int GQ = 0, GK = 768, GV = 1536;
constexpr int NQ = 0, NKC = 1536, NVC = 1792, NKS = 2048, NVS = 2304, NKW = 2560, NVW = 2816;
constexpr int RING_BYTES = 131072, LDSCTL_OFF = RING_BYTES, MISC_OFF = LDSCTL_OFF + 320, LDS_BYTES = 147456;
constexpr int N_PHASES = 12;

__device__ __forceinline__ float bf2f(bf16 v) { return __builtin_bit_cast(float, (unsigned)v << 16); }
__device__ __forceinline__ bf16 f2b(float f) { return (bf16)f2bf(f); }
__device__ __forceinline__ float wave_sum(float v) {
#pragma unroll
    for (int o = 1; o < 64; o <<= 1) v += __shfl_xor(v, o);
    return v;
}
__device__ __forceinline__ float silu_f(float x) { return x / (1.f + __expf(-x)); }
__device__ __forceinline__ float sigmoid_f(float x) { return 1.f / (1.f + __expf(-x)); }
__device__ __forceinline__ float logsigmoid_f(float x) { return fminf(x, 0.f) - log1pf(__expf(-fabsf(x))); }

__device__ __forceinline__ int win_src_col(int layer, int c) {
    const int ex = layer ? 36 : 16;
    if (c < 3072) return c;
    if (c < 5632) return c + ex;
    if (c < 5632 + ex) return c - 5632 + 3072;
    return -1;
}

__device__ __forceinline__ void transpose_item(const float* W, int ldw, int K, bf16* WT, int n0, int k0, int srcc, LAS float* scr, int lane) {
#pragma unroll 8
    for (int i = 0; i < 32; ++i) { const int kk = 2 * i + (lane >> 5); scr[kk * 33 + (lane & 31)] = (srcc >= 0) ? W[(size_t)(k0 + kk) * ldw + srcc] : 0.f; }
    LDS_WAIT(); asm volatile("" ::: "memory");
    const int c = lane & 7;
#pragma unroll
    for (int j = 0; j < 4; ++j) { const int n = (lane >> 3) + 8 * j; const LAS float* s = scr + (8 * c) * 33 + n;
        v4u o; o.x = pk2(s[0 * 33], s[1 * 33]); o.y = pk2(s[2 * 33], s[3 * 33]); o.z = pk2(s[4 * 33], s[5 * 33]); o.w = pk2(s[6 * 33], s[7 * 33]);
        *(v4u*)(WT + (size_t)(n0 + n) * K + k0 + 8 * c) = o; }
    LDS_WAIT(); asm volatile("" ::: "memory");
}

__device__ __forceinline__ void rms_row_to_bf16(const float* xrow, const float* g, bf16* orow, int lane) {
    const f32x4* xr = (const f32x4*)xrow + lane; const f32x4* gr = (const f32x4*)g + lane;
    f32x4 v[8]; float s = 0.f;
#pragma unroll
    for (int j = 0; j < 8; ++j) { v[j] = xr[64 * j]; s += (v[j].x * v[j].x + v[j].y * v[j].y) + (v[j].z * v[j].z + v[j].w * v[j].w); }
    const float rstd = rsqrtf(wave_sum(s) * (1.f / DM) + EPS);
    unsigned long long* o8 = (unsigned long long*)orow + lane;
#pragma unroll
    for (int j = 0; j < 8; ++j) { const f32x4 gg = gr[64 * j];
        o8[64 * j] = (unsigned long long)pk2(v[j].x * rstd * gg.x, v[j].y * rstd * gg.y) | ((unsigned long long)pk2(v[j].z * rstd * gg.z, v[j].w * rstd * gg.w) << 32); }
}

struct Args { const float* in[19]; float* out; unsigned char* ws; int ph_lo, ph_hi; };

struct Ctx {
    LAS unsigned char* lds;
    int tid, lane, wave, G, gw, NGW;
    const float *x, *mem, *ln_pre, *ln_post, *ln_mem, *w_mem_kv, *gla_w_in, *gla_w_gate, *gla_b_gate, *gla_norm, *gla_w_out;
    const float *nsa_w_in, *pe_k, *pe_v, *wk1, *wk2, *wv1, *wv2, *nsa_w_out;
    float* out; unsigned char* ws;
    bf16 *WIN0, *WIN1, *WOUT0, *WOUT1, *WMKV, *MEMKV, *KCMP, *VCMP, *XN, *P, *STATE, *MIX0, *MIX1, *OI;
    float* DEC;
};

__device__ __forceinline__ void phase_prep(Ctx& F) {
    LAS float* scr = (LAS float*)(F.lds + F.wave * 16384);
    constexpr int I_WIN = 32 * 184, I_WOUT = 32 * 64, I_MKV = 32 * 32;
    constexpr int NITEMS = 2 * I_WIN + 2 * I_WOUT + 2 * I_MKV;
    for (int it = F.gw; it < NITEMS; it += F.NGW) {
        int r = it;
        if (r < 2 * I_WIN) { const int layer = r / I_WIN; r -= layer * I_WIN; const int kb = r / 184, nb = r % 184;
            const int srcc = win_src_col(layer, nb * 32 + (F.lane & 31));
            transpose_item(layer ? F.nsa_w_in : F.gla_w_in, layer ? 5668 : 5648, DM, layer ? F.WIN1 : F.WIN0, nb * 32, kb * 64, srcc, scr, F.lane); continue; }
        r -= 2 * I_WIN;
        if (r < 2 * I_WOUT) { const int layer = r / I_WOUT; r -= layer * I_WOUT; const int kb = r / 64, nb = r % 64;
            transpose_item(layer ? F.nsa_w_out : F.gla_w_out, DM, DM, layer ? F.WOUT1 : F.WOUT0, nb * 32, kb * 64, nb * 32 + (F.lane & 31), scr, F.lane); continue; }
        r -= 2 * I_WOUT;
        { const int layer = r / I_MKV; r -= layer * I_MKV; const int kb = r / 32, nb = r % 32;
            transpose_item(F.w_mem_kv + (size_t)layer * DM * 1024, 1024, DM, F.WMKV + (size_t)layer * 1024 * DM, nb * 32, kb * 64, nb * 32 + (F.lane & 31), scr, F.lane); }
    }
    for (int m = F.gw; m < T; m += F.NGW) rms_row_to_bf16(F.x + (size_t)m * DM, F.ln_pre, F.XN + (size_t)m * DM, F.lane);
}

__device__ __forceinline__ void memkv_naive(Ctx& F) {
    const int gt = blockIdx.x * NTHR + F.tid, NT = F.G * NTHR;
    for (int o = gt; o < 2 * NMEM * 1024; o += NT) {
        const int layer = o >> 18, m = (o >> 10) & 255, n = o & 1023;
        const float* mr = F.mem + (size_t)m * DM; const float* g = F.ln_mem + layer * DM; const float* W = F.w_mem_kv + (size_t)layer * DM * 1024 + n;
        float ss = 0.f, acc = 0.f;
        for (int k = 0; k < DM; ++k) { const float a = mr[k]; ss += a * a; acc += a * g[k] * W[(size_t)k * 1024]; }
        const float v = acc * rsqrtf(ss * (1.f / DM) + EPS);
        const int kv = n >> 9, h = (n >> 7) & 3, d = n & 127;
        F.MEMKV[((((size_t)layer * 2 + kv) * 4 + h) * NMEM + m) * 128 + d] = f2b(v);
    }
}

__device__ __forceinline__ void cross_naive(Ctx& F, int layer, bf16* MIX) {
    const float scale = 0.08838834764831845f;
    for (int u = F.gw; u < T * 4; u += F.NGW) {
        const int t = u >> 2, h = u & 3;
        const bf16* pr = F.P + (size_t)t * NP;
        const unsigned qq = *(const unsigned*)(pr + CXQ + h * 128 + 2 * F.lane);
        const float q0 = bf2f((bf16)(qq & 0xffff)) * scale, q1 = bf2f((bf16)(qq >> 16)) * scale;
        const bf16* Kb = F.MEMKV + (((size_t)layer * 2 + 0) * 4 + h) * NMEM * 128;
        const bf16* Vb = F.MEMKV + (((size_t)layer * 2 + 1) * 4 + h) * NMEM * 128;
        float m = -1e30f, l = 0.f, o0 = 0.f, o1 = 0.f;
        for (int j = 0; j < NMEM; ++j) {
            const unsigned kk = *(const unsigned*)(Kb + j * 128 + 2 * F.lane), vv = *(const unsigned*)(Vb + j * 128 + 2 * F.lane);
            const float s = wave_sum(q0 * bf2f((bf16)(kk & 0xffff)) + q1 * bf2f((bf16)(kk >> 16)));
            const float mn = fmaxf(m, s), a = __expf(m - mn), p = __expf(s - mn);
            l = l * a + p; o0 = o0 * a + p * bf2f((bf16)(vv & 0xffff)); o1 = o1 * a + p * bf2f((bf16)(vv >> 16)); m = mn;
        }
        const unsigned gg = *(const unsigned*)(pr + CXG + h * 128 + 2 * F.lane);
        const float r0 = o0 / l * silu_f(bf2f((bf16)(gg & 0xffff))), r1 = o1 / l * silu_f(bf2f((bf16)(gg >> 16)));
        *(unsigned*)(MIX + (size_t)t * DM + 1536 + h * 128 + 2 * F.lane) = pk2(r0, r1);
    }
}

__device__ __forceinline__ void gla_g1_naive(Ctx& F) {
    LAS float* bcum = (LAS float*)(F.lds);
    LAS float* Aat = (LAS float*)(F.lds + 49152);
    LAS float* glr = (LAS float*)(F.lds + 65536);
    LAS float* blast = (LAS float*)(F.lds + 69632);
    const float qscale = 0.07216878364870323f;
    for (int u = blockIdx.x; u < 1024; u += F.G) {
        const int n = u >> 2, h = u & 3; const size_t row0 = (size_t)n * 64;
        for (int i = F.tid; i < 1024; i += NTHR) glr[i] = bf2f(F.P[(row0 + (i >> 4)) * NP + CGL + (i & 15)]);
        __syncthreads();
        if (F.tid < 192) {
            const int d = F.tid, col = h * 192 + d; float wg[16];
#pragma unroll
            for (int j = 0; j < 16; ++j) wg[j] = F.gla_w_gate[j * 768 + col];
            const float bias = F.gla_b_gate[col]; float b = 0.f;
            for (int c = 0; c < 64; ++c) { float gl = bias;
#pragma unroll
                for (int j = 0; j < 16; ++j) gl += glr[c * 16 + j] * wg[j];
                b += logsigmoid_f(gl) * (1.f / 16.f); bcum[c * 192 + d] = b; }
            blast[d] = b; F.DEC[n * 768 + col] = __expf(b);
        }
        __syncthreads();
        for (int i = 0; i < 8; ++i) { const int idx = F.tid + NTHR * i, c = idx >> 6, s = idx & 63; float a = 0.f;
            if (s <= c) { const bf16* qp = F.P + (row0 + c) * NP + GQ + h * 192; const bf16* kp = F.P + (row0 + s) * NP + GK + h * 192;
                for (int d = 0; d < 192; ++d) a += bf2f(qp[d]) * bf2f(kp[d]) * __expf(bcum[c * 192 + d] - bcum[s * 192 + d]);
                a *= qscale; }
            Aat[idx] = a; }
        __syncthreads();
        for (int i = 0; i < 48; ++i) { const int idx = F.tid + NTHR * i, c = idx / 384, e = idx % 384; float a = 0.f;
            for (int s = 0; s <= c; ++s) a += Aat[c * 64 + s] * bf2f(F.P[(row0 + s) * NP + GV + h * 384 + e]);
            F.OI[(row0 + c) * 1536 + h * 384 + e] = f2b(a); }
        for (int i = 0; i < 144; ++i) { const int idx = F.tid + NTHR * i, e = idx / 192, d = idx % 192; float a = 0.f; const float bl = blast[d];
            for (int c = 0; c < 64; ++c) a += bf2f(F.P[(row0 + c) * NP + GK + h * 192 + d]) * __expf(bl - bcum[c * 192 + d]) * bf2f(F.P[(row0 + c) * NP + GV + h * 384 + e]);
            F.STATE[((size_t)u * 384 + e) * 192 + d] = f2b(a); }
        __syncthreads();
        for (int i = 0; i < 24; ++i) { const int idx = F.tid + NTHR * i, c = idx / 192, d = idx % 192;
            bf16* qp = F.P + (row0 + c) * NP + GQ + h * 192 + d; *qp = f2b(bf2f(*qp) * qscale * __expf(bcum[c * 192 + d])); }
        __syncthreads();
    }
}

__device__ __forceinline__ void gla_scan(Ctx& F) {
    const int gt = blockIdx.x * NTHR + F.tid, NT = F.G * NTHR;
    constexpr int PER = 4 * 384 * 192;
    for (int item = gt; item < PER / 4; item += NT) {
        const int idx = item * 4, h = idx / (384 * 192), d0 = idx % 192;
        bf16* sp = F.STATE + idx; const float* dp = F.DEC + h * 192 + d0;
        float s0 = 0.f, s1 = 0.f, s2 = 0.f, s3 = 0.f;
        for (int n0 = 0; n0 < 256; n0 += 8) {
            unsigned long long u[8]; f32x4 dc[8];
#pragma unroll
            for (int j = 0; j < 8; ++j) { u[j] = *(const unsigned long long*)(sp + (size_t)(n0 + j) * PER); dc[j] = *(const f32x4*)(dp + (n0 + j) * 768); }
#pragma unroll
            for (int j = 0; j < 8; ++j) {
                const unsigned lo = (unsigned)u[j], hi = (unsigned)(u[j] >> 32);
                s0 = dc[j].x * s0 + bf2f((bf16)(lo & 0xffff)); s1 = dc[j].y * s1 + bf2f((bf16)(lo >> 16));
                s2 = dc[j].z * s2 + bf2f((bf16)(hi & 0xffff)); s3 = dc[j].w * s3 + bf2f((bf16)(hi >> 16));
                *(unsigned long long*)(sp + (size_t)(n0 + j) * PER) = (unsigned long long)pk2(s0, s1) | ((unsigned long long)pk2(s2, s3) << 32);
            }
        }
    }
}

__device__ __forceinline__ void gla_g3_naive(Ctx& F) {
    LAS float* o = (LAS float*)(F.lds);
    LAS float* rs = (LAS float*)(F.lds + 98304);
    for (int u = blockIdx.x; u < 1024; u += F.G) {
        const int n = u >> 2, h = u & 3; const size_t row0 = (size_t)n * 64;
        for (int i = 0; i < 48; ++i) { const int idx = F.tid + NTHR * i, c = idx / 384, e = idx % 384;
            float a = bf2f(F.OI[(row0 + c) * 1536 + h * 384 + e]);
            if (n > 0) { const bf16* sp = F.STATE + ((size_t)(u - 4) * 384 + e) * 192; const bf16* qp = F.P + (row0 + c) * NP + GQ + h * 192;
                for (int d = 0; d < 192; ++d) a += bf2f(qp[d]) * bf2f(sp[d]); }
            o[idx] = a; }
        __syncthreads();
        for (int c = F.wave; c < 64; c += NWAVES) { float ss = 0.f;
            for (int e = F.lane; e < 384; e += 64) { const float v = o[c * 384 + e]; ss += v * v; }
            ss = wave_sum(ss); if (F.lane == 0) rs[c] = rsqrtf(ss * (1.f / 384.f) + EPS); }
        __syncthreads();
        for (int i = 0; i < 48; ++i) { const int idx = F.tid + NTHR * i, c = idx / 384, e = idx % 384;
            const float v = o[idx] * rs[c] * F.gla_norm[e]; const float r = bf2f(F.P[(row0 + c) * NP + CR + h * 384 + e]);
            F.MIX0[(row0 + c) * DM + h * 384 + e] = f2b(v * silu_f(r)); }
        __syncthreads();
    }
}

__device__ __forceinline__ void post_rows(Ctx& F, const float* hin, const bf16* Y, const float* gpost, float* hout, const float* gpre, bf16* XNo) {
    for (int m = F.gw; m < T; m += F.NGW) {
        const v4u* yr = (const v4u*)(Y + (size_t)m * DM) + F.lane;
        float y[32]; float ss = 0.f;
#pragma unroll
        for (int j = 0; j < 4; ++j) { const v4u w = yr[64 * j];
            const unsigned ww[4] = {w.x, w.y, w.z, w.w};
#pragma unroll
            for (int q = 0; q < 4; ++q) { y[j * 8 + 2 * q] = bf2f((bf16)(ww[q] & 0xffff)); y[j * 8 + 2 * q + 1] = bf2f((bf16)(ww[q] >> 16)); } }
#pragma unroll
        for (int i = 0; i < 32; ++i) ss += y[i] * y[i];
        const float rstd = rsqrtf(wave_sum(ss) * (1.f / DM) + EPS);
        float hn[32]; float s2 = 0.f;
#pragma unroll
        for (int j = 0; j < 4; ++j) {
#pragma unroll
            for (int q = 0; q < 2; ++q) { const int col = j * 512 + F.lane * 8 + q * 4;
                const f32x4 hv = *(const f32x4*)(hin + (size_t)m * DM + col); const f32x4 gp = *(const f32x4*)(gpost + col);
                f32x4 r; r.x = hv.x + y[j * 8 + q * 4 + 0] * rstd * gp.x; r.y = hv.y + y[j * 8 + q * 4 + 1] * rstd * gp.y; r.z = hv.z + y[j * 8 + q * 4 + 2] * rstd * gp.z; r.w = hv.w + y[j * 8 + q * 4 + 3] * rstd * gp.w;
                *(f32x4*)(hout + (size_t)m * DM + col) = r;
                hn[j * 8 + q * 4 + 0] = r.x; hn[j * 8 + q * 4 + 1] = r.y; hn[j * 8 + q * 4 + 2] = r.z; hn[j * 8 + q * 4 + 3] = r.w;
                s2 += (r.x * r.x + r.y * r.y) + (r.z * r.z + r.w * r.w); } }
        if (gpre) {
            const float rstd2 = rsqrtf(wave_sum(s2) * (1.f / DM) + EPS);
#pragma unroll
            for (int j = 0; j < 4; ++j) { const int col = j * 512 + F.lane * 8;
                const f32x4 g0 = *(const f32x4*)(gpre + col), g1 = *(const f32x4*)(gpre + col + 4);
                v4u w; w.x = pk2(hn[j * 8 + 0] * rstd2 * g0.x, hn[j * 8 + 1] * rstd2 * g0.y); w.y = pk2(hn[j * 8 + 2] * rstd2 * g0.z, hn[j * 8 + 3] * rstd2 * g0.w);
                w.z = pk2(hn[j * 8 + 4] * rstd2 * g1.x, hn[j * 8 + 5] * rstd2 * g1.y); w.w = pk2(hn[j * 8 + 6] * rstd2 * g1.z, hn[j * 8 + 7] * rstd2 * g1.w);
                *((v4u*)(XNo + (size_t)m * DM) + F.lane + 64 * j) = w; }
        }
    }
}

__device__ __forceinline__ void nsa_compress_naive(Ctx& F) {
    LAS float* blk = (LAS float*)(F.lds);
    LAS float* part = (LAS float*)(F.lds + 65536);
    LAS float* hid = (LAS float*)(F.lds + 73728);
    for (int u = blockIdx.x; u < 1024; u += F.G) {
        const int kv = u & 1, g = (u >> 1) & 1, nq = u >> 2;
        const float* pe = kv ? F.pe_v : F.pe_k; const float* w1 = kv ? F.wv1 : F.wk1; const float* w2 = kv ? F.wv2 : F.wk2;
        const int colb = (kv ? NVC : NKC) + g * 128;
        for (int i = 0; i < 32; ++i) { const int idx = F.tid + NTHR * i, r = idx >> 12, i4 = idx & 4095, l = i4 >> 7, d = i4 & 127; const int n = nq * 4 + r;
            float v = 0.f; if (n < 1023) v = bf2f(F.P[(size_t)(16 * n + l) * NP + colb + d]) + pe[l * 128 + d];
            blk[idx] = v; }
        __syncthreads();
        { const int j = F.tid & 255, ih = F.tid >> 8; float a0 = 0.f, a1 = 0.f, a2 = 0.f, a3 = 0.f;
            for (int i = ih * 2048; i < ih * 2048 + 2048; ++i) { const float w = w1[(size_t)i * 256 + j];
                a0 += blk[i] * w; a1 += blk[4096 + i] * w; a2 += blk[8192 + i] * w; a3 += blk[12288 + i] * w; }
            part[(ih * 4 + 0) * 256 + j] = a0; part[(ih * 4 + 1) * 256 + j] = a1; part[(ih * 4 + 2) * 256 + j] = a2; part[(ih * 4 + 3) * 256 + j] = a3; }
        __syncthreads();
        for (int i = F.tid; i < 1024; i += NTHR) hid[i] = silu_f(part[i] + part[1024 + i]);
        __syncthreads();
        { const int d = F.tid & 127, r = F.tid >> 7; const int n = nq * 4 + r; float a = 0.f;
            for (int j = 0; j < 256; ++j) a += hid[r * 256 + j] * w2[j * 128 + d];
            if (n < 1023) (kv ? F.VCMP : F.KCMP)[((size_t)g * 1024 + n) * 128 + d] = f2b(a); }
        __syncthreads();
    }
}

__device__ __forceinline__ void nsa_main_naive(Ctx& F) {
    const float scale = 0.08838834764831845f;
    LAS float* ocs = (LAS float*)(F.lds + F.wave * 4096);
    const int lane = F.lane;
    for (int u = F.gw; u < T * 2; u += F.NGW) {
        const int t = u >> 1, g = u & 1; const bf16* pr = F.P + (size_t)t * NP;
        const int ncv = (t >= 31) ? min((t - 31) / 16 + 1, 1023) : 0;
        const bf16* Kc = F.KCMP + (size_t)g * 1024 * 128; const bf16* Vc = F.VCMP + (size_t)g * 1024 * 128;
        float imp0 = 0.f, imp1 = 0.f, imp2 = 0.f, imp3 = 0.f;
        for (int h = 0; h < 6; ++h) {
            const unsigned qq = *(const unsigned*)(pr + NQ + (g * 6 + h) * 128 + 2 * lane);
            const float q0 = bf2f((bf16)(qq & 0xffff)) * scale, q1 = bf2f((bf16)(qq >> 16)) * scale;
            float m = -1e30f, l = 0.f, o0 = 0.f, o1 = 0.f;
            for (int c = 0; c < ncv; ++c) {
                const unsigned kk = *(const unsigned*)(Kc + c * 128 + 2 * lane), vv = *(const unsigned*)(Vc + c * 128 + 2 * lane);
                const float s = wave_sum(q0 * bf2f((bf16)(kk & 0xffff)) + q1 * bf2f((bf16)(kk >> 16)));
                const float mn = fmaxf(m, s), a = __expf(m - mn), p = __expf(s - mn);
                l = l * a + p; o0 = o0 * a + p * bf2f((bf16)(vv & 0xffff)); o1 = o1 * a + p * bf2f((bf16)(vv >> 16)); m = mn;
            }
            const float gate = sigmoid_f(bf2f(pr[CGL + g * 18 + h * 3 + 0]));
            const float il = (ncv > 0) ? 1.f / l : 0.f;
            ocs[h * 128 + 2 * lane] = gate * o0 * il; ocs[h * 128 + 2 * lane + 1] = gate * o1 * il;
            for (int c = 0; c < ncv; ++c) {
                const unsigned kk = *(const unsigned*)(Kc + c * 128 + 2 * lane);
                const float s = wave_sum(q0 * bf2f((bf16)(kk & 0xffff)) + q1 * bf2f((bf16)(kk >> 16)));
                const float p = __expf(s - m) * il;
                const int ja = c >> 2, jb = (c + 1) >> 2;
                { const int jj = lane;       if (jj == ja || jj == jb) imp0 += p; }
                { const int jj = lane + 64;  if (jj == ja || jj == jb) imp1 += p; }
                { const int jj = lane + 128; if (jj == ja || jj == jb) imp2 += p; }
                { const int jj = lane + 192; if (jj == ja || jj == jb) imp3 += p; }
            }
        }
        const int cur = t >> 6;
        float iv[4] = {imp0, imp1, imp2, imp3};
#pragma unroll
        for (int i = 0; i < 4; ++i) { const int jj = lane + 64 * i; if (jj == 0 || jj == cur || jj == cur - 1) iv[i] = 1e4f; if (jj > cur) iv[i] = -1e4f; }
        int mysel = 0;
#pragma unroll
        for (int r = 0; r < 16; ++r) {
            float bv = iv[0]; int bi = lane;
#pragma unroll
            for (int i = 1; i < 4; ++i) { if (iv[i] > bv) { bv = iv[i]; bi = lane + 64 * i; } }
#pragma unroll
            for (int o = 1; o < 64; o <<= 1) { const float ov = __shfl_xor(bv, o); const int oi = __shfl_xor(bi, o); if (ov > bv || (ov == bv && oi < bi)) { bv = ov; bi = oi; } }
            mysel = (lane == r) ? bi : mysel;
#pragma unroll
            for (int i = 0; i < 4; ++i) if (lane + 64 * i == bi) iv[i] = -3e38f;
        }
        for (int h = 0; h < 6; ++h) {
            const unsigned qq = *(const unsigned*)(pr + NQ + (g * 6 + h) * 128 + 2 * lane);
            const float q0 = bf2f((bf16)(qq & 0xffff)) * scale, q1 = bf2f((bf16)(qq >> 16)) * scale;
            float m = -1e30f, l = 0.f, o0 = 0.f, o1 = 0.f;
            for (int r = 0; r < 16; ++r) { const int j = __shfl(mysel, r); if (j > cur) continue;
                const int kend = min(64, t - 64 * j + 1);
                for (int i = 0; i < kend; ++i) { const bf16* kr = F.P + (size_t)(64 * j + i) * NP;
                    const unsigned kk = *(const unsigned*)(kr + NKS + g * 128 + 2 * lane), vv = *(const unsigned*)(kr + NVS + g * 128 + 2 * lane);
                    const float s = wave_sum(q0 * bf2f((bf16)(kk & 0xffff)) + q1 * bf2f((bf16)(kk >> 16)));
                    const float mn = fmaxf(m, s), a = __expf(m - mn), p = __expf(s - mn);
                    l = l * a + p; o0 = o0 * a + p * bf2f((bf16)(vv & 0xffff)); o1 = o1 * a + p * bf2f((bf16)(vv >> 16)); m = mn; } }
            const float gs = sigmoid_f(bf2f(pr[CGL + g * 18 + h * 3 + 1]));
            float r0 = ocs[h * 128 + 2 * lane] + gs * o0 / l, r1 = ocs[h * 128 + 2 * lane + 1] + gs * o1 / l;
            m = -1e30f; l = 0.f; o0 = 0.f; o1 = 0.f;
            for (int p0 = max(0, t - 511); p0 <= t; ++p0) { const bf16* kr = F.P + (size_t)p0 * NP;
                const unsigned kk = *(const unsigned*)(kr + NKW + g * 128 + 2 * lane), vv = *(const unsigned*)(kr + NVW + g * 128 + 2 * lane);
                const float s = wave_sum(q0 * bf2f((bf16)(kk & 0xffff)) + q1 * bf2f((bf16)(kk >> 16)));
                const float mn = fmaxf(m, s), a = __expf(m - mn), p = __expf(s - mn);
                l = l * a + p; o0 = o0 * a + p * bf2f((bf16)(vv & 0xffff)); o1 = o1 * a + p * bf2f((bf16)(vv >> 16)); m = mn; }
            const float gw_ = sigmoid_f(bf2f(pr[CGL + g * 18 + h * 3 + 2]));
            r0 += gw_ * o0 / l; r1 += gw_ * o1 / l;
            const unsigned rr = *(const unsigned*)(pr + CR + (g * 6 + h) * 128 + 2 * lane);
            r0 *= silu_f(bf2f((bf16)(rr & 0xffff))); r1 *= silu_f(bf2f((bf16)(rr >> 16)));
            *(unsigned*)(F.MIX1 + (size_t)t * DM + (g * 6 + h) * 128 + 2 * lane) = pk2(r0, r1);
        }
    }
}


typedef short v4i16_t __attribute__((ext_vector_type(4)));
typedef short s16x4 __attribute__((ext_vector_type(4)));
__device__ __forceinline__ s16x4 vtr(const LAS unsigned char* p) { return __builtin_bit_cast(s16x4, __builtin_amdgcn_ds_read_tr16_b64_v4i16((LAS v4i16_t*)p)); }
constexpr int KROW = 288, ATT_TILE = 64 * KROW, ATT_BUF = 2 * ATT_TILE;
constexpr float LOG2E = 1.4426950408889634f;

struct ImpArgs { float gate0, gate1; bool hvalid; LAS float* imp; };
template <int MODE, class Src, class Mask>
__device__ __forceinline__ void attn_pass(Ctx& F, LAS unsigned char* base, const bf16x8 (&Q)[2][4], f32x4 (&O)[2][8], float (&m)[2], float (&l)[2],
                                          const int k0, const int nt, const Src& src, const Mask& mask, const int tok0, const int tok1, const float sl2, const ImpArgs ia = ImpArgs{0.f, 0.f, false, nullptr}) {
    int tidv = F.tid; asm volatile("" : "+v"(tidv));
    const int lane = tidv & 63, c16 = lane & 15, g = lane >> 4;
    const int r0 = tidv >> 4, ch = tidv & 15;
    v4u kr[2], vr[2];
    __syncthreads();
#pragma unroll
    for (int i = 0; i < 2; ++i) { const int key = k0 + r0 + 32 * i; kr[i] = *(const v4u*)(src.kptr(key) + ch * 8); if (MODE != 1) vr[i] = *(const v4u*)(src.vptr(key) + ch * 8); }
#pragma unroll
    for (int i = 0; i < 2; ++i) { *(LAS v4u*)(base + (r0 + 32 * i) * KROW + ch * 16) = kr[i]; if (MODE != 1) *(LAS v4u*)(base + ATT_TILE + (r0 + 32 * i) * KROW + ch * 16) = vr[i]; }
    __syncthreads();
    float carry0 = 0.f, carry1 = 0.f;
    for (int j = 0; j < nt; ++j) {
        const LAS unsigned char* Kb = base + (j & 1) * ATT_BUF; const LAS unsigned char* Vb = Kb + ATT_TILE;
        const bool more = (j + 1 < nt);
        if (more) {
#pragma unroll
            for (int i = 0; i < 2; ++i) { const int key = k0 + 64 * (j + 1) + r0 + 32 * i; kr[i] = *(const v4u*)(src.kptr(key) + ch * 8); if (MODE != 1) vr[i] = *(const v4u*)(src.vptr(key) + ch * 8); }
        }
#pragma unroll
        for (int s32 = 0; s32 < 2; ++s32) {
            f32x4 sc[2][2];
#pragma unroll
            for (int rt = 0; rt < 2; ++rt)
#pragma unroll
                for (int st = 0; st < 2; ++st) sc[rt][st] = (f32x4){0.f, 0.f, 0.f, 0.f};
#pragma unroll
            for (int st = 0; st < 2; ++st) {
                bf16x8 kf[4];
#pragma unroll
                for (int kd = 0; kd < 4; ++kd) kf[kd] = *(const LAS bf16x8*)(Kb + (s32 * 32 + st * 16 + c16) * KROW + (g * 8 + kd * 32) * 2);
#pragma unroll
                for (int kd = 0; kd < 4; ++kd) {
                    sc[0][st] = __builtin_amdgcn_mfma_f32_16x16x32_bf16(kf[kd], Q[0][kd], sc[0][st], 0, 0, 0);
                    sc[1][st] = __builtin_amdgcn_mfma_f32_16x16x32_bf16(kf[kd], Q[1][kd], sc[1][st], 0, 0, 0);
                }
            }
            bf16x8 pf[2];
#pragma unroll
            for (int rt = 0; rt < 2; ++rt) {
                const int tk = rt ? tok1 : tok0;
                float v[8]; bool ok[8]; float mx = -1e30f;
#pragma unroll
                for (int st = 0; st < 2; ++st)
#pragma unroll
                    for (int r = 0; r < 4; ++r) { const int kidx = k0 + 64 * j + s32 * 32 + st * 16 + g * 4 + r;
                        ok[st * 4 + r] = mask(tk, kidx); v[st * 4 + r] = ok[st * 4 + r] ? sc[rt][st][r] * sl2 : -1e30f; mx = fmaxf(mx, v[st * 4 + r]); }
                if (MODE != 2) {
                    mx = fmaxf(mx, __shfl_xor(mx, 16)); mx = fmaxf(mx, __shfl_xor(mx, 32));
                    const float mn = fmaxf(m[rt], mx), alpha = __builtin_amdgcn_exp2f(m[rt] - mn); m[rt] = mn;
                    float ps = 0.f;
#pragma unroll
                    for (int i = 0; i < 8; ++i) { v[i] = ok[i] ? __builtin_amdgcn_exp2f(v[i] - mn) : 0.f; ps += v[i]; }
                    l[rt] = l[rt] * alpha + ps;
                    if (MODE == 0) {
#pragma unroll
                        for (int dt = 0; dt < 8; ++dt) O[rt][dt] = O[rt][dt] * alpha;
                    }
                } else {
                    const float mn = m[rt], linv = ia.hvalid ? l[rt] : 0.f, gt = rt ? ia.gate1 : ia.gate0;
#pragma unroll
                    for (int i = 0; i < 8; ++i) v[i] = ok[i] ? __builtin_amdgcn_exp2f(v[i] - mn) * linv : 0.f;
                    float s40 = (v[0] + v[1]) + (v[2] + v[3]), s41 = (v[4] + v[5]) + (v[6] + v[7]), la0 = v[3], la1 = v[7];
#pragma unroll
                    for (int o = 1; o < 8; o <<= 1) { s40 += __shfl_xor(s40, o); s41 += __shfl_xor(s41, o); la0 += __shfl_xor(la0, o); la1 += __shfl_xor(la1, o); }
                    const float pl0 = __shfl(la0, (lane + 48) & 63), pl1 = __shfl(la1, (lane + 48) & 63);
                    const float cprev = rt ? carry1 : carry0;
                    const float i0 = s40 + (g > 0 ? pl0 : cprev), i1 = s41 + (g > 0 ? pl1 : pl0);
                    if (rt) carry1 = pl1; else carry0 = pl1;
                    if ((lane & 7) == 0) { const int jb = ((k0 + 64 * j) >> 2) + 8 * s32 + g; LAS float* ip = ia.imp + (rt * 2 + (c16 >> 3)) * 256 + jb; ip[0] = i0; ip[4] = i1; }
#pragma unroll
                    for (int i = 0; i < 8; ++i) v[i] *= gt;
                }
                if (MODE != 1) { v4u pw; pw.x = pk2(v[0], v[1]); pw.y = pk2(v[2], v[3]); pw.z = pk2(v[4], v[5]); pw.w = pk2(v[6], v[7]);
                    pf[rt] = __builtin_bit_cast(bf16x8, pw); }
            }
            if (MODE != 1) {
#pragma unroll
            for (int dt = 0; dt < 8; ++dt) {
                const LAS unsigned char* vp = Vb + (s32 * 32 + g * 4 + (c16 >> 2)) * KROW + (dt * 16 + 4 * (c16 & 3)) * 2;
                const s16x4 lo = vtr(vp), hi = vtr(vp + 16 * KROW);
                const bf16x8 vf = {lo[0], lo[1], lo[2], lo[3], hi[0], hi[1], hi[2], hi[3]};
                O[0][dt] = __builtin_amdgcn_mfma_f32_16x16x32_bf16(vf, pf[0], O[0][dt], 0, 0, 0);
                O[1][dt] = __builtin_amdgcn_mfma_f32_16x16x32_bf16(vf, pf[1], O[1][dt], 0, 0, 0);
            }
            }
        }
        if (more) {
            LAS unsigned char* nb = base + ((j + 1) & 1) * ATT_BUF;
#pragma unroll
            for (int i = 0; i < 2; ++i) { *(LAS v4u*)(nb + (r0 + 32 * i) * KROW + ch * 16) = kr[i]; if (MODE != 1) *(LAS v4u*)(nb + ATT_TILE + (r0 + 32 * i) * KROW + ch * 16) = vr[i]; }
        }
        __syncthreads();
    }
}

struct SrcMem { const bf16* K; const bf16* V;
    __device__ __forceinline__ const bf16* kptr(int key) const { return K + (size_t)min(key, NMEM - 1) * 128; }
    __device__ __forceinline__ const bf16* vptr(int key) const { return V + (size_t)min(key, NMEM - 1) * 128; } };
struct MaskNone { __device__ __forceinline__ bool operator()(int, int) const { return true; } };

__device__ __forceinline__ void cross_fast(Ctx& F, int layer, bf16* MIX) {
    const int lane = F.lane, c16 = lane & 15, g = lane >> 4;
    for (int u = blockIdx.x; u < 256; u += F.G) {
        const int h = u & 3, tb = u >> 2;
        int tok[2]; bf16x8 Q[2][4]; f32x4 O[2][8]; float m[2], l[2];
#pragma unroll
        for (int rt = 0; rt < 2; ++rt) { tok[rt] = tb * 256 + F.wave * 32 + rt * 16 + c16; m[rt] = -1e30f; l[rt] = 0.f;
#pragma unroll
            for (int kd = 0; kd < 4; ++kd) Q[rt][kd] = *(const bf16x8*)(F.P + (size_t)tok[rt] * NP + CXQ + h * 128 + g * 8 + kd * 32);
#pragma unroll
            for (int dt = 0; dt < 8; ++dt) O[rt][dt] = (f32x4){0.f, 0.f, 0.f, 0.f}; }
        SrcMem src{F.MEMKV + (((size_t)layer * 2 + 0) * 4 + h) * NMEM * 128, F.MEMKV + (((size_t)layer * 2 + 1) * 4 + h) * NMEM * 128};
        attn_pass<0>(F, F.lds, Q, O, m, l, 0, 4, src, MaskNone(), tok[0], tok[1], 0.08838834764831845f * LOG2E);
#pragma unroll
        for (int rt = 0; rt < 2; ++rt) {
            float lt = l[rt]; lt += __shfl_xor(lt, 16); lt += __shfl_xor(lt, 32);
            const float inv = 1.f / lt;
#pragma unroll
            for (int dt = 0; dt < 8; ++dt) { const int d = dt * 16 + g * 4;
                const unsigned long long xg = *(const unsigned long long*)(F.P + (size_t)tok[rt] * NP + CXG + h * 128 + d);
                const unsigned lo = (unsigned)xg, hi = (unsigned)(xg >> 32);
                const float o0 = O[rt][dt][0] * inv * silu_f(bf2f((bf16)(lo & 0xffff))), o1 = O[rt][dt][1] * inv * silu_f(bf2f((bf16)(lo >> 16)));
                const float o2 = O[rt][dt][2] * inv * silu_f(bf2f((bf16)(hi & 0xffff))), o3 = O[rt][dt][3] * inv * silu_f(bf2f((bf16)(hi >> 16)));
                *(unsigned long long*)(MIX + (size_t)tok[rt] * DM + 1536 + h * 128 + d) = (unsigned long long)pk2(o0, o1) | ((unsigned long long)pk2(o2, o3) << 32); }
        }
    }
}


struct SrcWin { const bf16* P; int g;
    __device__ __forceinline__ const bf16* kptr(int key) const { return P + (size_t)min(max(key, 0), T - 1) * NP + NKW + g * 128; }
    __device__ __forceinline__ const bf16* vptr(int key) const { return P + (size_t)min(max(key, 0), T - 1) * NP + NVW + g * 128; } };
struct MaskWin { __device__ __forceinline__ bool operator()(int t, int key) const { return key <= t && key > t - 512; } };
struct SrcCmp { const bf16* K; const bf16* V;
    __device__ __forceinline__ const bf16* kptr(int key) const { return K + (size_t)min(key, 1022) * 128; }
    __device__ __forceinline__ const bf16* vptr(int key) const { return V + (size_t)min(key, 1022) * 128; } };
struct MaskCmp { __device__ __forceinline__ bool operator()(int t, int key) const { return 16 * key + 31 <= t; } };

__device__ __forceinline__ void nsa_main_fast(Ctx& F) {
    const int lane = F.lane, c16 = lane & 15, gq = lane >> 4, ts = c16 >> 3, hs = c16 & 7; const bool hv = hs < 6;
    const float sl2 = 0.08838834764831845f * LOG2E;
    LAS float* imp = (LAS float*)(F.lds + 73728) + F.wave * 1024;
    LAS unsigned char* vbuf = F.lds + F.wave * 9216;
    for (int u = blockIdx.x; u < 1024; u += F.G) {
        const int g = u & 1, tb = u >> 1;
        int tok[2]; f32x4 O[2][8];
        {
            bf16x8 Q[2][4]; float m[2], l[2], gw[2], gc[2];
#pragma unroll
            for (int rt = 0; rt < 2; ++rt) { tok[rt] = tb * 32 + F.wave * 4 + rt * 2 + ts; m[rt] = -1e30f; l[rt] = 0.f;
                const bf16* pr = F.P + (size_t)tok[rt] * NP;
#pragma unroll
                for (int kd = 0; kd < 4; ++kd) { Q[rt][kd] = (bf16x8){0, 0, 0, 0, 0, 0, 0, 0}; if (hv) Q[rt][kd] = *(const bf16x8*)(pr + NQ + (g * 6 + hs) * 128 + gq * 8 + kd * 32); }
                gw[rt] = hv ? sigmoid_f(bf2f(pr[CGL + g * 18 + hs * 3 + 2])) : 0.f; gc[rt] = hv ? sigmoid_f(bf2f(pr[CGL + g * 18 + hs * 3 + 0])) : 0.f;
#pragma unroll
                for (int dt = 0; dt < 8; ++dt) O[rt][dt] = (f32x4){0.f, 0.f, 0.f, 0.f}; }
            { const int klo = max(0, tb * 32 - 511), k0 = (klo >> 6) << 6, nt = ((tb * 32 + 31 - k0) >> 6) + 1;
              attn_pass<0>(F, F.lds, Q, O, m, l, k0, nt, SrcWin{F.P, g}, MaskWin(), tok[0], tok[1], sl2); }
#pragma unroll
            for (int rt = 0; rt < 2; ++rt) { float lt = l[rt]; lt += __shfl_xor(lt, 16); lt += __shfl_xor(lt, 32); const float f = gw[rt] / lt;
#pragma unroll
                for (int dt = 0; dt < 8; ++dt) O[rt][dt] = O[rt][dt] * f; m[rt] = -1e30f; l[rt] = 0.f; }
            const int tlast = tb * 32 + 31, ncv = (tlast - 31) / 16 + 1, ntc = (ncv + 63) >> 6;
            SrcCmp sc_{F.KCMP + (size_t)g * 1024 * 128, F.VCMP + (size_t)g * 1024 * 128};
            attn_pass<1>(F, F.lds, Q, O, m, l, 0, ntc, sc_, MaskCmp(), tok[0], tok[1], sl2);
#pragma unroll
            for (int rt = 0; rt < 2; ++rt) { float lt = l[rt]; lt += __shfl_xor(lt, 16); lt += __shfl_xor(lt, 32); l[rt] = lt > 0.f ? 1.f / lt : 0.f; }
            attn_pass<2>(F, F.lds, Q, O, m, l, 0, ntc, sc_, MaskCmp(), tok[0], tok[1], sl2, ImpArgs{gc[0], gc[1], hv, imp});
        }
#pragma unroll
        for (int rt = 0; rt < 2; ++rt) {
            for (int tss = 0; tss < 2; ++tss) {
                const int tt = tb * 32 + F.wave * 4 + rt * 2 + tss, cur = tt >> 6;
                int mysel = 0;
                { float iv[4];
#pragma unroll
                  for (int i = 0; i < 4; ++i) { const int jj = lane + 64 * i; iv[i] = imp[(rt * 2 + tss) * 256 + jj]; if (jj == 0 || jj == cur || jj == cur - 1) iv[i] = 1e4f; if (jj > cur) iv[i] = -1e4f; }
#pragma unroll
                  for (int r = 0; r < 16; ++r) {
                      float bv = iv[0]; int bi = lane;
#pragma unroll
                      for (int i = 1; i < 4; ++i) { if (iv[i] > bv) { bv = iv[i]; bi = lane + 64 * i; } }
#pragma unroll
                      for (int o = 1; o < 64; o <<= 1) { const float ov = __shfl_xor(bv, o); const int oi = __shfl_xor(bi, o); if (ov > bv || (ov == bv && oi < bi)) { bv = ov; bi = oi; } }
                      mysel = (lane == r) ? bi : mysel;
#pragma unroll
                      for (int i = 0; i < 4; ++i) if (lane + 64 * i == bi) iv[i] = -3e38f;
                  } }
                const bool mine = hv && (ts == tss);
                const bf16* pr = F.P + (size_t)tok[rt] * NP;
                bf16x8 qz[4];
#pragma unroll
                for (int kd = 0; kd < 4; ++kd) { qz[kd] = (bf16x8){0, 0, 0, 0, 0, 0, 0, 0}; if (mine) qz[kd] = *(const bf16x8*)(pr + NQ + (g * 6 + hs) * 128 + gq * 8 + kd * 32); }
                f32x4 O2[8]; float m2 = -1e30f, l2 = 0.f;
#pragma unroll
                for (int dt = 0; dt < 8; ++dt) O2[dt] = (f32x4){0.f, 0.f, 0.f, 0.f};
                const int nsteps = 2 * min(16, cur + 1);
                bf16x8 kf[2][4];
                const unsigned koff = (unsigned)((c16 * NP + NKS + g * 128 + gq * 8) * 2), voff = (unsigned)((gq * NP + NVS + g * 128 + c16 * 8) * 2);
                { const int kb = 64 * __builtin_amdgcn_readlane(mysel, 0); const char* ub = (const char*)F.P + (size_t)kb * (NP * 2);
#pragma unroll
                  for (int st = 0; st < 2; ++st)
#pragma unroll
                      for (int kd = 0; kd < 4; ++kd) kf[st][kd] = *(const bf16x8*)(ub + (size_t)st * (16 * NP * 2) + koff + kd * 64); }
                for (int s = 0; s < nsteps; ++s) {
                    const int kbase = 64 * __builtin_amdgcn_readlane(mysel, s >> 1) + 32 * (s & 1);
                    const char* ubv = (const char*)F.P + (size_t)kbase * (NP * 2);
                    f32x4 sc[2] = {(f32x4){0.f, 0.f, 0.f, 0.f}, (f32x4){0.f, 0.f, 0.f, 0.f}};
#pragma unroll
                    for (int st = 0; st < 2; ++st)
#pragma unroll
                        for (int kd = 0; kd < 4; ++kd) sc[st] = __builtin_amdgcn_mfma_f32_16x16x32_bf16(kf[st][kd], qz[kd], sc[st], 0, 0, 0);
                    { v4u vs[8];
#pragma unroll
                      for (int i = 0; i < 8; ++i) vs[i] = *(const v4u*)(ubv + (size_t)i * (4 * NP * 2) + voff);
#pragma unroll
                      for (int i = 0; i < 8; ++i) *(LAS v4u*)(vbuf + (gq + 4 * i) * KROW + c16 * 16) = vs[i]; }
                    if (s + 1 < nsteps) { const int kbn = 64 * __builtin_amdgcn_readlane(mysel, (s + 1) >> 1) + 32 * ((s + 1) & 1); const char* ub = (const char*)F.P + (size_t)kbn * (NP * 2);
#pragma unroll
                        for (int st = 0; st < 2; ++st)
#pragma unroll
                            for (int kd = 0; kd < 4; ++kd) kf[st][kd] = *(const bf16x8*)(ub + (size_t)st * (16 * NP * 2) + koff + kd * 64); }
                    float v[8]; bool ok[8]; float mx = -1e30f;
#pragma unroll
                    for (int st = 0; st < 2; ++st)
#pragma unroll
                        for (int r = 0; r < 4; ++r) { const int kidx = kbase + st * 16 + gq * 4 + r; ok[st * 4 + r] = kidx <= tt; v[st * 4 + r] = ok[st * 4 + r] ? sc[st][r] * sl2 : -1e30f; mx = fmaxf(mx, v[st * 4 + r]); }
                    mx = fmaxf(mx, __shfl_xor(mx, 16)); mx = fmaxf(mx, __shfl_xor(mx, 32));
                    const float mn = fmaxf(m2, mx), alpha = __builtin_amdgcn_exp2f(m2 - mn); m2 = mn;
                    float ps = 0.f;
#pragma unroll
                    for (int i = 0; i < 8; ++i) { v[i] = ok[i] ? __builtin_amdgcn_exp2f(v[i] - mn) : 0.f; ps += v[i]; }
                    l2 = l2 * alpha + ps;
#pragma unroll
                    for (int dt = 0; dt < 8; ++dt) O2[dt] = O2[dt] * alpha;
                    v4u pw; pw.x = pk2(v[0], v[1]); pw.y = pk2(v[2], v[3]); pw.z = pk2(v[4], v[5]); pw.w = pk2(v[6], v[7]);
                    const bf16x8 pf = __builtin_bit_cast(bf16x8, pw);
#pragma unroll
                    for (int dt = 0; dt < 8; ++dt) {
                        const LAS unsigned char* vp = vbuf + (gq * 4 + (c16 >> 2)) * KROW + (dt * 16 + 4 * (c16 & 3)) * 2;
                        const s16x4 lo = vtr(vp), hi = vtr(vp + 16 * KROW);
                        const bf16x8 vf = {lo[0], lo[1], lo[2], lo[3], hi[0], hi[1], hi[2], hi[3]};
                        O2[dt] = __builtin_amdgcn_mfma_f32_16x16x32_bf16(vf, pf, O2[dt], 0, 0, 0);
                    }
                }
                float lt = l2; lt += __shfl_xor(lt, 16); lt += __shfl_xor(lt, 32);
                const float f = mine ? sigmoid_f(bf2f(pr[CGL + g * 18 + hs * 3 + 1])) / lt : 0.f;
#pragma unroll
                for (int dt = 0; dt < 8; ++dt) O[rt][dt] = O[rt][dt] + O2[dt] * f;
            }
        }
        if (hv) {
#pragma unroll
            for (int rt = 0; rt < 2; ++rt) {
#pragma unroll
                for (int dt = 0; dt < 8; ++dt) { const int d = dt * 16 + gq * 4; const int col = (g * 6 + hs) * 128 + d;
                    const unsigned long long rr = *(const unsigned long long*)(F.P + (size_t)tok[rt] * NP + CR + col);
                    const unsigned lo = (unsigned)rr, hi = (unsigned)(rr >> 32);
                    const float o0 = O[rt][dt][0] * silu_f(bf2f((bf16)(lo & 0xffff))), o1 = O[rt][dt][1] * silu_f(bf2f((bf16)(lo >> 16)));
                    const float o2 = O[rt][dt][2] * silu_f(bf2f((bf16)(hi & 0xffff))), o3 = O[rt][dt][3] * silu_f(bf2f((bf16)(hi >> 16)));
                    *(unsigned long long*)(F.MIX1 + (size_t)tok[rt] * DM + col) = (unsigned long long)pk2(o0, o1) | ((unsigned long long)pk2(o2, o3) << 32); }
            }
        }
    }
}

__global__ void __launch_bounds__(NTHR, 2) fwd_kernel(Args args) {
    extern __shared__ __attribute__((aligned(16))) unsigned char lds_raw[];
    Ctx F;
    F.lds = (LAS unsigned char*)lds_raw;
    F.tid = threadIdx.x; F.lane = F.tid & 63; F.wave = __builtin_amdgcn_readfirstlane(F.tid >> 6);
    F.G = gridDim.x; F.gw = blockIdx.x * NWAVES + F.wave; F.NGW = F.G * NWAVES;
    F.x = args.in[0]; F.mem = args.in[1]; F.ln_pre = args.in[2]; F.ln_post = args.in[3]; F.ln_mem = args.in[4]; F.w_mem_kv = args.in[5];
    F.gla_w_in = args.in[6]; F.gla_w_gate = args.in[7]; F.gla_b_gate = args.in[8]; F.gla_norm = args.in[9]; F.gla_w_out = args.in[10];
    F.nsa_w_in = args.in[11]; F.pe_k = args.in[12]; F.pe_v = args.in[13]; F.wk1 = args.in[14]; F.wk2 = args.in[15]; F.wv1 = args.in[16]; F.wv2 = args.in[17]; F.nsa_w_out = args.in[18];
    F.out = args.out; F.ws = args.ws;
    unsigned char* ws = args.ws;
    F.WIN0 = (bf16*)(ws + WS_WIN0); F.WIN1 = (bf16*)(ws + WS_WIN1); F.WOUT0 = (bf16*)(ws + WS_WOUT0); F.WOUT1 = (bf16*)(ws + WS_WOUT1); F.WMKV = (bf16*)(ws + WS_WMKV);
    F.MEMKV = (bf16*)(ws + WS_MEMKV); F.DEC = (float*)(ws + WS_DEC); F.KCMP = (bf16*)(ws + WS_KCMP); F.VCMP = (bf16*)(ws + WS_VCMP);
    F.XN = (bf16*)(ws + WS_XN); F.P = (bf16*)(ws + WS_P); F.STATE = (bf16*)(ws + WS_STATE); F.MIX1 = (bf16*)(ws + WS_MIX1);
    F.MIX0 = (bf16*)((unsigned char*)args.out + DO_MIX0); F.OI = (bf16*)((unsigned char*)args.out + DO_OI);

    volatile LAS unsigned* MISC = (volatile LAS unsigned*)(F.lds + MISC_OFF);
    for (int u = F.tid; u < (LDS_BYTES - LDSCTL_OFF) / 4; u += NTHR) ((LAS unsigned*)(F.lds + LDSCTL_OFF))[u] = 0u;
    __syncthreads();
    const int lo = args.ph_lo, hi = args.ph_hi;
    XcdBarrier bar; bar.bar = (unsigned*)(ws + WS_CTL); bar.x = 0; bar.st = nullptr;
    if (hi - lo > 1) bar = xcd_barrier_post((unsigned*)(ws + WS_CTL), MISC + 8);
#define IN(k) (lo <= (k) && (k) < hi)
#define REFRESH() do { int t_ = threadIdx.x; asm volatile("" : "+v"(t_)); F.tid = t_; F.lane = t_ & 63; } while (0)
#define SEAM(k) do { if (IN(k) && IN((k) + 1)) xcd_barrier(bar); } while (0)

    if (IN(0)) { REFRESH(); phase_prep(F); } SEAM(0);
    if (IN(1)) { REFRESH(); memkv_naive(F);
        pg8::Gemm g{F.XN, F.WIN0, T, NP, DM}; pg8::StaticOrder S; S.init(T, NP, F.G, (int)blockIdx.x);
        pg8::EpiBf16<0> E{F.P, NP, nullptr, 0, 0, 1.f};
        pg8::gemm_phase<pg8::EpiBf16<0>, pg8::StaticOrder, true, true>(F.lds, g, S, E); } SEAM(1);
    if (IN(2)) { REFRESH(); gla_g1_naive(F); REFRESH(); cross_fast(F, 0, F.MIX0); } SEAM(2);
    if (IN(3)) { REFRESH(); gla_scan(F); } SEAM(3);
    if (IN(4)) { REFRESH(); gla_g3_naive(F); } SEAM(4);
    if (IN(5)) { REFRESH(); pg8::Gemm g{F.MIX0, F.WOUT0, T, DM, DM}; pg8::StaticOrder S; S.init(T, DM, F.G, (int)blockIdx.x);
        pg8::EpiBf16<0> E{F.XN, DM, nullptr, 0, 0, 1.f};
        pg8::gemm_phase<pg8::EpiBf16<0>, pg8::StaticOrder, true, true>(F.lds, g, S, E); } SEAM(5);
    if (IN(6)) { REFRESH(); post_rows(F, F.x, F.XN, F.ln_post, F.out, F.ln_pre + DM, F.XN); } SEAM(6);
    if (IN(7)) { REFRESH(); pg8::Gemm g{F.XN, F.WIN1, T, NP, DM}; pg8::StaticOrder S; S.init(T, NP, F.G, (int)blockIdx.x);
        pg8::EpiBf16<0> E{F.P, NP, nullptr, 0, 0, 1.f};
        pg8::gemm_phase<pg8::EpiBf16<0>, pg8::StaticOrder, true, true>(F.lds, g, S, E); } SEAM(7);
    if (IN(8)) { REFRESH(); nsa_compress_naive(F); } SEAM(8);
    if (IN(9)) { REFRESH(); nsa_main_fast(F); REFRESH(); cross_fast(F, 1, F.MIX1); } SEAM(9);
    if (IN(10)) { REFRESH(); pg8::Gemm g{F.MIX1, F.WOUT1, T, DM, DM}; pg8::StaticOrder S; S.init(T, DM, F.G, (int)blockIdx.x);
        pg8::EpiBf16<0> E{F.XN, DM, nullptr, 0, 0, 1.f};
        pg8::gemm_phase<pg8::EpiBf16<0>, pg8::StaticOrder, true, true>(F.lds, g, S, E); } SEAM(10);
    if (IN(11)) { REFRESH(); post_rows(F, F.out, F.XN, F.ln_post + DM, F.out, nullptr, nullptr); }
#undef IN
#undef SEAM
}

#ifndef N_LAUNCHES
#define N_LAUNCHES 1
#endif
extern "C" void kernel_launch(void* const* d_in, const int* in_sizes, int n_in, void* d_out, int out_size, void* d_ws, size_t ws_size, hipStream_t stream) {
    static int grid = 0;
    if (grid == 0) {
        if (n_in != 19 || out_size != T * DM || ws_size < WS_END) { fprintf(stderr, "kernel_launch: unexpected shapes (n_in %d out %d ws %zu)\n", n_in, out_size, ws_size); grid = -1; return; }
        int dev = 0, cus = 0, per_cu = 0;
        if (hipGetDevice(&dev) != hipSuccess || hipDeviceGetAttribute(&cus, hipDeviceAttributeMultiprocessorCount, dev) != hipSuccess) { grid = -1; return; }
        if (hipFuncSetAttribute((const void*)fwd_kernel, hipFuncAttributeMaxDynamicSharedMemorySize, LDS_BYTES) != hipSuccess) { fprintf(stderr, "kernel_launch: hipFuncSetAttribute failed\n"); grid = -1; return; }
        if (hipOccupancyMaxActiveBlocksPerMultiprocessor(&per_cu, (const void*)fwd_kernel, NTHR, LDS_BYTES) != hipSuccess || per_cu < 1) fprintf(stderr, "kernel_launch: occupancy query reports %d\n", per_cu);
        (void)hipGetLastError();
        grid = cus;
    }
    if (grid < 0) return;
    if (hipMemsetAsync((char*)d_ws + WS_CTL, 0, CTL_ZERO_BYTES, stream) != hipSuccess) return;
    Args a{};
    for (int i = 0; i < 19; ++i) a.in[i] = (const float*)d_in[i];
    a.out = (float*)d_out; a.ws = (unsigned char*)d_ws;
    for (int li = 0; li < N_LAUNCHES; ++li) {
        a.ph_lo = li * N_PHASES / N_LAUNCHES; a.ph_hi = (li + 1) * N_PHASES / N_LAUNCHES;
        hipLaunchKernelGGL(fwd_kernel, dim3(grid), dim3(NTHR), LDS_BYTES, stream, a);
    }
}
```

```cpp
#include <hip/hip_runtime.h>
#include <cstdio>
#include <cstdint>
namespace pg8 {
#define PG8_LAS __attribute__((address_space(3)))
typedef unsigned short bf16_t;
typedef short bf16x8 __attribute__((ext_vector_type(8)));
typedef float f32x4 __attribute__((ext_vector_type(4)));
typedef unsigned u32x4 __attribute__((ext_vector_type(4)));
constexpr int BM = 256, BK = 64, HALF = 128, HTB = HALF * BK * 2  , STAGE_BYTES = 8 * HTB, NXCD = 8, WGM = 8;

__host__ __device__ __forceinline__ int lds_byte(int r, int c) { const int st = (r >> 4) * 2 + (c >> 5), rr = r & 15, cc = c & 31, ob = rr * 64 + cc * 2; return st * 1024 + (ob ^ (((ob >> 9) & 1) << 5)); }
__host__ __device__ __forceinline__ void stage_rc(int b, int& R, int& C) { const int st = b / 1024, sb = b % 1024, swz = sb ^ (((sb >> 9) & 1) << 5); R = (st >> 1) * 16 + swz / 64; C = (st & 1) * 32 + (swz % 64) / 2; }
__host__ __device__ __forceinline__ int perm32(int rho) { const int n = rho >> 4, i = rho & 15; return 8 * (i >> 2) + 4 * n + (i & 3); }

struct Unit { int pm, pn; };
struct Gemm { const bf16_t* A; const bf16_t* Bt; int M, N, K; };

struct StaticOrder {
    int nM, nN, nwg, G, c;
    __host__ __device__ void init(int M, int N, int G_, int c_) { nM = M / BM; nN = N / BM; nwg = nM * nN; G = G_; c = c_; }
    __host__ __device__ bool next(int i, Unit& u) const {
        const long L = (long)i * G + c; if (L >= nwg) return false;
        int wgid = (int)L; { const int q = nwg / NXCD, r = nwg % NXCD, xcd = wgid % NXCD, off = wgid / NXCD; wgid = (xcd < r ? xcd * (q + 1) : r * (q + 1) + (xcd - r) * q) + off; }
        const int nig = WGM * nN, gid = wgid / nig, fm = gid * WGM, gsz = (nM - fm) < WGM ? (nM - fm) : WGM;
        u.pm = fm + ((wgid % nig) % gsz); u.pn = (wgid % nig) / gsz; return true;
    }
    __device__ __forceinline__ void a_ready(const Unit&) const {}
    __device__ __forceinline__ void done(const Unit&) const {}
};

__device__ __forceinline__ unsigned cvt_pk_bf16(float lo, float hi) { unsigned r; asm volatile("v_cvt_pk_bf16_f32 %0, %1, %2" : "=v"(r) : "v"(lo), "v"(hi)); return r; }
typedef float f32x2 __attribute__((ext_vector_type(2)));
__device__ __forceinline__ f32x2 gelu_pk(f32x2 v) {
    const f32x2 av = __builtin_elementwise_abs(v), d = av * 0.2316418882f + 1.0f;
    f32x2 t; t.x = __builtin_amdgcn_rcpf(d.x); t.y = __builtin_amdgcn_rcpf(d.y);
    f32x2 q = t * 0.5307027145f + (-0.7265760135f); q = q * t + 0.7107068705f; q = q * t + (-0.142248368f); q = q * t + 0.127414796f; q = q * t;
    const f32x2 s = (v * v) * (-0.72134752044f);
    f32x2 e; e.x = __builtin_amdgcn_exp2f(s.x); e.y = __builtin_amdgcn_exp2f(s.y);
    const f32x2 m = v * (q * e), r = v - m;
    f32x2 o; o.x = v.x < 0.f ? m.x : r.x; o.y = v.y < 0.f ? m.y : r.y; return o;
}

template <int ACT  > struct EpiBf16 {
    static constexpr bool PERM = true, AFTER_DRAIN = false; static_assert(ACT == 0 || ACT == 1, "EpiBf16: ACT is 0 (none) or 1 (gelu_pk)");
    bf16_t* O; int ldc; const float* bias; int split_cols; size_t split_stride; float scale0;
    __device__ __forceinline__ void operator()(const f32x4 (&acc)[2][2][4][2], const Unit& u, int wr, int wc, int fr, int fq) const {
        const int row0 = u.pm * BM + wr * 64 + fr; int colt = u.pn * BM; bf16_t* base = O;
        float sc = 1.f; if (split_cols) { const int t = colt / split_cols; base += (size_t)t * split_stride; colt -= t * split_cols; if (t == 0) sc = scale0; }
        const int col0 = colt + wc * 32 + 8 * fq, bcol0 = u.pn * BM + wc * 32 + 8 * fq;
        f32x4 bv[2][2];
#pragma unroll
        for (int bj = 0; bj < 2; ++bj)
#pragma unroll
            for (int n = 0; n < 2; ++n) bv[bj][n] = bias ? *(const f32x4*)(bias + bcol0 + bj * HALF + 4 * n) : (f32x4){0.f, 0.f, 0.f, 0.f};
#pragma unroll
        for (int ai = 0; ai < 2; ++ai)
#pragma unroll
            for (int m = 0; m < 4; ++m) { bf16_t* rowp = base + (size_t)(row0 + ai * HALF + m * 16) * ldc + col0;
#pragma unroll
                for (int bj = 0; bj < 2; ++bj) { f32x4 v0 = acc[ai][bj][m][0] + bv[bj][0], v1 = acc[ai][bj][m][1] + bv[bj][1];
                    if (ACT == 1) { f32x2 a = gelu_pk((f32x2){v0[0], v0[1]}), b = gelu_pk((f32x2){v0[2], v0[3]}), c = gelu_pk((f32x2){v1[0], v1[1]}), d = gelu_pk((f32x2){v1[2], v1[3]});
                        v0 = (f32x4){a.x, a.y, b.x, b.y}; v1 = (f32x4){c.x, c.y, d.x, d.y}; }
                    v0 = v0 * sc; v1 = v1 * sc; u32x4 w; w.x = cvt_pk_bf16(v0[0], v0[1]); w.y = cvt_pk_bf16(v0[2], v0[3]); w.z = cvt_pk_bf16(v1[0], v1[1]); w.w = cvt_pk_bf16(v1[2], v1[3]);
                    *(u32x4*)(rowp + bj * HALF) = w; } }
    }
};

template <class Epi, class Sched, bool ALIGN_EPI = false, bool SP2 = false>
__device__ __forceinline__ void gemm_phase(PG8_LAS unsigned char* lds, const Gemm g, const Sched& S, const Epi& E) {
    const int tid = threadIdx.x, wid = __builtin_amdgcn_readfirstlane(tid >> 6), lane = tid & 63, wr = wid >> 2, wc = wid & 3, fr = lane & 15, fq = lane >> 4;
    const int K = g.K, nt = K / BK;
    unsigned voffA[2], voffB[2];
#pragma unroll
    for (int i = 0; i < 2; ++i) { int R, C; stage_rc(tid * 16 + i * 8192, R, C); const int Rb = Epi::PERM ? ((R & ~31) + perm32(R & 31)) : R;
        voffA[i] = (unsigned)(R * K + C) * 2u; voffB[i] = (unsigned)(Rb * K + C) * 2u; }
    const size_t kstep = (size_t)(BK * 2);
    const size_t hstep = (size_t)HALF * K * 2;
    const size_t tstep = 2 * hstep;
    const unsigned ldsw = (unsigned)wid * 1024u;
    const int aoff = lds_byte(wr * 64 + fr, fq * 8), boff = lds_byte(wc * 32 + fr, fq * 8);
#define PG8_SA(b, h) (((b) * 2 + (h)) * HTB)
#define PG8_SB(b, h) ((4 + (b) * 2 + (h)) * HTB)
#define PG8_STAGE(bufoff, gbase, voff) do { _Pragma("unroll") for (int _i = 0; _i < 2; ++_i) \
        __builtin_amdgcn_global_load_lds((const unsigned*)((const char*)(gbase) + (voff)[_i]), (PG8_LAS unsigned*)(lds + (bufoff) + ldsw + _i * 8192), 16, 0, 0); } while (0)
#define PG8_LDA(dst, b, h) do { _Pragma("unroll") for (int m = 0; m < 4; ++m) _Pragma("unroll") for (int k = 0; k < 2; ++k) dst[m][k] = *(const PG8_LAS bf16x8*)(lds + PG8_SA(b, h) + aoff + m * 2048 + k * 1024); } while (0)
#define PG8_LDB(dst, b, h) do { _Pragma("unroll") for (int n = 0; n < 2; ++n) _Pragma("unroll") for (int k = 0; k < 2; ++k) dst[n][k] = *(const PG8_LAS bf16x8*)(lds + PG8_SB(b, h) + boff + n * 2048 + k * 1024); } while (0)
#define PG8_MMA(ai, bj, At, Bt) do { __builtin_amdgcn_s_setprio(1); _Pragma("unroll") for (int m = 0; m < 4; ++m) _Pragma("unroll") for (int n = 0; n < 2; ++n) _Pragma("unroll") for (int k = 0; k < 2; ++k) \
        acc[ai][bj][m][n] = __builtin_amdgcn_mfma_f32_16x16x32_bf16(Bt[n][k], At[m][k], acc[ai][bj][m][n], 0, 0, 0); __builtin_amdgcn_s_setprio(0); } while (0)
#define PG8_WAIT_V(n) asm volatile("s_waitcnt vmcnt(" #n ")" ::: "memory")
#define PG8_WAIT_L(n) asm volatile("s_waitcnt lgkmcnt(" #n ")" ::: "memory")
#define PG8_BAR __builtin_amdgcn_s_barrier()
#define PG8_SCHED __builtin_amdgcn_sched_barrier(0)
    Unit cur, nxt; int ui = 0;
    if (!S.next(0, cur)) return;
    f32x4 acc[2][2][4][2];
#pragma unroll
    for (int a = 0; a < 2; ++a)
#pragma unroll
        for (int b = 0; b < 2; ++b)
#pragma unroll
            for (int m = 0; m < 4; ++m)
#pragma unroll
                for (int n = 0; n < 2; ++n) acc[a][b][m][n] = (f32x4){0.f, 0.f, 0.f, 0.f};
    bf16x8 At[4][2], B0[2][2], B1[2][2];
    const char* cA = (const char*)g.A + (size_t)cur.pm * tstep; const char* cB = (const char*)g.Bt + (size_t)cur.pn * tstep;
    S.a_ready(cur);
    if constexpr (SP2) {
        PG8_STAGE(PG8_SB(0, 0), cB, voffB); PG8_STAGE(PG8_SB(0, 1), cB + hstep, voffB); PG8_STAGE(PG8_SA(0, 0), cA, voffA); PG8_STAGE(PG8_SA(0, 1), cA + hstep, voffA);
        if (wr == 1) PG8_BAR;
        PG8_WAIT_V(2); PG8_BAR;
        PG8_STAGE(PG8_SB(1, 0), cB + kstep, voffB); PG8_STAGE(PG8_SA(1, 0), cA + kstep, voffA); PG8_STAGE(PG8_SB(1, 1), cB + hstep + kstep, voffB);
        PG8_WAIT_V(6); PG8_BAR;
    } else {
        PG8_STAGE(PG8_SB(0, 0), cB, voffB); PG8_STAGE(PG8_SA(0, 0), cA, voffA); PG8_STAGE(PG8_SB(0, 1), cB + hstep, voffB); PG8_STAGE(PG8_SA(0, 1), cA + hstep, voffA);
        if (wr == 1) PG8_BAR;
        PG8_WAIT_V(4); PG8_BAR;
        PG8_STAGE(PG8_SB(1, 0), cB + kstep, voffB); PG8_STAGE(PG8_SA(1, 0), cA + kstep, voffA); PG8_STAGE(PG8_SB(1, 1), cB + hstep + kstep, voffB);
        PG8_WAIT_V(6); PG8_BAR;
    }
    for (;;) {
        const bool has_next = S.next(ui + 1, nxt);
        const char* nA = has_next ? (const char*)g.A + (size_t)nxt.pm * tstep : cA; const char* nB = has_next ? (const char*)g.Bt + (size_t)nxt.pn * tstep : cB;
        for (int t = 0; t < nt; t += 2) {
            const bool last = (t == nt - 2);
            const char* a1 = cA + (size_t)(t + 1) * kstep;
            const char* a2 = last ? nA : cA + (size_t)(t + 2) * kstep; const char* b2 = last ? nB : cB + (size_t)(t + 2) * kstep;
            const char* a3 = a2 + kstep; const char* b3 = b2 + kstep;
            if (last && has_next) S.a_ready(nxt);
            if constexpr (SP2) {
            PG8_LDB(B0, 0, 0); PG8_LDB(B1, 0, 1); PG8_SCHED; PG8_LDA(At, 0, 0); PG8_STAGE(PG8_SA(1, 1), a1 + hstep, voffA);
            PG8_WAIT_V(8); PG8_WAIT_L(0); PG8_BAR; PG8_MMA(0, 0, At, B0); PG8_MMA(0, 1, At, B1); PG8_BAR; PG8_SCHED;
            PG8_LDA(At, 0, 1); PG8_STAGE(PG8_SB(0, 0), b2, voffB); PG8_STAGE(PG8_SB(0, 1), b2 + hstep, voffB); PG8_STAGE(PG8_SA(0, 0), a2, voffA);
            PG8_WAIT_V(8); PG8_WAIT_L(0); PG8_BAR; PG8_MMA(1, 0, At, B0); PG8_MMA(1, 1, At, B1); PG8_BAR; PG8_SCHED;
            PG8_LDB(B0, 1, 0); PG8_LDB(B1, 1, 1); PG8_SCHED; PG8_LDA(At, 1, 0); PG8_STAGE(PG8_SA(0, 1), a2 + hstep, voffA);
            PG8_WAIT_V(8); PG8_WAIT_L(0); PG8_BAR; PG8_MMA(0, 0, At, B0); PG8_MMA(0, 1, At, B1); PG8_BAR; PG8_SCHED;
            PG8_LDA(At, 1, 1); PG8_STAGE(PG8_SB(1, 0), b3, voffB); PG8_STAGE(PG8_SB(1, 1), b3 + hstep, voffB); PG8_STAGE(PG8_SA(1, 0), a3, voffA);
            PG8_WAIT_V(8); PG8_WAIT_L(0); PG8_BAR; PG8_MMA(1, 0, At, B0); PG8_MMA(1, 1, At, B1); PG8_BAR; PG8_SCHED;
            } else {
            PG8_LDB(B0, 0, 0); PG8_SCHED; PG8_LDA(At, 0, 0); PG8_STAGE(PG8_SA(1, 1), a1 + hstep, voffA);
            PG8_WAIT_L(8); PG8_BAR; PG8_WAIT_L(0); PG8_MMA(0, 0, At, B0); PG8_BAR; PG8_SCHED;
            PG8_LDB(B1, 0, 1); PG8_STAGE(PG8_SB(0, 0), b2, voffB);
            PG8_BAR; PG8_WAIT_L(0); PG8_MMA(0, 1, At, B1); PG8_BAR;
            PG8_LDA(At, 0, 1); PG8_STAGE(PG8_SA(0, 0), a2, voffA);
            PG8_BAR; PG8_WAIT_L(0); PG8_MMA(1, 0, At, B0); PG8_BAR; PG8_SCHED;
            PG8_STAGE(PG8_SB(0, 1), b2 + hstep, voffB);
            PG8_WAIT_V(6); PG8_BAR; PG8_MMA(1, 1, At, B1); PG8_BAR;
            PG8_LDB(B0, 1, 0); PG8_SCHED; PG8_LDA(At, 1, 0); PG8_STAGE(PG8_SA(0, 1), a2 + hstep, voffA);
            PG8_WAIT_L(8); PG8_BAR; PG8_WAIT_L(0); PG8_MMA(0, 0, At, B0); PG8_BAR; PG8_SCHED;
            PG8_LDB(B1, 1, 1); PG8_STAGE(PG8_SB(1, 0), b3, voffB);
            PG8_BAR; PG8_WAIT_L(0); PG8_MMA(0, 1, At, B1); PG8_BAR;
            PG8_LDA(At, 1, 1); PG8_STAGE(PG8_SA(1, 0), a3, voffA);
            PG8_BAR; PG8_WAIT_L(0); PG8_MMA(1, 0, At, B0); PG8_BAR; PG8_SCHED;
            PG8_STAGE(PG8_SB(1, 1), b3 + hstep, voffB);
            PG8_WAIT_V(6); PG8_BAR; PG8_MMA(1, 1, At, B1); PG8_BAR;
            }
        }
        if constexpr (ALIGN_EPI) { if (wr == 0) PG8_BAR; }
        if constexpr (!Epi::AFTER_DRAIN) { E(acc, cur, wr, wc, fr, fq); S.done(cur); }
        if (!has_next) break;
#pragma unroll
        for (int a = 0; a < 2; ++a)
#pragma unroll
            for (int b = 0; b < 2; ++b)
#pragma unroll
                for (int m = 0; m < 4; ++m)
#pragma unroll
                    for (int n = 0; n < 2; ++n) acc[a][b][m][n] = (f32x4){0.f, 0.f, 0.f, 0.f};
        cur = nxt; cA = nA; cB = nB; ++ui;
        if constexpr (ALIGN_EPI) { if (wr == 1) PG8_BAR; }
    }
    PG8_WAIT_V(0);
    if constexpr (!ALIGN_EPI) { if (wr == 0) PG8_BAR; }
    PG8_BAR;
    if constexpr (Epi::AFTER_DRAIN) { E.fused(acc, cur, wr, wc, fr, fq, lds, wid, lane); S.done(cur); }
#undef PG8_SA
#undef PG8_SB
#undef PG8_STAGE
#undef PG8_LDA
#undef PG8_LDB
#undef PG8_MMA
#undef PG8_WAIT_V
#undef PG8_WAIT_L
#undef PG8_BAR
#undef PG8_SCHED
}
}
#define GAS __attribute__((address_space(1)))
#define LAS __attribute__((address_space(3)))
typedef unsigned short bf16;
typedef unsigned v4u __attribute__((ext_vector_type(4)));
typedef float f32x4 __attribute__((ext_vector_type(4)));
typedef short bf16x8 __attribute__((ext_vector_type(8)));
typedef GAS unsigned gu32;
typedef GAS unsigned long long gu64;
#define RLX_AGENT __ATOMIC_RELAXED, __HIP_MEMORY_SCOPE_AGENT
#define LDS_WAIT() asm volatile("s_waitcnt lgkmcnt(0)" ::: "memory")
#define VM_WAIT() asm volatile("s_waitcnt vmcnt(0)" ::: "memory")
__device__ __forceinline__ unsigned long long rt() { return __builtin_amdgcn_s_memrealtime(); }
__device__ __forceinline__ unsigned f2bf(float f) { unsigned u = __builtin_bit_cast(unsigned, f); return (u + 0x7fffu + ((u >> 16) & 1u)) >> 16; }
__device__ __forceinline__ unsigned pk2(float lo, float hi) { return f2bf(lo) | (f2bf(hi) << 16); }

#define XB_TMO      128
#define XB_XCNT(j)  (256  + 64 * (j))
#define XB_XSUB(j)  (1280 + 64 * (j))
#define XB_XGEN(j)  (2304 + 64 * (j))
#define XB_TOP      3328
#define XB_TOPGEN   3392
#define XCD_BAR_WORDS 3456
#define XB_SPIN_CAP (1u << 18)

__device__ __forceinline__ unsigned xb_ld(unsigned* p)              { return __hip_atomic_load(p, __ATOMIC_RELAXED, __HIP_MEMORY_SCOPE_AGENT); }
__device__ __forceinline__ unsigned xb_add(unsigned* p, unsigned v) { return __hip_atomic_fetch_add(p, v, __ATOMIC_RELAXED, __HIP_MEMORY_SCOPE_AGENT); }
__device__ __forceinline__ unsigned xb_xcc_id() { return (unsigned)__builtin_amdgcn_s_getreg((3 << 11) | 20) & 0xFu; }
#define XB_SPIN(cond, bar) do { unsigned _sp = 0; while (cond) { __builtin_amdgcn_s_sleep(1); \
    if ((++_sp & 255u) == 0u) { if (xb_ld(&(bar)[XB_TMO])) break; if (_sp > XB_SPIN_CAP) { atomicAdd(&(bar)[XB_TMO], 1u); break; } } } } while (0)

struct XcdBarrier {
    unsigned* bar; unsigned x;
    volatile LAS unsigned* st;
};

__device__ __forceinline__ XcdBarrier xcd_barrier_post(unsigned* bar, volatile LAS unsigned* st) {
    XcdBarrier b; b.bar = bar; b.x = xb_xcc_id(); b.st = st;
    if (threadIdx.x == 0) (void)xb_add(&bar[XB_XCNT(b.x)], 1u);
    return b;
}
__device__ __forceinline__ void xcd_barrier_complete(unsigned* bar, unsigned x, unsigned& nloc, unsigned& nx) {
    const unsigned G = gridDim.x * gridDim.y * gridDim.z;
    unsigned sum, cnt, mine, sp = 0u;
    for (;;) {
        sum = 0u; cnt = 0u; mine = 0u;
#pragma unroll
        for (unsigned j = 0; j < 16; ++j) { const unsigned c = xb_ld(&bar[XB_XCNT(j)]); sum += c; cnt += (c > 0u) ? 1u : 0u; mine = (j == x) ? c : mine; }
        if (sum == G) break;
        __builtin_amdgcn_s_sleep(1);
        if ((++sp & 255u) == 0u) { if (xb_ld(&bar[XB_TMO])) break; if (sp > XB_SPIN_CAP) { atomicAdd(&bar[XB_TMO], 1u); break; } }
    }
    nloc = mine > 0u ? mine : 1u; nx = cnt > 0u ? cnt : 1u;
}

__device__ __forceinline__ void xcd_barrier(const XcdBarrier& b) {
    asm volatile("s_waitcnt vmcnt(0)" ::: "memory");
    __syncthreads();
    if (threadIdx.x == 0) {
        unsigned* bar = b.bar;
        __builtin_amdgcn_s_waitcnt(0);
        unsigned nloc = b.st[0], nx = b.st[1];
        if (nloc == 0u) { xcd_barrier_complete(bar, b.x, nloc, nx); b.st[0] = nloc; b.st[1] = nx; }
        const unsigned old = xb_add(&bar[XB_XSUB(b.x)], 1u);
        const unsigned gen = old / nloc;
        if (old + 1u == (gen + 1u) * nloc) {
            __builtin_amdgcn_fence(__ATOMIC_RELEASE, "agent");
            asm volatile("s_waitcnt vmcnt(0)" ::: "memory");
            const unsigned og = xb_add(&bar[XB_TOP], 1u);
            const unsigned tg = og / nx;
            if (og + 1u == (tg + 1u) * nx) xb_add(&bar[XB_TOPGEN], 1u);
            else XB_SPIN(xb_ld(&bar[XB_TOPGEN]) == tg, bar);
            __builtin_amdgcn_fence(__ATOMIC_ACQUIRE, "agent");
            xb_add(&bar[XB_XGEN(b.x)], 1u);
            asm volatile("s_waitcnt vmcnt(0)" ::: "memory");
        } else {
            XB_SPIN(xb_ld(&bar[XB_XGEN(b.x)]) == gen, bar);
            __builtin_amdgcn_fence(__ATOMIC_ACQUIRE, "agent");
            asm volatile("s_waitcnt vmcnt(0)" ::: "memory");
        }
    }
    __syncthreads();
}

constexpr int T = 16384, DM = 2048, NP = 5888, NMEM = 256;
constexpr int NWAVES = 8, NTHR = 512;
constexpr float EPS = 1e-6f;
constexpr size_t MiB = 1u << 20;
constexpr size_t WS_CTL = 0, CTL_ZERO_BYTES = 65536;
constexpr size_t WS_WIN0 = 1 * MiB, WS_WIN1 = 24 * MiB, WS_WOUT0 = 47 * MiB, WS_WOUT1 = 55 * MiB, WS_WMKV = 63 * MiB, WS_WK1T = 71 * MiB, WS_WV1T = 73 * MiB;
constexpr size_t WS_MEMKV = 75 * MiB, WS_DEC = 76 * MiB, WS_KCMP = 77 * MiB, WS_VCMP = 77 * MiB + 512 * 1024, WS_SEL = 78 * MiB;
constexpr size_t WS_XN = 80 * MiB, WS_P = 144 * MiB, WS_STATE = 328 * MiB, WS_END = 472 * MiB;
constexpr size_t WS_MIX1 = WS_STATE;
constexpr size_t DO_MIX0 = 0, DO_OI = 64 * MiB;
constexpr int CR = 3072, CXQ = 4608, CXG = 5120, CGL = 5632;
constexpr int GQ = 0, GK = 768, GV = 1536;
constexpr int NQ = 0, NKC = 1536, NVC = 1792, NKS = 2048, NVS = 2304, NKW = 2560, NVW = 2816;
constexpr int RING_BYTES = 131072, LDSCTL_OFF = RING_BYTES, MISC_OFF = LDSCTL_OFF + 320, LDS_BYTES = 147456;
constexpr int N_PHASES = 12;

__device__ __forceinline__ float bf2f(bf16 v) { return __builtin_bit_cast(float, (unsigned)v << 16); }
__device__ __forceinline__ bf16 f2b(float f) { return (bf16)f2bf(f); }
__device__ __forceinline__ float wave_sum(float v) {
#pragma unroll
    for (int o = 1; o < 64; o <<= 1) v += __shfl_xor(v, o);
    return v;
}
__device__ __forceinline__ float silu_f(float x) { return x / (1.f + __expf(-x)); }
__device__ __forceinline__ float sigmoid_f(float x) { return 1.f / (1.f + __expf(-x)); }
__device__ __forceinline__ float logsigmoid_f(float x) { return fminf(x, 0.f) - log1pf(__expf(-fabsf(x))); }

__device__ __forceinline__ int win_src_col(int layer, int c) {
    const int ex = layer ? 36 : 16;
    if (c < 3072) return c;
    if (c < 5632) return c + ex;
    if (c < 5632 + ex) return c - 5632 + 3072;
    return -1;
}

__device__ __forceinline__ void transpose_item(const float* W, int ldw, int K, bf16* WT, int n0, int k0, int srcc, LAS float* scr, int lane) {
#pragma unroll 8
    for (int i = 0; i < 32; ++i) { const int kk = 2 * i + (lane >> 5); scr[kk * 33 + (lane & 31)] = (srcc >= 0) ? W[(size_t)(k0 + kk) * ldw + srcc] : 0.f; }
    LDS_WAIT(); asm volatile("" ::: "memory");
    const int c = lane & 7;
#pragma unroll
    for (int j = 0; j < 4; ++j) { const int n = (lane >> 3) + 8 * j; const LAS float* s = scr + (8 * c) * 33 + n;
        v4u o; o.x = pk2(s[0 * 33], s[1 * 33]); o.y = pk2(s[2 * 33], s[3 * 33]); o.z = pk2(s[4 * 33], s[5 * 33]); o.w = pk2(s[6 * 33], s[7 * 33]);
        *(v4u*)(WT + (size_t)(n0 + n) * K + k0 + 8 * c) = o; }
    LDS_WAIT(); asm volatile("" ::: "memory");
}

__device__ __forceinline__ void rms_row_to_bf16(const float* xrow, const float* g, bf16* orow, int lane) {
    const f32x4* xr = (const f32x4*)xrow + lane; const f32x4* gr = (const f32x4*)g + lane;
    f32x4 v[8]; float s = 0.f;
#pragma unroll
    for (int j = 0; j < 8; ++j) { v[j] = xr[64 * j]; s += (v[j].x * v[j].x + v[j].y * v[j].y) + (v[j].z * v[j].z + v[j].w * v[j].w); }
    const float rstd = rsqrtf(wave_sum(s) * (1.f / DM) + EPS);
    unsigned long long* o8 = (unsigned long long*)orow + lane;
#pragma unroll
    for (int j = 0; j < 8; ++j) { const f32x4 gg = gr[64 * j];
        o8[64 * j] = (unsigned long long)pk2(v[j].x * rstd * gg.x, v[j].y * rstd * gg.y) | ((unsigned long long)pk2(v[j].z * rstd * gg.z, v[j].w * rstd * gg.w) << 32); }
}

struct Args { const float* in[19]; float* out; unsigned char* ws; int ph_lo, ph_hi; };

struct Ctx {
    LAS unsigned char* lds;
    int tid, lane, wave, G, gw, NGW;
    const float *x, *mem, *ln_pre, *ln_post, *ln_mem, *w_mem_kv, *gla_w_in, *gla_w_gate, *gla_b_gate, *gla_norm, *gla_w_out;
    const float *nsa_w_in, *pe_k, *pe_v, *wk1, *wk2, *wv1, *wv2, *nsa_w_out;
    float* out; unsigned char* ws;
    bf16 *WIN0, *WIN1, *WOUT0, *WOUT1, *WMKV, *MEMKV, *KCMP, *VCMP, *XN, *P, *STATE, *MIX0, *MIX1, *OI;
    float* DEC;
};

__device__ __forceinline__ void phase_prep(Ctx& F) {
    LAS float* scr = (LAS float*)(F.lds + F.wave * 16384);
    constexpr int I_WIN = 32 * 184, I_WOUT = 32 * 64, I_MKV = 32 * 32;
    constexpr int NITEMS = 2 * I_WIN + 2 * I_WOUT + 2 * I_MKV;
    for (int it = F.gw; it < NITEMS; it += F.NGW) {
        int r = it;
        if (r < 2 * I_WIN) { const int layer = r / I_WIN; r -= layer * I_WIN; const int kb = r / 184, nb = r % 184;
            const int srcc = win_src_col(layer, nb * 32 + (F.lane & 31));
            transpose_item(layer ? F.nsa_w_in : F.gla_w_in, layer ? 5668 : 5648, DM, layer ? F.WIN1 : F.WIN0, nb * 32, kb * 64, srcc, scr, F.lane); continue; }
        r -= 2 * I_WIN;
        if (r < 2 * I_WOUT) { const int layer = r / I_WOUT; r -= layer * I_WOUT; const int kb = r / 64, nb = r % 64;
            transpose_item(layer ? F.nsa_w_out : F.gla_w_out, DM, DM, layer ? F.WOUT1 : F.WOUT0, nb * 32, kb * 64, nb * 32 + (F.lane & 31), scr, F.lane); continue; }
        r -= 2 * I_WOUT;
        { const int layer = r / I_MKV; r -= layer * I_MKV; const int kb = r / 32, nb = r % 32;
            transpose_item(F.w_mem_kv + (size_t)layer * DM * 1024, 1024, DM, F.WMKV + (size_t)layer * 1024 * DM, nb * 32, kb * 64, nb * 32 + (F.lane & 31), scr, F.lane); }
    }
    for (int m = F.gw; m < T; m += F.NGW) rms_row_to_bf16(F.x + (size_t)m * DM, F.ln_pre, F.XN + (size_t)m * DM, F.lane);
}

__device__ __forceinline__ void memkv_naive(Ctx& F) {
    const int gt = blockIdx.x * NTHR + F.tid, NT = F.G * NTHR;
    for (int o = gt; o < 2 * NMEM * 1024; o += NT) {
        const int layer = o >> 18, m = (o >> 10) & 255, n = o & 1023;
        const float* mr = F.mem + (size_t)m * DM; const float* g = F.ln_mem + layer * DM; const float* W = F.w_mem_kv + (size_t)layer * DM * 1024 + n;
        float ss = 0.f, acc = 0.f;
        for (int k = 0; k < DM; ++k) { const float a = mr[k]; ss += a * a; acc += a * g[k] * W[(size_t)k * 1024]; }
        const float v = acc * rsqrtf(ss * (1.f / DM) + EPS);
        const int kv = n >> 9, h = (n >> 7) & 3, d = n & 127;
        F.MEMKV[((((size_t)layer * 2 + kv) * 4 + h) * NMEM + m) * 128 + d] = f2b(v);
    }
}

__device__ __forceinline__ void cross_naive(Ctx& F, int layer, bf16* MIX) {
    const float scale = 0.08838834764831845f;
    for (int u = F.gw; u < T * 4; u += F.NGW) {
        const int t = u >> 2, h = u & 3;
        const bf16* pr = F.P + (size_t)t * NP;
        const unsigned qq = *(const unsigned*)(pr + CXQ + h * 128 + 2 * F.lane);
        const float q0 = bf2f((bf16)(qq & 0xffff)) * scale, q1 = bf2f((bf16)(qq >> 16)) * scale;
        const bf16* Kb = F.MEMKV + (((size_t)layer * 2 + 0) * 4 + h) * NMEM * 128;
        const bf16* Vb = F.MEMKV + (((size_t)layer * 2 + 1) * 4 + h) * NMEM * 128;
        float m = -1e30f, l = 0.f, o0 = 0.f, o1 = 0.f;
        for (int j = 0; j < NMEM; ++j) {
            const unsigned kk = *(const unsigned*)(Kb + j * 128 + 2 * F.lane), vv = *(const unsigned*)(Vb + j * 128 + 2 * F.lane);
            const float s = wave_sum(q0 * bf2f((bf16)(kk & 0xffff)) + q1 * bf2f((bf16)(kk >> 16)));
            const float mn = fmaxf(m, s), a = __expf(m - mn), p = __expf(s - mn);
            l = l * a + p; o0 = o0 * a + p * bf2f((bf16)(vv & 0xffff)); o1 = o1 * a + p * bf2f((bf16)(vv >> 16)); m = mn;
        }
        const unsigned gg = *(const unsigned*)(pr + CXG + h * 128 + 2 * F.lane);
        const float r0 = o0 / l * silu_f(bf2f((bf16)(gg & 0xffff))), r1 = o1 / l * silu_f(bf2f((bf16)(gg >> 16)));
        *(unsigned*)(MIX + (size_t)t * DM + 1536 + h * 128 + 2 * F.lane) = pk2(r0, r1);
    }
}

__device__ __forceinline__ void gla_g1_naive(Ctx& F) {
    LAS float* bcum = (LAS float*)(F.lds);
    LAS float* Aat = (LAS float*)(F.lds + 49152);
    LAS float* glr = (LAS float*)(F.lds + 65536);
    LAS float* blast = (LAS float*)(F.lds + 69632);
    const float qscale = 0.07216878364870323f;
    for (int u = blockIdx.x; u < 1024; u += F.G) {
        const int n = u >> 2, h = u & 3; const size_t row0 = (size_t)n * 64;
        for (int i = F.tid; i < 1024; i += NTHR) glr[i] = bf2f(F.P[(row0 + (i >> 4)) * NP + CGL + (i & 15)]);
        __syncthreads();
        if (F.tid < 192) {
            const int d = F.tid, col = h * 192 + d; float wg[16];
#pragma unroll
            for (int j = 0; j < 16; ++j) wg[j] = F.gla_w_gate[j * 768 + col];
            const float bias = F.gla_b_gate[col]; float b = 0.f;
            for (int c = 0; c < 64; ++c) { float gl = bias;
#pragma unroll
                for (int j = 0; j < 16; ++j) gl += glr[c * 16 + j] * wg[j];
                b += logsigmoid_f(gl) * (1.f / 16.f); bcum[c * 192 + d] = b; }
            blast[d] = b; F.DEC[n * 768 + col] = __expf(b);
        }
        __syncthreads();
        for (int i = 0; i < 8; ++i) { const int idx = F.tid + NTHR * i, c = idx >> 6, s = idx & 63; float a = 0.f;
            if (s <= c) { const bf16* qp = F.P + (row0 + c) * NP + GQ + h * 192; const bf16* kp = F.P + (row0 + s) * NP + GK + h * 192;
                for (int d = 0; d < 192; ++d) a += bf2f(qp[d]) * bf2f(kp[d]) * __expf(bcum[c * 192 + d] - bcum[s * 192 + d]);
                a *= qscale; }
            Aat[idx] = a; }
        __syncthreads();
        for (int i = 0; i < 48; ++i) { const int idx = F.tid + NTHR * i, c = idx / 384, e = idx % 384; float a = 0.f;
            for (int s = 0; s <= c; ++s) a += Aat[c * 64 + s] * bf2f(F.P[(row0 + s) * NP + GV + h * 384 + e]);
            F.OI[(row0 + c) * 1536 + h * 384 + e] = f2b(a); }
        for (int i = 0; i < 144; ++i) { const int idx = F.tid + NTHR * i, e = idx / 192, d = idx % 192; float a = 0.f; const float bl = blast[d];
            for (int c = 0; c < 64; ++c) a += bf2f(F.P[(row0 + c) * NP + GK + h * 192 + d]) * __expf(bl - bcum[c * 192 + d]) * bf2f(F.P[(row0 + c) * NP + GV + h * 384 + e]);
            F.STATE[((size_t)u * 384 + e) * 192 + d] = f2b(a); }
        __syncthreads();
        for (int i = 0; i < 24; ++i) { const int idx = F.tid + NTHR * i, c = idx / 192, d = idx % 192;
            bf16* qp = F.P + (row0 + c) * NP + GQ + h * 192 + d; *qp = f2b(bf2f(*qp) * qscale * __expf(bcum[c * 192 + d])); }
        __syncthreads();
    }
}

__device__ __forceinline__ void gla_scan(Ctx& F) {
    const int gt = blockIdx.x * NTHR + F.tid, NT = F.G * NTHR;
    constexpr int PER = 4 * 384 * 192;
    for (int item = gt; item < PER / 4; item += NT) {
        const int idx = item * 4, h = idx / (384 * 192), d0 = idx % 192;
        bf16* sp = F.STATE + idx; const float* dp = F.DEC + h * 192 + d0;
        float s0 = 0.f, s1 = 0.f, s2 = 0.f, s3 = 0.f;
        for (int n0 = 0; n0 < 256; n0 += 8) {
            unsigned long long u[8]; f32x4 dc[8];
#pragma unroll
            for (int j = 0; j < 8; ++j) { u[j] = *(const unsigned long long*)(sp + (size_t)(n0 + j) * PER); dc[j] = *(const f32x4*)(dp + (n0 + j) * 768); }
#pragma unroll
            for (int j = 0; j < 8; ++j) {
                const unsigned lo = (unsigned)u[j], hi = (unsigned)(u[j] >> 32);
                s0 = dc[j].x * s0 + bf2f((bf16)(lo & 0xffff)); s1 = dc[j].y * s1 + bf2f((bf16)(lo >> 16));
                s2 = dc[j].z * s2 + bf2f((bf16)(hi & 0xffff)); s3 = dc[j].w * s3 + bf2f((bf16)(hi >> 16));
                *(unsigned long long*)(sp + (size_t)(n0 + j) * PER) = (unsigned long long)pk2(s0, s1) | ((unsigned long long)pk2(s2, s3) << 32);
            }
        }
    }
}

__device__ __forceinline__ void gla_g3_naive(Ctx& F) {
    LAS float* o = (LAS float*)(F.lds);
    LAS float* rs = (LAS float*)(F.lds + 98304);
    for (int u = blockIdx.x; u < 1024; u += F.G) {
        const int n = u >> 2, h = u & 3; const size_t row0 = (size_t)n * 64;
        for (int i = 0; i < 48; ++i) { const int idx = F.tid + NTHR * i, c = idx / 384, e = idx % 384;
            float a = bf2f(F.OI[(row0 + c) * 1536 + h * 384 + e]);
            if (n > 0) { const bf16* sp = F.STATE + ((size_t)(u - 4) * 384 + e) * 192; const bf16* qp = F.P + (row0 + c) * NP + GQ + h * 192;
                for (int d = 0; d < 192; ++d) a += bf2f(qp[d]) * bf2f(sp[d]); }
            o[idx] = a; }
        __syncthreads();
        for (int c = F.wave; c < 64; c += NWAVES) { float ss = 0.f;
            for (int e = F.lane; e < 384; e += 64) { const float v = o[c * 384 + e]; ss += v * v; }
            ss = wave_sum(ss); if (F.lane == 0) rs[c] = rsqrtf(ss * (1.f / 384.f) + EPS); }
        __syncthreads();
        for (int i = 0; i < 48; ++i) { const int idx = F.tid + NTHR * i, c = idx / 384, e = idx % 384;
            const float v = o[idx] * rs[c] * F.gla_norm[e]; const float r = bf2f(F.P[(row0 + c) * NP + CR + h * 384 + e]);
            F.MIX0[(row0 + c) * DM + h * 384 + e] = f2b(v * silu_f(r)); }
        __syncthreads();
    }
}

__device__ __forceinline__ void post_rows(Ctx& F, const float* hin, const bf16* Y, const float* gpost, float* hout, const float* gpre, bf16* XNo) {
    for (int m = F.gw; m < T; m += F.NGW) {
        const v4u* yr = (const v4u*)(Y + (size_t)m * DM) + F.lane;
        float y[32]; float ss = 0.f;
#pragma unroll
        for (int j = 0; j < 4; ++j) { const v4u w = yr[64 * j];
            const unsigned ww[4] = {w.x, w.y, w.z, w.w};
#pragma unroll
            for (int q = 0; q < 4; ++q) { y[j * 8 + 2 * q] = bf2f((bf16)(ww[q] & 0xffff)); y[j * 8 + 2 * q + 1] = bf2f((bf16)(ww[q] >> 16)); } }
#pragma unroll
        for (int i = 0; i < 32; ++i) ss += y[i] * y[i];
        const float rstd = rsqrtf(wave_sum(ss) * (1.f / DM) + EPS);
        float hn[32]; float s2 = 0.f;
#pragma unroll
        for (int j = 0; j < 4; ++j) {
#pragma unroll
            for (int q = 0; q < 2; ++q) { const int col = j * 512 + F.lane * 8 + q * 4;
                const f32x4 hv = *(const f32x4*)(hin + (size_t)m * DM + col); const f32x4 gp = *(const f32x4*)(gpost + col);
                f32x4 r; r.x = hv.x + y[j * 8 + q * 4 + 0] * rstd * gp.x; r.y = hv.y + y[j * 8 + q * 4 + 1] * rstd * gp.y; r.z = hv.z + y[j * 8 + q * 4 + 2] * rstd * gp.z; r.w = hv.w + y[j * 8 + q * 4 + 3] * rstd * gp.w;
                *(f32x4*)(hout + (size_t)m * DM + col) = r;
                hn[j * 8 + q * 4 + 0] = r.x; hn[j * 8 + q * 4 + 1] = r.y; hn[j * 8 + q * 4 + 2] = r.z; hn[j * 8 + q * 4 + 3] = r.w;
                s2 += (r.x * r.x + r.y * r.y) + (r.z * r.z + r.w * r.w); } }
        if (gpre) {
            const float rstd2 = rsqrtf(wave_sum(s2) * (1.f / DM) + EPS);
#pragma unroll
            for (int j = 0; j < 4; ++j) { const int col = j * 512 + F.lane * 8;
                const f32x4 g0 = *(const f32x4*)(gpre + col), g1 = *(const f32x4*)(gpre + col + 4);
                v4u w; w.x = pk2(hn[j * 8 + 0] * rstd2 * g0.x, hn[j * 8 + 1] * rstd2 * g0.y); w.y = pk2(hn[j * 8 + 2] * rstd2 * g0.z, hn[j * 8 + 3] * rstd2 * g0.w);
                w.z = pk2(hn[j * 8 + 4] * rstd2 * g1.x, hn[j * 8 + 5] * rstd2 * g1.y); w.w = pk2(hn[j * 8 + 6] * rstd2 * g1.z, hn[j * 8 + 7] * rstd2 * g1.w);
                *((v4u*)(XNo + (size_t)m * DM) + F.lane + 64 * j) = w; }
        }
    }
}

__device__ __forceinline__ void nsa_compress_naive(Ctx& F) {
    LAS float* blk = (LAS float*)(F.lds);
    LAS float* part = (LAS float*)(F.lds + 65536);
    LAS float* hid = (LAS float*)(F.lds + 73728);
    for (int u = blockIdx.x; u < 1024; u += F.G) {
        const int kv = u & 1, g = (u >> 1) & 1, nq = u >> 2;
        const float* pe = kv ? F.pe_v : F.pe_k; const float* w1 = kv ? F.wv1 : F.wk1; const float* w2 = kv ? F.wv2 : F.wk2;
        const int colb = (kv ? NVC : NKC) + g * 128;
        for (int i = 0; i < 32; ++i) { const int idx = F.tid + NTHR * i, r = idx >> 12, i4 = idx & 4095, l = i4 >> 7, d = i4 & 127; const int n = nq * 4 + r;
            float v = 0.f; if (n < 1023) v = bf2f(F.P[(size_t)(16 * n + l) * NP + colb + d]) + pe[l * 128 + d];
            blk[idx] = v; }
        __syncthreads();
        { const int j = F.tid & 255, ih = F.tid >> 8; float a0 = 0.f, a1 = 0.f, a2 = 0.f, a3 = 0.f;
            for (int i = ih * 2048; i < ih * 2048 + 2048; ++i) { const float w = w1[(size_t)i * 256 + j];
                a0 += blk[i] * w; a1 += blk[4096 + i] * w; a2 += blk[8192 + i] * w; a3 += blk[12288 + i] * w; }
            part[(ih * 4 + 0) * 256 + j] = a0; part[(ih * 4 + 1) * 256 + j] = a1; part[(ih * 4 + 2) * 256 + j] = a2; part[(ih * 4 + 3) * 256 + j] = a3; }
        __syncthreads();
        for (int i = F.tid; i < 1024; i += NTHR) hid[i] = silu_f(part[i] + part[1024 + i]);
        __syncthreads();
        { const int d = F.tid & 127, r = F.tid >> 7; const int n = nq * 4 + r; float a = 0.f;
            for (int j = 0; j < 256; ++j) a += hid[r * 256 + j] * w2[j * 128 + d];
            if (n < 1023) (kv ? F.VCMP : F.KCMP)[((size_t)g * 1024 + n) * 128 + d] = f2b(a); }
        __syncthreads();
    }
}

__device__ __forceinline__ void nsa_main_naive(Ctx& F) {
    const float scale = 0.08838834764831845f;
    LAS float* ocs = (LAS float*)(F.lds + F.wave * 4096);
    const int lane = F.lane;
    for (int u = F.gw; u < T * 2; u += F.NGW) {
        const int t = u >> 1, g = u & 1; const bf16* pr = F.P + (size_t)t * NP;
        const int ncv = (t >= 31) ? min((t - 31) / 16 + 1, 1023) : 0;
        const bf16* Kc = F.KCMP + (size_t)g * 1024 * 128; const bf16* Vc = F.VCMP + (size_t)g * 1024 * 128;
        float imp0 = 0.f, imp1 = 0.f, imp2 = 0.f, imp3 = 0.f;
        for (int h = 0; h < 6; ++h) {
            const unsigned qq = *(const unsigned*)(pr + NQ + (g * 6 + h) * 128 + 2 * lane);
            const float q0 = bf2f((bf16)(qq & 0xffff)) * scale, q1 = bf2f((bf16)(qq >> 16)) * scale;
            float m = -1e30f, l = 0.f, o0 = 0.f, o1 = 0.f;
            for (int c = 0; c < ncv; ++c) {
                const unsigned kk = *(const unsigned*)(Kc + c * 128 + 2 * lane), vv = *(const unsigned*)(Vc + c * 128 + 2 * lane);
                const float s = wave_sum(q0 * bf2f((bf16)(kk & 0xffff)) + q1 * bf2f((bf16)(kk >> 16)));
                const float mn = fmaxf(m, s), a = __expf(m - mn), p = __expf(s - mn);
                l = l * a + p; o0 = o0 * a + p * bf2f((bf16)(vv & 0xffff)); o1 = o1 * a + p * bf2f((bf16)(vv >> 16)); m = mn;
            }
            const float gate = sigmoid_f(bf2f(pr[CGL + g * 18 + h * 3 + 0]));
            const float il = (ncv > 0) ? 1.f / l : 0.f;
            ocs[h * 128 + 2 * lane] = gate * o0 * il; ocs[h * 128 + 2 * lane + 1] = gate * o1 * il;
            for (int c = 0; c < ncv; ++c) {
                const unsigned kk = *(const unsigned*)(Kc + c * 128 + 2 * lane);
                const float s = wave_sum(q0 * bf2f((bf16)(kk & 0xffff)) + q1 * bf2f((bf16)(kk >> 16)));
                const float p = __expf(s - m) * il;
                const int ja = c >> 2, jb = (c + 1) >> 2;
                { const int jj = lane;       if (jj == ja || jj == jb) imp0 += p; }
                { const int jj = lane + 64;  if (jj == ja || jj == jb) imp1 += p; }
                { const int jj = lane + 128; if (jj == ja || jj == jb) imp2 += p; }
                { const int jj = lane + 192; if (jj == ja || jj == jb) imp3 += p; }
            }
        }
        const int cur = t >> 6;
        float iv[4] = {imp0, imp1, imp2, imp3};
#pragma unroll
        for (int i = 0; i < 4; ++i) { const int jj = lane + 64 * i; if (jj == 0 || jj == cur || jj == cur - 1) iv[i] = 1e4f; if (jj > cur) iv[i] = -1e4f; }
        int mysel = 0;
#pragma unroll
        for (int r = 0; r < 16; ++r) {
            float bv = iv[0]; int bi = lane;
#pragma unroll
            for (int i = 1; i < 4; ++i) { if (iv[i] > bv) { bv = iv[i]; bi = lane + 64 * i; } }
#pragma unroll
            for (int o = 1; o < 64; o <<= 1) { const float ov = __shfl_xor(bv, o); const int oi = __shfl_xor(bi, o); if (ov > bv || (ov == bv && oi < bi)) { bv = ov; bi = oi; } }
            mysel = (lane == r) ? bi : mysel;
#pragma unroll
            for (int i = 0; i < 4; ++i) if (lane + 64 * i == bi) iv[i] = -3e38f;
        }
        for (int h = 0; h < 6; ++h) {
            const unsigned qq = *(const unsigned*)(pr + NQ + (g * 6 + h) * 128 + 2 * lane);
            const float q0 = bf2f((bf16)(qq & 0xffff)) * scale, q1 = bf2f((bf16)(qq >> 16)) * scale;
            float m = -1e30f, l = 0.f, o0 = 0.f, o1 = 0.f;
            for (int r = 0; r < 16; ++r) { const int j = __shfl(mysel, r); if (j > cur) continue;
                const int kend = min(64, t - 64 * j + 1);
                for (int i = 0; i < kend; ++i) { const bf16* kr = F.P + (size_t)(64 * j + i) * NP;
                    const unsigned kk = *(const unsigned*)(kr + NKS + g * 128 + 2 * lane), vv = *(const unsigned*)(kr + NVS + g * 128 + 2 * lane);
                    const float s = wave_sum(q0 * bf2f((bf16)(kk & 0xffff)) + q1 * bf2f((bf16)(kk >> 16)));
                    const float mn = fmaxf(m, s), a = __expf(m - mn), p = __expf(s - mn);
                    l = l * a + p; o0 = o0 * a + p * bf2f((bf16)(vv & 0xffff)); o1 = o1 * a + p * bf2f((bf16)(vv >> 16)); m = mn; } }
            const float gs = sigmoid_f(bf2f(pr[CGL + g * 18 + h * 3 + 1]));
            float r0 = ocs[h * 128 + 2 * lane] + gs * o0 / l, r1 = ocs[h * 128 + 2 * lane + 1] + gs * o1 / l;
            m = -1e30f; l = 0.f; o0 = 0.f; o1 = 0.f;
            for (int p0 = max(0, t - 511); p0 <= t; ++p0) { const bf16* kr = F.P + (size_t)p0 * NP;
                const unsigned kk = *(const unsigned*)(kr + NKW + g * 128 + 2 * lane), vv = *(const unsigned*)(kr + NVW + g * 128 + 2 * lane);
                const float s = wave_sum(q0 * bf2f((bf16)(kk & 0xffff)) + q1 * bf2f((bf16)(kk >> 16)));
                const float mn = fmaxf(m, s), a = __expf(m - mn), p = __expf(s - mn);
                l = l * a + p; o0 = o0 * a + p * bf2f((bf16)(vv & 0xffff)); o1 = o1 * a + p * bf2f((bf16)(vv >> 16)); m = mn; }
            const float gw_ = sigmoid_f(bf2f(pr[CGL + g * 18 + h * 3 + 2]));
            r0 += gw_ * o0 / l; r1 += gw_ * o1 / l;
            const unsigned rr = *(const unsigned*)(pr + CR + (g * 6 + h) * 128 + 2 * lane);
            r0 *= silu_f(bf2f((bf16)(rr & 0xffff))); r1 *= silu_f(bf2f((bf16)(rr >> 16)));
            *(unsigned*)(F.MIX1 + (size_t)t * DM + (g * 6 + h) * 128 + 2 * lane) = pk2(r0, r1);
        }
    }
}


typedef short v4i16_t __attribute__((ext_vector_type(4)));
typedef short s16x4 __attribute__((ext_vector_type(4)));
__device__ __forceinline__ s16x4 vtr(const LAS unsigned char* p) { return __builtin_bit_cast(s16x4, __builtin_amdgcn_ds_read_tr16_b64_v4i16((LAS v4i16_t*)p)); }
constexpr int KROW = 288, ATT_TILE = 64 * KROW, ATT_BUF = 2 * ATT_TILE;
constexpr float LOG2E = 1.4426950408889634f;

struct ImpArgs { float gate0, gate1; bool hvalid; LAS float* imp; };
template <int MODE, class Src, class Mask>
__device__ __forceinline__ void attn_pass(Ctx& F, LAS unsigned char* base, const bf16x8 (&Q)[2][4], f32x4 (&O)[2][8], float (&m)[2], float (&l)[2],
                                          const int k0, const int nt, const Src& src, const Mask& mask, const int tok0, const int tok1, const float sl2, const ImpArgs ia = ImpArgs{0.f, 0.f, false, nullptr}) {
    int tidv = F.tid; asm volatile("" : "+v"(tidv));
    const int lane = tidv & 63, c16 = lane & 15, g = lane >> 4;
    const int r0 = tidv >> 4, ch = tidv & 15;
    v4u kr[2], vr[2];
    __syncthreads();
#pragma unroll
    for (int i = 0; i < 2; ++i) { const int key = k0 + r0 + 32 * i; kr[i] = *(const v4u*)(src.kptr(key) + ch * 8); if (MODE != 1) vr[i] = *(const v4u*)(src.vptr(key) + ch * 8); }
#pragma unroll
    for (int i = 0; i < 2; ++i) { *(LAS v4u*)(base + (r0 + 32 * i) * KROW + ch * 16) = kr[i]; if (MODE != 1) *(LAS v4u*)(base + ATT_TILE + (r0 + 32 * i) * KROW + ch * 16) = vr[i]; }
    __syncthreads();
    float carry0 = 0.f, carry1 = 0.f;
    for (int j = 0; j < nt; ++j) {
        const LAS unsigned char* Kb = base + (j & 1) * ATT_BUF; const LAS unsigned char* Vb = Kb + ATT_TILE;
        const bool more = (j + 1 < nt);
        if (more) {
#pragma unroll
            for (int i = 0; i < 2; ++i) { const int key = k0 + 64 * (j + 1) + r0 + 32 * i; kr[i] = *(const v4u*)(src.kptr(key) + ch * 8); if (MODE != 1) vr[i] = *(const v4u*)(src.vptr(key) + ch * 8); }
        }
#pragma unroll
        for (int s32 = 0; s32 < 2; ++s32) {
            f32x4 sc[2][2];
#pragma unroll
            for (int rt = 0; rt < 2; ++rt)
#pragma unroll
                for (int st = 0; st < 2; ++st) sc[rt][st] = (f32x4){0.f, 0.f, 0.f, 0.f};
#pragma unroll
            for (int st = 0; st < 2; ++st) {
                bf16x8 kf[4];
#pragma unroll
                for (int kd = 0; kd < 4; ++kd) kf[kd] = *(const LAS bf16x8*)(Kb + (s32 * 32 + st * 16 + c16) * KROW + (g * 8 + kd * 32) * 2);
#pragma unroll
                for (int kd = 0; kd < 4; ++kd) {
                    sc[0][st] = __builtin_amdgcn_mfma_f32_16x16x32_bf16(kf[kd], Q[0][kd], sc[0][st], 0, 0, 0);
                    sc[1][st] = __builtin_amdgcn_mfma_f32_16x16x32_bf16(kf[kd], Q[1][kd], sc[1][st], 0, 0, 0);
                }
            }
            bf16x8 pf[2];
#pragma unroll
            for (int rt = 0; rt < 2; ++rt) {
                const int tk = rt ? tok1 : tok0;
                float v[8]; bool ok[8]; float mx = -1e30f;
#pragma unroll
                for (int st = 0; st < 2; ++st)
#pragma unroll
                    for (int r = 0; r < 4; ++r) { const int kidx = k0 + 64 * j + s32 * 32 + st * 16 + g * 4 + r;
                        ok[st * 4 + r] = mask(tk, kidx); v[st * 4 + r] = ok[st * 4 + r] ? sc[rt][st][r] * sl2 : -1e30f; mx = fmaxf(mx, v[st * 4 + r]); }
                if (MODE != 2) {
                    mx = fmaxf(mx, __shfl_xor(mx, 16)); mx = fmaxf(mx, __shfl_xor(mx, 32));
                    const float mn = fmaxf(m[rt], mx), alpha = __builtin_amdgcn_exp2f(m[rt] - mn); m[rt] = mn;
                    float ps = 0.f;
#pragma unroll
                    for (int i = 0; i < 8; ++i) { v[i] = ok[i] ? __builtin_amdgcn_exp2f(v[i] - mn) : 0.f; ps += v[i]; }
                    l[rt] = l[rt] * alpha + ps;
                    if (MODE == 0) {
#pragma unroll
                        for (int dt = 0; dt < 8; ++dt) O[rt][dt] = O[rt][dt] * alpha;
                    }
                } else {
                    const float mn = m[rt], linv = ia.hvalid ? l[rt] : 0.f, gt = rt ? ia.gate1 : ia.gate0;
#pragma unroll
                    for (int i = 0; i < 8; ++i) v[i] = ok[i] ? __builtin_amdgcn_exp2f(v[i] - mn) * linv : 0.f;
                    float s40 = (v[0] + v[1]) + (v[2] + v[3]), s41 = (v[4] + v[5]) + (v[6] + v[7]), la0 = v[3], la1 = v[7];
#pragma unroll
                    for (int o = 1; o < 8; o <<= 1) { s40 += __shfl_xor(s40, o); s41 += __shfl_xor(s41, o); la0 += __shfl_xor(la0, o); la1 += __shfl_xor(la1, o); }
                    const float pl0 = __shfl(la0, (lane + 48) & 63), pl1 = __shfl(la1, (lane + 48) & 63);
                    const float cprev = rt ? carry1 : carry0;
                    const float i0 = s40 + (g > 0 ? pl0 : cprev), i1 = s41 + (g > 0 ? pl1 : pl0);
                    if (rt) carry1 = pl1; else carry0 = pl1;
                    if ((lane & 7) == 0) { const int jb = ((k0 + 64 * j) >> 2) + 8 * s32 + g; LAS float* ip = ia.imp + (rt * 2 + (c16 >> 3)) * 256 + jb; ip[0] = i0; ip[4] = i1; }
#pragma unroll
                    for (int i = 0; i < 8; ++i) v[i] *= gt;
                }
                if (MODE != 1) { v4u pw; pw.x = pk2(v[0], v[1]); pw.y = pk2(v[2], v[3]); pw.z = pk2(v[4], v[5]); pw.w = pk2(v[6], v[7]);
                    pf[rt] = __builtin_bit_cast(bf16x8, pw); }
            }
            if (MODE != 1) {
#pragma unroll
            for (int dt = 0; dt < 8; ++dt) {
                const LAS unsigned char* vp = Vb + (s32 * 32 + g * 4 + (c16 >> 2)) * KROW + (dt * 16 + 4 * (c16 & 3)) * 2;
                const s16x4 lo = vtr(vp), hi = vtr(vp + 16 * KROW);
                const bf16x8 vf = {lo[0], lo[1], lo[2], lo[3], hi[0], hi[1], hi[2], hi[3]};
                O[0][dt] = __builtin_amdgcn_mfma_f32_16x16x32_bf16(vf, pf[0], O[0][dt], 0, 0, 0);
                O[1][dt] = __builtin_amdgcn_mfma_f32_16x16x32_bf16(vf, pf[1], O[1][dt], 0, 0, 0);
            }
            }
        }
        if (more) {
            LAS unsigned char* nb = base + ((j + 1) & 1) * ATT_BUF;
#pragma unroll
            for (int i = 0; i < 2; ++i) { *(LAS v4u*)(nb + (r0 + 32 * i) * KROW + ch * 16) = kr[i]; if (MODE != 1) *(LAS v4u*)(nb + ATT_TILE + (r0 + 32 * i) * KROW + ch * 16) = vr[i]; }
        }
        __syncthreads();
    }
}

struct SrcMem { const bf16* K; const bf16* V;
    __device__ __forceinline__ const bf16* kptr(int key) const { return K + (size_t)min(key, NMEM - 1) * 128; }
    __device__ __forceinline__ const bf16* vptr(int key) const { return V + (size_t)min(key, NMEM - 1) * 128; } };
struct MaskNone { __device__ __forceinline__ bool operator()(int, int) const { return true; } };

__device__ __forceinline__ void cross_fast(Ctx& F, int layer, bf16* MIX) {
    const int lane = F.lane, c16 = lane & 15, g = lane >> 4;
    for (int u = blockIdx.x; u < 256; u += F.G) {
        const int h = u & 3, tb = u >> 2;
        int tok[2]; bf16x8 Q[2][4]; f32x4 O[2][8]; float m[2], l[2];
#pragma unroll
        for (int rt = 0; rt < 2; ++rt) { tok[rt] = tb * 256 + F.wave * 32 + rt * 16 + c16; m[rt] = -1e30f; l[rt] = 0.f;
#pragma unroll
            for (int kd = 0; kd < 4; ++kd) Q[rt][kd] = *(const bf16x8*)(F.P + (size_t)tok[rt] * NP + CXQ + h * 128 + g * 8 + kd * 32);
#pragma unroll
            for (int dt = 0; dt < 8; ++dt) O[rt][dt] = (f32x4){0.f, 0.f, 0.f, 0.f}; }
        SrcMem src{F.MEMKV + (((size_t)layer * 2 + 0) * 4 + h) * NMEM * 128, F.MEMKV + (((size_t)layer * 2 + 1) * 4 + h) * NMEM * 128};
        attn_pass<0>(F, F.lds, Q, O, m, l, 0, 4, src, MaskNone(), tok[0], tok[1], 0.08838834764831845f * LOG2E);
#pragma unroll
        for (int rt = 0; rt < 2; ++rt) {
            float lt = l[rt]; lt += __shfl_xor(lt, 16); lt += __shfl_xor(lt, 32);
            const float inv = 1.f / lt;
#pragma unroll
            for (int dt = 0; dt < 8; ++dt) { const int d = dt * 16 + g * 4;
                const unsigned long long xg = *(const unsigned long long*)(F.P + (size_t)tok[rt] * NP + CXG + h * 128 + d);
                const unsigned lo = (unsigned)xg, hi = (unsigned)(xg >> 32);
                const float o0 = O[rt][dt][0] * inv * silu_f(bf2f((bf16)(lo & 0xffff))), o1 = O[rt][dt][1] * inv * silu_f(bf2f((bf16)(lo >> 16)));
                const float o2 = O[rt][dt][2] * inv * silu_f(bf2f((bf16)(hi & 0xffff))), o3 = O[rt][dt][3] * inv * silu_f(bf2f((bf16)(hi >> 16)));
                *(unsigned long long*)(MIX + (size_t)tok[rt] * DM + 1536 + h * 128 + d) = (unsigned long long)pk2(o0, o1) | ((unsigned long long)pk2(o2, o3) << 32); }
        }
    }
}


struct SrcWin { const bf16* P; int g;
    __device__ __forceinline__ const bf16* kptr(int key) const { return P + (size_t)min(max(key, 0), T - 1) * NP + NKW + g * 128; }
    __device__ __forceinline__ const bf16* vptr(int key) const { return P + (size_t)min(max(key, 0), T - 1) * NP + NVW + g * 128; } };
struct MaskWin { __device__ __forceinline__ bool operator()(int t, int key) const { return key <= t && key > t - 512; } };
struct SrcCmp { const bf16* K; const bf16* V;
    __device__ __forceinline__ const bf16* kptr(int key) const { return K + (size_t)min(key, 1022) * 128; }
    __device__ __forceinline__ const bf16* vptr(int key) const { return V + (size_t)min(key, 1022) * 128; } };
struct MaskCmp { __device__ __forceinline__ bool operator()(int t, int key) const { return 16 * key + 31 <= t; } };

__device__ __forceinline__ void nsa_main_fast(Ctx& F) {
    const int lane = F.lane, c16 = lane & 15, gq = lane >> 4, ts = c16 >> 3, hs = c16 & 7; const bool hv = hs < 6;
    const float sl2 = 0.08838834764831845f * LOG2E;
    LAS float* imp = (LAS float*)(F.lds + 73728) + F.wave * 1024;
    LAS unsigned char* vbuf = F.lds + F.wave * 9216;
    for (int u = blockIdx.x; u < 1024; u += F.G) {
        const int g = u & 1, tb = u >> 1;
        int tok[2]; f32x4 O[2][8];
        {
            bf16x8 Q[2][4]; float m[2], l[2], gw[2], gc[2];
#pragma unroll
            for (int rt = 0; rt < 2; ++rt) { tok[rt] = tb * 32 + F.wave * 4 + rt * 2 + ts; m[rt] = -1e30f; l[rt] = 0.f;
                const bf16* pr = F.P + (size_t)tok[rt] * NP;
#pragma unroll
                for (int kd = 0; kd < 4; ++kd) { Q[rt][kd] = (bf16x8){0, 0, 0, 0, 0, 0, 0, 0}; if (hv) Q[rt][kd] = *(const bf16x8*)(pr + NQ + (g * 6 + hs) * 128 + gq * 8 + kd * 32); }
                gw[rt] = hv ? sigmoid_f(bf2f(pr[CGL + g * 18 + hs * 3 + 2])) : 0.f; gc[rt] = hv ? sigmoid_f(bf2f(pr[CGL + g * 18 + hs * 3 + 0])) : 0.f;
#pragma unroll
                for (int dt = 0; dt < 8; ++dt) O[rt][dt] = (f32x4){0.f, 0.f, 0.f, 0.f}; }
            { const int klo = max(0, tb * 32 - 511), k0 = (klo >> 6) << 6, nt = ((tb * 32 + 31 - k0) >> 6) + 1;
              attn_pass<0>(F, F.lds, Q, O, m, l, k0, nt, SrcWin{F.P, g}, MaskWin(), tok[0], tok[1], sl2); }
#pragma unroll
            for (int rt = 0; rt < 2; ++rt) { float lt = l[rt]; lt += __shfl_xor(lt, 16); lt += __shfl_xor(lt, 32); const float f = gw[rt] / lt;
#pragma unroll
                for (int dt = 0; dt < 8; ++dt) O[rt][dt] = O[rt][dt] * f; m[rt] = -1e30f; l[rt] = 0.f; }
            const int tlast = tb * 32 + 31, ncv = (tlast - 31) / 16 + 1, ntc = (ncv + 63) >> 6;
            SrcCmp sc_{F.KCMP + (size_t)g * 1024 * 128, F.VCMP + (size_t)g * 1024 * 128};
            attn_pass<1>(F, F.lds, Q, O, m, l, 0, ntc, sc_, MaskCmp(), tok[0], tok[1], sl2);
#pragma unroll
            for (int rt = 0; rt < 2; ++rt) { float lt = l[rt]; lt += __shfl_xor(lt, 16); lt += __shfl_xor(lt, 32); l[rt] = lt > 0.f ? 1.f / lt : 0.f; }
            attn_pass<2>(F, F.lds, Q, O, m, l, 0, ntc, sc_, MaskCmp(), tok[0], tok[1], sl2, ImpArgs{gc[0], gc[1], hv, imp});
        }
#pragma unroll
        for (int rt = 0; rt < 2; ++rt) {
            for (int tss = 0; tss < 2; ++tss) {
                const int tt = tb * 32 + F.wave * 4 + rt * 2 + tss, cur = tt >> 6;
                int mysel = 0;
                { float iv[4];
#pragma unroll
                  for (int i = 0; i < 4; ++i) { const int jj = lane + 64 * i; iv[i] = imp[(rt * 2 + tss) * 256 + jj]; if (jj == 0 || jj == cur || jj == cur - 1) iv[i] = 1e4f; if (jj > cur) iv[i] = -1e4f; }
#pragma unroll
                  for (int r = 0; r < 16; ++r) {
                      float bv = iv[0]; int bi = lane;
#pragma unroll
                      for (int i = 1; i < 4; ++i) { if (iv[i] > bv) { bv = iv[i]; bi = lane + 64 * i; } }
#pragma unroll
                      for (int o = 1; o < 64; o <<= 1) { const float ov = __shfl_xor(bv, o); const int oi = __shfl_xor(bi, o); if (ov > bv || (ov == bv && oi < bi)) { bv = ov; bi = oi; } }
                      mysel = (lane == r) ? bi : mysel;
#pragma unroll
                      for (int i = 0; i < 4; ++i) if (lane + 64 * i == bi) iv[i] = -3e38f;
                  } }
                const bool mine = hv && (ts == tss);
                const bf16* pr = F.P + (size_t)tok[rt] * NP;
                bf16x8 qz[4];
#pragma unroll
                for (int kd = 0; kd < 4; ++kd) { qz[kd] = (bf16x8){0, 0, 0, 0, 0, 0, 0, 0}; if (mine) qz[kd] = *(const bf16x8*)(pr + NQ + (g * 6 + hs) * 128 + gq * 8 + kd * 32); }
                f32x4 O2[8]; float m2 = -1e30f, l2 = 0.f;
#pragma unroll
                for (int dt = 0; dt < 8; ++dt) O2[dt] = (f32x4){0.f, 0.f, 0.f, 0.f};
                const int nsteps = 2 * min(16, cur + 1);
                bf16x8 kf[2][4];
                const unsigned koff = (unsigned)((c16 * NP + NKS + g * 128 + gq * 8) * 2), voff = (unsigned)((gq * NP + NVS + g * 128 + c16 * 8) * 2);
                { const int kb = 64 * __builtin_amdgcn_readlane(mysel, 0); const char* ub = (const char*)F.P + (size_t)kb * (NP * 2);
#pragma unroll
                  for (int st = 0; st < 2; ++st)
#pragma unroll
                      for (int kd = 0; kd < 4; ++kd) kf[st][kd] = *(const bf16x8*)(ub + (size_t)st * (16 * NP * 2) + koff + kd * 64); }
                for (int s = 0; s < nsteps; ++s) {
                    const int kbase = 64 * __builtin_amdgcn_readlane(mysel, s >> 1) + 32 * (s & 1);
                    const char* ubv = (const char*)F.P + (size_t)kbase * (NP * 2);
                    f32x4 sc[2] = {(f32x4){0.f, 0.f, 0.f, 0.f}, (f32x4){0.f, 0.f, 0.f, 0.f}};
#pragma unroll
                    for (int st = 0; st < 2; ++st)
#pragma unroll
                        for (int kd = 0; kd < 4; ++kd) sc[st] = __builtin_amdgcn_mfma_f32_16x16x32_bf16(kf[st][kd], qz[kd], sc[st], 0, 0, 0);
                    { v4u vs[8];
#pragma unroll
                      for (int i = 0; i < 8; ++i) vs[i] = *(const v4u*)(ubv + (size_t)i * (4 * NP * 2) + voff);
#pragma unroll
                      for (int i = 0; i < 8; ++i) *(LAS v4u*)(vbuf + (gq + 4 * i) * KROW + c16 * 16) = vs[i]; }
                    if (s + 1 < nsteps) { const int kbn = 64 * __builtin_amdgcn_readlane(mysel, (s + 1) >> 1) + 32 * ((s + 1) & 1); const char* ub = (const char*)F.P + (size_t)kbn * (NP * 2);
#pragma unroll
                        for (int st = 0; st < 2; ++st)
#pragma unroll
                            for (int kd = 0; kd < 4; ++kd) kf[st][kd] = *(const bf16x8*)(ub + (size_t)st * (16 * NP * 2) + koff + kd * 64); }
                    float v[8]; bool ok[8]; float mx = -1e30f;
#pragma unroll
                    for (int st = 0; st < 2; ++st)
#pragma unroll
                        for (int r = 0; r < 4; ++r) { const int kidx = kbase + st * 16 + gq * 4 + r; ok[st * 4 + r] = kidx <= tt; v[st * 4 + r] = ok[st * 4 + r] ? sc[st][r] * sl2 : -1e30f; mx = fmaxf(mx, v[st * 4 + r]); }
                    mx = fmaxf(mx, __shfl_xor(mx, 16)); mx = fmaxf(mx, __shfl_xor(mx, 32));
                    const float mn = fmaxf(m2, mx), alpha = __builtin_amdgcn_exp2f(m2 - mn); m2 = mn;
                    float ps = 0.f;
#pragma unroll
                    for (int i = 0; i < 8; ++i) { v[i] = ok[i] ? __builtin_amdgcn_exp2f(v[i] - mn) : 0.f; ps += v[i]; }
                    l2 = l2 * alpha + ps;
#pragma unroll
                    for (int dt = 0; dt < 8; ++dt) O2[dt] = O2[dt] * alpha;
                    v4u pw; pw.x = pk2(v[0], v[1]); pw.y = pk2(v[2], v[3]); pw.z = pk2(v[4], v[5]); pw.w = pk2(v[6], v[7]);
                    const bf16x8 pf = __builtin_bit_cast(bf16x8, pw);
#pragma unroll
                    for (int dt = 0; dt < 8; ++dt) {
                        const LAS unsigned char* vp = vbuf + (gq * 4 + (c16 >> 2)) * KROW + (dt * 16 + 4 * (c16 & 3)) * 2;
                        const s16x4 lo = vtr(vp), hi = vtr(vp + 16 * KROW);
                        const bf16x8 vf = {lo[0], lo[1], lo[2], lo[3], hi[0], hi[1], hi[2], hi[3]};
                        O2[dt] = __builtin_amdgcn_mfma_f32_16x16x32_bf16(vf, pf, O2[dt], 0, 0, 0);
                    }
                }
                float lt = l2; lt += __shfl_xor(lt, 16); lt += __shfl_xor(lt, 32);
                const float f = mine ? sigmoid_f(bf2f(pr[CGL + g * 18 + hs * 3 + 1])) / lt : 0.f;
#pragma unroll
                for (int dt = 0; dt < 8; ++dt) O[rt][dt] = O[rt][dt] + O2[dt] * f;
            }
        }
        if (hv) {
#pragma unroll
            for (int rt = 0; rt < 2; ++rt) {
#pragma unroll
                for (int dt = 0; dt < 8; ++dt) { const int d = dt * 16 + gq * 4; const int col = (g * 6 + hs) * 128 + d;
                    const unsigned long long rr = *(const unsigned long long*)(F.P + (size_t)tok[rt] * NP + CR + col);
                    const unsigned lo = (unsigned)rr, hi = (unsigned)(rr >> 32);
                    const float o0 = O[rt][dt][0] * silu_f(bf2f((bf16)(lo & 0xffff))), o1 = O[rt][dt][1] * silu_f(bf2f((bf16)(lo >> 16)));
                    const float o2 = O[rt][dt][2] * silu_f(bf2f((bf16)(hi & 0xffff))), o3 = O[rt][dt][3] * silu_f(bf2f((bf16)(hi >> 16)));
                    *(unsigned long long*)(F.MIX1 + (size_t)tok[rt] * DM + col) = (unsigned long long)pk2(o0, o1) | ((unsigned long long)pk2(o2, o3) << 32); }
            }
        }
    }
}


__device__ __forceinline__ void gla_g1_fast(Ctx& F) {
    int tidv = F.tid; asm volatile("" : "+v"(tidv));
    const int tid = tidv, lane = tidv & 63, c16 = lane & 15, gq = lane >> 4, wave = F.wave;
    constexpr int QP = 416, VP = 800;
    LAS float* bcum = (LAS float*)F.lds;
    LAS unsigned char* Vt = F.lds;
    LAS unsigned char* QT = F.lds + 51200;
    LAS unsigned char* KT = F.lds + 51200 + 26624;
    LAS float* eblast = (LAS float*)(F.lds + 104448);
    LAS float* tot0 = (LAS float*)(F.lds + 105216);
    LAS float* glr = (LAS float*)(F.lds + 105984);
    const float qscale = 0.07216878364870323f;
    for (int u = blockIdx.x; u < 1024; u += F.G) {
        const int n = u >> 2, h = u & 3; const size_t row0 = (size_t)n * 64;
        for (int i = tid; i < 1024; i += NTHR) glr[i] = bf2f(F.P[(row0 + (i >> 4)) * NP + CGL + (i & 15)]);
        __syncthreads();
        if (tid < 384) {
            const int seg = tid >= 192 ? 1 : 0, d = tid - 192 * seg, col = h * 192 + d; float wg[16];
#pragma unroll
            for (int j = 0; j < 16; ++j) wg[j] = F.gla_w_gate[j * 768 + col];
            const float bias = F.gla_b_gate[col]; float b = 0.f;
            for (int c = 32 * seg; c < 32 * seg + 32; ++c) { float gl = bias;
#pragma unroll
                for (int j = 0; j < 16; ++j) gl += glr[c * 16 + j] * wg[j];
                b += logsigmoid_f(gl) * (1.f / 16.f); bcum[c * 192 + d] = b; }
            if (seg == 0) tot0[d] = b;
        }
        __syncthreads();
        if (tid >= 192 && tid < 384) { const int d = tid - 192; const float t0 = tot0[d];
            for (int c = 32; c < 64; ++c) bcum[c * 192 + d] += t0; }
        __syncthreads();
        if (tid < 192) { const float eb = __expf(bcum[63 * 192 + tid]); eblast[tid] = eb; F.DEC[n * 768 + h * 192 + tid] = eb; }
#pragma unroll
        for (int i = 0; i < 3; ++i) { const int idx = tid + NTHR * i, c = idx / 24, d8 = (idx % 24) * 8;
            bf16* qg = F.P + (row0 + c) * NP + GQ + h * 192 + d8; const bf16* kg = F.P + (row0 + c) * NP + GK + h * 192 + d8;
            const v4u qr = *(const v4u*)qg, kr = *(const v4u*)kg;
            const unsigned qw[4] = {qr.x, qr.y, qr.z, qr.w}, kw[4] = {kr.x, kr.y, kr.z, kr.w}; unsigned qo[4], ko[4];
#pragma unroll
            for (int j = 0; j < 4; ++j) { const float b0 = bcum[c * 192 + d8 + 2 * j], b1 = bcum[c * 192 + d8 + 2 * j + 1];
                qo[j] = pk2(bf2f((bf16)(qw[j] & 0xffff)) * qscale * __expf(b0), bf2f((bf16)(qw[j] >> 16)) * qscale * __expf(b1));
                ko[j] = pk2(bf2f((bf16)(kw[j] & 0xffff)) * __expf(-b0), bf2f((bf16)(kw[j] >> 16)) * __expf(-b1)); }
            const v4u qv = {qo[0], qo[1], qo[2], qo[3]}, kv = {ko[0], ko[1], ko[2], ko[3]};
            *(LAS v4u*)(QT + c * QP + d8 * 2) = qv; *(LAS v4u*)(KT + c * QP + d8 * 2) = kv; *(v4u*)qg = qv; }
        __syncthreads();
#pragma unroll
        for (int i = 0; i < 6; ++i) { const int idx = tid + NTHR * i, r = idx / 48, ch = idx % 48;
            *(LAS v4u*)(Vt + r * VP + ch * 16) = *(const v4u*)(F.P + (row0 + r) * NP + GV + h * 384 + ch * 8); }
        __syncthreads();
        {
            bf16x8 vB[3][2];
#pragma unroll
            for (int j = 0; j < 3; ++j)
#pragma unroll
                for (int ks = 0; ks < 2; ++ks) { const LAS unsigned char* p = Vt + (32 * ks + 4 * gq + (c16 >> 2)) * VP + (16 * (3 * wave + j) + 4 * (c16 & 3)) * 2;
                    const s16x4 lo = vtr(p), hi = vtr(p + 16 * VP); vB[j][ks] = (bf16x8){lo[0], lo[1], lo[2], lo[3], hi[0], hi[1], hi[2], hi[3]}; }
            for (int dt = 0; dt < 12; ++dt) {
                bf16x8 aK[2];
#pragma unroll
                for (int ks = 0; ks < 2; ++ks) { const LAS unsigned char* p = KT + (32 * ks + 4 * gq + (c16 >> 2)) * QP + (16 * dt + 4 * (c16 & 3)) * 2;
                    const s16x4 lo = vtr(p), hi = vtr(p + 16 * QP); aK[ks] = (bf16x8){lo[0], lo[1], lo[2], lo[3], hi[0], hi[1], hi[2], hi[3]}; }
                const f32x4 eb = *(const LAS f32x4*)(eblast + 16 * dt + 4 * gq);
#pragma unroll
                for (int j = 0; j < 3; ++j) { f32x4 acc = {0.f, 0.f, 0.f, 0.f};
                    acc = __builtin_amdgcn_mfma_f32_16x16x32_bf16(aK[0], vB[j][0], acc, 0, 0, 0);
                    acc = __builtin_amdgcn_mfma_f32_16x16x32_bf16(aK[1], vB[j][1], acc, 0, 0, 0);
                    const int e = 16 * (3 * wave + j) + c16;
                    *(unsigned long long*)(F.STATE + ((size_t)u * 384 + e) * 192 + 16 * dt + 4 * gq) = (unsigned long long)pk2(acc[0] * eb[0], acc[1] * eb[1]) | ((unsigned long long)pk2(acc[2] * eb[2], acc[3] * eb[3]) << 32); }
            }
        }
        {
            const int ct = wave & 3, eh = wave >> 2;
            bf16x8 qB[6];
#pragma unroll
            for (int kd = 0; kd < 6; ++kd) qB[kd] = *(const LAS bf16x8*)(QT + (16 * ct + c16) * QP + (8 * gq + 32 * kd) * 2);
            f32x4 at[4];
#pragma unroll
            for (int st = 0; st < 4; ++st) { at[st] = (f32x4){0.f, 0.f, 0.f, 0.f};
                if (st <= ct) {
#pragma unroll
                    for (int kd = 0; kd < 6; ++kd) { const bf16x8 kA = *(const LAS bf16x8*)(KT + (16 * st + c16) * QP + (8 * gq + 32 * kd) * 2);
                        at[st] = __builtin_amdgcn_mfma_f32_16x16x32_bf16(kA, qB[kd], at[st], 0, 0, 0); }
#pragma unroll
                    for (int r = 0; r < 4; ++r) if (16 * st + 4 * gq + r > 16 * ct + c16) at[st][r] = 0.f;
                } }
            v4u pw0, pw1; pw0.x = pk2(at[0][0], at[0][1]); pw0.y = pk2(at[0][2], at[0][3]); pw0.z = pk2(at[1][0], at[1][1]); pw0.w = pk2(at[1][2], at[1][3]);
            pw1.x = pk2(at[2][0], at[2][1]); pw1.y = pk2(at[2][2], at[2][3]); pw1.z = pk2(at[3][0], at[3][1]); pw1.w = pk2(at[3][2], at[3][3]);
            const bf16x8 pA0 = __builtin_bit_cast(bf16x8, pw0), pA1 = __builtin_bit_cast(bf16x8, pw1);
            for (int j = 0; j < 12; ++j) { const int et = 12 * eh + j;
                bf16x8 vA[2];
#pragma unroll
                for (int ks = 0; ks < 2; ++ks) { const LAS unsigned char* p = Vt + (32 * ks + 4 * gq + (c16 >> 2)) * VP + (16 * et + 4 * (c16 & 3)) * 2;
                    const s16x4 lo = vtr(p), hi = vtr(p + 16 * VP); vA[ks] = (bf16x8){lo[0], lo[1], lo[2], lo[3], hi[0], hi[1], hi[2], hi[3]}; }
                f32x4 acc = {0.f, 0.f, 0.f, 0.f};
                acc = __builtin_amdgcn_mfma_f32_16x16x32_bf16(vA[0], pA0, acc, 0, 0, 0);
                acc = __builtin_amdgcn_mfma_f32_16x16x32_bf16(vA[1], pA1, acc, 0, 0, 0);
                *(unsigned long long*)(F.OI + (row0 + 16 * ct + c16) * 1536 + h * 384 + 16 * et + 4 * gq) = (unsigned long long)pk2(acc[0], acc[1]) | ((unsigned long long)pk2(acc[2], acc[3]) << 32); }
        }
        __syncthreads();
    }
}

__device__ __forceinline__ void gla_g3_fast(Ctx& F) {
    int tidv = F.tid; asm volatile("" : "+v"(tidv));
    const int lane = tidv & 63, c16 = lane & 15, gq = lane >> 4, wave = F.wave, ct = wave & 3, eh = wave >> 2;
    LAS float* ssq = (LAS float*)F.lds;
    for (int u = blockIdx.x; u < 1024; u += F.G) {
        const int n = u >> 2, h = u & 3; const size_t crow = (size_t)n * 64 + 16 * ct + c16;
        f32x4 acc[12];
#pragma unroll
        for (int j = 0; j < 12; ++j) acc[j] = (f32x4){0.f, 0.f, 0.f, 0.f};
        if (n > 0) {
            bf16x8 qB[6];
#pragma unroll
            for (int kd = 0; kd < 6; ++kd) qB[kd] = *(const bf16x8*)(F.P + crow * NP + GQ + h * 192 + 8 * gq + 32 * kd);
            const bf16* Sp = F.STATE + ((size_t)(u - 4) * 384 + 192 * eh + c16) * 192 + 8 * gq;
#pragma unroll
            for (int j = 0; j < 12; ++j)
#pragma unroll
                for (int kd = 0; kd < 6; ++kd) { const bf16x8 a = *(const bf16x8*)(Sp + (size_t)(16 * j) * 192 + 32 * kd);
                    acc[j] = __builtin_amdgcn_mfma_f32_16x16x32_bf16(a, qB[kd], acc[j], 0, 0, 0); }
        }
        float ss = 0.f;
#pragma unroll
        for (int j = 0; j < 12; ++j) { const int e0 = h * 384 + 192 * eh + 16 * j + 4 * gq;
            const unsigned long long oi = *(const unsigned long long*)(F.OI + crow * 1536 + e0); const unsigned lo = (unsigned)oi, hi = (unsigned)(oi >> 32);
            acc[j][0] += bf2f((bf16)(lo & 0xffff)); acc[j][1] += bf2f((bf16)(lo >> 16)); acc[j][2] += bf2f((bf16)(hi & 0xffff)); acc[j][3] += bf2f((bf16)(hi >> 16));
            ss += (acc[j][0] * acc[j][0] + acc[j][1] * acc[j][1]) + (acc[j][2] * acc[j][2] + acc[j][3] * acc[j][3]); }
        ss += __shfl_xor(ss, 16); ss += __shfl_xor(ss, 32);
        if (gq == 0) ssq[eh * 64 + 16 * ct + c16] = ss;
        __syncthreads();
        const float rstd = rsqrtf((ssq[16 * ct + c16] + ssq[64 + 16 * ct + c16]) * (1.f / 384.f) + EPS);
#pragma unroll
        for (int j = 0; j < 12; ++j) { const int el = 192 * eh + 16 * j + 4 * gq, e0 = h * 384 + el;
            const f32x4 gn = *(const f32x4*)(F.gla_norm + el);
            const unsigned long long rr = *(const unsigned long long*)(F.P + crow * NP + CR + e0); const unsigned lo = (unsigned)rr, hi = (unsigned)(rr >> 32);
            const float o0 = acc[j][0] * rstd * gn[0] * silu_f(bf2f((bf16)(lo & 0xffff))), o1 = acc[j][1] * rstd * gn[1] * silu_f(bf2f((bf16)(lo >> 16)));
            const float o2 = acc[j][2] * rstd * gn[2] * silu_f(bf2f((bf16)(hi & 0xffff))), o3 = acc[j][3] * rstd * gn[3] * silu_f(bf2f((bf16)(hi >> 16)));
            *(unsigned long long*)(F.MIX0 + crow * DM + e0) = (unsigned long long)pk2(o0, o1) | ((unsigned long long)pk2(o2, o3) << 32); }
        __syncthreads();
    }
}

__global__ void __launch_bounds__(NTHR, 2) fwd_kernel(Args args) {
    extern __shared__ __attribute__((aligned(16))) unsigned char lds_raw[];
    Ctx F;
    F.lds = (LAS unsigned char*)lds_raw;
    F.tid = threadIdx.x; F.lane = F.tid & 63; F.wave = __builtin_amdgcn_readfirstlane(F.tid >> 6);
    F.G = gridDim.x; F.gw = blockIdx.x * NWAVES + F.wave; F.NGW = F.G * NWAVES;
    F.x = args.in[0]; F.mem = args.in[1]; F.ln_pre = args.in[2]; F.ln_post = args.in[3]; F.ln_mem = args.in[4]; F.w_mem_kv = args.in[5];
    F.gla_w_in = args.in[6]; F.gla_w_gate = args.in[7]; F.gla_b_gate = args.in[8]; F.gla_norm = args.in[9]; F.gla_w_out = args.in[10];
    F.nsa_w_in = args.in[11]; F.pe_k = args.in[12]; F.pe_v = args.in[13]; F.wk1 = args.in[14]; F.wk2 = args.in[15]; F.wv1 = args.in[16]; F.wv2 = args.in[17]; F.nsa_w_out = args.in[18];
    F.out = args.out; F.ws = args.ws;
    unsigned char* ws = args.ws;
    F.WIN0 = (bf16*)(ws + WS_WIN0); F.WIN1 = (bf16*)(ws + WS_WIN1); F.WOUT0 = (bf16*)(ws + WS_WOUT0); F.WOUT1 = (bf16*)(ws + WS_WOUT1); F.WMKV = (bf16*)(ws + WS_WMKV);
    F.MEMKV = (bf16*)(ws + WS_MEMKV); F.DEC = (float*)(ws + WS_DEC); F.KCMP = (bf16*)(ws + WS_KCMP); F.VCMP = (bf16*)(ws + WS_VCMP);
    F.XN = (bf16*)(ws + WS_XN); F.P = (bf16*)(ws + WS_P); F.STATE = (bf16*)(ws + WS_STATE); F.MIX1 = (bf16*)(ws + WS_MIX1);
    F.MIX0 = (bf16*)((unsigned char*)args.out + DO_MIX0); F.OI = (bf16*)((unsigned char*)args.out + DO_OI);

    volatile LAS unsigned* MISC = (volatile LAS unsigned*)(F.lds + MISC_OFF);
    for (int u = F.tid; u < (LDS_BYTES - LDSCTL_OFF) / 4; u += NTHR) ((LAS unsigned*)(F.lds + LDSCTL_OFF))[u] = 0u;
    __syncthreads();
    const int lo = args.ph_lo, hi = args.ph_hi;
    XcdBarrier bar; bar.bar = (unsigned*)(ws + WS_CTL); bar.x = 0; bar.st = nullptr;
    if (hi - lo > 1) bar = xcd_barrier_post((unsigned*)(ws + WS_CTL), MISC + 8);
#define IN(k) (lo <= (k) && (k) < hi)
#define REFRESH() do { int t_ = threadIdx.x; asm volatile("" : "+v"(t_)); F.tid = t_; F.lane = t_ & 63; } while (0)
#define SEAM(k) do { if (IN(k) && IN((k) + 1)) xcd_barrier(bar); } while (0)

    if (IN(0)) { REFRESH(); phase_prep(F); } SEAM(0);
    if (IN(1)) { REFRESH(); memkv_naive(F);
        pg8::Gemm g{F.XN, F.WIN0, T, NP, DM}; pg8::StaticOrder S; S.init(T, NP, F.G, (int)blockIdx.x);
        pg8::EpiBf16<0> E{F.P, NP, nullptr, 0, 0, 1.f};
        pg8::gemm_phase<pg8::EpiBf16<0>, pg8::StaticOrder, true, true>(F.lds, g, S, E); } SEAM(1);
    if (IN(2)) { REFRESH(); gla_g1_fast(F); REFRESH(); cross_fast(F, 0, F.MIX0); } SEAM(2);
    if (IN(3)) { REFRESH(); gla_scan(F); } SEAM(3);
    if (IN(4)) { REFRESH(); gla_g3_fast(F); } SEAM(4);
    if (IN(5)) { REFRESH(); pg8::Gemm g{F.MIX0, F.WOUT0, T, DM, DM}; pg8::StaticOrder S; S.init(T, DM, F.G, (int)blockIdx.x);
        pg8::EpiBf16<0> E{F.XN, DM, nullptr, 0, 0, 1.f};
        pg8::gemm_phase<pg8::EpiBf16<0>, pg8::StaticOrder, true, true>(F.lds, g, S, E); } SEAM(5);
    if (IN(6)) { REFRESH(); post_rows(F, F.x, F.XN, F.ln_post, F.out, F.ln_pre + DM, F.XN); } SEAM(6);
    if (IN(7)) { REFRESH(); pg8::Gemm g{F.XN, F.WIN1, T, NP, DM}; pg8::StaticOrder S; S.init(T, NP, F.G, (int)blockIdx.x);
        pg8::EpiBf16<0> E{F.P, NP, nullptr, 0, 0, 1.f};
        pg8::gemm_phase<pg8::EpiBf16<0>, pg8::StaticOrder, true, true>(F.lds, g, S, E); } SEAM(7);
    if (IN(8)) { REFRESH(); nsa_compress_naive(F); } SEAM(8);
    if (IN(9)) { REFRESH(); nsa_main_fast(F); REFRESH(); cross_fast(F, 1, F.MIX1); } SEAM(9);
    if (IN(10)) { REFRESH(); pg8::Gemm g{F.MIX1, F.WOUT1, T, DM, DM}; pg8::StaticOrder S; S.init(T, DM, F.G, (int)blockIdx.x);
        pg8::EpiBf16<0> E{F.XN, DM, nullptr, 0, 0, 1.f};
        pg8::gemm_phase<pg8::EpiBf16<0>, pg8::StaticOrder, true, true>(F.lds, g, S, E); } SEAM(10);
    if (IN(11)) { REFRESH(); post_rows(F, F.out, F.XN, F.ln_post + DM, F.out, nullptr, nullptr); }
#undef IN
#undef SEAM
}

#ifndef N_LAUNCHES
#define N_LAUNCHES 1
#endif
extern "C" void kernel_launch(void* const* d_in, const int* in_sizes, int n_in, void* d_out, int out_size, void* d_ws, size_t ws_size, hipStream_t stream) {
    static int grid = 0;
    if (grid == 0) {
        if (n_in != 19 || out_size != T * DM || ws_size < WS_END) { fprintf(stderr, "kernel_launch: unexpected shapes (n_in %d out %d ws %zu)\n", n_in, out_size, ws_size); grid = -1; return; }
        int dev = 0, cus = 0, per_cu = 0;
        if (hipGetDevice(&dev) != hipSuccess || hipDeviceGetAttribute(&cus, hipDeviceAttributeMultiprocessorCount, dev) != hipSuccess) { grid = -1; return; }
        if (hipFuncSetAttribute((const void*)fwd_kernel, hipFuncAttributeMaxDynamicSharedMemorySize, LDS_BYTES) != hipSuccess) { fprintf(stderr, "kernel_launch: hipFuncSetAttribute failed\n"); grid = -1; return; }
        if (hipOccupancyMaxActiveBlocksPerMultiprocessor(&per_cu, (const void*)fwd_kernel, NTHR, LDS_BYTES) != hipSuccess || per_cu < 1) fprintf(stderr, "kernel_launch: occupancy query reports %d\n", per_cu);
        (void)hipGetLastError();
        grid = cus;
    }
    if (grid < 0) return;
    if (hipMemsetAsync((char*)d_ws + WS_CTL, 0, CTL_ZERO_BYTES, stream) != hipSuccess) return;
    Args a{};
    for (int i = 0; i < 19; ++i) a.in[i] = (const float*)d_in[i];
    a.out = (float*)d_out; a.ws = (unsigned char*)d_ws;
    for (int li = 0; li < N_LAUNCHES; ++li) {
        a.ph_lo = li * N_PHASES / N_LAUNCHES; a.ph_hi = (li + 1) * N_PHASES / N_LAUNCHES;
        hipLaunchKernelGGL(fwd_kernel, dim3(grid), dim3(NTHR), LDS_BYTES, stream, a);
    }
}
```

```cpp
#include <hip/hip_runtime.h>
#include <cstdio>
#include <cstdint>
namespace pg8 {
#define PG8_LAS __attribute__((address_space(3)))
typedef unsigned short bf16_t;
typedef short bf16x8 __attribute__((ext_vector_type(8)));
typedef float f32x4 __attribute__((ext_vector_type(4)));
typedef unsigned u32x4 __attribute__((ext_vector_type(4)));
constexpr int BM = 256, BK = 64, HALF = 128, HTB = HALF * BK * 2  , STAGE_BYTES = 8 * HTB, NXCD = 8, WGM = 8;

__host__ __device__ __forceinline__ int lds_byte(int r, int c) { const int st = (r >> 4) * 2 + (c >> 5), rr = r & 15, cc = c & 31, ob = rr * 64 + cc * 2; return st * 1024 + (ob ^ (((ob >> 9) & 1) << 5)); }
__host__ __device__ __forceinline__ void stage_rc(int b, int& R, int& C) { const int st = b / 1024, sb = b % 1024, swz = sb ^ (((sb >> 9) & 1) << 5); R = (st >> 1) * 16 + swz / 64; C = (st & 1) * 32 + (swz % 64) / 2; }
__host__ __device__ __forceinline__ int perm32(int rho) { const int n = rho >> 4, i = rho & 15; return 8 * (i >> 2) + 4 * n + (i & 3); }

struct Unit { int pm, pn; };
struct Gemm { const bf16_t* A; const bf16_t* Bt; int M, N, K; };

struct StaticOrder {
    int nM, nN, nwg, G, c;
    __host__ __device__ void init(int M, int N, int G_, int c_) { nM = M / BM; nN = N / BM; nwg = nM * nN; G = G_; c = c_; }
    __host__ __device__ bool next(int i, Unit& u) const {
        const long L = (long)i * G + c; if (L >= nwg) return false;
        int wgid = (int)L; { const int q = nwg / NXCD, r = nwg % NXCD, xcd = wgid % NXCD, off = wgid / NXCD; wgid = (xcd < r ? xcd * (q + 1) : r * (q + 1) + (xcd - r) * q) + off; }
        const int nig = WGM * nN, gid = wgid / nig, fm = gid * WGM, gsz = (nM - fm) < WGM ? (nM - fm) : WGM;
        u.pm = fm + ((wgid % nig) % gsz); u.pn = (wgid % nig) / gsz; return true;
    }
    __device__ __forceinline__ void a_ready(const Unit&) const {}
    __device__ __forceinline__ void done(const Unit&) const {}
};

__device__ __forceinline__ unsigned cvt_pk_bf16(float lo, float hi) { unsigned r; asm volatile("v_cvt_pk_bf16_f32 %0, %1, %2" : "=v"(r) : "v"(lo), "v"(hi)); return r; }
typedef float f32x2 __attribute__((ext_vector_type(2)));
__device__ __forceinline__ f32x2 gelu_pk(f32x2 v) {
    const f32x2 av = __builtin_elementwise_abs(v), d = av * 0.2316418882f + 1.0f;
    f32x2 t; t.x = __builtin_amdgcn_rcpf(d.x); t.y = __builtin_amdgcn_rcpf(d.y);
    f32x2 q = t * 0.5307027145f + (-0.7265760135f); q = q * t + 0.7107068705f; q = q * t + (-0.142248368f); q = q * t + 0.127414796f; q = q * t;
    const f32x2 s = (v * v) * (-0.72134752044f);
    f32x2 e; e.x = __builtin_amdgcn_exp2f(s.x); e.y = __builtin_amdgcn_exp2f(s.y);
    const f32x2 m = v * (q * e), r = v - m;
    f32x2 o; o.x = v.x < 0.f ? m.x : r.x; o.y = v.y < 0.f ? m.y : r.y; return o;
}

template <int ACT  > struct EpiBf16 {
    static constexpr bool PERM = true, AFTER_DRAIN = false; static_assert(ACT == 0 || ACT == 1, "EpiBf16: ACT is 0 (none) or 1 (gelu_pk)");
    bf16_t* O; int ldc; const float* bias; int split_cols; size_t split_stride; float scale0;
    __device__ __forceinline__ void operator()(const f32x4 (&acc)[2][2][4][2], const Unit& u, int wr, int wc, int fr, int fq) const {
        const int row0 = u.pm * BM + wr * 64 + fr; int colt = u.pn * BM; bf16_t* base = O;
        float sc = 1.f; if (split_cols) { const int t = colt / split_cols; base += (size_t)t * split_stride; colt -= t * split_cols; if (t == 0) sc = scale0; }
        const int col0 = colt + wc * 32 + 8 * fq, bcol0 = u.pn * BM + wc * 32 + 8 * fq;
        f32x4 bv[2][2];
#pragma unroll
        for (int bj = 0; bj < 2; ++bj)
#pragma unroll
            for (int n = 0; n < 2; ++n) bv[bj][n] = bias ? *(const f32x4*)(bias + bcol0 + bj * HALF + 4 * n) : (f32x4){0.f, 0.f, 0.f, 0.f};
#pragma unroll
        for (int ai = 0; ai < 2; ++ai)
#pragma unroll
            for (int m = 0; m < 4; ++m) { bf16_t* rowp = base + (size_t)(row0 + ai * HALF + m * 16) * ldc + col0;
#pragma unroll
                for (int bj = 0; bj < 2; ++bj) { f32x4 v0 = acc[ai][bj][m][0] + bv[bj][0], v1 = acc[ai][bj][m][1] + bv[bj][1];
                    if (ACT == 1) { f32x2 a = gelu_pk((f32x2){v0[0], v0[1]}), b = gelu_pk((f32x2){v0[2], v0[3]}), c = gelu_pk((f32x2){v1[0], v1[1]}), d = gelu_pk((f32x2){v1[2], v1[3]});
                        v0 = (f32x4){a.x, a.y, b.x, b.y}; v1 = (f32x4){c.x, c.y, d.x, d.y}; }
                    v0 = v0 * sc; v1 = v1 * sc; u32x4 w; w.x = cvt_pk_bf16(v0[0], v0[1]); w.y = cvt_pk_bf16(v0[2], v0[3]); w.z = cvt_pk_bf16(v1[0], v1[1]); w.w = cvt_pk_bf16(v1[2], v1[3]);
                    *(u32x4*)(rowp + bj * HALF) = w; } }
    }
};

template <class Epi, class Sched, bool ALIGN_EPI = false, bool SP2 = false>
__device__ __forceinline__ void gemm_phase(PG8_LAS unsigned char* lds, const Gemm g, const Sched& S, const Epi& E) {
    const int tid = threadIdx.x, wid = __builtin_amdgcn_readfirstlane(tid >> 6), lane = tid & 63, wr = wid >> 2, wc = wid & 3, fr = lane & 15, fq = lane >> 4;
    const int K = g.K, nt = K / BK;
    unsigned voffA[2], voffB[2];
#pragma unroll
    for (int i = 0; i < 2; ++i) { int R, C; stage_rc(tid * 16 + i * 8192, R, C); const int Rb = Epi::PERM ? ((R & ~31) + perm32(R & 31)) : R;
        voffA[i] = (unsigned)(R * K + C) * 2u; voffB[i] = (unsigned)(Rb * K + C) * 2u; }
    const size_t kstep = (size_t)(BK * 2);
    const size_t hstep = (size_t)HALF * K * 2;
    const size_t tstep = 2 * hstep;
    const unsigned ldsw = (unsigned)wid * 1024u;
    const int aoff = lds_byte(wr * 64 + fr, fq * 8), boff = lds_byte(wc * 32 + fr, fq * 8);
#define PG8_SA(b, h) (((b) * 2 + (h)) * HTB)
#define PG8_SB(b, h) ((4 + (b) * 2 + (h)) * HTB)
#define PG8_STAGE(bufoff, gbase, voff) do { _Pragma("unroll") for (int _i = 0; _i < 2; ++_i) \
        __builtin_amdgcn_global_load_lds((const unsigned*)((const char*)(gbase) + (voff)[_i]), (PG8_LAS unsigned*)(lds + (bufoff) + ldsw + _i * 8192), 16, 0, 0); } while (0)
#define PG8_LDA(dst, b, h) do { _Pragma("unroll") for (int m = 0; m < 4; ++m) _Pragma("unroll") for (int k = 0; k < 2; ++k) dst[m][k] = *(const PG8_LAS bf16x8*)(lds + PG8_SA(b, h) + aoff + m * 2048 + k * 1024); } while (0)
#define PG8_LDB(dst, b, h) do { _Pragma("unroll") for (int n = 0; n < 2; ++n) _Pragma("unroll") for (int k = 0; k < 2; ++k) dst[n][k] = *(const PG8_LAS bf16x8*)(lds + PG8_SB(b, h) + boff + n * 2048 + k * 1024); } while (0)
#define PG8_MMA(ai, bj, At, Bt) do { __builtin_amdgcn_s_setprio(1); _Pragma("unroll") for (int m = 0; m < 4; ++m) _Pragma("unroll") for (int n = 0; n < 2; ++n) _Pragma("unroll") for (int k = 0; k < 2; ++k) \
        acc[ai][bj][m][n] = __builtin_amdgcn_mfma_f32_16x16x32_bf16(Bt[n][k], At[m][k], acc[ai][bj][m][n], 0, 0, 0); __builtin_amdgcn_s_setprio(0); } while (0)
#define PG8_WAIT_V(n) asm volatile("s_waitcnt vmcnt(" #n ")" ::: "memory")
#define PG8_WAIT_L(n) asm volatile("s_waitcnt lgkmcnt(" #n ")" ::: "memory")
#define PG8_BAR __builtin_amdgcn_s_barrier()
#define PG8_SCHED __builtin_amdgcn_sched_barrier(0)
    Unit cur, nxt; int ui = 0;
    if (!S.next(0, cur)) return;
    f32x4 acc[2][2][4][2];
#pragma unroll
    for (int a = 0; a < 2; ++a)
#pragma unroll
        for (int b = 0; b < 2; ++b)
#pragma unroll
            for (int m = 0; m < 4; ++m)
#pragma unroll
                for (int n = 0; n < 2; ++n) acc[a][b][m][n] = (f32x4){0.f, 0.f, 0.f, 0.f};
    bf16x8 At[4][2], B0[2][2], B1[2][2];
    const char* cA = (const char*)g.A + (size_t)cur.pm * tstep; const char* cB = (const char*)g.Bt + (size_t)cur.pn * tstep;
    S.a_ready(cur);
    if constexpr (SP2) {
        PG8_STAGE(PG8_SB(0, 0), cB, voffB); PG8_STAGE(PG8_SB(0, 1), cB + hstep, voffB); PG8_STAGE(PG8_SA(0, 0), cA, voffA); PG8_STAGE(PG8_SA(0, 1), cA + hstep, voffA);
        if (wr == 1) PG8_BAR;
        PG8_WAIT_V(2); PG8_BAR;
        PG8_STAGE(PG8_SB(1, 0), cB + kstep, voffB); PG8_STAGE(PG8_SA(1, 0), cA + kstep, voffA); PG8_STAGE(PG8_SB(1, 1), cB + hstep + kstep, voffB);
        PG8_WAIT_V(6); PG8_BAR;
    } else {
        PG8_STAGE(PG8_SB(0, 0), cB, voffB); PG8_STAGE(PG8_SA(0, 0), cA, voffA); PG8_STAGE(PG8_SB(0, 1), cB + hstep, voffB); PG8_STAGE(PG8_SA(0, 1), cA + hstep, voffA);
        if (wr == 1) PG8_BAR;
        PG8_WAIT_V(4); PG8_BAR;
        PG8_STAGE(PG8_SB(1, 0), cB + kstep, voffB); PG8_STAGE(PG8_SA(1, 0), cA + kstep, voffA); PG8_STAGE(PG8_SB(1, 1), cB + hstep + kstep, voffB);
        PG8_WAIT_V(6); PG8_BAR;
    }
    for (;;) {
        const bool has_next = S.next(ui + 1, nxt);
        const char* nA = has_next ? (const char*)g.A + (size_t)nxt.pm * tstep : cA; const char* nB = has_next ? (const char*)g.Bt + (size_t)nxt.pn * tstep : cB;
        for (int t = 0; t < nt; t += 2) {
            const bool last = (t == nt - 2);
            const char* a1 = cA + (size_t)(t + 1) * kstep;
            const char* a2 = last ? nA : cA + (size_t)(t + 2) * kstep; const char* b2 = last ? nB : cB + (size_t)(t + 2) * kstep;
            const char* a3 = a2 + kstep; const char* b3 = b2 + kstep;
            if (last && has_next) S.a_ready(nxt);
            if constexpr (SP2) {
            PG8_LDB(B0, 0, 0); PG8_LDB(B1, 0, 1); PG8_SCHED; PG8_LDA(At, 0, 0); PG8_STAGE(PG8_SA(1, 1), a1 + hstep, voffA);
            PG8_WAIT_V(8); PG8_WAIT_L(0); PG8_BAR; PG8_MMA(0, 0, At, B0); PG8_MMA(0, 1, At, B1); PG8_BAR; PG8_SCHED;
            PG8_LDA(At, 0, 1); PG8_STAGE(PG8_SB(0, 0), b2, voffB); PG8_STAGE(PG8_SB(0, 1), b2 + hstep, voffB); PG8_STAGE(PG8_SA(0, 0), a2, voffA);
            PG8_WAIT_V(8); PG8_WAIT_L(0); PG8_BAR; PG8_MMA(1, 0, At, B0); PG8_MMA(1, 1, At, B1); PG8_BAR; PG8_SCHED;
            PG8_LDB(B0, 1, 0); PG8_LDB(B1, 1, 1); PG8_SCHED; PG8_LDA(At, 1, 0); PG8_STAGE(PG8_SA(0, 1), a2 + hstep, voffA);
            PG8_WAIT_V(8); PG8_WAIT_L(0); PG8_BAR; PG8_MMA(0, 0, At, B0); PG8_MMA(0, 1, At, B1); PG8_BAR; PG8_SCHED;
            PG8_LDA(At, 1, 1); PG8_STAGE(PG8_SB(1, 0), b3, voffB); PG8_STAGE(PG8_SB(1, 1), b3 + hstep, voffB); PG8_STAGE(PG8_SA(1, 0), a3, voffA);
            PG8_WAIT_V(8); PG8_WAIT_L(0); PG8_BAR; PG8_MMA(1, 0, At, B0); PG8_MMA(1, 1, At, B1); PG8_BAR; PG8_SCHED;
            } else {
            PG8_LDB(B0, 0, 0); PG8_SCHED; PG8_LDA(At, 0, 0); PG8_STAGE(PG8_SA(1, 1), a1 + hstep, voffA);
            PG8_WAIT_L(8); PG8_BAR; PG8_WAIT_L(0); PG8_MMA(0, 0, At, B0); PG8_BAR; PG8_SCHED;
            PG8_LDB(B1, 0, 1); PG8_STAGE(PG8_SB(0, 0), b2, voffB);
            PG8_BAR; PG8_WAIT_L(0); PG8_MMA(0, 1, At, B1); PG8_BAR;
            PG8_LDA(At, 0, 1); PG8_STAGE(PG8_SA(0, 0), a2, voffA);
            PG8_BAR; PG8_WAIT_L(0); PG8_MMA(1, 0, At, B0); PG8_BAR; PG8_SCHED;
            PG8_STAGE(PG8_SB(0, 1), b2 + hstep, voffB);
            PG8_WAIT_V(6); PG8_BAR; PG8_MMA(1, 1, At, B1); PG8_BAR;
            PG8_LDB(B0, 1, 0); PG8_SCHED; PG8_LDA(At, 1, 0); PG8_STAGE(PG8_SA(0, 1), a2 + hstep, voffA);
            PG8_WAIT_L(8); PG8_BAR; PG8_WAIT_L(0); PG8_MMA(0, 0, At, B0); PG8_BAR; PG8_SCHED;
            PG8_LDB(B1, 1, 1); PG8_STAGE(PG8_SB(1, 0), b3, voffB);
            PG8_BAR; PG8_WAIT_L(0); PG8_MMA(0, 1, At, B1); PG8_BAR;
            PG8_LDA(At, 1, 1); PG8_STAGE(PG8_SA(1, 0), a3, voffA);
            PG8_BAR; PG8_WAIT_L(0); PG8_MMA(1, 0, At, B0); PG8_BAR; PG8_SCHED;
            PG8_STAGE(PG8_SB(1, 1), b3 + hstep, voffB);
            PG8_WAIT_V(6); PG8_BAR; PG8_MMA(1, 1, At, B1); PG8_BAR;
            }
        }
        if constexpr (ALIGN_EPI) { if (wr == 0) PG8_BAR; }
        if constexpr (!Epi::AFTER_DRAIN) { E(acc, cur, wr, wc, fr, fq); S.done(cur); }
        if (!has_next) break;
#pragma unroll
        for (int a = 0; a < 2; ++a)
#pragma unroll
            for (int b = 0; b < 2; ++b)
#pragma unroll
                for (int m = 0; m < 4; ++m)
#pragma unroll
                    for (int n = 0; n < 2; ++n) acc[a][b][m][n] = (f32x4){0.f, 0.f, 0.f, 0.f};
        cur = nxt; cA = nA; cB = nB; ++ui;
        if constexpr (ALIGN_EPI) { if (wr == 1) PG8_BAR; }
    }
    PG8_WAIT_V(0);
    if constexpr (!ALIGN_EPI) { if (wr == 0) PG8_BAR; }
    PG8_BAR;
    if constexpr (Epi::AFTER_DRAIN) { E.fused(acc, cur, wr, wc, fr, fq, lds, wid, lane); S.done(cur); }
#undef PG8_SA
#undef PG8_SB
#undef PG8_STAGE
#undef PG8_LDA
#undef PG8_LDB
#undef PG8_MMA
#undef PG8_WAIT_V
#undef PG8_WAIT_L
#undef PG8_BAR
#undef PG8_SCHED
}
}
#define GAS __attribute__((address_space(1)))
#define LAS __attribute__((address_space(3)))
typedef unsigned short bf16;
typedef unsigned v4u __attribute__((ext_vector_type(4)));
typedef float f32x4 __attribute__((ext_vector_type(4)));
typedef short bf16x8 __attribute__((ext_vector_type(8)));
typedef GAS unsigned gu32;
typedef GAS unsigned long long gu64;
#define RLX_AGENT __ATOMIC_RELAXED, __HIP_MEMORY_SCOPE_AGENT
#define LDS_WAIT() asm volatile("s_waitcnt lgkmcnt(0)" ::: "memory")
#define VM_WAIT() asm volatile("s_waitcnt vmcnt(0)" ::: "memory")
__device__ __forceinline__ unsigned long long rt() { return __builtin_amdgcn_s_memrealtime(); }
__device__ __forceinline__ unsigned f2bf(float f) { unsigned u = __builtin_bit_cast(unsigned, f); return (u + 0x7fffu + ((u >> 16) & 1u)) >> 16; }
__device__ __forceinline__ unsigned pk2(float lo, float hi) { return f2bf(lo) | (f2bf(hi) << 16); }

#define XB_TMO      128
#define XB_XCNT(j)  (256  + 64 * (j))
#define XB_XSUB(j)  (1280 + 64 * (j))
#define XB_XGEN(j)  (2304 + 64 * (j))
#define XB_TOP      3328
#define XB_TOPGEN   3392
#define XCD_BAR_WORDS 3456
#define XB_SPIN_CAP (1u << 18)

__device__ __forceinline__ unsigned xb_ld(unsigned* p)              { return __hip_atomic_load(p, __ATOMIC_RELAXED, __HIP_MEMORY_SCOPE_AGENT); }
__device__ __forceinline__ unsigned xb_add(unsigned* p, unsigned v) { return __hip_atomic_fetch_add(p, v, __ATOMIC_RELAXED, __HIP_MEMORY_SCOPE_AGENT); }
__device__ __forceinline__ unsigned xb_xcc_id() { return (unsigned)__builtin_amdgcn_s_getreg((3 << 11) | 20) & 0xFu; }
#define XB_SPIN(cond, bar) do { unsigned _sp = 0; while (cond) { __builtin_amdgcn_s_sleep(1); \
    if ((++_sp & 255u) == 0u) { if (xb_ld(&(bar)[XB_TMO])) break; if (_sp > XB_SPIN_CAP) { atomicAdd(&(bar)[XB_TMO], 1u); break; } } } } while (0)

struct XcdBarrier {
    unsigned* bar; unsigned x;
    volatile LAS unsigned* st;
};

__device__ __forceinline__ XcdBarrier xcd_barrier_post(unsigned* bar, volatile LAS unsigned* st) {
    XcdBarrier b; b.bar = bar; b.x = xb_xcc_id(); b.st = st;
    if (threadIdx.x == 0) (void)xb_add(&bar[XB_XCNT(b.x)], 1u);
    return b;
}
__device__ __forceinline__ void xcd_barrier_complete(unsigned* bar, unsigned x, unsigned& nloc, unsigned& nx) {
    const unsigned G = gridDim.x * gridDim.y * gridDim.z;
    unsigned sum, cnt, mine, sp = 0u;
    for (;;) {
        sum = 0u; cnt = 0u; mine = 0u;
#pragma unroll
        for (unsigned j = 0; j < 16; ++j) { const unsigned c = xb_ld(&bar[XB_XCNT(j)]); sum += c; cnt += (c > 0u) ? 1u : 0u; mine = (j == x) ? c : mine; }
        if (sum == G) break;
        __builtin_amdgcn_s_sleep(1);
        if ((++sp & 255u) == 0u) { if (xb_ld(&bar[XB_TMO])) break; if (sp > XB_SPIN_CAP) { atomicAdd(&bar[XB_TMO], 1u); break; } }
    }
    nloc = mine > 0u ? mine : 1u; nx = cnt > 0u ? cnt : 1u;
}

__device__ __forceinline__ void xcd_barrier(const XcdBarrier& b) {
    asm volatile("s_waitcnt vmcnt(0)" ::: "memory");
    __syncthreads();
    if (threadIdx.x == 0) {
        unsigned* bar = b.bar;
        __builtin_amdgcn_s_waitcnt(0);
        unsigned nloc = b.st[0], nx = b.st[1];
        if (nloc == 0u) { xcd_barrier_complete(bar, b.x, nloc, nx); b.st[0] = nloc; b.st[1] = nx; }
        const unsigned old = xb_add(&bar[XB_XSUB(b.x)], 1u);
        const unsigned gen = old / nloc;
        if (old + 1u == (gen + 1u) * nloc) {
            __builtin_amdgcn_fence(__ATOMIC_RELEASE, "agent");
            asm volatile("s_waitcnt vmcnt(0)" ::: "memory");
            const unsigned og = xb_add(&bar[XB_TOP], 1u);
            const unsigned tg = og / nx;
            if (og + 1u == (tg + 1u) * nx) xb_add(&bar[XB_TOPGEN], 1u);
            else XB_SPIN(xb_ld(&bar[XB_TOPGEN]) == tg, bar);
            __builtin_amdgcn_fence(__ATOMIC_ACQUIRE, "agent");
            xb_add(&bar[XB_XGEN(b.x)], 1u);
            asm volatile("s_waitcnt vmcnt(0)" ::: "memory");
        } else {
            XB_SPIN(xb_ld(&bar[XB_XGEN(b.x)]) == gen, bar);
            __builtin_amdgcn_fence(__ATOMIC_ACQUIRE, "agent");
            asm volatile("s_waitcnt vmcnt(0)" ::: "memory");
        }
    }
    __syncthreads();
}

constexpr int T = 16384, DM = 2048, NP = 5888, NMEM = 256;
constexpr int NWAVES = 8, NTHR = 512;
constexpr float EPS = 1e-6f;
constexpr size_t MiB = 1u << 20;
constexpr size_t WS_CTL = 0, CTL_ZERO_BYTES = 65536;
constexpr size_t WS_WIN0 = 1 * MiB, WS_WIN1 = 24 * MiB, WS_WOUT0 = 47 * MiB, WS_WOUT1 = 55 * MiB, WS_WMKV = 63 * MiB, WS_WK1T = 71 * MiB, WS_WV1T = 73 * MiB;
constexpr size_t WS_MEMKV = 75 * MiB, WS_DEC = 76 * MiB, WS_KCMP = 77 * MiB, WS_VCMP = 77 * MiB + 512 * 1024, WS_SEL = 78 * MiB;
constexpr size_t WS_XN = 80 * MiB, WS_P = 144 * MiB, WS_STATE = 328 * MiB, WS_END = 472 * MiB;
constexpr size_t WS_MIX1 = WS_STATE;
constexpr size_t WS_CP = WS_STATE + 64 * MiB;
constexpr size_t PLANE = (size_t)T * 128;
constexpr size_t DO_MIX0 = 0, DO_OI = 64 * MiB;
constexpr int CR = 3072, CXQ = 4608, CXG = 5120, CGL = 5632;
constexpr int GQ = 0, GK = 768, GV = 1536;
constexpr int NQ = 0, NKC = 1536, NVC = 1792, NKS = 2048, NVS = 2304, NKW = 2560, NVW = 2816;
constexpr int RING_BYTES = 131072, LDSCTL_OFF = RING_BYTES, MISC_OFF = LDSCTL_OFF + 320, LDS_BYTES = 147456;
constexpr int N_PHASES = 12;

__device__ __forceinline__ float bf2f(bf16 v) { return __builtin_bit_cast(float, (unsigned)v << 16); }
__device__ __forceinline__ bf16 f2b(float f) { return (bf16)f2bf(f); }
__device__ __forceinline__ float wave_sum(float v) {
#pragma unroll
    for (int o = 1; o < 64; o <<= 1) v += __shfl_xor(v, o);
    return v;
}
__device__ __forceinline__ float silu_f(float x) { return x / (1.f + __expf(-x)); }
__device__ __forceinline__ float sigmoid_f(float x) { return 1.f / (1.f + __expf(-x)); }
__device__ __forceinline__ float logsigmoid_f(float x) { return fminf(x, 0.f) - log1pf(__expf(-fabsf(x))); }

__device__ __forceinline__ int win_src_col(int layer, int c) {
    const int ex = layer ? 36 : 16;
    if (c < 3072) return c;
    if (c < 5632) return c + ex;
    if (c < 5632 + ex) return c - 5632 + 3072;
    return -1;
}

__device__ __forceinline__ void transpose_item(const float* W, int ldw, int K, bf16* WT, int n0, int k0, int srcc, LAS float* scr, int lane) {
#pragma unroll 8
    for (int i = 0; i < 32; ++i) { const int kk = 2 * i + (lane >> 5); scr[kk * 33 + (lane & 31)] = (srcc >= 0) ? W[(size_t)(k0 + kk) * ldw + srcc] : 0.f; }
    LDS_WAIT(); asm volatile("" ::: "memory");
    const int c = lane & 7;
#pragma unroll
    for (int j = 0; j < 4; ++j) { const int n = (lane >> 3) + 8 * j; const LAS float* s = scr + (8 * c) * 33 + n;
        v4u o; o.x = pk2(s[0 * 33], s[1 * 33]); o.y = pk2(s[2 * 33], s[3 * 33]); o.z = pk2(s[4 * 33], s[5 * 33]); o.w = pk2(s[6 * 33], s[7 * 33]);
        *(v4u*)(WT + (size_t)(n0 + n) * K + k0 + 8 * c) = o; }
    LDS_WAIT(); asm volatile("" ::: "memory");
}

__device__ __forceinline__ void rms_row_to_bf16(const float* xrow, const float* g, bf16* orow, int lane) {
    const f32x4* xr = (const f32x4*)xrow + lane; const f32x4* gr = (const f32x4*)g + lane;
    f32x4 v[8]; float s = 0.f;
#pragma unroll
    for (int j = 0; j < 8; ++j) { v[j] = xr[64 * j]; s += (v[j].x * v[j].x + v[j].y * v[j].y) + (v[j].z * v[j].z + v[j].w * v[j].w); }
    const float rstd = rsqrtf(wave_sum(s) * (1.f / DM) + EPS);
    unsigned long long* o8 = (unsigned long long*)orow + lane;
#pragma unroll
    for (int j = 0; j < 8; ++j) { const f32x4 gg = gr[64 * j];
        o8[64 * j] = (unsigned long long)pk2(v[j].x * rstd * gg.x, v[j].y * rstd * gg.y) | ((unsigned long long)pk2(v[j].z * rstd * gg.z, v[j].w * rstd * gg.w) << 32); }
}

struct EpiNsaIn {
    static constexpr bool PERM = true, AFTER_DRAIN = false;
    bf16* O; int ldc; bf16* CPb;
    __device__ __forceinline__ void operator()(const pg8::f32x4 (&acc)[2][2][4][2], const pg8::Unit& u, int wr, int wc, int fr, int fq) const {
        const int row0 = u.pm * pg8::BM + wr * 64 + fr; const bool pl = (u.pn >= 6 && u.pn < 12);
#pragma unroll
        for (int ai = 0; ai < 2; ++ai)
#pragma unroll
            for (int m = 0; m < 4; ++m) { const size_t row = (size_t)(row0 + ai * pg8::HALF + m * 16);
#pragma unroll
                for (int bj = 0; bj < 2; ++bj) { const pg8::f32x4 v0 = acc[ai][bj][m][0], v1 = acc[ai][bj][m][1];
                    pg8::u32x4 w; w.x = pg8::cvt_pk_bf16(v0[0], v0[1]); w.y = pg8::cvt_pk_bf16(v0[2], v0[3]); w.z = pg8::cvt_pk_bf16(v1[0], v1[1]); w.w = pg8::cvt_pk_bf16(v1[2], v1[3]);
                    bf16* dst = pl ? CPb + ((size_t)((u.pn - 6) * 2 + bj)) * PLANE + row * 128 + wc * 32 + 8 * fq
                                   : O + row * ldc + u.pn * pg8::BM + bj * pg8::HALF + wc * 32 + 8 * fq;
                    *(pg8::u32x4*)dst = w; } }
    }
};

struct Args { const float* in[19]; float* out; unsigned char* ws; int ph_lo, ph_hi; };

struct Ctx {
    LAS unsigned char* lds;
    int tid, lane, wave, G, gw, NGW;
    const float *x, *mem, *ln_pre, *ln_post, *ln_mem, *w_mem_kv, *gla_w_in, *gla_w_gate, *gla_b_gate, *gla_norm, *gla_w_out;
    const float *nsa_w_in, *pe_k, *pe_v, *wk1, *wk2, *wv1, *wv2, *nsa_w_out;
    float* out; unsigned char* ws;
    bf16 *WIN0, *WIN1, *WOUT0, *WOUT1, *WMKV, *WK1T, *WV1T, *MEMKV, *KCMP, *VCMP, *XN, *P, *STATE, *MIX0, *MIX1, *OI, *CP;
    float *DEC, *HB;
};

__device__ __forceinline__ void phase_prep(Ctx& F) {
    LAS float* scr = (LAS float*)(F.lds + F.wave * 16384);
    constexpr int I_WIN = 32 * 184, I_WOUT = 32 * 64, I_MKV = 32 * 32, I_W1 = 64 * 8;
    constexpr int NITEMS = 2 * I_WIN + 2 * I_WOUT + 2 * I_MKV + 2 * I_W1;
    for (int it = F.gw; it < NITEMS; it += F.NGW) {
        int r = it;
        if (r < 2 * I_WIN) { const int layer = r / I_WIN; r -= layer * I_WIN; const int kb = r / 184, nb = r % 184;
            const int srcc = win_src_col(layer, nb * 32 + (F.lane & 31));
            transpose_item(layer ? F.nsa_w_in : F.gla_w_in, layer ? 5668 : 5648, DM, layer ? F.WIN1 : F.WIN0, nb * 32, kb * 64, srcc, scr, F.lane); continue; }
        r -= 2 * I_WIN;
        if (r < 2 * I_WOUT) { const int layer = r / I_WOUT; r -= layer * I_WOUT; const int kb = r / 64, nb = r % 64;
            transpose_item(layer ? F.nsa_w_out : F.gla_w_out, DM, DM, layer ? F.WOUT1 : F.WOUT0, nb * 32, kb * 64, nb * 32 + (F.lane & 31), scr, F.lane); continue; }
        r -= 2 * I_WOUT;
        if (r < 2 * I_MKV) { const int layer = r / I_MKV; r -= layer * I_MKV; const int kb = r / 32, nb = r % 32;
            transpose_item(F.w_mem_kv + (size_t)layer * DM * 1024, 1024, DM, F.WMKV + (size_t)layer * 1024 * DM, nb * 32, kb * 64, nb * 32 + (F.lane & 31), scr, F.lane); continue; }
        r -= 2 * I_MKV;
        { const int kv = r / I_W1; r -= kv * I_W1; const int kb = r / 8, nb = r % 8;
            transpose_item(kv ? F.wv1 : F.wk1, 256, 4096, kv ? F.WV1T : F.WK1T, nb * 32, kb * 64, nb * 32 + (F.lane & 31), scr, F.lane); }
    }
    if ((int)blockIdx.x < 64) { const int kv = blockIdx.x >> 5, s = blockIdx.x & 31; const float* pe = kv ? F.pe_v : F.pe_k; const float* w1 = kv ? F.wv1 : F.wk1;
        __syncthreads();
        LAS float* red = (LAS float*)F.lds;
        const int j = F.tid & 255, ih = F.tid >> 8; float a = 0.f;
#pragma unroll 8
        for (int i = s * 128 + ih * 64; i < s * 128 + ih * 64 + 64; ++i) a += pe[i] * w1[(size_t)i * 256 + j];
        red[F.tid] = a; __syncthreads();
        if (F.tid < 256) F.HB[(kv * 32 + s) * 256 + j] = red[j] + red[256 + j];
        __syncthreads(); }
    for (int m = F.gw; m < T; m += F.NGW) rms_row_to_bf16(F.x + (size_t)m * DM, F.ln_pre, F.XN + (size_t)m * DM, F.lane);
}

__device__ __forceinline__ void memkv_naive(Ctx& F) {
    const int gt = blockIdx.x * NTHR + F.tid, NT = F.G * NTHR;
    for (int o = gt; o < 2 * NMEM * 1024; o += NT) {
        const int layer = o >> 18, m = (o >> 10) & 255, n = o & 1023;
        const float* mr = F.mem + (size_t)m * DM; const float* g = F.ln_mem + layer * DM; const float* W = F.w_mem_kv + (size_t)layer * DM * 1024 + n;
        float ss = 0.f, acc = 0.f;
        for (int k = 0; k < DM; ++k) { const float a = mr[k]; ss += a * a; acc += a * g[k] * W[(size_t)k * 1024]; }
        const float v = acc * rsqrtf(ss * (1.f / DM) + EPS);
        const int kv = n >> 9, h = (n >> 7) & 3, d = n & 127;
        F.MEMKV[((((size_t)layer * 2 + kv) * 4 + h) * NMEM + m) * 128 + d] = f2b(v);
    }
}

__device__ __forceinline__ void cross_naive(Ctx& F, int layer, bf16* MIX) {
    const float scale = 0.08838834764831845f;
    for (int u = F.gw; u < T * 4; u += F.NGW) {
        const int t = u >> 2, h = u & 3;
        const bf16* pr = F.P + (size_t)t * NP;
        const unsigned qq = *(const unsigned*)(pr + CXQ + h * 128 + 2 * F.lane);
        const float q0 = bf2f((bf16)(qq & 0xffff)) * scale, q1 = bf2f((bf16)(qq >> 16)) * scale;
        const bf16* Kb = F.MEMKV + (((size_t)layer * 2 + 0) * 4 + h) * NMEM * 128;
        const bf16* Vb = F.MEMKV + (((size_t)layer * 2 + 1) * 4 + h) * NMEM * 128;
        float m = -1e30f, l = 0.f, o0 = 0.f, o1 = 0.f;
        for (int j = 0; j < NMEM; ++j) {
            const unsigned kk = *(const unsigned*)(Kb + j * 128 + 2 * F.lane), vv = *(const unsigned*)(Vb + j * 128 + 2 * F.lane);
            const float s = wave_sum(q0 * bf2f((bf16)(kk & 0xffff)) + q1 * bf2f((bf16)(kk >> 16)));
            const float mn = fmaxf(m, s), a = __expf(m - mn), p = __expf(s - mn);
            l = l * a + p; o0 = o0 * a + p * bf2f((bf16)(vv & 0xffff)); o1 = o1 * a + p * bf2f((bf16)(vv >> 16)); m = mn;
        }
        const unsigned gg = *(const unsigned*)(pr + CXG + h * 128 + 2 * F.lane);
        const float r0 = o0 / l * silu_f(bf2f((bf16)(gg & 0xffff))), r1 = o1 / l * silu_f(bf2f((bf16)(gg >> 16)));
        *(unsigned*)(MIX + (size_t)t * DM + 1536 + h * 128 + 2 * F.lane) = pk2(r0, r1);
    }
}

__device__ __forceinline__ void gla_g1_naive(Ctx& F) {
    LAS float* bcum = (LAS float*)(F.lds);
    LAS float* Aat = (LAS float*)(F.lds + 49152);
    LAS float* glr = (LAS float*)(F.lds + 65536);
    LAS float* blast = (LAS float*)(F.lds + 69632);
    const float qscale = 0.07216878364870323f;
    for (int u = blockIdx.x; u < 1024; u += F.G) {
        const int n = u >> 2, h = u & 3; const size_t row0 = (size_t)n * 64;
        for (int i = F.tid; i < 1024; i += NTHR) glr[i] = bf2f(F.P[(row0 + (i >> 4)) * NP + CGL + (i & 15)]);
        __syncthreads();
        if (F.tid < 192) {
            const int d = F.tid, col = h * 192 + d; float wg[16];
#pragma unroll
            for (int j = 0; j < 16; ++j) wg[j] = F.gla_w_gate[j * 768 + col];
            const float bias = F.gla_b_gate[col]; float b = 0.f;
            for (int c = 0; c < 64; ++c) { float gl = bias;
#pragma unroll
                for (int j = 0; j < 16; ++j) gl += glr[c * 16 + j] * wg[j];
                b += logsigmoid_f(gl) * (1.f / 16.f); bcum[c * 192 + d] = b; }
            blast[d] = b; F.DEC[n * 768 + col] = __expf(b);
        }
        __syncthreads();
        for (int i = 0; i < 8; ++i) { const int idx = F.tid + NTHR * i, c = idx >> 6, s = idx & 63; float a = 0.f;
            if (s <= c) { const bf16* qp = F.P + (row0 + c) * NP + GQ + h * 192; const bf16* kp = F.P + (row0 + s) * NP + GK + h * 192;
                for (int d = 0; d < 192; ++d) a += bf2f(qp[d]) * bf2f(kp[d]) * __expf(bcum[c * 192 + d] - bcum[s * 192 + d]);
                a *= qscale; }
            Aat[idx] = a; }
        __syncthreads();
        for (int i = 0; i < 48; ++i) { const int idx = F.tid + NTHR * i, c = idx / 384, e = idx % 384; float a = 0.f;
            for (int s = 0; s <= c; ++s) a += Aat[c * 64 + s] * bf2f(F.P[(row0 + s) * NP + GV + h * 384 + e]);
            F.OI[(row0 + c) * 1536 + h * 384 + e] = f2b(a); }
        for (int i = 0; i < 144; ++i) { const int idx = F.tid + NTHR * i, e = idx / 192, d = idx % 192; float a = 0.f; const float bl = blast[d];
            for (int c = 0; c < 64; ++c) a += bf2f(F.P[(row0 + c) * NP + GK + h * 192 + d]) * __expf(bl - bcum[c * 192 + d]) * bf2f(F.P[(row0 + c) * NP + GV + h * 384 + e]);
            F.STATE[((size_t)u * 384 + e) * 192 + d] = f2b(a); }
        __syncthreads();
        for (int i = 0; i < 24; ++i) { const int idx = F.tid + NTHR * i, c = idx / 192, d = idx % 192;
            bf16* qp = F.P + (row0 + c) * NP + GQ + h * 192 + d; *qp = f2b(bf2f(*qp) * qscale * __expf(bcum[c * 192 + d])); }
        __syncthreads();
    }
}

__device__ __forceinline__ void gla_scan(Ctx& F) {
    const int gt = blockIdx.x * NTHR + F.tid, NT = F.G * NTHR;
    constexpr int PER = 4 * 384 * 192;
    for (int item = gt; item < PER / 4; item += NT) {
        const int idx = item * 4, h = idx / (384 * 192), d0 = idx % 192;
        bf16* sp = F.STATE + idx; const float* dp = F.DEC + h * 192 + d0;
        float s0 = 0.f, s1 = 0.f, s2 = 0.f, s3 = 0.f;
        for (int n0 = 0; n0 < 256; n0 += 8) {
            unsigned long long u[8]; f32x4 dc[8];
#pragma unroll
            for (int j = 0; j < 8; ++j) { u[j] = *(const unsigned long long*)(sp + (size_t)(n0 + j) * PER); dc[j] = *(const f32x4*)(dp + (n0 + j) * 768); }
#pragma unroll
            for (int j = 0; j < 8; ++j) {
                const unsigned lo = (unsigned)u[j], hi = (unsigned)(u[j] >> 32);
                s0 = dc[j].x * s0 + bf2f((bf16)(lo & 0xffff)); s1 = dc[j].y * s1 + bf2f((bf16)(lo >> 16));
                s2 = dc[j].z * s2 + bf2f((bf16)(hi & 0xffff)); s3 = dc[j].w * s3 + bf2f((bf16)(hi >> 16));
                *(unsigned long long*)(sp + (size_t)(n0 + j) * PER) = (unsigned long long)pk2(s0, s1) | ((unsigned long long)pk2(s2, s3) << 32);
            }
        }
    }
}

__device__ __forceinline__ void gla_g3_naive(Ctx& F) {
    LAS float* o = (LAS float*)(F.lds);
    LAS float* rs = (LAS float*)(F.lds + 98304);
    for (int u = blockIdx.x; u < 1024; u += F.G) {
        const int n = u >> 2, h = u & 3; const size_t row0 = (size_t)n * 64;
        for (int i = 0; i < 48; ++i) { const int idx = F.tid + NTHR * i, c = idx / 384, e = idx % 384;
            float a = bf2f(F.OI[(row0 + c) * 1536 + h * 384 + e]);
            if (n > 0) { const bf16* sp = F.STATE + ((size_t)(u - 4) * 384 + e) * 192; const bf16* qp = F.P + (row0 + c) * NP + GQ + h * 192;
                for (int d = 0; d < 192; ++d) a += bf2f(qp[d]) * bf2f(sp[d]); }
            o[idx] = a; }
        __syncthreads();
        for (int c = F.wave; c < 64; c += NWAVES) { float ss = 0.f;
            for (int e = F.lane; e < 384; e += 64) { const float v = o[c * 384 + e]; ss += v * v; }
            ss = wave_sum(ss); if (F.lane == 0) rs[c] = rsqrtf(ss * (1.f / 384.f) + EPS); }
        __syncthreads();
        for (int i = 0; i < 48; ++i) { const int idx = F.tid + NTHR * i, c = idx / 384, e = idx % 384;
            const float v = o[idx] * rs[c] * F.gla_norm[e]; const float r = bf2f(F.P[(row0 + c) * NP + CR + h * 384 + e]);
            F.MIX0[(row0 + c) * DM + h * 384 + e] = f2b(v * silu_f(r)); }
        __syncthreads();
    }
}

__device__ __forceinline__ void post_rows(Ctx& F, const float* hin, const bf16* Y, const float* gpost, float* hout, const float* gpre, bf16* XNo) {
    for (int m = F.gw; m < T; m += F.NGW) {
        const v4u* yr = (const v4u*)(Y + (size_t)m * DM) + F.lane;
        float y[32]; float ss = 0.f;
#pragma unroll
        for (int j = 0; j < 4; ++j) { const v4u w = yr[64 * j];
            const unsigned ww[4] = {w.x, w.y, w.z, w.w};
#pragma unroll
            for (int q = 0; q < 4; ++q) { y[j * 8 + 2 * q] = bf2f((bf16)(ww[q] & 0xffff)); y[j * 8 + 2 * q + 1] = bf2f((bf16)(ww[q] >> 16)); } }
#pragma unroll
        for (int i = 0; i < 32; ++i) ss += y[i] * y[i];
        const float rstd = rsqrtf(wave_sum(ss) * (1.f / DM) + EPS);
        float hn[32]; float s2 = 0.f;
#pragma unroll
        for (int j = 0; j < 4; ++j) {
#pragma unroll
            for (int q = 0; q < 2; ++q) { const int col = j * 512 + F.lane * 8 + q * 4;
                const f32x4 hv = *(const f32x4*)(hin + (size_t)m * DM + col); const f32x4 gp = *(const f32x4*)(gpost + col);
                f32x4 r; r.x = hv.x + y[j * 8 + q * 4 + 0] * rstd * gp.x; r.y = hv.y + y[j * 8 + q * 4 + 1] * rstd * gp.y; r.z = hv.z + y[j * 8 + q * 4 + 2] * rstd * gp.z; r.w = hv.w + y[j * 8 + q * 4 + 3] * rstd * gp.w;
                *(f32x4*)(hout + (size_t)m * DM + col) = r;
                hn[j * 8 + q * 4 + 0] = r.x; hn[j * 8 + q * 4 + 1] = r.y; hn[j * 8 + q * 4 + 2] = r.z; hn[j * 8 + q * 4 + 3] = r.w;
                s2 += (r.x * r.x + r.y * r.y) + (r.z * r.z + r.w * r.w); } }
        if (gpre) {
            const float rstd2 = rsqrtf(wave_sum(s2) * (1.f / DM) + EPS);
#pragma unroll
            for (int j = 0; j < 4; ++j) { const int col = j * 512 + F.lane * 8;
                const f32x4 g0 = *(const f32x4*)(gpre + col), g1 = *(const f32x4*)(gpre + col + 4);
                v4u w; w.x = pk2(hn[j * 8 + 0] * rstd2 * g0.x, hn[j * 8 + 1] * rstd2 * g0.y); w.y = pk2(hn[j * 8 + 2] * rstd2 * g0.z, hn[j * 8 + 3] * rstd2 * g0.w);
                w.z = pk2(hn[j * 8 + 4] * rstd2 * g1.x, hn[j * 8 + 5] * rstd2 * g1.y); w.w = pk2(hn[j * 8 + 6] * rstd2 * g1.z, hn[j * 8 + 7] * rstd2 * g1.w);
                *((v4u*)(XNo + (size_t)m * DM) + F.lane + 64 * j) = w; }
        }
    }
}

__device__ __forceinline__ void nsa_compress_naive(Ctx& F) {
    LAS float* blk = (LAS float*)(F.lds);
    LAS float* part = (LAS float*)(F.lds + 65536);
    LAS float* hid = (LAS float*)(F.lds + 73728);
    for (int u = blockIdx.x; u < 1024; u += F.G) {
        const int kv = u & 1, g = (u >> 1) & 1, nq = u >> 2;
        const float* pe = kv ? F.pe_v : F.pe_k; const float* w1 = kv ? F.wv1 : F.wk1; const float* w2 = kv ? F.wv2 : F.wk2;
        const int colb = (kv ? NVC : NKC) + g * 128;
        for (int i = 0; i < 32; ++i) { const int idx = F.tid + NTHR * i, r = idx >> 12, i4 = idx & 4095, l = i4 >> 7, d = i4 & 127; const int n = nq * 4 + r;
            float v = 0.f; if (n < 1023) v = bf2f(F.P[(size_t)(16 * n + l) * NP + colb + d]) + pe[l * 128 + d];
            blk[idx] = v; }
        __syncthreads();
        { const int j = F.tid & 255, ih = F.tid >> 8; float a0 = 0.f, a1 = 0.f, a2 = 0.f, a3 = 0.f;
            for (int i = ih * 2048; i < ih * 2048 + 2048; ++i) { const float w = w1[(size_t)i * 256 + j];
                a0 += blk[i] * w; a1 += blk[4096 + i] * w; a2 += blk[8192 + i] * w; a3 += blk[12288 + i] * w; }
            part[(ih * 4 + 0) * 256 + j] = a0; part[(ih * 4 + 1) * 256 + j] = a1; part[(ih * 4 + 2) * 256 + j] = a2; part[(ih * 4 + 3) * 256 + j] = a3; }
        __syncthreads();
        for (int i = F.tid; i < 1024; i += NTHR) hid[i] = silu_f(part[i] + part[1024 + i]);
        __syncthreads();
        { const int d = F.tid & 127, r = F.tid >> 7; const int n = nq * 4 + r; float a = 0.f;
            for (int j = 0; j < 256; ++j) a += hid[r * 256 + j] * w2[j * 128 + d];
            if (n < 1023) (kv ? F.VCMP : F.KCMP)[((size_t)g * 1024 + n) * 128 + d] = f2b(a); }
        __syncthreads();
    }
}

__device__ __forceinline__ void nsa_main_naive(Ctx& F) {
    const float scale = 0.08838834764831845f;
    LAS float* ocs = (LAS float*)(F.lds + F.wave * 4096);
    const int lane = F.lane;
    for (int u = F.gw; u < T * 2; u += F.NGW) {
        const int t = u >> 1, g = u & 1; const bf16* pr = F.P + (size_t)t * NP;
        const int ncv = (t >= 31) ? min((t - 31) / 16 + 1, 1023) : 0;
        const bf16* Kc = F.KCMP + (size_t)g * 1024 * 128; const bf16* Vc = F.VCMP + (size_t)g * 1024 * 128;
        float imp0 = 0.f, imp1 = 0.f, imp2 = 0.f, imp3 = 0.f;
        for (int h = 0; h < 6; ++h) {
            const unsigned qq = *(const unsigned*)(pr + NQ + (g * 6 + h) * 128 + 2 * lane);
            const float q0 = bf2f((bf16)(qq & 0xffff)) * scale, q1 = bf2f((bf16)(qq >> 16)) * scale;
            float m = -1e30f, l = 0.f, o0 = 0.f, o1 = 0.f;
            for (int c = 0; c < ncv; ++c) {
                const unsigned kk = *(const unsigned*)(Kc + c * 128 + 2 * lane), vv = *(const unsigned*)(Vc + c * 128 + 2 * lane);
                const float s = wave_sum(q0 * bf2f((bf16)(kk & 0xffff)) + q1 * bf2f((bf16)(kk >> 16)));
                const float mn = fmaxf(m, s), a = __expf(m - mn), p = __expf(s - mn);
                l = l * a + p; o0 = o0 * a + p * bf2f((bf16)(vv & 0xffff)); o1 = o1 * a + p * bf2f((bf16)(vv >> 16)); m = mn;
            }
            const float gate = sigmoid_f(bf2f(pr[CGL + g * 18 + h * 3 + 0]));
            const float il = (ncv > 0) ? 1.f / l : 0.f;
            ocs[h * 128 + 2 * lane] = gate * o0 * il; ocs[h * 128 + 2 * lane + 1] = gate * o1 * il;
            for (int c = 0; c < ncv; ++c) {
                const unsigned kk = *(const unsigned*)(Kc + c * 128 + 2 * lane);
                const float s = wave_sum(q0 * bf2f((bf16)(kk & 0xffff)) + q1 * bf2f((bf16)(kk >> 16)));
                const float p = __expf(s - m) * il;
                const int ja = c >> 2, jb = (c + 1) >> 2;
                { const int jj = lane;       if (jj == ja || jj == jb) imp0 += p; }
                { const int jj = lane + 64;  if (jj == ja || jj == jb) imp1 += p; }
                { const int jj = lane + 128; if (jj == ja || jj == jb) imp2 += p; }
                { const int jj = lane + 192; if (jj == ja || jj == jb) imp3 += p; }
            }
        }
        const int cur = t >> 6;
        float iv[4] = {imp0, imp1, imp2, imp3};
#pragma unroll
        for (int i = 0; i < 4; ++i) { const int jj = lane + 64 * i; if (jj == 0 || jj == cur || jj == cur - 1) iv[i] = 1e4f; if (jj > cur) iv[i] = -1e4f; }
        int mysel = 0;
#pragma unroll
        for (int r = 0; r < 16; ++r) {
            float bv = iv[0]; int bi = lane;
#pragma unroll
            for (int i = 1; i < 4; ++i) { if (iv[i] > bv) { bv = iv[i]; bi = lane + 64 * i; } }
#pragma unroll
            for (int o = 1; o < 64; o <<= 1) { const float ov = __shfl_xor(bv, o); const int oi = __shfl_xor(bi, o); if (ov > bv || (ov == bv && oi < bi)) { bv = ov; bi = oi; } }
            mysel = (lane == r) ? bi : mysel;
#pragma unroll
            for (int i = 0; i < 4; ++i) if (lane + 64 * i == bi) iv[i] = -3e38f;
        }
        for (int h = 0; h < 6; ++h) {
            const unsigned qq = *(const unsigned*)(pr + NQ + (g * 6 + h) * 128 + 2 * lane);
            const float q0 = bf2f((bf16)(qq & 0xffff)) * scale, q1 = bf2f((bf16)(qq >> 16)) * scale;
            float m = -1e30f, l = 0.f, o0 = 0.f, o1 = 0.f;
            for (int r = 0; r < 16; ++r) { const int j = __shfl(mysel, r); if (j > cur) continue;
                const int kend = min(64, t - 64 * j + 1);
                for (int i = 0; i < kend; ++i) { const bf16* kr = F.P + (size_t)(64 * j + i) * NP;
                    const unsigned kk = *(const unsigned*)(kr + NKS + g * 128 + 2 * lane), vv = *(const unsigned*)(kr + NVS + g * 128 + 2 * lane);
                    const float s = wave_sum(q0 * bf2f((bf16)(kk & 0xffff)) + q1 * bf2f((bf16)(kk >> 16)));
                    const float mn = fmaxf(m, s), a = __expf(m - mn), p = __expf(s - mn);
                    l = l * a + p; o0 = o0 * a + p * bf2f((bf16)(vv & 0xffff)); o1 = o1 * a + p * bf2f((bf16)(vv >> 16)); m = mn; } }
            const float gs = sigmoid_f(bf2f(pr[CGL + g * 18 + h * 3 + 1]));
            float r0 = ocs[h * 128 + 2 * lane] + gs * o0 / l, r1 = ocs[h * 128 + 2 * lane + 1] + gs * o1 / l;
            m = -1e30f; l = 0.f; o0 = 0.f; o1 = 0.f;
            for (int p0 = max(0, t - 511); p0 <= t; ++p0) { const bf16* kr = F.P + (size_t)p0 * NP;
                const unsigned kk = *(const unsigned*)(kr + NKW + g * 128 + 2 * lane), vv = *(const unsigned*)(kr + NVW + g * 128 + 2 * lane);
                const float s = wave_sum(q0 * bf2f((bf16)(kk & 0xffff)) + q1 * bf2f((bf16)(kk >> 16)));
                const float mn = fmaxf(m, s), a = __expf(m - mn), p = __expf(s - mn);
                l = l * a + p; o0 = o0 * a + p * bf2f((bf16)(vv & 0xffff)); o1 = o1 * a + p * bf2f((bf16)(vv >> 16)); m = mn; }
            const float gw_ = sigmoid_f(bf2f(pr[CGL + g * 18 + h * 3 + 2]));
            r0 += gw_ * o0 / l; r1 += gw_ * o1 / l;
            const unsigned rr = *(const unsigned*)(pr + CR + (g * 6 + h) * 128 + 2 * lane);
            r0 *= silu_f(bf2f((bf16)(rr & 0xffff))); r1 *= silu_f(bf2f((bf16)(rr >> 16)));
            *(unsigned*)(F.MIX1 + (size_t)t * DM + (g * 6 + h) * 128 + 2 * lane) = pk2(r0, r1);
        }
    }
}


typedef short v4i16_t __attribute__((ext_vector_type(4)));
typedef short s16x4 __attribute__((ext_vector_type(4)));
__device__ __forceinline__ s16x4 vtr(const LAS unsigned char* p) { return __builtin_bit_cast(s16x4, __builtin_amdgcn_ds_read_tr16_b64_v4i16((LAS v4i16_t*)p)); }
constexpr int KROW = 288;
constexpr int RING = 3, TILE_K = 16384, TILE_KV = 32768;
__device__ __forceinline__ int swz_off(int row, int chunk) { return row * 256 + ((((((chunk >> 1) ^ row) & 7)) << 1) | (chunk & 1)) * 16; }
constexpr float LOG2E = 1.4426950408889634f;

struct ImpArgs { float gate0, gate1; bool hvalid; LAS float* imp; const LAS unsigned* bm; };
typedef float f32x2_t __attribute__((ext_vector_type(2)));
typedef __bf16 bf16x2_t __attribute__((ext_vector_type(2)));
__device__ __forceinline__ unsigned cvtpk(float lo, float hi) { const f32x2_t v = {lo, hi}; return __builtin_bit_cast(unsigned, __builtin_convertvector(v, bf16x2_t)); }
__device__ __forceinline__ float xmax4(float x) { x = fmaxf(x, __shfl_xor(x, 16)); return fmaxf(x, __shfl_xor(x, 32)); }
__device__ __forceinline__ float xsum4(float x) { x += __shfl_xor(x, 16); return x + __shfl_xor(x, 32); }
template <int CTRL> __device__ __forceinline__ float dppf(float x) { return __builtin_bit_cast(float, __builtin_amdgcn_update_dpp(0, __builtin_bit_cast(int, x), CTRL, 0xF, 0xF, true)); }
__device__ __forceinline__ float sum8(float x) { x += dppf<0xB1>(x); x += dppf<0x4E>(x); x += dppf<0x141>(x); return x; }

template <int MODE, int RTM, bool FULL, class Mask>
__device__ __forceinline__ void attn_tile(const LAS unsigned char* Kb, const LAS unsigned char* Vb, const bf16x8 (&Q)[2][4], f32x4 (&O)[2][8], float (&m)[2], float (&l)[2],
                                          const int kt, const Mask& mask, const int tok0, const int tok1, const float sl2, const ImpArgs& ia, const bool sb0, const bool sb1,
                                          float& carry0, float& carry1, const int lane) {
    const int c16 = lane & 15, g = lane >> 4;
#pragma unroll
    for (int s32 = 0; s32 < 2; ++s32) {
        f32x4 sc[2][2];
#pragma unroll
        for (int rt = 0; rt < 2; ++rt)
#pragma unroll
            for (int st = 0; st < 2; ++st) sc[rt][st] = (f32x4){0.f, 0.f, 0.f, 0.f};
#pragma unroll
        for (int st = 0; st < 2; ++st) {
            bf16x8 kf[4];
#pragma unroll
            for (int kd = 0; kd < 4; ++kd) kf[kd] = *(const LAS bf16x8*)(Kb + swz_off(s32 * 32 + st * 16 + c16, g + 4 * kd));
#pragma unroll
            for (int kd = 0; kd < 4; ++kd) {
                if (RTM & 1) sc[0][st] = __builtin_amdgcn_mfma_f32_16x16x32_bf16(kf[kd], Q[0][kd], sc[0][st], 0, 0, 0);
                if (RTM & 2) sc[1][st] = __builtin_amdgcn_mfma_f32_16x16x32_bf16(kf[kd], Q[1][kd], sc[1][st], 0, 0, 0);
            }
        }
        __builtin_amdgcn_sched_barrier(0);
        bf16x8 pf[2];
#pragma unroll
        for (int rt = 0; rt < 2; ++rt) {
            if (!((RTM >> rt) & 1)) continue;
            const int tk = rt ? tok1 : tok0; const bool sb = rt ? sb1 : sb0;
            float v[8]; bool ok[8]; float mx = -3e38f;
#pragma unroll
            for (int st = 0; st < 2; ++st)
#pragma unroll
                for (int r = 0; r < 4; ++r) { const int kidx = kt + s32 * 32 + st * 16 + g * 4 + r;
                    ok[st * 4 + r] = FULL ? true : mask(tk, kidx); v[st * 4 + r] = ok[st * 4 + r] ? sc[rt][st][r] : -3e38f; mx = fmaxf(mx, v[st * 4 + r]); }
            if (MODE != 2) {
                mx = xmax4(mx);
                const float mo = m[rt]; float mn = fmaxf(mo, mx * sl2); if (MODE == 3) mn = sb ? mn : mo;
                m[rt] = mn;
                float ps = 0.f;
#pragma unroll
                for (int i = 0; i < 8; ++i) { const float e = __builtin_amdgcn_exp2f(fmaf(v[i], sl2, -mn)); v[i] = (ok[i] && (MODE != 3 || sb)) ? e : 0.f; ps += v[i]; }
                if (__any(mn > mo)) {
                    const float alpha = __builtin_amdgcn_exp2f(mo - mn);
                    l[rt] = l[rt] * alpha;
                    if (MODE == 0 || MODE == 3) {
#pragma unroll
                        for (int dt = 0; dt < 8; ++dt) O[rt][dt] = O[rt][dt] * alpha;
                    }
                }
                l[rt] += ps;
            } else {
                const float mn = m[rt], linv = ia.hvalid ? l[rt] : 0.f, gt = rt ? ia.gate1 : ia.gate0;
#pragma unroll
                for (int i = 0; i < 8; ++i) v[i] = ok[i] ? __builtin_amdgcn_exp2f(fmaf(v[i], sl2, -mn)) * linv : 0.f;
                const float s40 = sum8((v[0] + v[1]) + (v[2] + v[3])), s41 = sum8((v[4] + v[5]) + (v[6] + v[7])), la0 = sum8(v[3]), la1 = sum8(v[7]);
                const float pl0 = __shfl(la0, (lane + 48) & 63), pl1 = __shfl(la1, (lane + 48) & 63);
                const float cprev = rt ? carry1 : carry0;
                const float i0 = s40 + (g > 0 ? pl0 : cprev), i1 = s41 + (g > 0 ? pl1 : pl0);
                if (rt) carry1 = pl1; else carry0 = pl1;
                if ((lane & 7) == 0) { const int jb = (kt >> 2) + 8 * s32 + g; LAS float* ip = ia.imp + (rt * 2 + (c16 >> 3)) * 256 + jb; ip[0] = i0; ip[4] = i1; }
#pragma unroll
                for (int i = 0; i < 8; ++i) v[i] *= gt;
            }
            if (MODE != 1) { v4u pw; pw.x = cvtpk(v[0], v[1]); pw.y = cvtpk(v[2], v[3]); pw.z = cvtpk(v[4], v[5]); pw.w = cvtpk(v[6], v[7]);
                pf[rt] = __builtin_bit_cast(bf16x8, pw); }
            __builtin_amdgcn_sched_barrier(0);
        }
        if (MODE != 1) {
            const int vrow = s32 * 32 + g * 4 + (c16 >> 2);
            const unsigned vb0 = (unsigned)(size_t)Vb + (unsigned)(vrow * 256 + ((c16 >> 1) & 1) * 16 + (c16 & 1) * 8), r7 = (unsigned)(vrow & 7);
#pragma unroll
            for (int dh = 0; dh < 2; ++dh) {
                s16x4 tv[8];
                const unsigned a0 = vb0 + (((unsigned)(4 * dh + 0) ^ r7) << 5), a1 = vb0 + (((unsigned)(4 * dh + 1) ^ r7) << 5), a2 = vb0 + (((unsigned)(4 * dh + 2) ^ r7) << 5), a3 = vb0 + (((unsigned)(4 * dh + 3) ^ r7) << 5);
                asm volatile("ds_read_b64_tr_b16 %0, %8\n\tds_read_b64_tr_b16 %1, %8 offset:4096\n\tds_read_b64_tr_b16 %2, %9\n\tds_read_b64_tr_b16 %3, %9 offset:4096\n\t"
                             "ds_read_b64_tr_b16 %4, %10\n\tds_read_b64_tr_b16 %5, %10 offset:4096\n\tds_read_b64_tr_b16 %6, %11\n\tds_read_b64_tr_b16 %7, %11 offset:4096\n\t"
                             "s_waitcnt lgkmcnt(0)"
                             : "=&v"(tv[0]), "=&v"(tv[1]), "=&v"(tv[2]), "=&v"(tv[3]), "=&v"(tv[4]), "=&v"(tv[5]), "=&v"(tv[6]), "=&v"(tv[7]) : "v"(a0), "v"(a1), "v"(a2), "v"(a3) : "memory");
#pragma unroll
                for (int q = 0; q < 4; ++q) { const int dt = 4 * dh + q;
                    const bf16x8 vf = {tv[2 * q][0], tv[2 * q][1], tv[2 * q][2], tv[2 * q][3], tv[2 * q + 1][0], tv[2 * q + 1][1], tv[2 * q + 1][2], tv[2 * q + 1][3]};
                    if (RTM & 1) O[0][dt] = __builtin_amdgcn_mfma_f32_16x16x32_bf16(vf, pf[0], O[0][dt], 0, 0, 0);
                    if (RTM & 2) O[1][dt] = __builtin_amdgcn_mfma_f32_16x16x32_bf16(vf, pf[1], O[1][dt], 0, 0, 0); }
            }
        }
        __builtin_amdgcn_sched_barrier(0);
    }
}

template <int MODE, class Src, class Mask>
__device__ __forceinline__ void attn_pass(Ctx& F, LAS unsigned char* base, const bf16x8 (&Q)[2][4], f32x4 (&O)[2][8], float (&m)[2], float (&l)[2],
                                          const int k0, const int nt, const Src& src, const Mask& mask, const int tok0, const int tok1, const float sl2, const ImpArgs ia = ImpArgs{0.f, 0.f, false, nullptr, nullptr}) {
    int tidv = F.tid; asm volatile("" : "+v"(tidv));
    const int lane = tidv & 63, c16 = lane & 15, g = lane >> 4;
    const int wv = F.wave;
    constexpr int NL = (MODE == 1) ? 2 : 4;
#define ATT_DMA(tj, bufi) do { const int kt_ = k0 + 64 * min((tj), nt - 1); \
        _Pragma("unroll") for (int i_ = 0; i_ < 2; ++i_) { const int pc_ = wv * 2 + i_, row_ = pc_ * 4 + g, c_ = (((((c16 >> 1) ^ row_) & 7)) << 1) | (c16 & 1); \
            const unsigned go_ = src.off(kt_ + row_) + (unsigned)(c_ * 16); \
            __builtin_amdgcn_global_load_lds((const unsigned*)(src.kb + go_), (LAS unsigned*)(base + (bufi) * TILE_KV + pc_ * 1024), 16, 0, 0); \
            if (MODE != 1) __builtin_amdgcn_global_load_lds((const unsigned*)(src.vb + go_), (LAS unsigned*)(base + (bufi) * TILE_KV + TILE_K + pc_ * 1024), 16, 0, 0); } } while (0)
    __syncthreads();
#pragma unroll
    for (int t_ = 0; t_ < RING - 1; ++t_) ATT_DMA(t_, t_);
    float carry0 = 0.f, carry1 = 0.f;
    int bcur = 0;
    for (int j = 0; j < nt; ++j) {
        if (NL == 4) asm volatile("s_waitcnt vmcnt(%0)" :: "n"((RING - 2) * 4) : "memory"); else asm volatile("s_waitcnt vmcnt(%0)" :: "n"((RING - 2) * 2) : "memory");
        __builtin_amdgcn_s_barrier();
        { const int bnext = (bcur == 0) ? RING - 1 : bcur - 1; ATT_DMA(j + RING - 1, bnext); }
        const LAS unsigned char* Kb = base + bcur * TILE_KV; const LAS unsigned char* Vb = Kb + TILE_K;
        const int kt = k0 + 64 * j;
        if (MODE == 3) {
            const int jb = kt >> 6; const unsigned w0 = ia.bm[(c16 >> 3) * 8 + (jb >> 5)], w1 = ia.bm[(2 + (c16 >> 3)) * 8 + (jb >> 5)];
            const bool sb0 = ia.hvalid && ((w0 >> (jb & 31)) & 1u), sb1 = ia.hvalid && ((w1 >> (jb & 31)) & 1u); const bool act0 = __any(sb0), act1 = __any(sb1);
            if (act0 && act1) attn_tile<MODE, 3, false>(Kb, Vb, Q, O, m, l, kt, mask, tok0, tok1, sl2, ia, sb0, sb1, carry0, carry1, lane);
            else if (act0) attn_tile<MODE, 1, false>(Kb, Vb, Q, O, m, l, kt, mask, tok0, tok1, sl2, ia, sb0, sb1, carry0, carry1, lane);
            else if (act1) attn_tile<MODE, 2, false>(Kb, Vb, Q, O, m, l, kt, mask, tok0, tok1, sl2, ia, sb0, sb1, carry0, carry1, lane);
        } else { int lj = lane; asm volatile("" : "+v"(lj));
            const bool full = __all(mask(tok0, kt) && mask(tok0, kt + 63) && mask(tok1, kt) && mask(tok1, kt + 63));
            if (full) attn_tile<MODE, 3, true>(Kb, Vb, Q, O, m, l, kt, mask, tok0, tok1, sl2, ia, true, true, carry0, carry1, lj);
            else attn_tile<MODE, 3, false>(Kb, Vb, Q, O, m, l, kt, mask, tok0, tok1, sl2, ia, true, true, carry0, carry1, lj); }
        bcur = (bcur == RING - 1) ? 0 : bcur + 1;
    }
    asm volatile("s_waitcnt vmcnt(0)" ::: "memory");
    __syncthreads();
#undef ATT_DMA
}

template <class Src, class Mask>
__device__ __forceinline__ void slc_pass(Ctx& F, LAS unsigned char* base, const bf16x8 (&Q)[2][4], f32x4 (&O)[2][8], float (&m)[2], float (&l)[2],
                                         const int nt, const Src& src, const Mask& mask, const int tok0, const int tok1, const float sl2, const ImpArgs ia) {
    int tidv = F.tid; asm volatile("" : "+v"(tidv));
    const int lane = tidv & 63, c16 = lane & 15, g = lane >> 4;
    const int wv = F.wave;
    volatile LAS unsigned* flg = (volatile LAS unsigned*)(base + RING_BYTES + 2048);
#define SLC_DMA(tj) do { const int kt_ = 64 * (tj); \
        _Pragma("unroll") for (int i_ = 0; i_ < 2; ++i_) { const int pc_ = wv * 2 + i_, row_ = pc_ * 4 + g, c_ = (((((c16 >> 1) ^ row_) & 7)) << 1) | (c16 & 1); \
            const unsigned go_ = src.off(kt_ + row_) + (unsigned)(c_ * 16); \
            __builtin_amdgcn_global_load_lds((const unsigned*)(src.kb + go_), (LAS unsigned*)(base + ((tj) & 3) * TILE_KV + pc_ * 1024), 16, 0, 0); \
            __builtin_amdgcn_global_load_lds((const unsigned*)(src.vb + go_), (LAS unsigned*)(base + ((tj) & 3) * TILE_KV + TILE_K + pc_ * 1024), 16, 0, 0); } } while (0)
#define SLC_SPIN(off, target) do { for (;;) { const unsigned v_ = flg[(off) + (lane & 7)]; if (__all(v_ >= (unsigned)(target))) break; __builtin_amdgcn_s_sleep(1); } asm volatile("" ::: "memory"); __builtin_amdgcn_sched_barrier(0); } while (0)
    __syncthreads();
    if (tidv < 16) flg[tidv] = 0u;
    __syncthreads();
    SLC_DMA(0); if (nt > 1) SLC_DMA(1);
    float carry0 = 0.f, carry1 = 0.f;
    for (int j = 0; j < nt; ++j) {
        if (j + 2 < nt) { if (j >= 2) SLC_SPIN(8, j - 1); SLC_DMA(j + 2); }
        if (j + 2 < nt) asm volatile("s_waitcnt vmcnt(4)" ::: "memory"); else asm volatile("s_waitcnt vmcnt(0)" ::: "memory");
        asm volatile("" ::: "memory");
        if (lane == 0) flg[wv] = (unsigned)min(j + 2, nt);
        asm volatile("" ::: "memory");
        const unsigned w0 = ia.bm[(c16 >> 3) * 8 + (j >> 5)], w1 = ia.bm[(2 + (c16 >> 3)) * 8 + (j >> 5)];
        const bool sb0 = ia.hvalid && ((w0 >> (j & 31)) & 1u), sb1 = ia.hvalid && ((w1 >> (j & 31)) & 1u); const bool act0 = __any(sb0), act1 = __any(sb1);
        if (act0 || act1) {
            SLC_SPIN(0, j + 1);
            const LAS unsigned char* Kb = base + (j & 3) * TILE_KV; const LAS unsigned char* Vb = Kb + TILE_K;
            int lj = lane; asm volatile("" : "+v"(lj));
            if (act0 && act1) attn_tile<3, 3, false>(Kb, Vb, Q, O, m, l, 64 * j, mask, tok0, tok1, sl2, ia, sb0, sb1, carry0, carry1, lj);
            else if (act0) attn_tile<3, 1, false>(Kb, Vb, Q, O, m, l, 64 * j, mask, tok0, tok1, sl2, ia, sb0, sb1, carry0, carry1, lj);
            else attn_tile<3, 2, false>(Kb, Vb, Q, O, m, l, 64 * j, mask, tok0, tok1, sl2, ia, sb0, sb1, carry0, carry1, lj);
            asm volatile("s_waitcnt lgkmcnt(0)" ::: "memory");
        }
        asm volatile("" ::: "memory");
        if (lane == 0) flg[8 + wv] = (unsigned)(j + 1);
        asm volatile("" ::: "memory");
    }
    asm volatile("s_waitcnt vmcnt(0)" ::: "memory");
    __syncthreads();
#undef SLC_DMA
#undef SLC_SPIN
}

struct SrcMem { const char* kb; const char* vb;
    __device__ __forceinline__ unsigned off(int key) const { return (unsigned)min(key, NMEM - 1) * 256u; } };
struct MaskNone { __device__ __forceinline__ bool operator()(int, int) const { return true; } };

__device__ __forceinline__ void cross_fast(Ctx& F, int layer, bf16* MIX) {
    for (int u = blockIdx.x; u < 256; u += F.G) {
        int tidv = F.tid; asm volatile("" : "+v"(tidv));
        const int lane = tidv & 63, c16 = lane & 15, g = lane >> 4;
        const int h = u & 3, tb = u >> 2;
        int tok[2]; bf16x8 Q[2][4]; f32x4 O[2][8]; float m[2], l[2];
#pragma unroll
        for (int rt = 0; rt < 2; ++rt) { tok[rt] = tb * 256 + F.wave * 32 + rt * 16 + c16; m[rt] = -1e30f; l[rt] = 0.f;
#pragma unroll
            for (int kd = 0; kd < 4; ++kd) Q[rt][kd] = *(const bf16x8*)((const char*)F.P + ((unsigned)tok[rt] * (unsigned)(NP * 2) + (unsigned)((CXQ + h * 128 + g * 8 + kd * 32) * 2)));
#pragma unroll
            for (int dt = 0; dt < 8; ++dt) O[rt][dt] = (f32x4){0.f, 0.f, 0.f, 0.f}; }
        SrcMem src{(const char*)(F.MEMKV + (((size_t)layer * 2 + 0) * 4 + h) * NMEM * 128), (const char*)(F.MEMKV + (((size_t)layer * 2 + 1) * 4 + h) * NMEM * 128)};
        attn_pass<0>(F, F.lds, Q, O, m, l, 0, 4, src, MaskNone(), tok[0], tok[1], 0.08838834764831845f * LOG2E);
#pragma unroll
        for (int rt = 0; rt < 2; ++rt) {
            float lt = xsum4(l[rt]);
            const float inv = 1.f / lt;
#pragma unroll
            for (int dt = 0; dt < 8; ++dt) { const int d = dt * 16 + g * 4;
                const unsigned long long xg = *(const unsigned long long*)((const char*)F.P + ((unsigned)tok[rt] * (unsigned)(NP * 2) + (unsigned)((CXG + h * 128 + d) * 2)));
                const unsigned lo = (unsigned)xg, hi = (unsigned)(xg >> 32);
                const float o0 = O[rt][dt][0] * inv * silu_f(bf2f((bf16)(lo & 0xffff))), o1 = O[rt][dt][1] * inv * silu_f(bf2f((bf16)(lo >> 16)));
                const float o2 = O[rt][dt][2] * inv * silu_f(bf2f((bf16)(hi & 0xffff))), o3 = O[rt][dt][3] * inv * silu_f(bf2f((bf16)(hi >> 16)));
                *(unsigned long long*)((char*)MIX + ((unsigned)tok[rt] * (unsigned)(DM * 2) + (unsigned)((1536 + h * 128 + d) * 2))) = (unsigned long long)pk2(o0, o1) | ((unsigned long long)pk2(o2, o3) << 32); }
        }
    }
}


struct SrcRows { const char* kb; const char* vb;
    __device__ __forceinline__ unsigned off(int key) const { return (unsigned)min(max(key, 0), T - 1) * 256u; } };
struct MaskWin { __device__ __forceinline__ bool operator()(int t, int key) const { return key <= t && key > t - 512; } };
struct SrcCmp { const char* kb; const char* vb;
    __device__ __forceinline__ unsigned off(int key) const { return (unsigned)min(key, 1022) * 256u; } };
struct MaskCmp { __device__ __forceinline__ bool operator()(int t, int key) const { return 16 * key + 31 <= t; } };

struct MaskCausal { __device__ __forceinline__ bool operator()(int t, int key) const { return key <= t; } };

__device__ __forceinline__ void nsa_main_fast(Ctx& F) {
    const float sl2 = 0.08838834764831845f * LOG2E;
    LAS float* imp = (LAS float*)(F.lds + RING * TILE_KV) + F.wave * 1024;
    LAS unsigned* bm = (LAS unsigned*)(F.lds + RING_BYTES + 1024) + F.wave * 32;
    for (int ui = 0, ub = blockIdx.x; ub < 1024; ub += F.G, ++ui) {
        const int u = ((ui & 1) && (1024 % F.G == 0)) ? (ub - (int)blockIdx.x) + (F.G - 1 - (int)blockIdx.x) : ub;
        const int g = u & 1, tb = u >> 1;
        int tidv = F.tid; asm volatile("" : "+v"(tidv));
        const int lane = tidv & 63, c16 = lane & 15, gq = lane >> 4, ts = c16 >> 3, hs = c16 & 7; const bool hv = hs < 6;
        int tok[2]; f32x4 O[2][8]; bf16x8 Q[2][4]; float m[2], l[2];
        {
            float gw[2], gc[2];
#pragma unroll
            for (int rt = 0; rt < 2; ++rt) { tok[rt] = tb * 32 + F.wave * 4 + rt * 2 + ts; m[rt] = -1e30f; l[rt] = 0.f;
                const char* Pb = (const char*)F.P; const unsigned ro = (unsigned)tok[rt] * (unsigned)(NP * 2);
#pragma unroll
                for (int kd = 0; kd < 4; ++kd) { Q[rt][kd] = (bf16x8){0, 0, 0, 0, 0, 0, 0, 0}; if (hv) Q[rt][kd] = *(const bf16x8*)(Pb + (ro + (unsigned)((NQ + (g * 6 + hs) * 128 + gq * 8 + kd * 32) * 2))); }
                gw[rt] = hv ? sigmoid_f(bf2f(*(const bf16*)(Pb + (ro + (unsigned)((CGL + g * 18 + hs * 3 + 2) * 2))))) : 0.f;
                gc[rt] = hv ? sigmoid_f(bf2f(*(const bf16*)(Pb + (ro + (unsigned)((CGL + g * 18 + hs * 3 + 0) * 2))))) : 0.f;
#pragma unroll
                for (int dt = 0; dt < 8; ++dt) O[rt][dt] = (f32x4){0.f, 0.f, 0.f, 0.f}; }
            { const int klo = max(0, tb * 32 - 511), k0 = (klo >> 6) << 6, nt = ((tb * 32 + 31 - k0) >> 6) + 1;
              attn_pass<0>(F, F.lds, Q, O, m, l, k0, nt, SrcRows{(const char*)(F.CP + (8 + g) * PLANE), (const char*)(F.CP + (10 + g) * PLANE)}, MaskWin(), tok[0], tok[1], sl2); }
#pragma unroll
            for (int rt = 0; rt < 2; ++rt) { float lt = xsum4(l[rt]); const float f = gw[rt] / lt;
#pragma unroll
                for (int dt = 0; dt < 8; ++dt) O[rt][dt] = O[rt][dt] * f; m[rt] = -1e30f; l[rt] = 0.f; }
            const int tlast = tb * 32 + 31, ncv = (tlast - 31) / 16 + 1, ntc = (ncv + 63) >> 6;
            SrcCmp sc_{(const char*)(F.KCMP + (size_t)g * 1024 * 128), (const char*)(F.VCMP + (size_t)g * 1024 * 128)};
            attn_pass<1>(F, F.lds, Q, O, m, l, 0, ntc, sc_, MaskCmp(), tok[0], tok[1], sl2);
#pragma unroll
            for (int rt = 0; rt < 2; ++rt) { float lt = xsum4(l[rt]); l[rt] = lt > 0.f ? 1.f / lt : 0.f; }
            attn_pass<2>(F, F.lds, Q, O, m, l, 0, ntc, sc_, MaskCmp(), tok[0], tok[1], sl2, ImpArgs{gc[0], gc[1], hv, imp, nullptr});
        }
        for (int s = 0; s < 4; ++s) {
            const int tt = tb * 32 + F.wave * 4 + s, cur = tt >> 6;
            float iv[4]; unsigned myword = 0u;
#pragma unroll
            for (int i = 0; i < 4; ++i) { const int jj = lane + 64 * i; iv[i] = imp[s * 256 + jj]; if (jj == 0 || jj == cur || jj == cur - 1) iv[i] = 1e4f; if (jj > cur) iv[i] = -1e4f; }
#pragma unroll
            for (int r = 0; r < 16; ++r) {
                float bv = iv[0]; int bi = lane;
#pragma unroll
                for (int i = 1; i < 4; ++i) { if (iv[i] > bv) { bv = iv[i]; bi = lane + 64 * i; } }
#pragma unroll
                for (int o = 1; o < 64; o <<= 1) { const float ov = __shfl_xor(bv, o); const int oi = __shfl_xor(bi, o); if (ov > bv || (ov == bv && oi < bi)) { bv = ov; bi = oi; } }
                if (lane == (bi >> 5)) myword |= 1u << (bi & 31);
#pragma unroll
                for (int i = 0; i < 4; ++i) if (lane + 64 * i == bi) iv[i] = -3e38f;
            }
            if (lane < 8) bm[s * 8 + lane] = myword;
        }
        if (hv) {
#pragma unroll
            for (int rt = 0; rt < 2; ++rt)
#pragma unroll
                for (int dt = 0; dt < 8; ++dt) { const int col = (g * 6 + hs) * 128 + dt * 16 + gq * 4;
                    *(unsigned long long*)((char*)F.MIX1 + ((unsigned)tok[rt] * (unsigned)(DM * 2) + (unsigned)(col * 2))) = (unsigned long long)cvtpk(O[rt][dt][0], O[rt][dt][1]) | ((unsigned long long)cvtpk(O[rt][dt][2], O[rt][dt][3]) << 32); }
        }
#pragma unroll
        for (int rt = 0; rt < 2; ++rt) { m[rt] = -1e30f; l[rt] = 0.f;
#pragma unroll
            for (int dt = 0; dt < 8; ++dt) O[rt][dt] = (f32x4){0.f, 0.f, 0.f, 0.f}; }
        slc_pass(F, F.lds, Q, O, m, l, ((tb * 32) >> 6) + 1, SrcRows{(const char*)(F.CP + (4 + g) * PLANE), (const char*)(F.CP + (6 + g) * PLANE)}, MaskCausal(), tok[0], tok[1], sl2, ImpArgs{0.f, 0.f, hv, nullptr, bm});
        const float lts0 = xsum4(l[0]), lts1 = xsum4(l[1]);
        if (hv) {
#pragma unroll
            for (int rt = 0; rt < 2; ++rt) {
                const float lt = rt ? lts1 : lts0;
                const float f = sigmoid_f(bf2f(*(const bf16*)((const char*)F.P + ((unsigned)tok[rt] * (unsigned)(NP * 2) + (unsigned)((CGL + g * 18 + hs * 3 + 1) * 2))))) / lt;
#pragma unroll
                for (int dt = 0; dt < 8; ++dt) { const int col = (g * 6 + hs) * 128 + dt * 16 + gq * 4;
                    char* mp = (char*)F.MIX1 + ((unsigned)tok[rt] * (unsigned)(DM * 2) + (unsigned)(col * 2));
                    const unsigned long long pp = *(const unsigned long long*)mp; const unsigned plo = (unsigned)pp, phi = (unsigned)(pp >> 32);
                    const unsigned long long rr = *(const unsigned long long*)((const char*)F.P + ((unsigned)tok[rt] * (unsigned)(NP * 2) + (unsigned)((CR + col) * 2))); const unsigned lo = (unsigned)rr, hi = (unsigned)(rr >> 32);
                    const float o0 = (O[rt][dt][0] * f + bf2f((bf16)(plo & 0xffff))) * silu_f(bf2f((bf16)(lo & 0xffff))), o1 = (O[rt][dt][1] * f + bf2f((bf16)(plo >> 16))) * silu_f(bf2f((bf16)(lo >> 16)));
                    const float o2 = (O[rt][dt][2] * f + bf2f((bf16)(phi & 0xffff))) * silu_f(bf2f((bf16)(hi & 0xffff))), o3 = (O[rt][dt][3] * f + bf2f((bf16)(phi >> 16))) * silu_f(bf2f((bf16)(hi >> 16)));
                    *(unsigned long long*)mp = (unsigned long long)cvtpk(o0, o1) | ((unsigned long long)cvtpk(o2, o3) << 32); }
            }
        }
    }
}

__device__ __forceinline__ void gla_g1_fast(Ctx& F) {
    int tidv = F.tid; asm volatile("" : "+v"(tidv));
    const int tid = tidv, lane = tidv & 63, c16 = lane & 15, gq = lane >> 4, wave = F.wave;
    constexpr int QP = 416, VP = 800;
    LAS float* bcum = (LAS float*)F.lds;
    LAS unsigned char* Vt = F.lds;
    LAS unsigned char* QT = F.lds + 51200;
    LAS unsigned char* KT = F.lds + 51200 + 26624;
    LAS float* eblast = (LAS float*)(F.lds + 104448);
    LAS float* tot0 = (LAS float*)(F.lds + 105216);
    LAS float* glr = (LAS float*)(F.lds + 105984);
    const float qscale = 0.07216878364870323f;
    for (int u = blockIdx.x; u < 1024; u += F.G) {
        const int n = u >> 2, h = u & 3; const size_t row0 = (size_t)n * 64;
        for (int i = tid; i < 1024; i += NTHR) glr[i] = bf2f(F.P[(row0 + (i >> 4)) * NP + CGL + (i & 15)]);
        __syncthreads();
        if (tid < 384) {
            const int seg = tid >= 192 ? 1 : 0, d = tid - 192 * seg, col = h * 192 + d; float wg[16];
#pragma unroll
            for (int j = 0; j < 16; ++j) wg[j] = F.gla_w_gate[j * 768 + col];
            const float bias = F.gla_b_gate[col]; float b = 0.f;
            for (int c = 32 * seg; c < 32 * seg + 32; ++c) { float gl = bias;
#pragma unroll
                for (int j = 0; j < 16; ++j) gl += glr[c * 16 + j] * wg[j];
                b += logsigmoid_f(gl) * (1.f / 16.f); bcum[c * 192 + d] = b; }
            if (seg == 0) tot0[d] = b;
        }
        __syncthreads();
        if (tid >= 192 && tid < 384) { const int d = tid - 192; const float t0 = tot0[d];
            for (int c = 32; c < 64; ++c) bcum[c * 192 + d] += t0; }
        __syncthreads();
        if (tid < 192) { const float eb = __expf(bcum[63 * 192 + tid]); eblast[tid] = eb; F.DEC[n * 768 + h * 192 + tid] = eb; }
#pragma unroll
        for (int i = 0; i < 3; ++i) { const int idx = tid + NTHR * i, c = idx / 24, d8 = (idx % 24) * 8;
            bf16* qg = F.P + (row0 + c) * NP + GQ + h * 192 + d8; const bf16* kg = F.P + (row0 + c) * NP + GK + h * 192 + d8;
            const v4u qr = *(const v4u*)qg, kr = *(const v4u*)kg;
            const unsigned qw[4] = {qr.x, qr.y, qr.z, qr.w}, kw[4] = {kr.x, kr.y, kr.z, kr.w}; unsigned qo[4], ko[4];
#pragma unroll
            for (int j = 0; j < 4; ++j) { const float b0 = bcum[c * 192 + d8 + 2 * j], b1 = bcum[c * 192 + d8 + 2 * j + 1];
                qo[j] = pk2(bf2f((bf16)(qw[j] & 0xffff)) * qscale * __expf(b0), bf2f((bf16)(qw[j] >> 16)) * qscale * __expf(b1));
                ko[j] = pk2(bf2f((bf16)(kw[j] & 0xffff)) * __expf(-b0), bf2f((bf16)(kw[j] >> 16)) * __expf(-b1)); }
            const v4u qv = {qo[0], qo[1], qo[2], qo[3]}, kv = {ko[0], ko[1], ko[2], ko[3]};
            *(LAS v4u*)(QT + c * QP + d8 * 2) = qv; *(LAS v4u*)(KT + c * QP + d8 * 2) = kv; *(v4u*)qg = qv; }
        __syncthreads();
#pragma unroll
        for (int i = 0; i < 6; ++i) { const int idx = tid + NTHR * i, r = idx / 48, ch = idx % 48;
            *(LAS v4u*)(Vt + r * VP + ch * 16) = *(const v4u*)(F.P + (row0 + r) * NP + GV + h * 384 + ch * 8); }
        __syncthreads();
        {
            bf16x8 vB[3][2];
#pragma unroll
            for (int j = 0; j < 3; ++j)
#pragma unroll
                for (int ks = 0; ks < 2; ++ks) { const LAS unsigned char* p = Vt + (32 * ks + 4 * gq + (c16 >> 2)) * VP + (16 * (3 * wave + j) + 4 * (c16 & 3)) * 2;
                    const s16x4 lo = vtr(p), hi = vtr(p + 16 * VP); vB[j][ks] = (bf16x8){lo[0], lo[1], lo[2], lo[3], hi[0], hi[1], hi[2], hi[3]}; }
            for (int dt = 0; dt < 12; ++dt) {
                bf16x8 aK[2];
#pragma unroll
                for (int ks = 0; ks < 2; ++ks) { const LAS unsigned char* p = KT + (32 * ks + 4 * gq + (c16 >> 2)) * QP + (16 * dt + 4 * (c16 & 3)) * 2;
                    const s16x4 lo = vtr(p), hi = vtr(p + 16 * QP); aK[ks] = (bf16x8){lo[0], lo[1], lo[2], lo[3], hi[0], hi[1], hi[2], hi[3]}; }
                const f32x4 eb = *(const LAS f32x4*)(eblast + 16 * dt + 4 * gq);
#pragma unroll
                for (int j = 0; j < 3; ++j) { f32x4 acc = {0.f, 0.f, 0.f, 0.f};
                    acc = __builtin_amdgcn_mfma_f32_16x16x32_bf16(aK[0], vB[j][0], acc, 0, 0, 0);
                    acc = __builtin_amdgcn_mfma_f32_16x16x32_bf16(aK[1], vB[j][1], acc, 0, 0, 0);
                    const int e = 16 * (3 * wave + j) + c16;
                    *(unsigned long long*)(F.STATE + ((size_t)u * 384 + e) * 192 + 16 * dt + 4 * gq) = (unsigned long long)pk2(acc[0] * eb[0], acc[1] * eb[1]) | ((unsigned long long)pk2(acc[2] * eb[2], acc[3] * eb[3]) << 32); }
            }
        }
        {
            const int ct = wave & 3, eh = wave >> 2;
            bf16x8 qB[6];
#pragma unroll
            for (int kd = 0; kd < 6; ++kd) qB[kd] = *(const LAS bf16x8*)(QT + (16 * ct + c16) * QP + (8 * gq + 32 * kd) * 2);
            f32x4 at[4];
#pragma unroll
            for (int st = 0; st < 4; ++st) { at[st] = (f32x4){0.f, 0.f, 0.f, 0.f};
                if (st <= ct) {
#pragma unroll
                    for (int kd = 0; kd < 6; ++kd) { const bf16x8 kA = *(const LAS bf16x8*)(KT + (16 * st + c16) * QP + (8 * gq + 32 * kd) * 2);
                        at[st] = __builtin_amdgcn_mfma_f32_16x16x32_bf16(kA, qB[kd], at[st], 0, 0, 0); }
#pragma unroll
                    for (int r = 0; r < 4; ++r) if (16 * st + 4 * gq + r > 16 * ct + c16) at[st][r] = 0.f;
                } }
            v4u pw0, pw1; pw0.x = pk2(at[0][0], at[0][1]); pw0.y = pk2(at[0][2], at[0][3]); pw0.z = pk2(at[1][0], at[1][1]); pw0.w = pk2(at[1][2], at[1][3]);
            pw1.x = pk2(at[2][0], at[2][1]); pw1.y = pk2(at[2][2], at[2][3]); pw1.z = pk2(at[3][0], at[3][1]); pw1.w = pk2(at[3][2], at[3][3]);
            const bf16x8 pA0 = __builtin_bit_cast(bf16x8, pw0), pA1 = __builtin_bit_cast(bf16x8, pw1);
            for (int j = 0; j < 12; ++j) { const int et = 12 * eh + j;
                bf16x8 vA[2];
#pragma unroll
                for (int ks = 0; ks < 2; ++ks) { const LAS unsigned char* p = Vt + (32 * ks + 4 * gq + (c16 >> 2)) * VP + (16 * et + 4 * (c16 & 3)) * 2;
                    const s16x4 lo = vtr(p), hi = vtr(p + 16 * VP); vA[ks] = (bf16x8){lo[0], lo[1], lo[2], lo[3], hi[0], hi[1], hi[2], hi[3]}; }
                f32x4 acc = {0.f, 0.f, 0.f, 0.f};
                acc = __builtin_amdgcn_mfma_f32_16x16x32_bf16(vA[0], pA0, acc, 0, 0, 0);
                acc = __builtin_amdgcn_mfma_f32_16x16x32_bf16(vA[1], pA1, acc, 0, 0, 0);
                *(unsigned long long*)(F.OI + (row0 + 16 * ct + c16) * 1536 + h * 384 + 16 * et + 4 * gq) = (unsigned long long)pk2(acc[0], acc[1]) | ((unsigned long long)pk2(acc[2], acc[3]) << 32); }
        }
        __syncthreads();
    }
}

__device__ __forceinline__ void gla_g3_fast(Ctx& F) {
    int tidv = F.tid; asm volatile("" : "+v"(tidv));
    const int lane = tidv & 63, c16 = lane & 15, gq = lane >> 4, wave = F.wave, ct = wave & 3, eh = wave >> 2;
    LAS float* ssq = (LAS float*)F.lds;
    for (int u = blockIdx.x; u < 1024; u += F.G) {
        const int n = u >> 2, h = u & 3; const size_t crow = (size_t)n * 64 + 16 * ct + c16;
        f32x4 acc[12];
#pragma unroll
        for (int j = 0; j < 12; ++j) acc[j] = (f32x4){0.f, 0.f, 0.f, 0.f};
        if (n > 0) {
            bf16x8 qB[6];
#pragma unroll
            for (int kd = 0; kd < 6; ++kd) qB[kd] = *(const bf16x8*)(F.P + crow * NP + GQ + h * 192 + 8 * gq + 32 * kd);
            const bf16* Sp = F.STATE + ((size_t)(u - 4) * 384 + 192 * eh + c16) * 192 + 8 * gq;
#pragma unroll
            for (int j = 0; j < 12; ++j)
#pragma unroll
                for (int kd = 0; kd < 6; ++kd) { const bf16x8 a = *(const bf16x8*)(Sp + (size_t)(16 * j) * 192 + 32 * kd);
                    acc[j] = __builtin_amdgcn_mfma_f32_16x16x32_bf16(a, qB[kd], acc[j], 0, 0, 0); }
        }
        float ss = 0.f;
#pragma unroll
        for (int j = 0; j < 12; ++j) { const int e0 = h * 384 + 192 * eh + 16 * j + 4 * gq;
            const unsigned long long oi = *(const unsigned long long*)(F.OI + crow * 1536 + e0); const unsigned lo = (unsigned)oi, hi = (unsigned)(oi >> 32);
            acc[j][0] += bf2f((bf16)(lo & 0xffff)); acc[j][1] += bf2f((bf16)(lo >> 16)); acc[j][2] += bf2f((bf16)(hi & 0xffff)); acc[j][3] += bf2f((bf16)(hi >> 16));
            ss += (acc[j][0] * acc[j][0] + acc[j][1] * acc[j][1]) + (acc[j][2] * acc[j][2] + acc[j][3] * acc[j][3]); }
        ss += __shfl_xor(ss, 16); ss += __shfl_xor(ss, 32);
        if (gq == 0) ssq[eh * 64 + 16 * ct + c16] = ss;
        __syncthreads();
        const float rstd = rsqrtf((ssq[16 * ct + c16] + ssq[64 + 16 * ct + c16]) * (1.f / 384.f) + EPS);
#pragma unroll
        for (int j = 0; j < 12; ++j) { const int el = 192 * eh + 16 * j + 4 * gq, e0 = h * 384 + el;
            const f32x4 gn = *(const f32x4*)(F.gla_norm + el);
            const unsigned long long rr = *(const unsigned long long*)(F.P + crow * NP + CR + e0); const unsigned lo = (unsigned)rr, hi = (unsigned)(rr >> 32);
            const float o0 = acc[j][0] * rstd * gn[0] * silu_f(bf2f((bf16)(lo & 0xffff))), o1 = acc[j][1] * rstd * gn[1] * silu_f(bf2f((bf16)(lo >> 16)));
            const float o2 = acc[j][2] * rstd * gn[2] * silu_f(bf2f((bf16)(hi & 0xffff))), o3 = acc[j][3] * rstd * gn[3] * silu_f(bf2f((bf16)(hi >> 16)));
            *(unsigned long long*)(F.MIX0 + crow * DM + e0) = (unsigned long long)pk2(o0, o1) | ((unsigned long long)pk2(o2, o3) << 32); }
        __syncthreads();
    }
}


__device__ __forceinline__ void memkv_fast(Ctx& F) {
    int tidv = F.tid; asm volatile("" : "+v"(tidv));
    const int lane = tidv & 63, c16 = lane & 15, gq = lane >> 4;
    for (int u = F.gw; u < 2048; u += F.NGW) {
        const int layer = u >> 10, mt = (u >> 6) & 15, ntile = u & 63;
        const float* ar = F.mem + (size_t)(16 * mt + c16) * DM + 8 * gq; const float* gr = F.ln_mem + layer * DM + 8 * gq;
        const bf16* br = F.WMKV + ((size_t)layer * 1024 + 16 * ntile + c16) * DM + 8 * gq;
        f32x4 acc = {0.f, 0.f, 0.f, 0.f}; float ss = 0.f;
#pragma unroll 4
        for (int ks = 0; ks < 64; ++ks) {
            const f32x4 a0 = *(const f32x4*)(ar + 32 * ks), a1 = *(const f32x4*)(ar + 32 * ks + 4), g0 = *(const f32x4*)(gr + 32 * ks), g1 = *(const f32x4*)(gr + 32 * ks + 4);
            ss += (a0.x * a0.x + a0.y * a0.y) + (a0.z * a0.z + a0.w * a0.w) + (a1.x * a1.x + a1.y * a1.y) + (a1.z * a1.z + a1.w * a1.w);
            v4u aw; aw.x = pk2(a0.x * g0.x, a0.y * g0.y); aw.y = pk2(a0.z * g0.z, a0.w * g0.w); aw.z = pk2(a1.x * g1.x, a1.y * g1.y); aw.w = pk2(a1.z * g1.z, a1.w * g1.w);
            const bf16x8 bfr = *(const bf16x8*)(br + 32 * ks);
            acc = __builtin_amdgcn_mfma_f32_16x16x32_bf16(__builtin_bit_cast(bf16x8, aw), bfr, acc, 0, 0, 0);
        }
        ss += __shfl_xor(ss, 16); ss += __shfl_xor(ss, 32);
        const float rs = rsqrtf(ss * (1.f / DM) + EPS);
        const int n = 16 * ntile + c16, kv = n >> 9, h = (n >> 7) & 3, d = n & 127;
#pragma unroll
        for (int r = 0; r < 4; ++r) { const int ml = 4 * gq + r; const float rr = __shfl(rs, ml);
            F.MEMKV[((((size_t)layer * 2 + kv) * 4 + h) * NMEM + 16 * mt + ml) * 128 + d] = f2b(acc[r] * rr); }
    }
}

__device__ __forceinline__ void nsa_compress_fast(Ctx& F) {
    int tidv = F.tid; asm volatile("" : "+v"(tidv));
    const int lane = tidv & 63, c16 = lane & 15, gq = lane >> 4, wave = F.wave;
    LAS unsigned char* hid = F.lds;
    constexpr int HP = 544;
    for (int u = blockIdx.x; u < 256; u += F.G) {
        const int kv = u & 1, g = (u >> 1) & 1, nt16 = u >> 2;
        const bf16* W1T = kv ? F.WV1T : F.WK1T; const float* w2 = kv ? F.wv2 : F.wk2; const float* hb = F.HB + kv * 32 * 256;
        const int n = min(16 * nt16 + c16, 1022);
        const bf16* ar = F.CP + (size_t)(kv * 2 + g) * PLANE + (size_t)(16 * n) * 128 + 8 * gq;
        const bf16* b0 = W1T + (size_t)(32 * wave + c16) * 4096 + 8 * gq; const bf16* b1 = b0 + (size_t)16 * 4096;
        f32x4 acc0 = {0.f, 0.f, 0.f, 0.f}, acc1 = {0.f, 0.f, 0.f, 0.f};
        for (int l = 0; l < 32; ++l) {
#pragma unroll
            for (int kd = 0; kd < 4; ++kd) { const bf16x8 a = *(const bf16x8*)(ar + l * 128 + 32 * kd);
                const bf16x8 w0 = *(const bf16x8*)(b0 + l * 128 + 32 * kd), w1 = *(const bf16x8*)(b1 + l * 128 + 32 * kd);
                acc0 = __builtin_amdgcn_mfma_f32_16x16x32_bf16(a, w0, acc0, 0, 0, 0); acc1 = __builtin_amdgcn_mfma_f32_16x16x32_bf16(a, w1, acc1, 0, 0, 0); }
        }
        { const int j0 = 32 * wave + c16; float h0 = 0.f, h1 = 0.f;
#pragma unroll 8
          for (int s = 0; s < 32; ++s) { h0 += hb[s * 256 + j0]; h1 += hb[s * 256 + j0 + 16]; }
#pragma unroll
          for (int r = 0; r < 4; ++r) { *(LAS bf16*)(hid + (4 * gq + r) * HP + j0 * 2) = f2b(silu_f(acc0[r] + h0)); *(LAS bf16*)(hid + (4 * gq + r) * HP + (j0 + 16) * 2) = f2b(silu_f(acc1[r] + h1)); } }
        __syncthreads();
        { f32x4 acc = {0.f, 0.f, 0.f, 0.f}; const int d = 16 * wave + c16;
#pragma unroll
          for (int ks = 0; ks < 8; ++ks) { const bf16x8 a = *(const LAS bf16x8*)(hid + c16 * HP + (8 * gq + 32 * ks) * 2);
              const float* wp = w2 + (size_t)(8 * gq + 32 * ks) * 128 + d;
              v4u bw; bw.x = pk2(wp[0], wp[128]); bw.y = pk2(wp[256], wp[384]); bw.z = pk2(wp[512], wp[640]); bw.w = pk2(wp[768], wp[896]);
              acc = __builtin_amdgcn_mfma_f32_16x16x32_bf16(a, __builtin_bit_cast(bf16x8, bw), acc, 0, 0, 0); }
          bf16* outp = (kv ? F.VCMP : F.KCMP) + (size_t)g * 1024 * 128;
#pragma unroll
          for (int r = 0; r < 4; ++r) { const int nn = 16 * nt16 + 4 * gq + r; if (nn < 1023) outp[(size_t)nn * 128 + d] = f2b(acc[r]); } }
        __syncthreads();
    }
}


__device__ __forceinline__ void load_ptrs(Ctx& F) {
    typedef const float* cfp;
    const volatile __attribute__((address_space(4))) cfp* ka = (const volatile __attribute__((address_space(4))) cfp*)__builtin_amdgcn_kernarg_segment_ptr();
    F.x = ka[0]; F.mem = ka[1]; F.ln_pre = ka[2]; F.ln_post = ka[3]; F.ln_mem = ka[4]; F.w_mem_kv = ka[5];
    F.gla_w_in = ka[6]; F.gla_w_gate = ka[7]; F.gla_b_gate = ka[8]; F.gla_norm = ka[9]; F.gla_w_out = ka[10];
    F.nsa_w_in = ka[11]; F.pe_k = ka[12]; F.pe_v = ka[13]; F.wk1 = ka[14]; F.wk2 = ka[15]; F.wv1 = ka[16]; F.wv2 = ka[17]; F.nsa_w_out = ka[18];
    F.out = (float*)ka[19]; F.ws = (unsigned char*)ka[20];
    unsigned char* ws = F.ws;
    F.WIN0 = (bf16*)(ws + WS_WIN0); F.WIN1 = (bf16*)(ws + WS_WIN1); F.WOUT0 = (bf16*)(ws + WS_WOUT0); F.WOUT1 = (bf16*)(ws + WS_WOUT1); F.WMKV = (bf16*)(ws + WS_WMKV);
    F.WK1T = (bf16*)(ws + WS_WK1T); F.WV1T = (bf16*)(ws + WS_WV1T); F.HB = (float*)(ws + WS_SEL);
    F.MEMKV = (bf16*)(ws + WS_MEMKV); F.DEC = (float*)(ws + WS_DEC); F.KCMP = (bf16*)(ws + WS_KCMP); F.VCMP = (bf16*)(ws + WS_VCMP);
    F.XN = (bf16*)(ws + WS_XN); F.P = (bf16*)(ws + WS_P); F.STATE = (bf16*)(ws + WS_STATE); F.MIX1 = (bf16*)(ws + WS_MIX1); F.CP = (bf16*)(ws + WS_CP);
    F.MIX0 = (bf16*)((unsigned char*)F.out + DO_MIX0); F.OI = (bf16*)((unsigned char*)F.out + DO_OI);
}
__global__ void __launch_bounds__(NTHR, 2) fwd_kernel(Args args) {
    extern __shared__ __attribute__((aligned(16))) unsigned char lds_raw[];
    Ctx F;
    F.lds = (LAS unsigned char*)lds_raw;
    F.tid = threadIdx.x; F.lane = F.tid & 63; F.wave = __builtin_amdgcn_readfirstlane(F.tid >> 6);
    F.G = gridDim.x; F.gw = blockIdx.x * NWAVES + F.wave; F.NGW = F.G * NWAVES;
    load_ptrs(F);
    unsigned char* ws = F.ws;

    volatile LAS unsigned* MISC = (volatile LAS unsigned*)(F.lds + MISC_OFF);
    for (int u = F.tid; u < (LDS_BYTES - LDSCTL_OFF) / 4; u += NTHR) ((LAS unsigned*)(F.lds + LDSCTL_OFF))[u] = 0u;
    __syncthreads();
    const int lo = args.ph_lo, hi = args.ph_hi;
    XcdBarrier bar; bar.bar = (unsigned*)(ws + WS_CTL); bar.x = 0; bar.st = nullptr;
    if (hi - lo > 1) bar = xcd_barrier_post((unsigned*)(ws + WS_CTL), MISC + 8);
#define IN(k) (lo <= (k) && (k) < hi)
#define REFRESH() do { int t_ = threadIdx.x; asm volatile("" : "+v"(t_)); F.tid = t_; F.lane = t_ & 63; load_ptrs(F); } while (0)
#define SEAM(k) do { if (IN(k) && IN((k) + 1)) xcd_barrier(bar); } while (0)

    if (IN(0)) { REFRESH(); phase_prep(F); } SEAM(0);
    if (IN(1)) { REFRESH(); memkv_fast(F); REFRESH();
        pg8::Gemm g{F.XN, F.WIN0, T, NP, DM}; pg8::StaticOrder S; S.init(T, NP, F.G, (int)blockIdx.x);
        pg8::EpiBf16<0> E{F.P, NP, nullptr, 0, 0, 1.f};
        pg8::gemm_phase<pg8::EpiBf16<0>, pg8::StaticOrder, true, true>(F.lds, g, S, E); } SEAM(1);
    if (IN(2)) { REFRESH(); gla_g1_fast(F); REFRESH(); cross_fast(F, 0, F.MIX0); } SEAM(2);
    if (IN(3)) { REFRESH(); gla_scan(F); } SEAM(3);
    if (IN(4)) { REFRESH(); gla_g3_fast(F); } SEAM(4);
    if (IN(5)) { REFRESH(); pg8::Gemm g{F.MIX0, F.WOUT0, T, DM, DM}; pg8::StaticOrder S; S.init(T, DM, F.G, (int)blockIdx.x);
        pg8::EpiBf16<0> E{F.XN, DM, nullptr, 0, 0, 1.f};
        pg8::gemm_phase<pg8::EpiBf16<0>, pg8::StaticOrder, true, true>(F.lds, g, S, E); } SEAM(5);
    if (IN(6)) { REFRESH(); post_rows(F, F.x, F.XN, F.ln_post, F.out, F.ln_pre + DM, F.XN); } SEAM(6);
    if (IN(7)) { REFRESH(); pg8::Gemm g{F.XN, F.WIN1, T, NP, DM}; pg8::StaticOrder S; S.init(T, NP, F.G, (int)blockIdx.x);
        EpiNsaIn E{F.P, NP, F.CP};
        pg8::gemm_phase<EpiNsaIn, pg8::StaticOrder, true, true>(F.lds, g, S, E); } SEAM(7);
    if (IN(8)) { REFRESH(); nsa_compress_fast(F); } SEAM(8);
    if (IN(9)) { REFRESH(); nsa_main_fast(F); REFRESH(); cross_fast(F, 1, F.MIX1); } SEAM(9);
    if (IN(10)) { REFRESH(); pg8::Gemm g{F.MIX1, F.WOUT1, T, DM, DM}; pg8::StaticOrder S; S.init(T, DM, F.G, (int)blockIdx.x);
        pg8::EpiBf16<0> E{F.XN, DM, nullptr, 0, 0, 1.f};
        pg8::gemm_phase<pg8::EpiBf16<0>, pg8::StaticOrder, true, true>(F.lds, g, S, E); } SEAM(10);
    if (IN(11)) { REFRESH(); post_rows(F, F.out, F.XN, F.ln_post + DM, F.out, nullptr, nullptr); }
#undef IN
#undef SEAM
}

#ifndef N_LAUNCHES
#define N_LAUNCHES 1
#endif
extern "C" void kernel_launch(void* const* d_in, const int* in_sizes, int n_in, void* d_out, int out_size, void* d_ws, size_t ws_size, hipStream_t stream) {
    static int grid = 0;
    if (grid == 0) {
        if (n_in != 19 || out_size != T * DM || ws_size < WS_END) { fprintf(stderr, "kernel_launch: unexpected shapes (n_in %d out %d ws %zu)\n", n_in, out_size, ws_size); grid = -1; return; }
        int dev = 0, cus = 0, per_cu = 0;
        if (hipGetDevice(&dev) != hipSuccess || hipDeviceGetAttribute(&cus, hipDeviceAttributeMultiprocessorCount, dev) != hipSuccess) { grid = -1; return; }
        if (hipFuncSetAttribute((const void*)fwd_kernel, hipFuncAttributeMaxDynamicSharedMemorySize, LDS_BYTES) != hipSuccess) { fprintf(stderr, "kernel_launch: hipFuncSetAttribute failed\n"); grid = -1; return; }
        if (hipOccupancyMaxActiveBlocksPerMultiprocessor(&per_cu, (const void*)fwd_kernel, NTHR, LDS_BYTES) != hipSuccess || per_cu < 1) fprintf(stderr, "kernel_launch: occupancy query reports %d\n", per_cu);
        (void)hipGetLastError();
        grid = cus;
    }
    if (grid < 0) return;
    if (hipMemsetAsync((char*)d_ws + WS_CTL, 0, CTL_ZERO_BYTES, stream) != hipSuccess) return;
    Args a{};
    for (int i = 0; i < 19; ++i) a.in[i] = (const float*)d_in[i];
    a.out = (float*)d_out; a.ws = (unsigned char*)d_ws;
    for (int li = 0; li < N_LAUNCHES; ++li) {
        a.ph_lo = li * N_PHASES / N_LAUNCHES; a.ph_hi = (li + 1) * N_PHASES / N_LAUNCHES;
        hipLaunchKernelGGL(fwd_kernel, dim3(grid), dim3(NTHR), LDS_BYTES, stream, a);
    }
}
```

```cpp
#include <hip/hip_runtime.h>
#include <cstdio>
#include <cstdint>
namespace pg8 {
#define PG8_LAS __attribute__((address_space(3)))
typedef unsigned short bf16_t;
typedef short bf16x8 __attribute__((ext_vector_type(8)));
typedef float f32x4 __attribute__((ext_vector_type(4)));
typedef unsigned u32x4 __attribute__((ext_vector_type(4)));
constexpr int BM = 256, BK = 64, HALF = 128, HTB = HALF * BK * 2  , STAGE_BYTES = 8 * HTB, NXCD = 8, WGM = 8;

__host__ __device__ __forceinline__ int lds_byte(int r, int c) { const int st = (r >> 4) * 2 + (c >> 5), rr = r & 15, cc = c & 31, ob = rr * 64 + cc * 2; return st * 1024 + (ob ^ (((ob >> 9) & 1) << 5)); }
__host__ __device__ __forceinline__ void stage_rc(int b, int& R, int& C) { const int st = b / 1024, sb = b % 1024, swz = sb ^ (((sb >> 9) & 1) << 5); R = (st >> 1) * 16 + swz / 64; C = (st & 1) * 32 + (swz % 64) / 2; }
__host__ __device__ __forceinline__ int perm32(int rho) { const int n = rho >> 4, i = rho & 15; return 8 * (i >> 2) + 4 * n + (i & 3); }

struct Unit { int pm, pn; };
struct Gemm { const bf16_t* A; const bf16_t* Bt; int M, N, K; int wave; };

struct StaticOrder {
    int nM, nN, nwg, G, c;
    __host__ __device__ void init(int M, int N, int G_, int c_) { nM = M / BM; nN = N / BM; nwg = nM * nN; G = G_; c = c_; }
    __host__ __device__ bool next(int i, Unit& u) const {
        const long L = (long)i * G + c; if (L >= nwg) return false;
        int wgid = (int)L; { const int q = nwg / NXCD, r = nwg % NXCD, xcd = wgid % NXCD, off = wgid / NXCD; wgid = (xcd < r ? xcd * (q + 1) : r * (q + 1) + (xcd - r) * q) + off; }
        const int nig = WGM * nN, gid = wgid / nig, fm = gid * WGM, gsz = (nM - fm) < WGM ? (nM - fm) : WGM;
        u.pm = fm + ((wgid % nig) % gsz); u.pn = (wgid % nig) / gsz; return true;
    }
    __device__ __forceinline__ void a_ready(const Unit&) const {}
    __device__ __forceinline__ void done(const Unit&) const {}
};

__device__ __forceinline__ unsigned cvt_pk_bf16(float lo, float hi) { unsigned r; asm volatile("v_cvt_pk_bf16_f32 %0, %1, %2" : "=v"(r) : "v"(lo), "v"(hi)); return r; }
typedef float f32x2 __attribute__((ext_vector_type(2)));
__device__ __forceinline__ f32x2 gelu_pk(f32x2 v) {
    const f32x2 av = __builtin_elementwise_abs(v), d = av * 0.2316418882f + 1.0f;
    f32x2 t; t.x = __builtin_amdgcn_rcpf(d.x); t.y = __builtin_amdgcn_rcpf(d.y);
    f32x2 q = t * 0.5307027145f + (-0.7265760135f); q = q * t + 0.7107068705f; q = q * t + (-0.142248368f); q = q * t + 0.127414796f; q = q * t;
    const f32x2 s = (v * v) * (-0.72134752044f);
    f32x2 e; e.x = __builtin_amdgcn_exp2f(s.x); e.y = __builtin_amdgcn_exp2f(s.y);
    const f32x2 m = v * (q * e), r = v - m;
    f32x2 o; o.x = v.x < 0.f ? m.x : r.x; o.y = v.y < 0.f ? m.y : r.y; return o;
}

template <int ACT  > struct EpiBf16 {
    static constexpr bool PERM = true, AFTER_DRAIN = false; static_assert(ACT == 0 || ACT == 1, "EpiBf16: ACT is 0 (none) or 1 (gelu_pk)");
    bf16_t* O; int ldc; const float* bias; int split_cols; size_t split_stride; float scale0;
    __device__ __forceinline__ void operator()(const f32x4 (&acc)[2][2][4][2], const Unit& u, int wr, int wc, int fr, int fq) const {
        const int row0 = u.pm * BM + wr * 64 + fr; int colt = u.pn * BM; bf16_t* base = O;
        float sc = 1.f; if (split_cols) { const int t = colt / split_cols; base += (size_t)t * split_stride; colt -= t * split_cols; if (t == 0) sc = scale0; }
        const int col0 = colt + wc * 32 + 8 * fq, bcol0 = u.pn * BM + wc * 32 + 8 * fq;
        f32x4 bv[2][2];
#pragma unroll
        for (int bj = 0; bj < 2; ++bj)
#pragma unroll
            for (int n = 0; n < 2; ++n) bv[bj][n] = bias ? *(const f32x4*)(bias + bcol0 + bj * HALF + 4 * n) : (f32x4){0.f, 0.f, 0.f, 0.f};
#pragma unroll
        for (int ai = 0; ai < 2; ++ai)
#pragma unroll
            for (int m = 0; m < 4; ++m) { bf16_t* rowp = base + (size_t)(row0 + ai * HALF + m * 16) * ldc + col0;
#pragma unroll
                for (int bj = 0; bj < 2; ++bj) { f32x4 v0 = acc[ai][bj][m][0] + bv[bj][0], v1 = acc[ai][bj][m][1] + bv[bj][1];
                    if (ACT == 1) { f32x2 a = gelu_pk((f32x2){v0[0], v0[1]}), b = gelu_pk((f32x2){v0[2], v0[3]}), c = gelu_pk((f32x2){v1[0], v1[1]}), d = gelu_pk((f32x2){v1[2], v1[3]});
                        v0 = (f32x4){a.x, a.y, b.x, b.y}; v1 = (f32x4){c.x, c.y, d.x, d.y}; }
                    v0 = v0 * sc; v1 = v1 * sc; u32x4 w; w.x = cvt_pk_bf16(v0[0], v0[1]); w.y = cvt_pk_bf16(v0[2], v0[3]); w.z = cvt_pk_bf16(v1[0], v1[1]); w.w = cvt_pk_bf16(v1[2], v1[3]);
                    *(u32x4*)(rowp + bj * HALF) = w; } }
    }
};

template <class Epi, class Sched, bool ALIGN_EPI = false, bool SP2 = false>
__device__ __forceinline__ void gemm_phase(PG8_LAS unsigned char* lds, const Gemm g, const Sched& S, const Epi& E) {
    const int wid = g.wave, lane = (int)__builtin_amdgcn_mbcnt_hi(~0u, __builtin_amdgcn_mbcnt_lo(~0u, 0u)), tid = wid * 64 + lane, wr = wid >> 2, wc = wid & 3, fr = lane & 15, fq = lane >> 4;
    const int K = g.K, nt = K / BK;
    unsigned voffA[2], voffB[2];
#pragma unroll
    for (int i = 0; i < 2; ++i) { int R, C; stage_rc(tid * 16 + i * 8192, R, C); const int Rb = Epi::PERM ? ((R & ~31) + perm32(R & 31)) : R;
        voffA[i] = (unsigned)(R * K + C) * 2u; voffB[i] = (unsigned)(Rb * K + C) * 2u; }
    const size_t kstep = (size_t)(BK * 2);
    const size_t hstep = (size_t)HALF * K * 2;
    const size_t tstep = 2 * hstep;
    const unsigned ldsw = (unsigned)wid * 1024u;
    const int aoff = lds_byte(wr * 64 + fr, fq * 8), boff = lds_byte(wc * 32 + fr, fq * 8);
#define PG8_SA(b, h) (((b) * 2 + (h)) * HTB)
#define PG8_SB(b, h) ((4 + (b) * 2 + (h)) * HTB)
#define PG8_STAGE(bufoff, gbase, voff) do { _Pragma("unroll") for (int _i = 0; _i < 2; ++_i) \
        __builtin_amdgcn_global_load_lds((const unsigned*)((const char*)(gbase) + (voff)[_i]), (PG8_LAS unsigned*)(lds + (bufoff) + ldsw + _i * 8192), 16, 0, 0); } while (0)
#define PG8_LDA(dst, b, h) do { _Pragma("unroll") for (int m = 0; m < 4; ++m) _Pragma("unroll") for (int k = 0; k < 2; ++k) dst[m][k] = *(const PG8_LAS bf16x8*)(lds + PG8_SA(b, h) + aoff + m * 2048 + k * 1024); } while (0)
#define PG8_LDB(dst, b, h) do { _Pragma("unroll") for (int n = 0; n < 2; ++n) _Pragma("unroll") for (int k = 0; k < 2; ++k) dst[n][k] = *(const PG8_LAS bf16x8*)(lds + PG8_SB(b, h) + boff + n * 2048 + k * 1024); } while (0)
#define PG8_MMA(ai, bj, At, Bt) do { __builtin_amdgcn_s_setprio(1); _Pragma("unroll") for (int m = 0; m < 4; ++m) _Pragma("unroll") for (int n = 0; n < 2; ++n) _Pragma("unroll") for (int k = 0; k < 2; ++k) \
        acc[ai][bj][m][n] = __builtin_amdgcn_mfma_f32_16x16x32_bf16(Bt[n][k], At[m][k], acc[ai][bj][m][n], 0, 0, 0); __builtin_amdgcn_s_setprio(0); } while (0)
#define PG8_WAIT_V(n) asm volatile("s_waitcnt vmcnt(" #n ")" ::: "memory")
#define PG8_WAIT_L(n) asm volatile("s_waitcnt lgkmcnt(" #n ")" ::: "memory")
#define PG8_BAR __builtin_amdgcn_s_barrier()
#define PG8_SCHED __builtin_amdgcn_sched_barrier(0)
    Unit cur, nxt; int ui = 0;
    if (!S.next(0, cur)) return;
    f32x4 acc[2][2][4][2];
#pragma unroll
    for (int a = 0; a < 2; ++a)
#pragma unroll
        for (int b = 0; b < 2; ++b)
#pragma unroll
            for (int m = 0; m < 4; ++m)
#pragma unroll
                for (int n = 0; n < 2; ++n) acc[a][b][m][n] = (f32x4){0.f, 0.f, 0.f, 0.f};
    bf16x8 At[4][2], B0[2][2], B1[2][2];
    const char* cA = (const char*)g.A + (size_t)cur.pm * tstep; const char* cB = (const char*)g.Bt + (size_t)cur.pn * tstep;
    S.a_ready(cur);
    if constexpr (SP2) {
        PG8_STAGE(PG8_SB(0, 0), cB, voffB); PG8_STAGE(PG8_SB(0, 1), cB + hstep, voffB); PG8_STAGE(PG8_SA(0, 0), cA, voffA); PG8_STAGE(PG8_SA(0, 1), cA + hstep, voffA);
        if (wr == 1) PG8_BAR;
        PG8_WAIT_V(2); PG8_BAR;
        PG8_STAGE(PG8_SB(1, 0), cB + kstep, voffB); PG8_STAGE(PG8_SA(1, 0), cA + kstep, voffA); PG8_STAGE(PG8_SB(1, 1), cB + hstep + kstep, voffB);
        PG8_WAIT_V(6); PG8_BAR;
    } else {
        PG8_STAGE(PG8_SB(0, 0), cB, voffB); PG8_STAGE(PG8_SA(0, 0), cA, voffA); PG8_STAGE(PG8_SB(0, 1), cB + hstep, voffB); PG8_STAGE(PG8_SA(0, 1), cA + hstep, voffA);
        if (wr == 1) PG8_BAR;
        PG8_WAIT_V(4); PG8_BAR;
        PG8_STAGE(PG8_SB(1, 0), cB + kstep, voffB); PG8_STAGE(PG8_SA(1, 0), cA + kstep, voffA); PG8_STAGE(PG8_SB(1, 1), cB + hstep + kstep, voffB);
        PG8_WAIT_V(6); PG8_BAR;
    }
    for (;;) {
        const bool has_next = S.next(ui + 1, nxt);
        const char* nA = has_next ? (const char*)g.A + (size_t)nxt.pm * tstep : cA; const char* nB = has_next ? (const char*)g.Bt + (size_t)nxt.pn * tstep : cB;
        for (int t = 0; t < nt; t += 2) {
            const bool last = (t == nt - 2);
            const char* a1 = cA + (size_t)(t + 1) * kstep;
            const char* a2 = last ? nA : cA + (size_t)(t + 2) * kstep; const char* b2 = last ? nB : cB + (size_t)(t + 2) * kstep;
            const char* a3 = a2 + kstep; const char* b3 = b2 + kstep;
            if (last && has_next) S.a_ready(nxt);
            if constexpr (SP2) {
            PG8_LDB(B0, 0, 0); PG8_LDB(B1, 0, 1); PG8_SCHED; PG8_LDA(At, 0, 0); PG8_STAGE(PG8_SA(1, 1), a1 + hstep, voffA);
            PG8_WAIT_V(8); PG8_WAIT_L(0); PG8_BAR; PG8_MMA(0, 0, At, B0); PG8_MMA(0, 1, At, B1); PG8_BAR; PG8_SCHED;
            PG8_LDA(At, 0, 1); PG8_STAGE(PG8_SB(0, 0), b2, voffB); PG8_STAGE(PG8_SB(0, 1), b2 + hstep, voffB); PG8_STAGE(PG8_SA(0, 0), a2, voffA);
            PG8_WAIT_V(8); PG8_WAIT_L(0); PG8_BAR; PG8_MMA(1, 0, At, B0); PG8_MMA(1, 1, At, B1); PG8_BAR; PG8_SCHED;
            PG8_LDB(B0, 1, 0); PG8_LDB(B1, 1, 1); PG8_SCHED; PG8_LDA(At, 1, 0); PG8_STAGE(PG8_SA(0, 1), a2 + hstep, voffA);
            PG8_WAIT_V(8); PG8_WAIT_L(0); PG8_BAR; PG8_MMA(0, 0, At, B0); PG8_MMA(0, 1, At, B1); PG8_BAR; PG8_SCHED;
            PG8_LDA(At, 1, 1); PG8_STAGE(PG8_SB(1, 0), b3, voffB); PG8_STAGE(PG8_SB(1, 1), b3 + hstep, voffB); PG8_STAGE(PG8_SA(1, 0), a3, voffA);
            PG8_WAIT_V(8); PG8_WAIT_L(0); PG8_BAR; PG8_MMA(1, 0, At, B0); PG8_MMA(1, 1, At, B1); PG8_BAR; PG8_SCHED;
            } else {
            PG8_LDB(B0, 0, 0); PG8_SCHED; PG8_LDA(At, 0, 0); PG8_STAGE(PG8_SA(1, 1), a1 + hstep, voffA);
            PG8_WAIT_L(8); PG8_BAR; PG8_WAIT_L(0); PG8_MMA(0, 0, At, B0); PG8_BAR; PG8_SCHED;
            PG8_LDB(B1, 0, 1); PG8_STAGE(PG8_SB(0, 0), b2, voffB);
            PG8_BAR; PG8_WAIT_L(0); PG8_MMA(0, 1, At, B1); PG8_BAR;
            PG8_LDA(At, 0, 1); PG8_STAGE(PG8_SA(0, 0), a2, voffA);
            PG8_BAR; PG8_WAIT_L(0); PG8_MMA(1, 0, At, B0); PG8_BAR; PG8_SCHED;
            PG8_STAGE(PG8_SB(0, 1), b2 + hstep, voffB);
            PG8_WAIT_V(6); PG8_BAR; PG8_MMA(1, 1, At, B1); PG8_BAR;
            PG8_LDB(B0, 1, 0); PG8_SCHED; PG8_LDA(At, 1, 0); PG8_STAGE(PG8_SA(0, 1), a2 + hstep, voffA);
            PG8_WAIT_L(8); PG8_BAR; PG8_WAIT_L(0); PG8_MMA(0, 0, At, B0); PG8_BAR; PG8_SCHED;
            PG8_LDB(B1, 1, 1); PG8_STAGE(PG8_SB(1, 0), b3, voffB);
            PG8_BAR; PG8_WAIT_L(0); PG8_MMA(0, 1, At, B1); PG8_BAR;
            PG8_LDA(At, 1, 1); PG8_STAGE(PG8_SA(1, 0), a3, voffA);
            PG8_BAR; PG8_WAIT_L(0); PG8_MMA(1, 0, At, B0); PG8_BAR; PG8_SCHED;
            PG8_STAGE(PG8_SB(1, 1), b3 + hstep, voffB);
            PG8_WAIT_V(6); PG8_BAR; PG8_MMA(1, 1, At, B1); PG8_BAR;
            }
        }
        if constexpr (ALIGN_EPI) { if (wr == 0) PG8_BAR; }
        if constexpr (!Epi::AFTER_DRAIN) { E(acc, cur, wr, wc, fr, fq); S.done(cur); }
        if (!has_next) break;
#pragma unroll
        for (int a = 0; a < 2; ++a)
#pragma unroll
            for (int b = 0; b < 2; ++b)
#pragma unroll
                for (int m = 0; m < 4; ++m)
#pragma unroll
                    for (int n = 0; n < 2; ++n) acc[a][b][m][n] = (f32x4){0.f, 0.f, 0.f, 0.f};
        cur = nxt; cA = nA; cB = nB; ++ui;
        if constexpr (ALIGN_EPI) { if (wr == 1) PG8_BAR; }
    }
    PG8_WAIT_V(0);
    if constexpr (!ALIGN_EPI) { if (wr == 0) PG8_BAR; }
    PG8_BAR;
    if constexpr (Epi::AFTER_DRAIN) { E.fused(acc, cur, wr, wc, fr, fq, lds, wid, lane); S.done(cur); }
#undef PG8_SA
#undef PG8_SB
#undef PG8_STAGE
#undef PG8_LDA
#undef PG8_LDB
#undef PG8_MMA
#undef PG8_WAIT_V
#undef PG8_WAIT_L
#undef PG8_BAR
#undef PG8_SCHED
}
}
#define GAS __attribute__((address_space(1)))
#define LAS __attribute__((address_space(3)))
typedef unsigned short bf16;
typedef unsigned v4u __attribute__((ext_vector_type(4)));
typedef float f32x4 __attribute__((ext_vector_type(4)));
typedef short bf16x8 __attribute__((ext_vector_type(8)));
typedef GAS unsigned gu32;
typedef GAS unsigned long long gu64;
#define RLX_AGENT __ATOMIC_RELAXED, __HIP_MEMORY_SCOPE_AGENT
#define LDS_WAIT() asm volatile("s_waitcnt lgkmcnt(0)" ::: "memory")
#define VM_WAIT() asm volatile("s_waitcnt vmcnt(0)" ::: "memory")
__device__ __forceinline__ unsigned long long rt() { return __builtin_amdgcn_s_memrealtime(); }
__device__ __forceinline__ unsigned f2bf(float f) { unsigned u = __builtin_bit_cast(unsigned, f); return (u + 0x7fffu + ((u >> 16) & 1u)) >> 16; }
__device__ __forceinline__ unsigned pk2(float lo, float hi) { return f2bf(lo) | (f2bf(hi) << 16); }

#define XB_TMO      128
#define XB_XCNT(j)  (256  + 64 * (j))
#define XB_XSUB(j)  (1280 + 64 * (j))
#define XB_XGEN(j)  (2304 + 64 * (j))
#define XB_TOP      3328
#define XB_TOPGEN   3392
#define XCD_BAR_WORDS 3456
#define XB_SPIN_CAP (1u << 18)

__device__ __forceinline__ unsigned xb_ld(unsigned* p)              { return __hip_atomic_load(p, __ATOMIC_RELAXED, __HIP_MEMORY_SCOPE_AGENT); }
__device__ __forceinline__ unsigned xb_add(unsigned* p, unsigned v) { return __hip_atomic_fetch_add(p, v, __ATOMIC_RELAXED, __HIP_MEMORY_SCOPE_AGENT); }
__device__ __forceinline__ unsigned xb_xcc_id() { return (unsigned)__builtin_amdgcn_s_getreg((3 << 11) | 20) & 0xFu; }
#define XB_SPIN(cond, bar) do { unsigned _sp = 0; while (cond) { __builtin_amdgcn_s_sleep(1); \
    if ((++_sp & 255u) == 0u) { if (xb_ld(&(bar)[XB_TMO])) break; if (_sp > XB_SPIN_CAP) { atomicAdd(&(bar)[XB_TMO], 1u); break; } } } } while (0)

static __device__ __forceinline__ bool xb_t0_impl(int wave) { return wave == 0 && __builtin_amdgcn_mbcnt_hi(~0u, __builtin_amdgcn_mbcnt_lo(~0u, 0u)) == 0u; }
#define xb_t0() xb_t0_impl(xb_wave)
struct XcdBarrier {
    unsigned* bar; unsigned x;
    volatile LAS unsigned* st;
};

__device__ __forceinline__ XcdBarrier xcd_barrier_post(unsigned* bar, volatile LAS unsigned* st, const int xb_wave) {
    XcdBarrier b; b.bar = bar; b.x = xb_xcc_id(); b.st = st;
    if (xb_t0()) (void)xb_add(&bar[XB_XCNT(b.x)], 1u);
    return b;
}
__device__ __forceinline__ void xcd_barrier_complete(unsigned* bar, unsigned x, unsigned& nloc, unsigned& nx) {
    const unsigned G = gridDim.x * gridDim.y * gridDim.z;
    unsigned sum, cnt, mine, sp = 0u;
    for (;;) {
        sum = 0u; cnt = 0u; mine = 0u;
#pragma unroll
        for (unsigned j = 0; j < 16; ++j) { const unsigned c = xb_ld(&bar[XB_XCNT(j)]); sum += c; cnt += (c > 0u) ? 1u : 0u; mine = (j == x) ? c : mine; }
        if (sum == G) break;
        __builtin_amdgcn_s_sleep(1);
        if ((++sp & 255u) == 0u) { if (xb_ld(&bar[XB_TMO])) break; if (sp > XB_SPIN_CAP) { atomicAdd(&bar[XB_TMO], 1u); break; } }
    }
    nloc = mine > 0u ? mine : 1u; nx = cnt > 0u ? cnt : 1u;
}

__device__ __forceinline__ void xcd_barrier(const XcdBarrier& b, const int xb_wave) {
    asm volatile("s_waitcnt vmcnt(0)" ::: "memory");
    __syncthreads();
    if (xb_t0()) {
        unsigned* bar = b.bar;
        __builtin_amdgcn_s_waitcnt(0);
        unsigned nloc = b.st[0], nx = b.st[1];
        if (nloc == 0u) { xcd_barrier_complete(bar, b.x, nloc, nx); b.st[0] = nloc; b.st[1] = nx; }
        const unsigned old = xb_add(&bar[XB_XSUB(b.x)], 1u);
        const unsigned gen = old / nloc;
        if (old + 1u == (gen + 1u) * nloc) {
            __builtin_amdgcn_fence(__ATOMIC_RELEASE, "agent");
            asm volatile("s_waitcnt vmcnt(0)" ::: "memory");
            const unsigned og = xb_add(&bar[XB_TOP], 1u);
            const unsigned tg = og / nx;
            if (og + 1u == (tg + 1u) * nx) xb_add(&bar[XB_TOPGEN], 1u);
            else XB_SPIN(xb_ld(&bar[XB_TOPGEN]) == tg, bar);
            __builtin_amdgcn_fence(__ATOMIC_ACQUIRE, "agent");
            xb_add(&bar[XB_XGEN(b.x)], 1u);
            asm volatile("s_waitcnt vmcnt(0)" ::: "memory");
        } else {
            XB_SPIN(xb_ld(&bar[XB_XGEN(b.x)]) == gen, bar);
            __builtin_amdgcn_fence(__ATOMIC_ACQUIRE, "agent");
            asm volatile("s_waitcnt vmcnt(0)" ::: "memory");
        }
    }
    __syncthreads();
}

constexpr int T = 16384, DM = 2048, NP = 5888, NMEM = 256;
constexpr int NWAVES = 8, NTHR = 512;
constexpr float EPS = 1e-6f;
constexpr size_t MiB = 1u << 20;
constexpr size_t WS_CTL = 0, CTL_ZERO_BYTES = 65536;
constexpr size_t WS_WIN0 = 1 * MiB, WS_WIN1 = 24 * MiB, WS_WOUT0 = 47 * MiB, WS_WOUT1 = 55 * MiB, WS_WMKV = 63 * MiB, WS_WK1T = 71 * MiB, WS_WV1T = 73 * MiB;
constexpr size_t WS_MEMKV = 75 * MiB, WS_DEC = 76 * MiB, WS_KCMP = 77 * MiB, WS_VCMP = 77 * MiB + 512 * 1024, WS_SEL = 78 * MiB;
constexpr size_t WS_XN = 80 * MiB, WS_P = 144 * MiB, WS_STATE = 328 * MiB, WS_END = 472 * MiB;
constexpr size_t WS_MIX1 = WS_STATE;
constexpr size_t WS_CP = WS_STATE + 64 * MiB;
constexpr size_t PLANE = (size_t)T * 128;
constexpr size_t DO_MIX0 = 0, DO_OI = 64 * MiB;
constexpr int CR = 3072, CXQ = 4608, CXG = 5120, CGL = 5632;
constexpr int GQ = 0, GK = 768, GV = 1536;
constexpr int NQ = 0, NKC = 1536, NVC = 1792, NKS = 2048, NVS = 2304, NKW = 2560, NVW = 2816;
constexpr int RING_BYTES = 131072, LDSCTL_OFF = RING_BYTES, MISC_OFF = LDSCTL_OFF + 320, LDS_BYTES = 147456;
constexpr int N_PHASES = 12;

__device__ __forceinline__ float bf2f(bf16 v) { return __builtin_bit_cast(float, (unsigned)v << 16); }
__device__ __forceinline__ bf16 f2b(float f) { return (bf16)f2bf(f); }
__device__ __forceinline__ float wave_sum(float v) {
#pragma unroll
    for (int o = 1; o < 64; o <<= 1) v += __shfl_xor(v, o);
    return v;
}
__device__ __forceinline__ float silu_f(float x) { return x / (1.f + __expf(-x)); }
__device__ __forceinline__ float sigmoid_f(float x) { return 1.f / (1.f + __expf(-x)); }
__device__ __forceinline__ float logsigmoid_f(float x) { return fminf(x, 0.f) - log1pf(__expf(-fabsf(x))); }

__device__ __forceinline__ int win_src_col(int layer, int c) {
    const int ex = layer ? 36 : 16;
    if (c < 3072) return c;
    if (c < 5632) return c + ex;
    if (c < 5632 + ex) return c - 5632 + 3072;
    return -1;
}

__device__ __forceinline__ void transpose_item(const float* W, int ldw, int K, bf16* WT, int n0, int k0, int srcc, LAS float* scr, int lane) {
#pragma unroll 8
    for (int i = 0; i < 32; ++i) { const int kk = 2 * i + (lane >> 5); scr[kk * 33 + (lane & 31)] = (srcc >= 0) ? W[(size_t)(k0 + kk) * ldw + srcc] : 0.f; }
    LDS_WAIT(); asm volatile("" ::: "memory");
    const int c = lane & 7;
#pragma unroll
    for (int j = 0; j < 4; ++j) { const int n = (lane >> 3) + 8 * j; const LAS float* s = scr + (8 * c) * 33 + n;
        v4u o; o.x = pk2(s[0 * 33], s[1 * 33]); o.y = pk2(s[2 * 33], s[3 * 33]); o.z = pk2(s[4 * 33], s[5 * 33]); o.w = pk2(s[6 * 33], s[7 * 33]);
        *(v4u*)(WT + (size_t)(n0 + n) * K + k0 + 8 * c) = o; }
    LDS_WAIT(); asm volatile("" ::: "memory");
}

__device__ __forceinline__ void rms_row_to_bf16(const float* xrow, const float* g, bf16* orow, int lane) {
    const f32x4* xr = (const f32x4*)xrow + lane; const f32x4* gr = (const f32x4*)g + lane;
    f32x4 v[8]; float s = 0.f;
#pragma unroll
    for (int j = 0; j < 8; ++j) { v[j] = xr[64 * j]; s += (v[j].x * v[j].x + v[j].y * v[j].y) + (v[j].z * v[j].z + v[j].w * v[j].w); }
    const float rstd = rsqrtf(wave_sum(s) * (1.f / DM) + EPS);
    unsigned long long* o8 = (unsigned long long*)orow + lane;
#pragma unroll
    for (int j = 0; j < 8; ++j) { const f32x4 gg = gr[64 * j];
        o8[64 * j] = (unsigned long long)pk2(v[j].x * rstd * gg.x, v[j].y * rstd * gg.y) | ((unsigned long long)pk2(v[j].z * rstd * gg.z, v[j].w * rstd * gg.w) << 32); }
}

struct EpiNsaIn {
    static constexpr bool PERM = true, AFTER_DRAIN = false;
    bf16* O; int ldc; bf16* CPb;
    __device__ __forceinline__ void operator()(const pg8::f32x4 (&acc)[2][2][4][2], const pg8::Unit& u, int wr, int wc, int fr, int fq) const {
        const int row0 = u.pm * pg8::BM + wr * 64 + fr; const bool pl = (u.pn >= 6 && u.pn < 12);
#pragma unroll
        for (int ai = 0; ai < 2; ++ai)
#pragma unroll
            for (int m = 0; m < 4; ++m) { const size_t row = (size_t)(row0 + ai * pg8::HALF + m * 16);
#pragma unroll
                for (int bj = 0; bj < 2; ++bj) { const pg8::f32x4 v0 = acc[ai][bj][m][0], v1 = acc[ai][bj][m][1];
                    pg8::u32x4 w; w.x = pg8::cvt_pk_bf16(v0[0], v0[1]); w.y = pg8::cvt_pk_bf16(v0[2], v0[3]); w.z = pg8::cvt_pk_bf16(v1[0], v1[1]); w.w = pg8::cvt_pk_bf16(v1[2], v1[3]);
                    bf16* dst = pl ? CPb + ((size_t)((u.pn - 6) * 2 + bj)) * PLANE + row * 128 + wc * 32 + 8 * fq
                                   : O + row * ldc + u.pn * pg8::BM + bj * pg8::HALF + wc * 32 + 8 * fq;
                    *(pg8::u32x4*)dst = w; } }
    }
};

struct Args { const float* in[19]; float* out; unsigned char* ws; int ph_lo, ph_hi; };

struct Ctx {
    LAS unsigned char* lds;
    int tid, lane, wave, G, gw, NGW;
    const float *x, *mem, *ln_pre, *ln_post, *ln_mem, *w_mem_kv, *gla_w_in, *gla_w_gate, *gla_b_gate, *gla_norm, *gla_w_out;
    const float *nsa_w_in, *pe_k, *pe_v, *wk1, *wk2, *wv1, *wv2, *nsa_w_out;
    float* out; unsigned char* ws;
    bf16 *WIN0, *WIN1, *WOUT0, *WOUT1, *WMKV, *WK1T, *WV1T, *MEMKV, *KCMP, *VCMP, *XN, *P, *STATE, *MIX0, *MIX1, *OI, *CP;
    float *DEC, *HB;
};

__device__ __forceinline__ void phase_prep(Ctx& F) {
    LAS float* scr = (LAS float*)(F.lds + F.wave * 16384);
    constexpr int I_WIN = 32 * 184, I_WOUT = 32 * 64, I_MKV = 32 * 32, I_W1 = 64 * 8;
    constexpr int NITEMS = 2 * I_WIN + 2 * I_WOUT + 2 * I_MKV + 2 * I_W1;
    for (int it = F.gw; it < NITEMS; it += F.NGW) {
        int r = it;
        if (r < 2 * I_WIN) { const int layer = r / I_WIN; r -= layer * I_WIN; const int kb = r / 184, nb = r % 184;
            const int srcc = win_src_col(layer, nb * 32 + (F.lane & 31));
            transpose_item(layer ? F.nsa_w_in : F.gla_w_in, layer ? 5668 : 5648, DM, layer ? F.WIN1 : F.WIN0, nb * 32, kb * 64, srcc, scr, F.lane); continue; }
        r -= 2 * I_WIN;
        if (r < 2 * I_WOUT) { const int layer = r / I_WOUT; r -= layer * I_WOUT; const int kb = r / 64, nb = r % 64;
            transpose_item(layer ? F.nsa_w_out : F.gla_w_out, DM, DM, layer ? F.WOUT1 : F.WOUT0, nb * 32, kb * 64, nb * 32 + (F.lane & 31), scr, F.lane); continue; }
        r -= 2 * I_WOUT;
        if (r < 2 * I_MKV) { const int layer = r / I_MKV; r -= layer * I_MKV; const int kb = r / 32, nb = r % 32;
            transpose_item(F.w_mem_kv + (size_t)layer * DM * 1024, 1024, DM, F.WMKV + (size_t)layer * 1024 * DM, nb * 32, kb * 64, nb * 32 + (F.lane & 31), scr, F.lane); continue; }
        r -= 2 * I_MKV;
        { const int kv = r / I_W1; r -= kv * I_W1; const int kb = r / 8, nb = r % 8;
            transpose_item(kv ? F.wv1 : F.wk1, 256, 4096, kv ? F.WV1T : F.WK1T, nb * 32, kb * 64, nb * 32 + (F.lane & 31), scr, F.lane); }
    }
    if ((int)blockIdx.x < 64) { const int kv = blockIdx.x >> 5, s = blockIdx.x & 31; const float* pe = kv ? F.pe_v : F.pe_k; const float* w1 = kv ? F.wv1 : F.wk1;
        __syncthreads();
        LAS float* red = (LAS float*)F.lds;
        const int j = F.tid & 255, ih = F.tid >> 8; float a = 0.f;
#pragma unroll 8
        for (int i = s * 128 + ih * 64; i < s * 128 + ih * 64 + 64; ++i) a += pe[i] * w1[(size_t)i * 256 + j];
        red[F.tid] = a; __syncthreads();
        if (F.tid < 256) F.HB[(kv * 32 + s) * 256 + j] = red[j] + red[256 + j];
        __syncthreads(); }
    for (int m = F.gw; m < T; m += F.NGW) rms_row_to_bf16(F.x + (size_t)m * DM, F.ln_pre, F.XN + (size_t)m * DM, F.lane);
}

__device__ __forceinline__ void memkv_naive(Ctx& F) {
    const int gt = blockIdx.x * NTHR + F.tid, NT = F.G * NTHR;
    for (int o = gt; o < 2 * NMEM * 1024; o += NT) {
        const int layer = o >> 18, m = (o >> 10) & 255, n = o & 1023;
        const float* mr = F.mem + (size_t)m * DM; const float* g = F.ln_mem + layer * DM; const float* W = F.w_mem_kv + (size_t)layer * DM * 1024 + n;
        float ss = 0.f, acc = 0.f;
        for (int k = 0; k < DM; ++k) { const float a = mr[k]; ss += a * a; acc += a * g[k] * W[(size_t)k * 1024]; }
        const float v = acc * rsqrtf(ss * (1.f / DM) + EPS);
        const int kv = n >> 9, h = (n >> 7) & 3, d = n & 127;
        F.MEMKV[((((size_t)layer * 2 + kv) * 4 + h) * NMEM + m) * 128 + d] = f2b(v);
    }
}

__device__ __forceinline__ void cross_naive(Ctx& F, int layer, bf16* MIX) {
    const float scale = 0.08838834764831845f;
    for (int u = F.gw; u < T * 4; u += F.NGW) {
        const int t = u >> 2, h = u & 3;
        const bf16* pr = F.P + (size_t)t * NP;
        const unsigned qq = *(const unsigned*)(pr + CXQ + h * 128 + 2 * F.lane);
        const float q0 = bf2f((bf16)(qq & 0xffff)) * scale, q1 = bf2f((bf16)(qq >> 16)) * scale;
        const bf16* Kb = F.MEMKV + (((size_t)layer * 2 + 0) * 4 + h) * NMEM * 128;
        const bf16* Vb = F.MEMKV + (((size_t)layer * 2 + 1) * 4 + h) * NMEM * 128;
        float m = -1e30f, l = 0.f, o0 = 0.f, o1 = 0.f;
        for (int j = 0; j < NMEM; ++j) {
            const unsigned kk = *(const unsigned*)(Kb + j * 128 + 2 * F.lane), vv = *(const unsigned*)(Vb + j * 128 + 2 * F.lane);
            const float s = wave_sum(q0 * bf2f((bf16)(kk & 0xffff)) + q1 * bf2f((bf16)(kk >> 16)));
            const float mn = fmaxf(m, s), a = __expf(m - mn), p = __expf(s - mn);
            l = l * a + p; o0 = o0 * a + p * bf2f((bf16)(vv & 0xffff)); o1 = o1 * a + p * bf2f((bf16)(vv >> 16)); m = mn;
        }
        const unsigned gg = *(const unsigned*)(pr + CXG + h * 128 + 2 * F.lane);
        const float r0 = o0 / l * silu_f(bf2f((bf16)(gg & 0xffff))), r1 = o1 / l * silu_f(bf2f((bf16)(gg >> 16)));
        *(unsigned*)(MIX + (size_t)t * DM + 1536 + h * 128 + 2 * F.lane) = pk2(r0, r1);
    }
}

__device__ __forceinline__ void gla_g1_naive(Ctx& F) {
    LAS float* bcum = (LAS float*)(F.lds);
    LAS float* Aat = (LAS float*)(F.lds + 49152);
    LAS float* glr = (LAS float*)(F.lds + 65536);
    LAS float* blast = (LAS float*)(F.lds + 69632);
    const float qscale = 0.07216878364870323f;
    for (int u = blockIdx.x; u < 1024; u += F.G) {
        const int n = u >> 2, h = u & 3; const size_t row0 = (size_t)n * 64;
        for (int i = F.tid; i < 1024; i += NTHR) glr[i] = bf2f(F.P[(row0 + (i >> 4)) * NP + CGL + (i & 15)]);
        __syncthreads();
        if (F.tid < 192) {
            const int d = F.tid, col = h * 192 + d; float wg[16];
#pragma unroll
            for (int j = 0; j < 16; ++j) wg[j] = F.gla_w_gate[j * 768 + col];
            const float bias = F.gla_b_gate[col]; float b = 0.f;
            for (int c = 0; c < 64; ++c) { float gl = bias;
#pragma unroll
                for (int j = 0; j < 16; ++j) gl += glr[c * 16 + j] * wg[j];
                b += logsigmoid_f(gl) * (1.f / 16.f); bcum[c * 192 + d] = b; }
            blast[d] = b; F.DEC[n * 768 + col] = __expf(b);
        }
        __syncthreads();
        for (int i = 0; i < 8; ++i) { const int idx = F.tid + NTHR * i, c = idx >> 6, s = idx & 63; float a = 0.f;
            if (s <= c) { const bf16* qp = F.P + (row0 + c) * NP + GQ + h * 192; const bf16* kp = F.P + (row0 + s) * NP + GK + h * 192;
                for (int d = 0; d < 192; ++d) a += bf2f(qp[d]) * bf2f(kp[d]) * __expf(bcum[c * 192 + d] - bcum[s * 192 + d]);
                a *= qscale; }
            Aat[idx] = a; }
        __syncthreads();
        for (int i = 0; i < 48; ++i) { const int idx = F.tid + NTHR * i, c = idx / 384, e = idx % 384; float a = 0.f;
            for (int s = 0; s <= c; ++s) a += Aat[c * 64 + s] * bf2f(F.P[(row0 + s) * NP + GV + h * 384 + e]);
            F.OI[(row0 + c) * 1536 + h * 384 + e] = f2b(a); }
        for (int i = 0; i < 144; ++i) { const int idx = F.tid + NTHR * i, e = idx / 192, d = idx % 192; float a = 0.f; const float bl = blast[d];
            for (int c = 0; c < 64; ++c) a += bf2f(F.P[(row0 + c) * NP + GK + h * 192 + d]) * __expf(bl - bcum[c * 192 + d]) * bf2f(F.P[(row0 + c) * NP + GV + h * 384 + e]);
            F.STATE[((size_t)u * 384 + e) * 192 + d] = f2b(a); }
        __syncthreads();
        for (int i = 0; i < 24; ++i) { const int idx = F.tid + NTHR * i, c = idx / 192, d = idx % 192;
            bf16* qp = F.P + (row0 + c) * NP + GQ + h * 192 + d; *qp = f2b(bf2f(*qp) * qscale * __expf(bcum[c * 192 + d])); }
        __syncthreads();
    }
}

__device__ __forceinline__ void gla_scan(Ctx& F) {
    const int gt = blockIdx.x * NTHR + F.tid, NT = F.G * NTHR;
    constexpr int PER = 4 * 384 * 192;
    for (int item = gt; item < PER / 4; item += NT) {
        const int idx = item * 4, h = idx / (384 * 192), d0 = idx % 192;
        bf16* sp = F.STATE + idx; const float* dp = F.DEC + h * 192 + d0;
        float s0 = 0.f, s1 = 0.f, s2 = 0.f, s3 = 0.f;
        for (int n0 = 0; n0 < 256; n0 += 8) {
            unsigned long long u[8]; f32x4 dc[8];
#pragma unroll
            for (int j = 0; j < 8; ++j) { u[j] = *(const unsigned long long*)(sp + (size_t)(n0 + j) * PER); dc[j] = *(const f32x4*)(dp + (n0 + j) * 768); }
#pragma unroll
            for (int j = 0; j < 8; ++j) {
                const unsigned lo = (unsigned)u[j], hi = (unsigned)(u[j] >> 32);
                s0 = dc[j].x * s0 + bf2f((bf16)(lo & 0xffff)); s1 = dc[j].y * s1 + bf2f((bf16)(lo >> 16));
                s2 = dc[j].z * s2 + bf2f((bf16)(hi & 0xffff)); s3 = dc[j].w * s3 + bf2f((bf16)(hi >> 16));
                *(unsigned long long*)(sp + (size_t)(n0 + j) * PER) = (unsigned long long)pk2(s0, s1) | ((unsigned long long)pk2(s2, s3) << 32);
            }
        }
    }
}

__device__ __forceinline__ void gla_g3_naive(Ctx& F) {
    LAS float* o = (LAS float*)(F.lds);
    LAS float* rs = (LAS float*)(F.lds + 98304);
    for (int u = blockIdx.x; u < 1024; u += F.G) {
        const int n = u >> 2, h = u & 3; const size_t row0 = (size_t)n * 64;
        for (int i = 0; i < 48; ++i) { const int idx = F.tid + NTHR * i, c = idx / 384, e = idx % 384;
            float a = bf2f(F.OI[(row0 + c) * 1536 + h * 384 + e]);
            if (n > 0) { const bf16* sp = F.STATE + ((size_t)(u - 4) * 384 + e) * 192; const bf16* qp = F.P + (row0 + c) * NP + GQ + h * 192;
                for (int d = 0; d < 192; ++d) a += bf2f(qp[d]) * bf2f(sp[d]); }
            o[idx] = a; }
        __syncthreads();
        for (int c = F.wave; c < 64; c += NWAVES) { float ss = 0.f;
            for (int e = F.lane; e < 384; e += 64) { const float v = o[c * 384 + e]; ss += v * v; }
            ss = wave_sum(ss); if (F.lane == 0) rs[c] = rsqrtf(ss * (1.f / 384.f) + EPS); }
        __syncthreads();
        for (int i = 0; i < 48; ++i) { const int idx = F.tid + NTHR * i, c = idx / 384, e = idx % 384;
            const float v = o[idx] * rs[c] * F.gla_norm[e]; const float r = bf2f(F.P[(row0 + c) * NP + CR + h * 384 + e]);
            F.MIX0[(row0 + c) * DM + h * 384 + e] = f2b(v * silu_f(r)); }
        __syncthreads();
    }
}

__device__ __forceinline__ void post_rows(Ctx& F, const float* hin, const bf16* Y, const float* gpost, float* hout, const float* gpre, bf16* XNo) {
    for (int m = F.gw; m < T; m += F.NGW) {
        const v4u* yr = (const v4u*)(Y + (size_t)m * DM) + F.lane;
        float y[32]; float ss = 0.f;
#pragma unroll
        for (int j = 0; j < 4; ++j) { const v4u w = yr[64 * j];
            const unsigned ww[4] = {w.x, w.y, w.z, w.w};
#pragma unroll
            for (int q = 0; q < 4; ++q) { y[j * 8 + 2 * q] = bf2f((bf16)(ww[q] & 0xffff)); y[j * 8 + 2 * q + 1] = bf2f((bf16)(ww[q] >> 16)); } }
#pragma unroll
        for (int i = 0; i < 32; ++i) ss += y[i] * y[i];
        const float rstd = rsqrtf(wave_sum(ss) * (1.f / DM) + EPS);
        float hn[32]; float s2 = 0.f;
#pragma unroll
        for (int j = 0; j < 4; ++j) {
#pragma unroll
            for (int q = 0; q < 2; ++q) { const int col = j * 512 + F.lane * 8 + q * 4;
                const f32x4 hv = *(const f32x4*)(hin + (size_t)m * DM + col); const f32x4 gp = *(const f32x4*)(gpost + col);
                f32x4 r; r.x = hv.x + y[j * 8 + q * 4 + 0] * rstd * gp.x; r.y = hv.y + y[j * 8 + q * 4 + 1] * rstd * gp.y; r.z = hv.z + y[j * 8 + q * 4 + 2] * rstd * gp.z; r.w = hv.w + y[j * 8 + q * 4 + 3] * rstd * gp.w;
                *(f32x4*)(hout + (size_t)m * DM + col) = r;
                hn[j * 8 + q * 4 + 0] = r.x; hn[j * 8 + q * 4 + 1] = r.y; hn[j * 8 + q * 4 + 2] = r.z; hn[j * 8 + q * 4 + 3] = r.w;
                s2 += (r.x * r.x + r.y * r.y) + (r.z * r.z + r.w * r.w); } }
        if (gpre) {
            const float rstd2 = rsqrtf(wave_sum(s2) * (1.f / DM) + EPS);
#pragma unroll
            for (int j = 0; j < 4; ++j) { const int col = j * 512 + F.lane * 8;
                const f32x4 g0 = *(const f32x4*)(gpre + col), g1 = *(const f32x4*)(gpre + col + 4);
                v4u w; w.x = pk2(hn[j * 8 + 0] * rstd2 * g0.x, hn[j * 8 + 1] * rstd2 * g0.y); w.y = pk2(hn[j * 8 + 2] * rstd2 * g0.z, hn[j * 8 + 3] * rstd2 * g0.w);
                w.z = pk2(hn[j * 8 + 4] * rstd2 * g1.x, hn[j * 8 + 5] * rstd2 * g1.y); w.w = pk2(hn[j * 8 + 6] * rstd2 * g1.z, hn[j * 8 + 7] * rstd2 * g1.w);
                *((v4u*)(XNo + (size_t)m * DM) + F.lane + 64 * j) = w; }
        }
    }
}

__device__ __forceinline__ void nsa_compress_naive(Ctx& F) {
    LAS float* blk = (LAS float*)(F.lds);
    LAS float* part = (LAS float*)(F.lds + 65536);
    LAS float* hid = (LAS float*)(F.lds + 73728);
    for (int u = blockIdx.x; u < 1024; u += F.G) {
        const int kv = u & 1, g = (u >> 1) & 1, nq = u >> 2;
        const float* pe = kv ? F.pe_v : F.pe_k; const float* w1 = kv ? F.wv1 : F.wk1; const float* w2 = kv ? F.wv2 : F.wk2;
        const int colb = (kv ? NVC : NKC) + g * 128;
        for (int i = 0; i < 32; ++i) { const int idx = F.tid + NTHR * i, r = idx >> 12, i4 = idx & 4095, l = i4 >> 7, d = i4 & 127; const int n = nq * 4 + r;
            float v = 0.f; if (n < 1023) v = bf2f(F.P[(size_t)(16 * n + l) * NP + colb + d]) + pe[l * 128 + d];
            blk[idx] = v; }
        __syncthreads();
        { const int j = F.tid & 255, ih = F.tid >> 8; float a0 = 0.f, a1 = 0.f, a2 = 0.f, a3 = 0.f;
            for (int i = ih * 2048; i < ih * 2048 + 2048; ++i) { const float w = w1[(size_t)i * 256 + j];
                a0 += blk[i] * w; a1 += blk[4096 + i] * w; a2 += blk[8192 + i] * w; a3 += blk[12288 + i] * w; }
            part[(ih * 4 + 0) * 256 + j] = a0; part[(ih * 4 + 1) * 256 + j] = a1; part[(ih * 4 + 2) * 256 + j] = a2; part[(ih * 4 + 3) * 256 + j] = a3; }
        __syncthreads();
        for (int i = F.tid; i < 1024; i += NTHR) hid[i] = silu_f(part[i] + part[1024 + i]);
        __syncthreads();
        { const int d = F.tid & 127, r = F.tid >> 7; const int n = nq * 4 + r; float a = 0.f;
            for (int j = 0; j < 256; ++j) a += hid[r * 256 + j] * w2[j * 128 + d];
            if (n < 1023) (kv ? F.VCMP : F.KCMP)[((size_t)g * 1024 + n) * 128 + d] = f2b(a); }
        __syncthreads();
    }
}

__device__ __forceinline__ void nsa_main_naive(Ctx& F) {
    const float scale = 0.08838834764831845f;
    LAS float* ocs = (LAS float*)(F.lds + F.wave * 4096);
    const int lane = F.lane;
    for (int u = F.gw; u < T * 2; u += F.NGW) {
        const int t = u >> 1, g = u & 1; const bf16* pr = F.P + (size_t)t * NP;
        const int ncv = (t >= 31) ? min((t - 31) / 16 + 1, 1023) : 0;
        const bf16* Kc = F.KCMP + (size_t)g * 1024 * 128; const bf16* Vc = F.VCMP + (size_t)g * 1024 * 128;
        float imp0 = 0.f, imp1 = 0.f, imp2 = 0.f, imp3 = 0.f;
        for (int h = 0; h < 6; ++h) {
            const unsigned qq = *(const unsigned*)(pr + NQ + (g * 6 + h) * 128 + 2 * lane);
            const float q0 = bf2f((bf16)(qq & 0xffff)) * scale, q1 = bf2f((bf16)(qq >> 16)) * scale;
            float m = -1e30f, l = 0.f, o0 = 0.f, o1 = 0.f;
            for (int c = 0; c < ncv; ++c) {
                const unsigned kk = *(const unsigned*)(Kc + c * 128 + 2 * lane), vv = *(const unsigned*)(Vc + c * 128 + 2 * lane);
                const float s = wave_sum(q0 * bf2f((bf16)(kk & 0xffff)) + q1 * bf2f((bf16)(kk >> 16)));
                const float mn = fmaxf(m, s), a = __expf(m - mn), p = __expf(s - mn);
                l = l * a + p; o0 = o0 * a + p * bf2f((bf16)(vv & 0xffff)); o1 = o1 * a + p * bf2f((bf16)(vv >> 16)); m = mn;
            }
            const float gate = sigmoid_f(bf2f(pr[CGL + g * 18 + h * 3 + 0]));
            const float il = (ncv > 0) ? 1.f / l : 0.f;
            ocs[h * 128 + 2 * lane] = gate * o0 * il; ocs[h * 128 + 2 * lane + 1] = gate * o1 * il;
            for (int c = 0; c < ncv; ++c) {
                const unsigned kk = *(const unsigned*)(Kc + c * 128 + 2 * lane);
                const float s = wave_sum(q0 * bf2f((bf16)(kk & 0xffff)) + q1 * bf2f((bf16)(kk >> 16)));
                const float p = __expf(s - m) * il;
                const int ja = c >> 2, jb = (c + 1) >> 2;
                { const int jj = lane;       if (jj == ja || jj == jb) imp0 += p; }
                { const int jj = lane + 64;  if (jj == ja || jj == jb) imp1 += p; }
                { const int jj = lane + 128; if (jj == ja || jj == jb) imp2 += p; }
                { const int jj = lane + 192; if (jj == ja || jj == jb) imp3 += p; }
            }
        }
        const int cur = t >> 6;
        float iv[4] = {imp0, imp1, imp2, imp3};
#pragma unroll
        for (int i = 0; i < 4; ++i) { const int jj = lane + 64 * i; if (jj == 0 || jj == cur || jj == cur - 1) iv[i] = 1e4f; if (jj > cur) iv[i] = -1e4f; }
        int mysel = 0;
#pragma unroll
        for (int r = 0; r < 16; ++r) {
            float bv = iv[0]; int bi = lane;
#pragma unroll
            for (int i = 1; i < 4; ++i) { if (iv[i] > bv) { bv = iv[i]; bi = lane + 64 * i; } }
#pragma unroll
            for (int o = 1; o < 64; o <<= 1) { const float ov = __shfl_xor(bv, o); const int oi = __shfl_xor(bi, o); if (ov > bv || (ov == bv && oi < bi)) { bv = ov; bi = oi; } }
            mysel = (lane == r) ? bi : mysel;
#pragma unroll
            for (int i = 0; i < 4; ++i) if (lane + 64 * i == bi) iv[i] = -3e38f;
        }
        for (int h = 0; h < 6; ++h) {
            const unsigned qq = *(const unsigned*)(pr + NQ + (g * 6 + h) * 128 + 2 * lane);
            const float q0 = bf2f((bf16)(qq & 0xffff)) * scale, q1 = bf2f((bf16)(qq >> 16)) * scale;
            float m = -1e30f, l = 0.f, o0 = 0.f, o1 = 0.f;
            for (int r = 0; r < 16; ++r) { const int j = __shfl(mysel, r); if (j > cur) continue;
                const int kend = min(64, t - 64 * j + 1);
                for (int i = 0; i < kend; ++i) { const bf16* kr = F.P + (size_t)(64 * j + i) * NP;
                    const unsigned kk = *(const unsigned*)(kr + NKS + g * 128 + 2 * lane), vv = *(const unsigned*)(kr + NVS + g * 128 + 2 * lane);
                    const float s = wave_sum(q0 * bf2f((bf16)(kk & 0xffff)) + q1 * bf2f((bf16)(kk >> 16)));
                    const float mn = fmaxf(m, s), a = __expf(m - mn), p = __expf(s - mn);
                    l = l * a + p; o0 = o0 * a + p * bf2f((bf16)(vv & 0xffff)); o1 = o1 * a + p * bf2f((bf16)(vv >> 16)); m = mn; } }
            const float gs = sigmoid_f(bf2f(pr[CGL + g * 18 + h * 3 + 1]));
            float r0 = ocs[h * 128 + 2 * lane] + gs * o0 / l, r1 = ocs[h * 128 + 2 * lane + 1] + gs * o1 / l;
            m = -1e30f; l = 0.f; o0 = 0.f; o1 = 0.f;
            for (int p0 = max(0, t - 511); p0 <= t; ++p0) { const bf16* kr = F.P + (size_t)p0 * NP;
                const unsigned kk = *(const unsigned*)(kr + NKW + g * 128 + 2 * lane), vv = *(const unsigned*)(kr + NVW + g * 128 + 2 * lane);
                const float s = wave_sum(q0 * bf2f((bf16)(kk & 0xffff)) + q1 * bf2f((bf16)(kk >> 16)));
                const float mn = fmaxf(m, s), a = __expf(m - mn), p = __expf(s - mn);
                l = l * a + p; o0 = o0 * a + p * bf2f((bf16)(vv & 0xffff)); o1 = o1 * a + p * bf2f((bf16)(vv >> 16)); m = mn; }
            const float gw_ = sigmoid_f(bf2f(pr[CGL + g * 18 + h * 3 + 2]));
            r0 += gw_ * o0 / l; r1 += gw_ * o1 / l;
            const unsigned rr = *(const unsigned*)(pr + CR + (g * 6 + h) * 128 + 2 * lane);
            r0 *= silu_f(bf2f((bf16)(rr & 0xffff))); r1 *= silu_f(bf2f((bf16)(rr >> 16)));
            *(unsigned*)(F.MIX1 + (size_t)t * DM + (g * 6 + h) * 128 + 2 * lane) = pk2(r0, r1);
        }
    }
}


typedef short v4i16_t __attribute__((ext_vector_type(4)));
typedef short s16x4 __attribute__((ext_vector_type(4)));
__device__ __forceinline__ s16x4 vtr(const LAS unsigned char* p) { return __builtin_bit_cast(s16x4, __builtin_amdgcn_ds_read_tr16_b64_v4i16((LAS v4i16_t*)p)); }
constexpr int KROW = 288;
constexpr int RING = 3, TILE_K = 16384, TILE_KV = 32768;
__device__ __forceinline__ int swz_off(int row, int chunk) { return row * 256 + ((((((chunk >> 1) ^ row) & 7)) << 1) | (chunk & 1)) * 16; }
constexpr float LOG2E = 1.4426950408889634f;

struct ImpArgs { float gate0, gate1; bool hvalid; LAS float* imp; const LAS unsigned* bm; };
__device__ __forceinline__ void dma16(const char* sbase, unsigned voff, unsigned lds_dst) {
    unsigned keep;
    asm volatile("s_mov_b32 %0, m0\n\ts_mov_b32 m0, %3\n\ts_nop 0\n\tglobal_load_lds_dwordx4 %1, %2\n\ts_mov_b32 m0, %0" : "=&s"(keep) : "v"(voff), "s"(sbase), "s"(lds_dst) : "memory");
}
typedef float f32x2_t __attribute__((ext_vector_type(2)));
typedef __bf16 bf16x2_t __attribute__((ext_vector_type(2)));
__device__ __forceinline__ unsigned cvtpk(float lo, float hi) { const f32x2_t v = {lo, hi}; return __builtin_bit_cast(unsigned, __builtin_convertvector(v, bf16x2_t)); }
__device__ __forceinline__ float bperm(float x, int srclane) { return __builtin_bit_cast(float, __builtin_amdgcn_ds_bpermute(srclane << 2, __builtin_bit_cast(int, x))); }
__device__ __forceinline__ float xmax4(float x, int lane) { x = fmaxf(x, bperm(x, lane ^ 16)); return fmaxf(x, bperm(x, lane ^ 32)); }
__device__ __forceinline__ float xsum4(float x, int lane) { x += bperm(x, lane ^ 16); return x + bperm(x, lane ^ 32); }
template <int CTRL> __device__ __forceinline__ float dppf(float x) { return __builtin_bit_cast(float, __builtin_amdgcn_update_dpp(0, __builtin_bit_cast(int, x), CTRL, 0xF, 0xF, true)); }
__device__ __forceinline__ float sum8(float x) { x += dppf<0xB1>(x); x += dppf<0x4E>(x); x += dppf<0x141>(x); return x; }

template <int MODE, int RTM, bool FULL, class Mask>
__device__ __forceinline__ void attn_tile(const LAS unsigned char* Kb, const LAS unsigned char* Vb, const bf16x8 (&Q)[2][4], f32x4 (&O)[2][8], float (&m)[2], float (&l)[2],
                                          const int kt, const Mask& mask, const int tok0, const int tok1, const float sl2, const ImpArgs& ia, const bool sb0, const bool sb1,
                                          float& carry0, float& carry1, const int lane) {
    const int c16 = lane & 15, g = lane >> 4;
#pragma unroll
    for (int s32 = 0; s32 < 2; ++s32) {
        f32x4 sc[2][2];
#pragma unroll
        for (int rt = 0; rt < 2; ++rt)
#pragma unroll
            for (int st = 0; st < 2; ++st) sc[rt][st] = (f32x4){0.f, 0.f, 0.f, 0.f};
#pragma unroll
        for (int st = 0; st < 2; ++st) {
            bf16x8 kf[4];
#pragma unroll
            for (int kd = 0; kd < 4; ++kd) kf[kd] = *(const LAS bf16x8*)(Kb + swz_off(s32 * 32 + st * 16 + c16, g + 4 * kd));
#pragma unroll
            for (int kd = 0; kd < 4; ++kd) {
                if (RTM & 1) sc[0][st] = __builtin_amdgcn_mfma_f32_16x16x32_bf16(kf[kd], Q[0][kd], sc[0][st], 0, 0, 0);
                if (RTM & 2) sc[1][st] = __builtin_amdgcn_mfma_f32_16x16x32_bf16(kf[kd], Q[1][kd], sc[1][st], 0, 0, 0);
            }
        }
        bf16x8 pf[2];
#pragma unroll
        for (int rt = 0; rt < 2; ++rt) {
            if (!((RTM >> rt) & 1)) continue;
            const int tk = rt ? tok1 : tok0; const bool sb = rt ? sb1 : sb0;
            float v[8]; float mx = -3e38f;
#pragma unroll
            for (int st = 0; st < 2; ++st)
#pragma unroll
                for (int r = 0; r < 4; ++r) { const int kidx = kt + s32 * 32 + st * 16 + g * 4 + r;
                    v[st * 4 + r] = (FULL || (mask(tk, kidx) && (MODE != 3 || sb))) ? sc[rt][st][r] : -3e38f; mx = fmaxf(mx, v[st * 4 + r]); }
            if (MODE != 2) {
                const float mo = m[rt];
                bool need = (mx * sl2 - mo) > 64.f; if (MODE == 3) need = need && sb;
                if (__any(need)) {
                    const float mxa = xmax4(mx, lane); float mn = fmaxf(mo, mxa * sl2); if (MODE == 3) mn = sb ? mn : mo;
                    const float alpha = __builtin_amdgcn_exp2f(mo - mn);
                    m[rt] = mn; l[rt] = l[rt] * alpha;
                    if (MODE == 0 || MODE == 3) {
#pragma unroll
                        for (int dt = 0; dt < 8; ++dt) O[rt][dt] = O[rt][dt] * alpha;
                    }
                }
                const float mn = m[rt];
                float ps = 0.f;
#pragma unroll
                for (int i = 0; i < 8; ++i) { v[i] = __builtin_amdgcn_exp2f(fmaf(v[i], sl2, -mn)); ps += v[i]; }
                l[rt] += ps;
            } else {
                const float mn = m[rt], linv = ia.hvalid ? l[rt] : 0.f, gt = rt ? ia.gate1 : ia.gate0;
#pragma unroll
                for (int i = 0; i < 8; ++i) v[i] = __builtin_amdgcn_exp2f(fmaf(v[i], sl2, -mn)) * linv;
                const float s40 = sum8((v[0] + v[1]) + (v[2] + v[3])), s41 = sum8((v[4] + v[5]) + (v[6] + v[7])), la0 = sum8(v[3]), la1 = sum8(v[7]);
                const float pl0 = bperm(la0, (lane + 48) & 63), pl1 = bperm(la1, (lane + 48) & 63);
                const float cprev = rt ? carry1 : carry0;
                const float i0 = s40 + (g > 0 ? pl0 : cprev), i1 = s41 + (g > 0 ? pl1 : pl0);
                if (rt) carry1 = pl1; else carry0 = pl1;
                if ((lane & 7) == 0) { const int jb = (kt >> 2) + 8 * s32 + g; LAS float* ip = ia.imp + (rt * 2 + (c16 >> 3)) * 256 + jb; ip[0] = i0; ip[4] = i1; }
#pragma unroll
                for (int i = 0; i < 8; ++i) v[i] *= gt;
            }
            if (MODE != 1) { v4u pw; pw.x = cvtpk(v[0], v[1]); pw.y = cvtpk(v[2], v[3]); pw.z = cvtpk(v[4], v[5]); pw.w = cvtpk(v[6], v[7]);
                pf[rt] = __builtin_bit_cast(bf16x8, pw); }
        }
        if (MODE != 1) {
            const int vrow = s32 * 32 + g * 4 + (c16 >> 2);
            const LAS unsigned char* vb0 = Vb + vrow * 256 + ((c16 >> 1) & 1) * 16 + (c16 & 1) * 8; const int r7 = vrow & 7;
#pragma unroll
            for (int dt = 0; dt < 8; ++dt) {
                const LAS unsigned char* vp = vb0 + ((dt ^ r7) << 5);
                const s16x4 lo = vtr(vp), hi = vtr(vp + 4096);
                const bf16x8 vf = {lo[0], lo[1], lo[2], lo[3], hi[0], hi[1], hi[2], hi[3]};
                if (RTM & 1) O[0][dt] = __builtin_amdgcn_mfma_f32_16x16x32_bf16(vf, pf[0], O[0][dt], 0, 0, 0);
                if (RTM & 2) O[1][dt] = __builtin_amdgcn_mfma_f32_16x16x32_bf16(vf, pf[1], O[1][dt], 0, 0, 0);
            }
        }
    }
}

template <int MODE, class Src, class Mask>
__device__ __forceinline__ void attn_pass(Ctx& F, LAS unsigned char* base, const bf16x8 (&Q)[2][4], f32x4 (&O)[2][8], float (&m)[2], float (&l)[2],
                                          const int k0, const int nt, const Src& src, const Mask& mask, const int tok0, const int tok1, const float sl2, const ImpArgs ia = ImpArgs{0.f, 0.f, false, nullptr, nullptr}) {
    int tidv = F.wave * 64 + (int)__builtin_amdgcn_mbcnt_hi(~0u, __builtin_amdgcn_mbcnt_lo(~0u, 0u)); asm volatile("" : "+v"(tidv));
    const int lane = tidv & 63, c16 = lane & 15, g = lane >> 4;
    const int wv = F.wave;
    constexpr int NL = (MODE == 1) ? 2 : 4;
#define ATT_DMA(tj, bufi) do { const int kt_ = k0 + 64 * min((tj), nt - 1); \
        _Pragma("unroll") for (int i_ = 0; i_ < 2; ++i_) { const int pc_ = wv * 2 + i_, row_ = pc_ * 4 + g, c_ = (((((c16 >> 1) ^ row_) & 7)) << 1) | (c16 & 1); \
            const unsigned go_ = src.off(kt_ + row_) + (unsigned)(c_ * 16); \
            dma16(src.kb, go_, (unsigned)(size_t)base + (unsigned)((bufi) * TILE_KV + pc_ * 1024)); \
            if (MODE != 1) dma16(src.vb, go_, (unsigned)(size_t)base + (unsigned)((bufi) * TILE_KV + TILE_K + pc_ * 1024)); } } while (0)
    __syncthreads();
#pragma unroll
    for (int t_ = 0; t_ < RING - 1; ++t_) ATT_DMA(t_, t_);
    float carry0 = 0.f, carry1 = 0.f;
    int bcur = 0;
    for (int j = 0; j < nt; ++j) {
        if (NL == 4) asm volatile("s_waitcnt vmcnt(%0)" :: "n"((RING - 2) * 4) : "memory"); else asm volatile("s_waitcnt vmcnt(%0)" :: "n"((RING - 2) * 2) : "memory");
        __builtin_amdgcn_s_barrier();
        { const int bnext = (bcur == 0) ? RING - 1 : bcur - 1; ATT_DMA(j + RING - 1, bnext); }
        const LAS unsigned char* Kb = base + bcur * TILE_KV; const LAS unsigned char* Vb = Kb + TILE_K;
        const int kt = k0 + 64 * j;
        if (MODE == 3) {
            const int jb = kt >> 6; const unsigned w0 = ia.bm[(c16 >> 3) * 8 + (jb >> 5)], w1 = ia.bm[(2 + (c16 >> 3)) * 8 + (jb >> 5)];
            const bool sb0 = ia.hvalid && ((w0 >> (jb & 31)) & 1u), sb1 = ia.hvalid && ((w1 >> (jb & 31)) & 1u); const bool act0 = __any(sb0), act1 = __any(sb1);
            if (act0 && act1) attn_tile<MODE, 3, false>(Kb, Vb, Q, O, m, l, kt, mask, tok0, tok1, sl2, ia, sb0, sb1, carry0, carry1, lane);
            else if (act0) attn_tile<MODE, 1, false>(Kb, Vb, Q, O, m, l, kt, mask, tok0, tok1, sl2, ia, sb0, sb1, carry0, carry1, lane);
            else if (act1) attn_tile<MODE, 2, false>(Kb, Vb, Q, O, m, l, kt, mask, tok0, tok1, sl2, ia, sb0, sb1, carry0, carry1, lane);
        } else { int lj = lane; asm volatile("" : "+v"(lj));
            const bool full = __all(mask(tok0, kt) && mask(tok0, kt + 63) && mask(tok1, kt) && mask(tok1, kt + 63));
            if (full) attn_tile<MODE, 3, true>(Kb, Vb, Q, O, m, l, kt, mask, tok0, tok1, sl2, ia, true, true, carry0, carry1, lj);
            else attn_tile<MODE, 3, false>(Kb, Vb, Q, O, m, l, kt, mask, tok0, tok1, sl2, ia, true, true, carry0, carry1, lj); }
        bcur = (bcur == RING - 1) ? 0 : bcur + 1;
    }
    asm volatile("s_waitcnt vmcnt(0)" ::: "memory");
    __syncthreads();
#undef ATT_DMA
}

template <class Mask>
__device__ __forceinline__ void slc_visit1(const LAS unsigned char* Kb, const LAS unsigned char* Vb, const bf16x8 (&Qr)[4], f32x4 (&Or)[8], float& mr, float& lr,
                                           const int kt, const Mask& mask, const int tok, const float sl2, const bool sb, const int lane) {
    const int c16 = lane & 15, g = lane >> 4;
    f32x4 sc[4];
#pragma unroll
    for (int st = 0; st < 4; ++st) { sc[st] = (f32x4){0.f, 0.f, 0.f, 0.f};
#pragma unroll
        for (int kd = 0; kd < 4; ++kd) { const bf16x8 kf = *(const LAS bf16x8*)(Kb + swz_off(st * 16 + c16, g + 4 * kd));
            sc[st] = __builtin_amdgcn_mfma_f32_16x16x32_bf16(kf, Qr[kd], sc[st], 0, 0, 0); } }
    float v[16]; float mx = -3e38f;
#pragma unroll
    for (int st = 0; st < 4; ++st)
#pragma unroll
        for (int r = 0; r < 4; ++r) { const int kidx = kt + st * 16 + g * 4 + r; v[st * 4 + r] = (mask(tok, kidx) && sb) ? sc[st][r] : -3e38f; mx = fmaxf(mx, v[st * 4 + r]); }
    const float mo = mr;
    if (__any((mx * sl2 - mo) > 64.f)) {
        const float mxa = xmax4(mx, lane); const float mn = sb ? fmaxf(mo, mxa * sl2) : mo; const float alpha = __builtin_amdgcn_exp2f(mo - mn);
        mr = mn; lr *= alpha;
#pragma unroll
        for (int dt = 0; dt < 8; ++dt) Or[dt] = Or[dt] * alpha;
    }
    const float mn = mr; float ps = 0.f;
#pragma unroll
    for (int i = 0; i < 16; ++i) { v[i] = __builtin_amdgcn_exp2f(fmaf(v[i], sl2, -mn)); ps += v[i]; }
    lr += ps;
    bf16x8 pf[2];
#pragma unroll
    for (int ks = 0; ks < 2; ++ks) { v4u pw; pw.x = cvtpk(v[8 * ks + 0], v[8 * ks + 1]); pw.y = cvtpk(v[8 * ks + 2], v[8 * ks + 3]); pw.z = cvtpk(v[8 * ks + 4], v[8 * ks + 5]); pw.w = cvtpk(v[8 * ks + 6], v[8 * ks + 7]);
        pf[ks] = __builtin_bit_cast(bf16x8, pw); }
#pragma unroll
    for (int ks = 0; ks < 2; ++ks) { const int vrow = ks * 32 + g * 4 + (c16 >> 2);
        const LAS unsigned char* vb0 = Vb + vrow * 256 + ((c16 >> 1) & 1) * 16 + (c16 & 1) * 8; const int r7 = vrow & 7;
#pragma unroll
        for (int dt = 0; dt < 8; ++dt) { const LAS unsigned char* vp = vb0 + ((dt ^ r7) << 5);
            const s16x4 lo = vtr(vp), hi = vtr(vp + 4096);
            const bf16x8 vf = {lo[0], lo[1], lo[2], lo[3], hi[0], hi[1], hi[2], hi[3]};
            Or[dt] = __builtin_amdgcn_mfma_f32_16x16x32_bf16(vf, pf[ks], Or[dt], 0, 0, 0); } }
}

template <class Src, class Mask>
__device__ __forceinline__ void slc_pass(Ctx& F, LAS unsigned char* base, const bf16x8 (&Q)[2][4], f32x4 (&O)[2][8], float (&m)[2], float (&l)[2],
                                         const int nt, const Src& src, const Mask& mask, const int tok0, const int tok1, const float sl2, const ImpArgs ia) {
    int tidv = F.wave * 64 + (int)__builtin_amdgcn_mbcnt_hi(~0u, __builtin_amdgcn_mbcnt_lo(~0u, 0u)); asm volatile("" : "+v"(tidv));
    const int lane = tidv & 63, c16 = lane & 15, g = lane >> 4;
    const int wv = F.wave;
    volatile LAS unsigned* flg = (volatile LAS unsigned*)(base + RING_BYTES + 2048);
#define SLC_DMA(tj) do { const int kt_ = 64 * (tj); \
        _Pragma("unroll") for (int i_ = 0; i_ < 2; ++i_) { const int pc_ = wv * 2 + i_, row_ = pc_ * 4 + g, c_ = (((((c16 >> 1) ^ row_) & 7)) << 1) | (c16 & 1); \
            const unsigned go_ = src.off(kt_ + row_) + (unsigned)(c_ * 16); \
            dma16(src.kb, go_, (unsigned)(size_t)base + (unsigned)(((tj) & 3) * TILE_KV + pc_ * 1024)); \
            dma16(src.vb, go_, (unsigned)(size_t)base + (unsigned)(((tj) & 3) * TILE_KV + TILE_K + pc_ * 1024)); } } while (0)
#define SLC_SPIN(off, target) do { for (;;) { const unsigned v_ = flg[(off) + (lane & 7)]; if (__all(v_ >= (unsigned)(target))) break; __builtin_amdgcn_s_sleep(1); } asm volatile("" ::: "memory"); __builtin_amdgcn_sched_barrier(0); } while (0)
    __syncthreads();
    if (tidv < 16) flg[tidv] = 0u;
    __syncthreads();
    SLC_DMA(0); if (nt > 1) SLC_DMA(1);
    float carry0 = 0.f, carry1 = 0.f;
    int done_min = 0;
    for (int j = 0; j < nt; ++j) {
        if (j + 2 < nt) {
            if (j >= 2 && done_min < j - 1) { for (;;) { unsigned v_ = flg[8 + (lane & 7)]; v_ = min(v_, (unsigned)__builtin_amdgcn_update_dpp(0, (int)v_, 0xB1, 0xF, 0xF, true)); v_ = min(v_, (unsigned)__builtin_amdgcn_update_dpp(0, (int)v_, 0x4E, 0xF, 0xF, true));
                    v_ = min(v_, (unsigned)__builtin_amdgcn_update_dpp(0, (int)v_, 0x141, 0xF, 0xF, true)); done_min = __builtin_amdgcn_readfirstlane((int)v_);
                    if (done_min >= j - 1) break; __builtin_amdgcn_s_sleep(1); }
                asm volatile("" ::: "memory"); __builtin_amdgcn_sched_barrier(0); }
            SLC_DMA(j + 2); }
        if (j + 2 < nt) asm volatile("s_waitcnt vmcnt(4)" ::: "memory"); else asm volatile("s_waitcnt vmcnt(0)" ::: "memory");
        asm volatile("" ::: "memory");
        if (lane == 0) flg[wv] = (unsigned)min(j + 2, nt);
        asm volatile("" ::: "memory");
        const unsigned w0 = ia.bm[(c16 >> 3) * 8 + (j >> 5)], w1 = ia.bm[(2 + (c16 >> 3)) * 8 + (j >> 5)];
        const bool sb0 = ia.hvalid && ((w0 >> (j & 31)) & 1u), sb1 = ia.hvalid && ((w1 >> (j & 31)) & 1u); const bool act0 = __any(sb0), act1 = __any(sb1);
        if (act0 || act1) {
            SLC_SPIN(0, j + 1);
            const LAS unsigned char* Kb = base + (j & 3) * TILE_KV; const LAS unsigned char* Vb = Kb + TILE_K;
            int lj = lane; asm volatile("" : "+v"(lj));
            if (act0 && act1) attn_tile<3, 3, false>(Kb, Vb, Q, O, m, l, 64 * j, mask, tok0, tok1, sl2, ia, sb0, sb1, carry0, carry1, lj);
            else if (act0) slc_visit1(Kb, Vb, Q[0], O[0], m[0], l[0], 64 * j, mask, tok0, sl2, sb0, lj);
            else slc_visit1(Kb, Vb, Q[1], O[1], m[1], l[1], 64 * j, mask, tok1, sl2, sb1, lj);
            asm volatile("s_waitcnt lgkmcnt(0)" ::: "memory");
        }
        asm volatile("" ::: "memory");
        if (lane == 0) flg[8 + wv] = (unsigned)(j + 1);
        asm volatile("" ::: "memory");
    }
    asm volatile("s_waitcnt vmcnt(0)" ::: "memory");
    __syncthreads();
#undef SLC_DMA
#undef SLC_SPIN
}

struct SrcMem { const char* kb; const char* vb;
    __device__ __forceinline__ unsigned off(int key) const { return (unsigned)min(key, NMEM - 1) * 256u; } };
struct MaskNone { __device__ __forceinline__ bool operator()(int, int) const { return true; } };

__device__ __forceinline__ void cross_fast(Ctx& F, int layer, bf16* MIX) {
    for (int u = blockIdx.x; u < 256; u += F.G) {
        int tidv = F.wave * 64 + (int)__builtin_amdgcn_mbcnt_hi(~0u, __builtin_amdgcn_mbcnt_lo(~0u, 0u)); asm volatile("" : "+v"(tidv));
        const int lane = tidv & 63, c16 = lane & 15, g = lane >> 4;
        const int h = u & 3, tb = u >> 2;
        int tok[2]; bf16x8 Q[2][4]; f32x4 O[2][8]; float m[2], l[2];
#pragma unroll
        for (int rt = 0; rt < 2; ++rt) { tok[rt] = tb * 256 + F.wave * 32 + rt * 16 + c16; m[rt] = -1e30f; l[rt] = 0.f;
#pragma unroll
            for (int kd = 0; kd < 4; ++kd) Q[rt][kd] = *(const bf16x8*)((const char*)F.P + ((unsigned)tok[rt] * (unsigned)(NP * 2) + (unsigned)((CXQ + h * 128 + g * 8 + kd * 32) * 2)));
#pragma unroll
            for (int dt = 0; dt < 8; ++dt) O[rt][dt] = (f32x4){0.f, 0.f, 0.f, 0.f}; }
        SrcMem src{(const char*)(F.MEMKV + (((size_t)layer * 2 + 0) * 4 + h) * NMEM * 128), (const char*)(F.MEMKV + (((size_t)layer * 2 + 1) * 4 + h) * NMEM * 128)};
        attn_pass<0>(F, F.lds, Q, O, m, l, 0, 4, src, MaskNone(), tok[0], tok[1], 0.08838834764831845f * LOG2E);
#pragma unroll
        for (int rt = 0; rt < 2; ++rt) {
            float lt = xsum4(l[rt], lane);
            const float inv = 1.f / lt;
#pragma unroll
            for (int dt = 0; dt < 8; ++dt) { const int d = dt * 16 + g * 4;
                const unsigned long long xg = *(const unsigned long long*)((const char*)F.P + ((unsigned)tok[rt] * (unsigned)(NP * 2) + (unsigned)((CXG + h * 128 + d) * 2)));
                const unsigned lo = (unsigned)xg, hi = (unsigned)(xg >> 32);
                const float o0 = O[rt][dt][0] * inv * silu_f(bf2f((bf16)(lo & 0xffff))), o1 = O[rt][dt][1] * inv * silu_f(bf2f((bf16)(lo >> 16)));
                const float o2 = O[rt][dt][2] * inv * silu_f(bf2f((bf16)(hi & 0xffff))), o3 = O[rt][dt][3] * inv * silu_f(bf2f((bf16)(hi >> 16)));
                *(unsigned long long*)((char*)MIX + ((unsigned)tok[rt] * (unsigned)(DM * 2) + (unsigned)((1536 + h * 128 + d) * 2))) = (unsigned long long)pk2(o0, o1) | ((unsigned long long)pk2(o2, o3) << 32); }
        }
    }
}


struct SrcRows { const char* kb; const char* vb;
    __device__ __forceinline__ unsigned off(int key) const { return (unsigned)min(max(key, 0), T - 1) * 256u; } };
struct MaskWin { __device__ __forceinline__ bool operator()(int t, int key) const { return key <= t && key > t - 512; } };
struct SrcCmp { const char* kb; const char* vb;
    __device__ __forceinline__ unsigned off(int key) const { return (unsigned)min(key, 1022) * 256u; } };
struct MaskCmp { __device__ __forceinline__ bool operator()(int t, int key) const { return 16 * key + 31 <= t; } };

struct MaskCausal { __device__ __forceinline__ bool operator()(int t, int key) const { return key <= t; } };

__device__ __forceinline__ void nsa_main_fast(Ctx& F) {
    const float sl2 = 0.08838834764831845f * LOG2E;
    LAS float* imp = (LAS float*)(F.lds + RING * TILE_KV) + F.wave * 1024;
    LAS unsigned* bm = (LAS unsigned*)(F.lds + RING_BYTES + 1024) + F.wave * 32;
    for (;;) {
        int zq = 0; asm volatile("" : "+s"(zq));
        unsigned* qctr = (unsigned*)(F.ws + WS_CTL) + 8192 + zq;
        volatile LAS int* qslot = (volatile LAS int*)(F.lds + RING_BYTES + 3072) + zq;
        __syncthreads();
        if (F.wave == 0 && __builtin_amdgcn_mbcnt_hi(~0u, __builtin_amdgcn_mbcnt_lo(~0u, 0u)) == 0) qslot[0] = (int)__hip_atomic_fetch_add(qctr, 1u, __ATOMIC_RELAXED, __HIP_MEMORY_SCOPE_AGENT);
        __syncthreads();
        const int ticket = qslot[0];
        if (ticket >= 1024) break;
        const int g = ticket & 1, tb = 511 - (ticket >> 1);
        int tidv = F.wave * 64 + (int)__builtin_amdgcn_mbcnt_hi(~0u, __builtin_amdgcn_mbcnt_lo(~0u, 0u)); asm volatile("" : "+v"(tidv));
        const int lane = tidv & 63, c16 = lane & 15, gq = lane >> 4, ts = c16 >> 3, hs = c16 & 7; const bool hv = hs < 6;
        int tok[2]; f32x4 O[2][8]; bf16x8 Q[2][4]; float m[2], l[2];
        {
            float gw[2], gc[2];
#pragma unroll
            for (int rt = 0; rt < 2; ++rt) { tok[rt] = tb * 32 + F.wave * 4 + rt * 2 + ts; m[rt] = -1e30f; l[rt] = 0.f;
                const char* Pb = (const char*)F.P; const unsigned ro = (unsigned)tok[rt] * (unsigned)(NP * 2);
#pragma unroll
                for (int kd = 0; kd < 4; ++kd) { Q[rt][kd] = (bf16x8){0, 0, 0, 0, 0, 0, 0, 0}; if (hv) Q[rt][kd] = *(const bf16x8*)(Pb + (ro + (unsigned)((NQ + (g * 6 + hs) * 128 + gq * 8 + kd * 32) * 2))); }
                gw[rt] = hv ? sigmoid_f(bf2f(*(const bf16*)(Pb + (ro + (unsigned)((CGL + g * 18 + hs * 3 + 2) * 2))))) : 0.f;
                gc[rt] = hv ? sigmoid_f(bf2f(*(const bf16*)(Pb + (ro + (unsigned)((CGL + g * 18 + hs * 3 + 0) * 2))))) : 0.f;
#pragma unroll
                for (int dt = 0; dt < 8; ++dt) O[rt][dt] = (f32x4){0.f, 0.f, 0.f, 0.f}; }
            { const int klo = max(0, tb * 32 - 511), k0 = (klo >> 6) << 6, nt = ((tb * 32 + 31 - k0) >> 6) + 1;
              attn_pass<0>(F, F.lds, Q, O, m, l, k0, nt, SrcRows{(const char*)(F.CP + (8 + g) * PLANE), (const char*)(F.CP + (10 + g) * PLANE)}, MaskWin(), tok[0], tok[1], sl2); }
#pragma unroll
            for (int rt = 0; rt < 2; ++rt) { float lt = xsum4(l[rt], lane); const float f = gw[rt] / lt;
#pragma unroll
                for (int dt = 0; dt < 8; ++dt) O[rt][dt] = O[rt][dt] * f; m[rt] = -1e30f; l[rt] = 0.f; }
            const int tlast = tb * 32 + 31, ncv = (tlast - 31) / 16 + 1, ntc = (ncv + 63) >> 6;
            SrcCmp sc_{(const char*)(F.KCMP + (size_t)g * 1024 * 128), (const char*)(F.VCMP + (size_t)g * 1024 * 128)};
            attn_pass<1>(F, F.lds, Q, O, m, l, 0, ntc, sc_, MaskCmp(), tok[0], tok[1], sl2);
#pragma unroll
            for (int rt = 0; rt < 2; ++rt) { float lt = xsum4(l[rt], lane); l[rt] = lt > 0.f ? 1.f / lt : 0.f; }
            attn_pass<2>(F, F.lds, Q, O, m, l, 0, ntc, sc_, MaskCmp(), tok[0], tok[1], sl2, ImpArgs{gc[0], gc[1], hv, imp, nullptr});
        }
        for (int s = 0; s < 4; ++s) {
            const int tt = tb * 32 + F.wave * 4 + s, cur = tt >> 6;
            unsigned key[4]; bool sel[4];
#pragma unroll
            for (int i = 0; i < 4; ++i) { const int jj = lane + 64 * i; float f = imp[s * 256 + jj]; if (jj == 0 || jj == cur || jj == cur - 1) f = 1e4f;
                key[i] = (jj > cur) ? 0u : __builtin_bit_cast(unsigned, fmaxf(f, 0.f)) + 1u; sel[i] = (jj <= cur); }
            if (cur + 1 > 16) {
                unsigned prefix = 0u;
                for (int bit = 31; bit >= 0; --bit) { const unsigned cand = prefix | (1u << bit);
                    const int cnt = __popcll(__ballot(key[0] >= cand)) + __popcll(__ballot(key[1] >= cand)) + __popcll(__ballot(key[2] >= cand)) + __popcll(__ballot(key[3] >= cand));
                    if (cnt >= 16) prefix = cand; }
                const unsigned long long g0 = __ballot(key[0] > prefix), g1 = __ballot(key[1] > prefix), g2 = __ballot(key[2] > prefix), g3 = __ballot(key[3] > prefix);
                const unsigned long long e0 = __ballot(key[0] == prefix), e1 = __ballot(key[1] == prefix), e2 = __ballot(key[2] == prefix), e3 = __ballot(key[3] == prefix);
                const int need = 16 - (__popcll(g0) + __popcll(g1) + __popcll(g2) + __popcll(g3));
                const unsigned long long lt = (1ull << lane) - 1ull;
                const int r0 = __popcll(e0 & lt), r1 = __popcll(e0) + __popcll(e1 & lt), r2 = __popcll(e0) + __popcll(e1) + __popcll(e2 & lt), r3 = __popcll(e0) + __popcll(e1) + __popcll(e2) + __popcll(e3 & lt);
                sel[0] = (key[0] > prefix) || (key[0] == prefix && r0 < need); sel[1] = (key[1] > prefix) || (key[1] == prefix && r1 < need);
                sel[2] = (key[2] > prefix) || (key[2] == prefix && r2 < need); sel[3] = (key[3] > prefix) || (key[3] == prefix && r3 < need);
            }
#pragma unroll
            for (int i = 0; i < 4; ++i) { const unsigned long long b = __ballot(sel[i]); if (lane == 0) { bm[s * 8 + 2 * i] = (unsigned)b; bm[s * 8 + 2 * i + 1] = (unsigned)(b >> 32); } }
        }
        if (hv) {
#pragma unroll
            for (int rt = 0; rt < 2; ++rt)
#pragma unroll
                for (int dt = 0; dt < 8; ++dt) { const int col = (g * 6 + hs) * 128 + dt * 16 + gq * 4;
                    *(unsigned long long*)((char*)F.MIX1 + ((unsigned)tok[rt] * (unsigned)(DM * 2) + (unsigned)(col * 2))) = (unsigned long long)cvtpk(O[rt][dt][0], O[rt][dt][1]) | ((unsigned long long)cvtpk(O[rt][dt][2], O[rt][dt][3]) << 32); }
        }
#pragma unroll
        for (int rt = 0; rt < 2; ++rt) { m[rt] = -1e30f; l[rt] = 0.f;
#pragma unroll
            for (int dt = 0; dt < 8; ++dt) O[rt][dt] = (f32x4){0.f, 0.f, 0.f, 0.f}; }
        slc_pass(F, F.lds, Q, O, m, l, ((tb * 32) >> 6) + 1, SrcRows{(const char*)(F.CP + (4 + g) * PLANE), (const char*)(F.CP + (6 + g) * PLANE)}, MaskCausal(), tok[0], tok[1], sl2, ImpArgs{0.f, 0.f, hv, nullptr, bm});
        const float lts0 = xsum4(l[0], lane), lts1 = xsum4(l[1], lane);
        if (hv) {
#pragma unroll
            for (int rt = 0; rt < 2; ++rt) {
                const float lt = rt ? lts1 : lts0;
                const float f = sigmoid_f(bf2f(*(const bf16*)((const char*)F.P + ((unsigned)tok[rt] * (unsigned)(NP * 2) + (unsigned)((CGL + g * 18 + hs * 3 + 1) * 2))))) / lt;
#pragma unroll
                for (int dt = 0; dt < 8; ++dt) { const int col = (g * 6 + hs) * 128 + dt * 16 + gq * 4;
                    char* mp = (char*)F.MIX1 + ((unsigned)tok[rt] * (unsigned)(DM * 2) + (unsigned)(col * 2));
                    const unsigned long long pp = *(const unsigned long long*)mp; const unsigned plo = (unsigned)pp, phi = (unsigned)(pp >> 32);
                    const unsigned long long rr = *(const unsigned long long*)((const char*)F.P + ((unsigned)tok[rt] * (unsigned)(NP * 2) + (unsigned)((CR + col) * 2))); const unsigned lo = (unsigned)rr, hi = (unsigned)(rr >> 32);
                    const float o0 = (O[rt][dt][0] * f + bf2f((bf16)(plo & 0xffff))) * silu_f(bf2f((bf16)(lo & 0xffff))), o1 = (O[rt][dt][1] * f + bf2f((bf16)(plo >> 16))) * silu_f(bf2f((bf16)(lo >> 16)));
                    const float o2 = (O[rt][dt][2] * f + bf2f((bf16)(phi & 0xffff))) * silu_f(bf2f((bf16)(hi & 0xffff))), o3 = (O[rt][dt][3] * f + bf2f((bf16)(phi >> 16))) * silu_f(bf2f((bf16)(hi >> 16)));
                    *(unsigned long long*)mp = (unsigned long long)cvtpk(o0, o1) | ((unsigned long long)cvtpk(o2, o3) << 32); }
            }
        }
    }
}

__device__ __forceinline__ void gla_g1_fast(Ctx& F) {
    int tidv = F.wave * 64 + (int)__builtin_amdgcn_mbcnt_hi(~0u, __builtin_amdgcn_mbcnt_lo(~0u, 0u)); asm volatile("" : "+v"(tidv));
    const int tid = tidv, lane = tidv & 63, c16 = lane & 15, gq = lane >> 4, wave = F.wave;
    constexpr int QP = 416, VP = 800;
    LAS float* bcum = (LAS float*)F.lds;
    LAS unsigned char* Vt = F.lds;
    LAS unsigned char* QT = F.lds + 51200;
    LAS unsigned char* KT = F.lds + 51200 + 26624;
    LAS float* eblast = (LAS float*)(F.lds + 104448);
    LAS float* tot0 = (LAS float*)(F.lds + 105216);
    LAS float* glr = (LAS float*)(F.lds + 105984);
    const float qscale = 0.07216878364870323f;
    for (int u = blockIdx.x; u < 1024; u += F.G) {
        const int n = u >> 2, h = u & 3; const size_t row0 = (size_t)n * 64;
        for (int i = tid; i < 1024; i += NTHR) glr[i] = bf2f(F.P[(row0 + (i >> 4)) * NP + CGL + (i & 15)]);
        __syncthreads();
        if (tid < 384) {
            const int seg = tid >= 192 ? 1 : 0, d = tid - 192 * seg, col = h * 192 + d; float wg[16];
#pragma unroll
            for (int j = 0; j < 16; ++j) wg[j] = F.gla_w_gate[j * 768 + col];
            const float bias = F.gla_b_gate[col]; float b = 0.f;
            for (int c = 32 * seg; c < 32 * seg + 32; ++c) { float gl = bias;
#pragma unroll
                for (int j = 0; j < 16; ++j) gl += glr[c * 16 + j] * wg[j];
                b += logsigmoid_f(gl) * (1.f / 16.f); bcum[c * 192 + d] = b; }
            if (seg == 0) tot0[d] = b;
        }
        __syncthreads();
        if (tid >= 192 && tid < 384) { const int d = tid - 192; const float t0 = tot0[d];
            for (int c = 32; c < 64; ++c) bcum[c * 192 + d] += t0; }
        __syncthreads();
        if (tid < 192) { const float eb = __expf(bcum[63 * 192 + tid]); eblast[tid] = eb; F.DEC[n * 768 + h * 192 + tid] = eb; }
#pragma unroll
        for (int i = 0; i < 3; ++i) { const int idx = tid + NTHR * i, c = idx / 24, d8 = (idx % 24) * 8;
            bf16* qg = F.P + (row0 + c) * NP + GQ + h * 192 + d8; const bf16* kg = F.P + (row0 + c) * NP + GK + h * 192 + d8;
            const v4u qr = *(const v4u*)qg, kr = *(const v4u*)kg;
            const unsigned qw[4] = {qr.x, qr.y, qr.z, qr.w}, kw[4] = {kr.x, kr.y, kr.z, kr.w}; unsigned qo[4], ko[4];
#pragma unroll
            for (int j = 0; j < 4; ++j) { const float b0 = bcum[c * 192 + d8 + 2 * j], b1 = bcum[c * 192 + d8 + 2 * j + 1];
                qo[j] = pk2(bf2f((bf16)(qw[j] & 0xffff)) * qscale * __expf(b0), bf2f((bf16)(qw[j] >> 16)) * qscale * __expf(b1));
                ko[j] = pk2(bf2f((bf16)(kw[j] & 0xffff)) * __expf(-b0), bf2f((bf16)(kw[j] >> 16)) * __expf(-b1)); }
            const v4u qv = {qo[0], qo[1], qo[2], qo[3]}, kv = {ko[0], ko[1], ko[2], ko[3]};
            *(LAS v4u*)(QT + c * QP + d8 * 2) = qv; *(LAS v4u*)(KT + c * QP + d8 * 2) = kv; *(v4u*)qg = qv; }
        __syncthreads();
#pragma unroll
        for (int i = 0; i < 6; ++i) { const int idx = tid + NTHR * i, r = idx / 48, ch = idx % 48;
            *(LAS v4u*)(Vt + r * VP + ch * 16) = *(const v4u*)(F.P + (row0 + r) * NP + GV + h * 384 + ch * 8); }
        __syncthreads();
        {
            bf16x8 vB[3][2];
#pragma unroll
            for (int j = 0; j < 3; ++j)
#pragma unroll
                for (int ks = 0; ks < 2; ++ks) { const LAS unsigned char* p = Vt + (32 * ks + 4 * gq + (c16 >> 2)) * VP + (16 * (3 * wave + j) + 4 * (c16 & 3)) * 2;
                    const s16x4 lo = vtr(p), hi = vtr(p + 16 * VP); vB[j][ks] = (bf16x8){lo[0], lo[1], lo[2], lo[3], hi[0], hi[1], hi[2], hi[3]}; }
            for (int dt = 0; dt < 12; ++dt) {
                bf16x8 aK[2];
#pragma unroll
                for (int ks = 0; ks < 2; ++ks) { const LAS unsigned char* p = KT + (32 * ks + 4 * gq + (c16 >> 2)) * QP + (16 * dt + 4 * (c16 & 3)) * 2;
                    const s16x4 lo = vtr(p), hi = vtr(p + 16 * QP); aK[ks] = (bf16x8){lo[0], lo[1], lo[2], lo[3], hi[0], hi[1], hi[2], hi[3]}; }
                const f32x4 eb = *(const LAS f32x4*)(eblast + 16 * dt + 4 * gq);
#pragma unroll
                for (int j = 0; j < 3; ++j) { f32x4 acc = {0.f, 0.f, 0.f, 0.f};
                    acc = __builtin_amdgcn_mfma_f32_16x16x32_bf16(aK[0], vB[j][0], acc, 0, 0, 0);
                    acc = __builtin_amdgcn_mfma_f32_16x16x32_bf16(aK[1], vB[j][1], acc, 0, 0, 0);
                    const int e = 16 * (3 * wave + j) + c16;
                    *(unsigned long long*)(F.STATE + ((size_t)u * 384 + e) * 192 + 16 * dt + 4 * gq) = (unsigned long long)pk2(acc[0] * eb[0], acc[1] * eb[1]) | ((unsigned long long)pk2(acc[2] * eb[2], acc[3] * eb[3]) << 32); }
            }
        }
        {
            const int ct = wave & 3, eh = wave >> 2;
            bf16x8 qB[6];
#pragma unroll
            for (int kd = 0; kd < 6; ++kd) qB[kd] = *(const LAS bf16x8*)(QT + (16 * ct + c16) * QP + (8 * gq + 32 * kd) * 2);
            f32x4 at[4];
#pragma unroll
            for (int st = 0; st < 4; ++st) { at[st] = (f32x4){0.f, 0.f, 0.f, 0.f};
                if (st <= ct) {
#pragma unroll
                    for (int kd = 0; kd < 6; ++kd) { const bf16x8 kA = *(const LAS bf16x8*)(KT + (16 * st + c16) * QP + (8 * gq + 32 * kd) * 2);
                        at[st] = __builtin_amdgcn_mfma_f32_16x16x32_bf16(kA, qB[kd], at[st], 0, 0, 0); }
#pragma unroll
                    for (int r = 0; r < 4; ++r) if (16 * st + 4 * gq + r > 16 * ct + c16) at[st][r] = 0.f;
                } }
            v4u pw0, pw1; pw0.x = pk2(at[0][0], at[0][1]); pw0.y = pk2(at[0][2], at[0][3]); pw0.z = pk2(at[1][0], at[1][1]); pw0.w = pk2(at[1][2], at[1][3]);
            pw1.x = pk2(at[2][0], at[2][1]); pw1.y = pk2(at[2][2], at[2][3]); pw1.z = pk2(at[3][0], at[3][1]); pw1.w = pk2(at[3][2], at[3][3]);
            const bf16x8 pA0 = __builtin_bit_cast(bf16x8, pw0), pA1 = __builtin_bit_cast(bf16x8, pw1);
            for (int j = 0; j < 12; ++j) { const int et = 12 * eh + j;
                bf16x8 vA[2];
#pragma unroll
                for (int ks = 0; ks < 2; ++ks) { const LAS unsigned char* p = Vt + (32 * ks + 4 * gq + (c16 >> 2)) * VP + (16 * et + 4 * (c16 & 3)) * 2;
                    const s16x4 lo = vtr(p), hi = vtr(p + 16 * VP); vA[ks] = (bf16x8){lo[0], lo[1], lo[2], lo[3], hi[0], hi[1], hi[2], hi[3]}; }
                f32x4 acc = {0.f, 0.f, 0.f, 0.f};
                acc = __builtin_amdgcn_mfma_f32_16x16x32_bf16(vA[0], pA0, acc, 0, 0, 0);
                acc = __builtin_amdgcn_mfma_f32_16x16x32_bf16(vA[1], pA1, acc, 0, 0, 0);
                *(unsigned long long*)(F.OI + (row0 + 16 * ct + c16) * 1536 + h * 384 + 16 * et + 4 * gq) = (unsigned long long)pk2(acc[0], acc[1]) | ((unsigned long long)pk2(acc[2], acc[3]) << 32); }
        }
        __syncthreads();
    }
}

__device__ __forceinline__ void gla_g3_fast(Ctx& F) {
    int tidv = F.wave * 64 + (int)__builtin_amdgcn_mbcnt_hi(~0u, __builtin_amdgcn_mbcnt_lo(~0u, 0u)); asm volatile("" : "+v"(tidv));
    const int lane = tidv & 63, c16 = lane & 15, gq = lane >> 4, wave = F.wave, ct = wave & 3, eh = wave >> 2;
    LAS float* ssq = (LAS float*)F.lds;
    for (int u = blockIdx.x; u < 1024; u += F.G) {
        const int n = u >> 2, h = u & 3; const size_t crow = (size_t)n * 64 + 16 * ct + c16;
        f32x4 acc[12];
#pragma unroll
        for (int j = 0; j < 12; ++j) acc[j] = (f32x4){0.f, 0.f, 0.f, 0.f};
        if (n > 0) {
            bf16x8 qB[6];
#pragma unroll
            for (int kd = 0; kd < 6; ++kd) qB[kd] = *(const bf16x8*)(F.P + crow * NP + GQ + h * 192 + 8 * gq + 32 * kd);
            const bf16* Sp = F.STATE + ((size_t)(u - 4) * 384 + 192 * eh + c16) * 192 + 8 * gq;
#pragma unroll
            for (int j = 0; j < 12; ++j)
#pragma unroll
                for (int kd = 0; kd < 6; ++kd) { const bf16x8 a = *(const bf16x8*)(Sp + (size_t)(16 * j) * 192 + 32 * kd);
                    acc[j] = __builtin_amdgcn_mfma_f32_16x16x32_bf16(a, qB[kd], acc[j], 0, 0, 0); }
        }
        float ss = 0.f;
#pragma unroll
        for (int j = 0; j < 12; ++j) { const int e0 = h * 384 + 192 * eh + 16 * j + 4 * gq;
            const unsigned long long oi = *(const unsigned long long*)(F.OI + crow * 1536 + e0); const unsigned lo = (unsigned)oi, hi = (unsigned)(oi >> 32);
            acc[j][0] += bf2f((bf16)(lo & 0xffff)); acc[j][1] += bf2f((bf16)(lo >> 16)); acc[j][2] += bf2f((bf16)(hi & 0xffff)); acc[j][3] += bf2f((bf16)(hi >> 16));
            ss += (acc[j][0] * acc[j][0] + acc[j][1] * acc[j][1]) + (acc[j][2] * acc[j][2] + acc[j][3] * acc[j][3]); }
        ss += __shfl_xor(ss, 16); ss += __shfl_xor(ss, 32);
        if (gq == 0) ssq[eh * 64 + 16 * ct + c16] = ss;
        __syncthreads();
        const float rstd = rsqrtf((ssq[16 * ct + c16] + ssq[64 + 16 * ct + c16]) * (1.f / 384.f) + EPS);
#pragma unroll
        for (int j = 0; j < 12; ++j) { const int el = 192 * eh + 16 * j + 4 * gq, e0 = h * 384 + el;
            const f32x4 gn = *(const f32x4*)(F.gla_norm + el);
            const unsigned long long rr = *(const unsigned long long*)(F.P + crow * NP + CR + e0); const unsigned lo = (unsigned)rr, hi = (unsigned)(rr >> 32);
            const float o0 = acc[j][0] * rstd * gn[0] * silu_f(bf2f((bf16)(lo & 0xffff))), o1 = acc[j][1] * rstd * gn[1] * silu_f(bf2f((bf16)(lo >> 16)));
            const float o2 = acc[j][2] * rstd * gn[2] * silu_f(bf2f((bf16)(hi & 0xffff))), o3 = acc[j][3] * rstd * gn[3] * silu_f(bf2f((bf16)(hi >> 16)));
            *(unsigned long long*)(F.MIX0 + crow * DM + e0) = (unsigned long long)pk2(o0, o1) | ((unsigned long long)pk2(o2, o3) << 32); }
        __syncthreads();
    }
}


__device__ __forceinline__ void memkv_fast(Ctx& F) {
    int tidv = F.wave * 64 + (int)__builtin_amdgcn_mbcnt_hi(~0u, __builtin_amdgcn_mbcnt_lo(~0u, 0u)); asm volatile("" : "+v"(tidv));
    const int lane = tidv & 63, c16 = lane & 15, gq = lane >> 4;
    for (int u = F.gw; u < 2048; u += F.NGW) {
        const int layer = u >> 10, mt = (u >> 6) & 15, ntile = u & 63;
        const float* ar = F.mem + (size_t)(16 * mt + c16) * DM + 8 * gq; const float* gr = F.ln_mem + layer * DM + 8 * gq;
        const bf16* br = F.WMKV + ((size_t)layer * 1024 + 16 * ntile + c16) * DM + 8 * gq;
        f32x4 acc = {0.f, 0.f, 0.f, 0.f}; float ss = 0.f;
#pragma unroll 4
        for (int ks = 0; ks < 64; ++ks) {
            const f32x4 a0 = *(const f32x4*)(ar + 32 * ks), a1 = *(const f32x4*)(ar + 32 * ks + 4), g0 = *(const f32x4*)(gr + 32 * ks), g1 = *(const f32x4*)(gr + 32 * ks + 4);
            ss += (a0.x * a0.x + a0.y * a0.y) + (a0.z * a0.z + a0.w * a0.w) + (a1.x * a1.x + a1.y * a1.y) + (a1.z * a1.z + a1.w * a1.w);
            v4u aw; aw.x = pk2(a0.x * g0.x, a0.y * g0.y); aw.y = pk2(a0.z * g0.z, a0.w * g0.w); aw.z = pk2(a1.x * g1.x, a1.y * g1.y); aw.w = pk2(a1.z * g1.z, a1.w * g1.w);
            const bf16x8 bfr = *(const bf16x8*)(br + 32 * ks);
            acc = __builtin_amdgcn_mfma_f32_16x16x32_bf16(__builtin_bit_cast(bf16x8, aw), bfr, acc, 0, 0, 0);
        }
        ss += __shfl_xor(ss, 16); ss += __shfl_xor(ss, 32);
        const float rs = rsqrtf(ss * (1.f / DM) + EPS);
        const int n = 16 * ntile + c16, kv = n >> 9, h = (n >> 7) & 3, d = n & 127;
#pragma unroll
        for (int r = 0; r < 4; ++r) { const int ml = 4 * gq + r; const float rr = __shfl(rs, ml);
            F.MEMKV[((((size_t)layer * 2 + kv) * 4 + h) * NMEM + 16 * mt + ml) * 128 + d] = f2b(acc[r] * rr); }
    }
}

__device__ __forceinline__ void nsa_compress_fast(Ctx& F) {
    int tidv = F.wave * 64 + (int)__builtin_amdgcn_mbcnt_hi(~0u, __builtin_amdgcn_mbcnt_lo(~0u, 0u)); asm volatile("" : "+v"(tidv));
    const int lane = tidv & 63, c16 = lane & 15, gq = lane >> 4, wave = F.wave;
    LAS unsigned char* hid = F.lds;
    constexpr int HP = 544;
    for (int u = blockIdx.x; u < 256; u += F.G) {
        const int kv = u & 1, g = (u >> 1) & 1, nt16 = u >> 2;
        const bf16* W1T = kv ? F.WV1T : F.WK1T; const float* w2 = kv ? F.wv2 : F.wk2; const float* hb = F.HB + kv * 32 * 256;
        const int n = min(16 * nt16 + c16, 1022);
        const bf16* ar = F.CP + (size_t)(kv * 2 + g) * PLANE + (size_t)(16 * n) * 128 + 8 * gq;
        const bf16* b0 = W1T + (size_t)(32 * wave + c16) * 4096 + 8 * gq; const bf16* b1 = b0 + (size_t)16 * 4096;
        f32x4 acc0 = {0.f, 0.f, 0.f, 0.f}, acc1 = {0.f, 0.f, 0.f, 0.f};
        for (int l = 0; l < 32; ++l) {
#pragma unroll
            for (int kd = 0; kd < 4; ++kd) { const bf16x8 a = *(const bf16x8*)(ar + l * 128 + 32 * kd);
                const bf16x8 w0 = *(const bf16x8*)(b0 + l * 128 + 32 * kd), w1 = *(const bf16x8*)(b1 + l * 128 + 32 * kd);
                acc0 = __builtin_amdgcn_mfma_f32_16x16x32_bf16(a, w0, acc0, 0, 0, 0); acc1 = __builtin_amdgcn_mfma_f32_16x16x32_bf16(a, w1, acc1, 0, 0, 0); }
        }
        { const int j0 = 32 * wave + c16; float h0 = 0.f, h1 = 0.f;
#pragma unroll 8
          for (int s = 0; s < 32; ++s) { h0 += hb[s * 256 + j0]; h1 += hb[s * 256 + j0 + 16]; }
#pragma unroll
          for (int r = 0; r < 4; ++r) { *(LAS bf16*)(hid + (4 * gq + r) * HP + j0 * 2) = f2b(silu_f(acc0[r] + h0)); *(LAS bf16*)(hid + (4 * gq + r) * HP + (j0 + 16) * 2) = f2b(silu_f(acc1[r] + h1)); } }
        __syncthreads();
        { f32x4 acc = {0.f, 0.f, 0.f, 0.f}; const int d = 16 * wave + c16;
#pragma unroll
          for (int ks = 0; ks < 8; ++ks) { const bf16x8 a = *(const LAS bf16x8*)(hid + c16 * HP + (8 * gq + 32 * ks) * 2);
              const float* wp = w2 + (size_t)(8 * gq + 32 * ks) * 128 + d;
              v4u bw; bw.x = pk2(wp[0], wp[128]); bw.y = pk2(wp[256], wp[384]); bw.z = pk2(wp[512], wp[640]); bw.w = pk2(wp[768], wp[896]);
              acc = __builtin_amdgcn_mfma_f32_16x16x32_bf16(a, __builtin_bit_cast(bf16x8, bw), acc, 0, 0, 0); }
          bf16* outp = (kv ? F.VCMP : F.KCMP) + (size_t)g * 1024 * 128;
#pragma unroll
          for (int r = 0; r < 4; ++r) { const int nn = 16 * nt16 + 4 * gq + r; if (nn < 1023) outp[(size_t)nn * 128 + d] = f2b(acc[r]); } }
        __syncthreads();
    }
}


__device__ __forceinline__ void load_ptrs(Ctx& F) {
    typedef const float* cfp;
    const volatile __attribute__((address_space(4))) cfp* ka = (const volatile __attribute__((address_space(4))) cfp*)__builtin_amdgcn_kernarg_segment_ptr();
    F.x = ka[0]; F.mem = ka[1]; F.ln_pre = ka[2]; F.ln_post = ka[3]; F.ln_mem = ka[4]; F.w_mem_kv = ka[5];
    F.gla_w_in = ka[6]; F.gla_w_gate = ka[7]; F.gla_b_gate = ka[8]; F.gla_norm = ka[9]; F.gla_w_out = ka[10];
    F.nsa_w_in = ka[11]; F.pe_k = ka[12]; F.pe_v = ka[13]; F.wk1 = ka[14]; F.wk2 = ka[15]; F.wv1 = ka[16]; F.wv2 = ka[17]; F.nsa_w_out = ka[18];
    F.out = (float*)ka[19]; F.ws = (unsigned char*)ka[20];
    unsigned char* ws = F.ws;
    F.WIN0 = (bf16*)(ws + WS_WIN0); F.WIN1 = (bf16*)(ws + WS_WIN1); F.WOUT0 = (bf16*)(ws + WS_WOUT0); F.WOUT1 = (bf16*)(ws + WS_WOUT1); F.WMKV = (bf16*)(ws + WS_WMKV);
    F.WK1T = (bf16*)(ws + WS_WK1T); F.WV1T = (bf16*)(ws + WS_WV1T); F.HB = (float*)(ws + WS_SEL);
    F.MEMKV = (bf16*)(ws + WS_MEMKV); F.DEC = (float*)(ws + WS_DEC); F.KCMP = (bf16*)(ws + WS_KCMP); F.VCMP = (bf16*)(ws + WS_VCMP);
    F.XN = (bf16*)(ws + WS_XN); F.P = (bf16*)(ws + WS_P); F.STATE = (bf16*)(ws + WS_STATE); F.MIX1 = (bf16*)(ws + WS_MIX1); F.CP = (bf16*)(ws + WS_CP);
    F.MIX0 = (bf16*)((unsigned char*)F.out + DO_MIX0); F.OI = (bf16*)((unsigned char*)F.out + DO_OI);
}
__global__ void __launch_bounds__(NTHR, 2) fwd_kernel(Args args) {
    extern __shared__ __attribute__((aligned(16))) unsigned char lds_raw[];
    Ctx F;
    F.lds = (LAS unsigned char*)lds_raw;
    F.tid = threadIdx.x; F.lane = F.tid & 63; F.wave = __builtin_amdgcn_readfirstlane(F.tid >> 6);
    F.G = gridDim.x; F.gw = blockIdx.x * NWAVES + F.wave; F.NGW = F.G * NWAVES;
    load_ptrs(F);
    unsigned char* ws = F.ws;

    volatile LAS unsigned* MISC = (volatile LAS unsigned*)(F.lds + MISC_OFF);
    for (int u = F.tid; u < (LDS_BYTES - LDSCTL_OFF) / 4; u += NTHR) ((LAS unsigned*)(F.lds + LDSCTL_OFF))[u] = 0u;
    __syncthreads();
    const int lo = args.ph_lo, hi = args.ph_hi;
    XcdBarrier bar; bar.bar = (unsigned*)(ws + WS_CTL); bar.x = 0; bar.st = nullptr;
    if (hi - lo > 1) bar = xcd_barrier_post((unsigned*)(ws + WS_CTL), MISC + 8, F.wave);
#define IN(k) (lo <= (k) && (k) < hi)
#define REFRESH() do { int t_ = F.wave * 64 + (int)__builtin_amdgcn_mbcnt_hi(~0u, __builtin_amdgcn_mbcnt_lo(~0u, 0u)); asm volatile("" : "+v"(t_)); F.tid = t_; F.lane = t_ & 63; load_ptrs(F); } while (0)
#define SEAM(k) do { if (IN(k) && IN((k) + 1)) xcd_barrier(bar, F.wave); } while (0)

    if (IN(0)) { REFRESH(); phase_prep(F); } SEAM(0);
    if (IN(1)) { REFRESH(); memkv_fast(F); REFRESH();
        pg8::Gemm g{F.XN, F.WIN0, T, NP, DM, F.wave}; pg8::StaticOrder S; S.init(T, NP, F.G, (int)blockIdx.x);
        pg8::EpiBf16<0> E{F.P, NP, nullptr, 0, 0, 1.f};
        pg8::gemm_phase<pg8::EpiBf16<0>, pg8::StaticOrder, true, true>(F.lds, g, S, E); } SEAM(1);
    if (IN(2)) { REFRESH(); gla_g1_fast(F); REFRESH(); cross_fast(F, 0, F.MIX0); } SEAM(2);
    if (IN(3)) { REFRESH(); gla_scan(F); } SEAM(3);
    if (IN(4)) { REFRESH(); gla_g3_fast(F); } SEAM(4);
    if (IN(5)) { REFRESH(); pg8::Gemm g{F.MIX0, F.WOUT0, T, DM, DM, F.wave}; pg8::StaticOrder S; S.init(T, DM, F.G, (int)blockIdx.x);
        pg8::EpiBf16<0> E{F.XN, DM, nullptr, 0, 0, 1.f};
        pg8::gemm_phase<pg8::EpiBf16<0>, pg8::StaticOrder, true, true>(F.lds, g, S, E); } SEAM(5);
    if (IN(6)) { REFRESH(); post_rows(F, F.x, F.XN, F.ln_post, F.out, F.ln_pre + DM, F.XN); } SEAM(6);
    if (IN(7)) { REFRESH(); pg8::Gemm g{F.XN, F.WIN1, T, NP, DM, F.wave}; pg8::StaticOrder S; S.init(T, NP, F.G, (int)blockIdx.x);
        EpiNsaIn E{F.P, NP, F.CP};
        pg8::gemm_phase<EpiNsaIn, pg8::StaticOrder, true, true>(F.lds, g, S, E); } SEAM(7);
    if (IN(8)) { REFRESH(); nsa_compress_fast(F); } SEAM(8);
    if (IN(9)) { REFRESH(); nsa_main_fast(F); REFRESH(); cross_fast(F, 1, F.MIX1); } SEAM(9);
    if (IN(10)) { REFRESH(); pg8::Gemm g{F.MIX1, F.WOUT1, T, DM, DM, F.wave}; pg8::StaticOrder S; S.init(T, DM, F.G, (int)blockIdx.x);
        pg8::EpiBf16<0> E{F.XN, DM, nullptr, 0, 0, 1.f};
        pg8::gemm_phase<pg8::EpiBf16<0>, pg8::StaticOrder, true, true>(F.lds, g, S, E); } SEAM(10);
    if (IN(11)) { REFRESH(); post_rows(F, F.out, F.XN, F.ln_post + DM, F.out, nullptr, nullptr); }
#undef IN
#undef SEAM
}

#ifndef N_LAUNCHES
#define N_LAUNCHES 1
#endif
extern "C" void kernel_launch(void* const* d_in, const int* in_sizes, int n_in, void* d_out, int out_size, void* d_ws, size_t ws_size, hipStream_t stream) {
    static int grid = 0;
    if (grid == 0) {
        if (n_in != 19 || out_size != T * DM || ws_size < WS_END) { fprintf(stderr, "kernel_launch: unexpected shapes (n_in %d out %d ws %zu)\n", n_in, out_size, ws_size); grid = -1; return; }
        int dev = 0, cus = 0, per_cu = 0;
        if (hipGetDevice(&dev) != hipSuccess || hipDeviceGetAttribute(&cus, hipDeviceAttributeMultiprocessorCount, dev) != hipSuccess) { grid = -1; return; }
        if (hipFuncSetAttribute((const void*)fwd_kernel, hipFuncAttributeMaxDynamicSharedMemorySize, LDS_BYTES) != hipSuccess) { fprintf(stderr, "kernel_launch: hipFuncSetAttribute failed\n"); grid = -1; return; }
        if (hipOccupancyMaxActiveBlocksPerMultiprocessor(&per_cu, (const void*)fwd_kernel, NTHR, LDS_BYTES) != hipSuccess || per_cu < 1) fprintf(stderr, "kernel_launch: occupancy query reports %d\n", per_cu);
        (void)hipGetLastError();
        grid = cus;
    }
    if (grid < 0) return;
    if (hipMemsetAsync((char*)d_ws + WS_CTL, 0, CTL_ZERO_BYTES, stream) != hipSuccess) return;
    Args a{};
    for (int i = 0; i < 19; ++i) a.in[i] = (const float*)d_in[i];
    a.out = (float*)d_out; a.ws = (unsigned char*)d_ws;
    for (int li = 0; li < N_LAUNCHES; ++li) {
        a.ph_lo = li * N_PHASES / N_LAUNCHES; a.ph_hi = (li + 1) * N_PHASES / N_LAUNCHES;
        hipLaunchKernelGGL(fwd_kernel, dim3(grid), dim3(NTHR), LDS_BYTES, stream, a);
    }
}
```

```cpp
#include <hip/hip_runtime.h>
#include <cstdio>
#include <cstdint>
namespace pg8 {
#define PG8_LAS __attribute__((address_space(3)))
typedef unsigned short bf16_t;
typedef short bf16x8 __attribute__((ext_vector_type(8)));
typedef float f32x4 __attribute__((ext_vector_type(4)));
typedef unsigned u32x4 __attribute__((ext_vector_type(4)));
constexpr int BM = 256, BK = 64, HALF = 128, HTB = HALF * BK * 2  , STAGE_BYTES = 8 * HTB, NXCD = 8, WGM = 8;

__host__ __device__ __forceinline__ int lds_byte(int r, int c) { const int st = (r >> 4) * 2 + (c >> 5), rr = r & 15, cc = c & 31, ob = rr * 64 + cc * 2; return st * 1024 + (ob ^ (((ob >> 9) & 1) << 5)); }
__host__ __device__ __forceinline__ void stage_rc(int b, int& R, int& C) { const int st = b / 1024, sb = b % 1024, swz = sb ^ (((sb >> 9) & 1) << 5); R = (st >> 1) * 16 + swz / 64; C = (st & 1) * 32 + (swz % 64) / 2; }
__host__ __device__ __forceinline__ int perm32(int rho) { const int n = rho >> 4, i = rho & 15; return 8 * (i >> 2) + 4 * n + (i & 3); }

struct Unit { int pm, pn; };
struct Gemm { const bf16_t* A; const bf16_t* Bt; int M, N, K; int wave; };

struct StaticOrder {
    int nM, nN, nwg, G, c;
    __host__ __device__ void init(int M, int N, int G_, int c_) { nM = M / BM; nN = N / BM; nwg = nM * nN; G = G_; c = c_; }
    __host__ __device__ bool next(int i, Unit& u) const {
        const long L = (long)i * G + c; if (L >= nwg) return false;
        int wgid = (int)L; { const int q = nwg / NXCD, r = nwg % NXCD, xcd = wgid % NXCD, off = wgid / NXCD; wgid = (xcd < r ? xcd * (q + 1) : r * (q + 1) + (xcd - r) * q) + off; }
        const int nig = WGM * nN, gid = wgid / nig, fm = gid * WGM, gsz = (nM - fm) < WGM ? (nM - fm) : WGM;
        u.pm = fm + ((wgid % nig) % gsz); u.pn = (wgid % nig) / gsz; return true;
    }
    __device__ __forceinline__ void a_ready(const Unit&) const {}
    __device__ __forceinline__ void done(const Unit&) const {}
};

__device__ __forceinline__ unsigned cvt_pk_bf16(float lo, float hi) { unsigned r; asm volatile("v_cvt_pk_bf16_f32 %0, %1, %2" : "=v"(r) : "v"(lo), "v"(hi)); return r; }
typedef float f32x2 __attribute__((ext_vector_type(2)));
__device__ __forceinline__ f32x2 gelu_pk(f32x2 v) {
    const f32x2 av = __builtin_elementwise_abs(v), d = av * 0.2316418882f + 1.0f;
    f32x2 t; t.x = __builtin_amdgcn_rcpf(d.x); t.y = __builtin_amdgcn_rcpf(d.y);
    f32x2 q = t * 0.5307027145f + (-0.7265760135f); q = q * t + 0.7107068705f; q = q * t + (-0.142248368f); q = q * t + 0.127414796f; q = q * t;
    const f32x2 s = (v * v) * (-0.72134752044f);
    f32x2 e; e.x = __builtin_amdgcn_exp2f(s.x); e.y = __builtin_amdgcn_exp2f(s.y);
    const f32x2 m = v * (q * e), r = v - m;
    f32x2 o; o.x = v.x < 0.f ? m.x : r.x; o.y = v.y < 0.f ? m.y : r.y; return o;
}

template <int ACT  > struct EpiBf16 {
    static constexpr bool PERM = true, AFTER_DRAIN = false; static_assert(ACT == 0 || ACT == 1, "EpiBf16: ACT is 0 (none) or 1 (gelu_pk)");
    bf16_t* O; int ldc; const float* bias; int split_cols; size_t split_stride; float scale0;
    __device__ __forceinline__ void operator()(const f32x4 (&acc)[2][2][4][2], const Unit& u, int wr, int wc, int fr, int fq) const {
        const int row0 = u.pm * BM + wr * 64 + fr; int colt = u.pn * BM; bf16_t* base = O;
        float sc = 1.f; if (split_cols) { const int t = colt / split_cols; base += (size_t)t * split_stride; colt -= t * split_cols; if (t == 0) sc = scale0; }
        const int col0 = colt + wc * 32 + 8 * fq, bcol0 = u.pn * BM + wc * 32 + 8 * fq;
        f32x4 bv[2][2];
#pragma unroll
        for (int bj = 0; bj < 2; ++bj)
#pragma unroll
            for (int n = 0; n < 2; ++n) bv[bj][n] = bias ? *(const f32x4*)(bias + bcol0 + bj * HALF + 4 * n) : (f32x4){0.f, 0.f, 0.f, 0.f};
#pragma unroll
        for (int ai = 0; ai < 2; ++ai)
#pragma unroll
            for (int m = 0; m < 4; ++m) { bf16_t* rowp = base + (size_t)(row0 + ai * HALF + m * 16) * ldc + col0;
#pragma unroll
                for (int bj = 0; bj < 2; ++bj) { f32x4 v0 = acc[ai][bj][m][0] + bv[bj][0], v1 = acc[ai][bj][m][1] + bv[bj][1];
                    if (ACT == 1) { f32x2 a = gelu_pk((f32x2){v0[0], v0[1]}), b = gelu_pk((f32x2){v0[2], v0[3]}), c = gelu_pk((f32x2){v1[0], v1[1]}), d = gelu_pk((f32x2){v1[2], v1[3]});
                        v0 = (f32x4){a.x, a.y, b.x, b.y}; v1 = (f32x4){c.x, c.y, d.x, d.y}; }
                    v0 = v0 * sc; v1 = v1 * sc; u32x4 w; w.x = cvt_pk_bf16(v0[0], v0[1]); w.y = cvt_pk_bf16(v0[2], v0[3]); w.z = cvt_pk_bf16(v1[0], v1[1]); w.w = cvt_pk_bf16(v1[2], v1[3]);
                    *(u32x4*)(rowp + bj * HALF) = w; } }
    }
};

template <class Epi, class Sched, bool ALIGN_EPI = false, bool SP2 = false>
__device__ __forceinline__ void gemm_phase(PG8_LAS unsigned char* lds, const Gemm g, const Sched& S, const Epi& E) {
    const int wid = g.wave, lane = (int)__builtin_amdgcn_mbcnt_hi(~0u, __builtin_amdgcn_mbcnt_lo(~0u, 0u)), tid = wid * 64 + lane, wr = wid >> 2, wc = wid & 3, fr = lane & 15, fq = lane >> 4;
    const int K = g.K, nt = K / BK;
    unsigned voffA[2], voffB[2];
#pragma unroll
    for (int i = 0; i < 2; ++i) { int R, C; stage_rc(tid * 16 + i * 8192, R, C); const int Rb = Epi::PERM ? ((R & ~31) + perm32(R & 31)) : R;
        voffA[i] = (unsigned)(R * K + C) * 2u; voffB[i] = (unsigned)(Rb * K + C) * 2u; }
    const size_t kstep = (size_t)(BK * 2);
    const size_t hstep = (size_t)HALF * K * 2;
    const size_t tstep = 2 * hstep;
    const unsigned ldsw = (unsigned)wid * 1024u;
    const int aoff = lds_byte(wr * 64 + fr, fq * 8), boff = lds_byte(wc * 32 + fr, fq * 8);
#define PG8_SA(b, h) (((b) * 2 + (h)) * HTB)
#define PG8_SB(b, h) ((4 + (b) * 2 + (h)) * HTB)
#define PG8_STAGE(bufoff, gbase, voff) do { _Pragma("unroll") for (int _i = 0; _i < 2; ++_i) \
        __builtin_amdgcn_global_load_lds((const unsigned*)((const char*)(gbase) + (voff)[_i]), (PG8_LAS unsigned*)(lds + (bufoff) + ldsw + _i * 8192), 16, 0, 0); } while (0)
#define PG8_LDA(dst, b, h) do { _Pragma("unroll") for (int m = 0; m < 4; ++m) _Pragma("unroll") for (int k = 0; k < 2; ++k) dst[m][k] = *(const PG8_LAS bf16x8*)(lds + PG8_SA(b, h) + aoff + m * 2048 + k * 1024); } while (0)
#define PG8_LDB(dst, b, h) do { _Pragma("unroll") for (int n = 0; n < 2; ++n) _Pragma("unroll") for (int k = 0; k < 2; ++k) dst[n][k] = *(const PG8_LAS bf16x8*)(lds + PG8_SB(b, h) + boff + n * 2048 + k * 1024); } while (0)
#define PG8_MMA(ai, bj, At, Bt) do { __builtin_amdgcn_s_setprio(1); _Pragma("unroll") for (int m = 0; m < 4; ++m) _Pragma("unroll") for (int n = 0; n < 2; ++n) _Pragma("unroll") for (int k = 0; k < 2; ++k) \
        acc[ai][bj][m][n] = __builtin_amdgcn_mfma_f32_16x16x32_bf16(Bt[n][k], At[m][k], acc[ai][bj][m][n], 0, 0, 0); __builtin_amdgcn_s_setprio(0); } while (0)
#define PG8_WAIT_V(n) asm volatile("s_waitcnt vmcnt(" #n ")" ::: "memory")
#define PG8_WAIT_L(n) asm volatile("s_waitcnt lgkmcnt(" #n ")" ::: "memory")
#define PG8_BAR __builtin_amdgcn_s_barrier()
#define PG8_SCHED __builtin_amdgcn_sched_barrier(0)
    Unit cur, nxt; int ui = 0;
    if (!S.next(0, cur)) return;
    f32x4 acc[2][2][4][2];
#pragma unroll
    for (int a = 0; a < 2; ++a)
#pragma unroll
        for (int b = 0; b < 2; ++b)
#pragma unroll
            for (int m = 0; m < 4; ++m)
#pragma unroll
                for (int n = 0; n < 2; ++n) acc[a][b][m][n] = (f32x4){0.f, 0.f, 0.f, 0.f};
    bf16x8 At[4][2], B0[2][2], B1[2][2];
    const char* cA = (const char*)g.A + (size_t)cur.pm * tstep; const char* cB = (const char*)g.Bt + (size_t)cur.pn * tstep;
    S.a_ready(cur);
    if constexpr (SP2) {
        PG8_STAGE(PG8_SB(0, 0), cB, voffB); PG8_STAGE(PG8_SB(0, 1), cB + hstep, voffB); PG8_STAGE(PG8_SA(0, 0), cA, voffA); PG8_STAGE(PG8_SA(0, 1), cA + hstep, voffA);
        if (wr == 1) PG8_BAR;
        PG8_WAIT_V(2); PG8_BAR;
        PG8_STAGE(PG8_SB(1, 0), cB + kstep, voffB); PG8_STAGE(PG8_SA(1, 0), cA + kstep, voffA); PG8_STAGE(PG8_SB(1, 1), cB + hstep + kstep, voffB);
        PG8_WAIT_V(6); PG8_BAR;
    } else {
        PG8_STAGE(PG8_SB(0, 0), cB, voffB); PG8_STAGE(PG8_SA(0, 0), cA, voffA); PG8_STAGE(PG8_SB(0, 1), cB + hstep, voffB); PG8_STAGE(PG8_SA(0, 1), cA + hstep, voffA);
        if (wr == 1) PG8_BAR;
        PG8_WAIT_V(4); PG8_BAR;
        PG8_STAGE(PG8_SB(1, 0), cB + kstep, voffB); PG8_STAGE(PG8_SA(1, 0), cA + kstep, voffA); PG8_STAGE(PG8_SB(1, 1), cB + hstep + kstep, voffB);
        PG8_WAIT_V(6); PG8_BAR;
    }
    for (;;) {
        const bool has_next = S.next(ui + 1, nxt);
        const char* nA = has_next ? (const char*)g.A + (size_t)nxt.pm * tstep : cA; const char* nB = has_next ? (const char*)g.Bt + (size_t)nxt.pn * tstep : cB;
        for (int t = 0; t < nt; t += 2) {
            const bool last = (t == nt - 2);
            const char* a1 = cA + (size_t)(t + 1) * kstep;
            const char* a2 = last ? nA : cA + (size_t)(t + 2) * kstep; const char* b2 = last ? nB : cB + (size_t)(t + 2) * kstep;
            const char* a3 = a2 + kstep; const char* b3 = b2 + kstep;
            if (last && has_next) S.a_ready(nxt);
            if constexpr (SP2) {
            PG8_LDB(B0, 0, 0); PG8_LDB(B1, 0, 1); PG8_SCHED; PG8_LDA(At, 0, 0); PG8_STAGE(PG8_SA(1, 1), a1 + hstep, voffA);
            PG8_WAIT_V(8); PG8_WAIT_L(0); PG8_BAR; PG8_MMA(0, 0, At, B0); PG8_MMA(0, 1, At, B1); PG8_BAR; PG8_SCHED;
            PG8_LDA(At, 0, 1); PG8_STAGE(PG8_SB(0, 0), b2, voffB); PG8_STAGE(PG8_SB(0, 1), b2 + hstep, voffB); PG8_STAGE(PG8_SA(0, 0), a2, voffA);
            PG8_WAIT_V(8); PG8_WAIT_L(0); PG8_BAR; PG8_MMA(1, 0, At, B0); PG8_MMA(1, 1, At, B1); PG8_BAR; PG8_SCHED;
            PG8_LDB(B0, 1, 0); PG8_LDB(B1, 1, 1); PG8_SCHED; PG8_LDA(At, 1, 0); PG8_STAGE(PG8_SA(0, 1), a2 + hstep, voffA);
            PG8_WAIT_V(8); PG8_WAIT_L(0); PG8_BAR; PG8_MMA(0, 0, At, B0); PG8_MMA(0, 1, At, B1); PG8_BAR; PG8_SCHED;
            PG8_LDA(At, 1, 1); PG8_STAGE(PG8_SB(1, 0), b3, voffB); PG8_STAGE(PG8_SB(1, 1), b3 + hstep, voffB); PG8_STAGE(PG8_SA(1, 0), a3, voffA);
            PG8_WAIT_V(8); PG8_WAIT_L(0); PG8_BAR; PG8_MMA(1, 0, At, B0); PG8_MMA(1, 1, At, B1); PG8_BAR; PG8_SCHED;
            } else {
            PG8_LDB(B0, 0, 0); PG8_SCHED; PG8_LDA(At, 0, 0); PG8_STAGE(PG8_SA(1, 1), a1 + hstep, voffA);
            PG8_WAIT_L(8); PG8_BAR; PG8_WAIT_L(0); PG8_MMA(0, 0, At, B0); PG8_BAR; PG8_SCHED;
            PG8_LDB(B1, 0, 1); PG8_STAGE(PG8_SB(0, 0), b2, voffB);
            PG8_BAR; PG8_WAIT_L(0); PG8_MMA(0, 1, At, B1); PG8_BAR;
            PG8_LDA(At, 0, 1); PG8_STAGE(PG8_SA(0, 0), a2, voffA);
            PG8_BAR; PG8_WAIT_L(0); PG8_MMA(1, 0, At, B0); PG8_BAR; PG8_SCHED;
            PG8_STAGE(PG8_SB(0, 1), b2 + hstep, voffB);
            PG8_WAIT_V(6); PG8_BAR; PG8_MMA(1, 1, At, B1); PG8_BAR;
            PG8_LDB(B0, 1, 0); PG8_SCHED; PG8_LDA(At, 1, 0); PG8_STAGE(PG8_SA(0, 1), a2 + hstep, voffA);
            PG8_WAIT_L(8); PG8_BAR; PG8_WAIT_L(0); PG8_MMA(0, 0, At, B0); PG8_BAR; PG8_SCHED;
            PG8_LDB(B1, 1, 1); PG8_STAGE(PG8_SB(1, 0), b3, voffB);
            PG8_BAR; PG8_WAIT_L(0); PG8_MMA(0, 1, At, B1); PG8_BAR;
            PG8_LDA(At, 1, 1); PG8_STAGE(PG8_SA(1, 0), a3, voffA);
            PG8_BAR; PG8_WAIT_L(0); PG8_MMA(1, 0, At, B0); PG8_BAR; PG8_SCHED;
            PG8_STAGE(PG8_SB(1, 1), b3 + hstep, voffB);
            PG8_WAIT_V(6); PG8_BAR; PG8_MMA(1, 1, At, B1); PG8_BAR;
            }
        }
        if constexpr (ALIGN_EPI) { if (wr == 0) PG8_BAR; }
        if constexpr (!Epi::AFTER_DRAIN) { E(acc, cur, wr, wc, fr, fq); S.done(cur); }
        if (!has_next) break;
#pragma unroll
        for (int a = 0; a < 2; ++a)
#pragma unroll
            for (int b = 0; b < 2; ++b)
#pragma unroll
                for (int m = 0; m < 4; ++m)
#pragma unroll
                    for (int n = 0; n < 2; ++n) acc[a][b][m][n] = (f32x4){0.f, 0.f, 0.f, 0.f};
        cur = nxt; cA = nA; cB = nB; ++ui;
        if constexpr (ALIGN_EPI) { if (wr == 1) PG8_BAR; }
    }
    PG8_WAIT_V(0);
    if constexpr (!ALIGN_EPI) { if (wr == 0) PG8_BAR; }
    PG8_BAR;
    if constexpr (Epi::AFTER_DRAIN) { E.fused(acc, cur, wr, wc, fr, fq, lds, wid, lane); S.done(cur); }
#undef PG8_SA
#undef PG8_SB
#undef PG8_STAGE
#undef PG8_LDA
#undef PG8_LDB
#undef PG8_MMA
#undef PG8_WAIT_V
#undef PG8_WAIT_L
#undef PG8_BAR
#undef PG8_SCHED
}
}
#define GAS __attribute__((address_space(1)))
#define LAS __attribute__((address_space(3)))
typedef unsigned short bf16;
typedef unsigned v4u __attribute__((ext_vector_type(4)));
typedef float f32x4 __attribute__((ext_vector_type(4)));
typedef short bf16x8 __attribute__((ext_vector_type(8)));
typedef GAS unsigned gu32;
typedef GAS unsigned long long gu64;
#define RLX_AGENT __ATOMIC_RELAXED, __HIP_MEMORY_SCOPE_AGENT
#define LDS_WAIT() asm volatile("s_waitcnt lgkmcnt(0)" ::: "memory")
#define VM_WAIT() asm volatile("s_waitcnt vmcnt(0)" ::: "memory")
__device__ __forceinline__ unsigned long long rt() { return __builtin_amdgcn_s_memrealtime(); }
__device__ __forceinline__ unsigned f2bf(float f) { unsigned u = __builtin_bit_cast(unsigned, f); return (u + 0x7fffu + ((u >> 16) & 1u)) >> 16; }
__device__ __forceinline__ unsigned pk2(float lo, float hi) { return f2bf(lo) | (f2bf(hi) << 16); }

#define XB_TMO      128
#define XB_XCNT(j)  (256  + 64 * (j))
#define XB_XSUB(j)  (1280 + 64 * (j))
#define XB_XGEN(j)  (2304 + 64 * (j))
#define XB_TOP      3328
#define XB_TOPGEN   3392
#define XCD_BAR_WORDS 3456
#define XB_SPIN_CAP (1u << 18)

__device__ __forceinline__ unsigned xb_ld(unsigned* p)              { return __hip_atomic_load(p, __ATOMIC_RELAXED, __HIP_MEMORY_SCOPE_AGENT); }
__device__ __forceinline__ unsigned xb_add(unsigned* p, unsigned v) { return __hip_atomic_fetch_add(p, v, __ATOMIC_RELAXED, __HIP_MEMORY_SCOPE_AGENT); }
__device__ __forceinline__ unsigned xb_xcc_id() { return (unsigned)__builtin_amdgcn_s_getreg((3 << 11) | 20) & 0xFu; }
#define XB_SPIN(cond, bar) do { unsigned _sp = 0; while (cond) { __builtin_amdgcn_s_sleep(1); \
    if ((++_sp & 255u) == 0u) { if (xb_ld(&(bar)[XB_TMO])) break; if (_sp > XB_SPIN_CAP) { atomicAdd(&(bar)[XB_TMO], 1u); break; } } } } while (0)

static __device__ __forceinline__ bool xb_t0_impl(int wave) { return wave == 0 && __builtin_amdgcn_mbcnt_hi(~0u, __builtin_amdgcn_mbcnt_lo(~0u, 0u)) == 0u; }
#define xb_t0() xb_t0_impl(xb_wave)
struct XcdBarrier {
    unsigned* bar; unsigned x;
    volatile LAS unsigned* st;
};

__device__ __forceinline__ XcdBarrier xcd_barrier_post(unsigned* bar, volatile LAS unsigned* st, const int xb_wave) {
    XcdBarrier b; b.bar = bar; b.x = xb_xcc_id(); b.st = st;
    if (xb_t0()) (void)xb_add(&bar[XB_XCNT(b.x)], 1u);
    return b;
}
__device__ __forceinline__ void xcd_barrier_complete(unsigned* bar, unsigned x, unsigned& nloc, unsigned& nx) {
    const unsigned G = gridDim.x * gridDim.y * gridDim.z;
    unsigned sum, cnt, mine, sp = 0u;
    for (;;) {
        sum = 0u; cnt = 0u; mine = 0u;
#pragma unroll
        for (unsigned j = 0; j < 16; ++j) { const unsigned c = xb_ld(&bar[XB_XCNT(j)]); sum += c; cnt += (c > 0u) ? 1u : 0u; mine = (j == x) ? c : mine; }
        if (sum == G) break;
        __builtin_amdgcn_s_sleep(1);
        if ((++sp & 255u) == 0u) { if (xb_ld(&bar[XB_TMO])) break; if (sp > XB_SPIN_CAP) { atomicAdd(&bar[XB_TMO], 1u); break; } }
    }
    nloc = mine > 0u ? mine : 1u; nx = cnt > 0u ? cnt : 1u;
}

__device__ __forceinline__ void xcd_barrier(const XcdBarrier& b, const int xb_wave) {
    asm volatile("s_waitcnt vmcnt(0)" ::: "memory");
    __syncthreads();
    if (xb_t0()) {
        unsigned* bar = b.bar;
        __builtin_amdgcn_s_waitcnt(0);
        unsigned nloc = b.st[0], nx = b.st[1];
        if (nloc == 0u) { xcd_barrier_complete(bar, b.x, nloc, nx); b.st[0] = nloc; b.st[1] = nx; }
        const unsigned old = xb_add(&bar[XB_XSUB(b.x)], 1u);
        const unsigned gen = old / nloc;
        if (old + 1u == (gen + 1u) * nloc) {
            __builtin_amdgcn_fence(__ATOMIC_RELEASE, "agent");
            asm volatile("s_waitcnt vmcnt(0)" ::: "memory");
            const unsigned og = xb_add(&bar[XB_TOP], 1u);
            const unsigned tg = og / nx;
            if (og + 1u == (tg + 1u) * nx) xb_add(&bar[XB_TOPGEN], 1u);
            else XB_SPIN(xb_ld(&bar[XB_TOPGEN]) == tg, bar);
            __builtin_amdgcn_fence(__ATOMIC_ACQUIRE, "agent");
            xb_add(&bar[XB_XGEN(b.x)], 1u);
            asm volatile("s_waitcnt vmcnt(0)" ::: "memory");
        } else {
            XB_SPIN(xb_ld(&bar[XB_XGEN(b.x)]) == gen, bar);
            __builtin_amdgcn_fence(__ATOMIC_ACQUIRE, "agent");
            asm volatile("s_waitcnt vmcnt(0)" ::: "memory");
        }
    }
    __syncthreads();
}

constexpr int T = 16384, DM = 2048, NP = 5888, NMEM = 256;
constexpr int NWAVES = 8, NTHR = 512;
constexpr float EPS = 1e-6f;
constexpr size_t MiB = 1u << 20;
constexpr size_t WS_CTL = 0, CTL_ZERO_BYTES = 65536;
constexpr size_t WS_WIN0 = 1 * MiB, WS_WIN1 = 24 * MiB, WS_WOUT0 = 47 * MiB, WS_WOUT1 = 55 * MiB, WS_WMKV = 63 * MiB, WS_WK1T = 71 * MiB, WS_WV1T = 73 * MiB;
constexpr size_t WS_MEMKV = 75 * MiB, WS_DEC = 76 * MiB, WS_KCMP = 77 * MiB, WS_VCMP = 77 * MiB + 512 * 1024, WS_SEL = 78 * MiB;
constexpr size_t WS_XN = 80 * MiB, WS_P = 144 * MiB, WS_STATE = 328 * MiB, WS_END = 472 * MiB;
constexpr size_t WS_MIX1 = WS_STATE;
constexpr size_t WS_CP = WS_STATE + 64 * MiB;
constexpr size_t PLANE = (size_t)T * 128;
constexpr size_t DO_MIX0 = 0, DO_OI = 64 * MiB;
constexpr int CR = 3072, CXQ = 4608, CXG = 5120, CGL = 5632;
constexpr int GQ = 0, GK = 768, GV = 1536;
constexpr int NQ = 0, NKC = 1536, NVC = 1792, NKS = 2048, NVS = 2304, NKW = 2560, NVW = 2816;
constexpr int RING_BYTES = 131072, LDSCTL_OFF = RING_BYTES, MISC_OFF = LDSCTL_OFF + 320, LDS_BYTES = 147456;
constexpr int N_PHASES = 12;

__device__ __forceinline__ float bf2f(bf16 v) { return __builtin_bit_cast(float, (unsigned)v << 16); }
__device__ __forceinline__ bf16 f2b(float f) { return (bf16)f2bf(f); }
__device__ __forceinline__ float wave_sum(float v) {
#pragma unroll
    for (int o = 1; o < 64; o <<= 1) v += __shfl_xor(v, o);
    return v;
}
__device__ __forceinline__ float silu_f(float x) { return x / (1.f + __expf(-x)); }
__device__ __forceinline__ float sigmoid_f(float x) { return 1.f / (1.f + __expf(-x)); }
__device__ __forceinline__ float logsigmoid_f(float x) { return fminf(x, 0.f) - log1pf(__expf(-fabsf(x))); }

__device__ __forceinline__ int win_src_col(int layer, int c) {
    const int ex = layer ? 36 : 16;
    if (c < 3072) return c;
    if (c < 5632) return c + ex;
    if (c < 5632 + ex) return c - 5632 + 3072;
    return -1;
}

__device__ __forceinline__ void transpose_item(const float* W, int ldw, int K, bf16* WT, int n0, int k0, int srcc, LAS float* scr, int lane) {
#pragma unroll 8
    for (int i = 0; i < 32; ++i) { const int kk = 2 * i + (lane >> 5); scr[kk * 33 + (lane & 31)] = (srcc >= 0) ? W[(size_t)(k0 + kk) * ldw + srcc] : 0.f; }
    LDS_WAIT(); asm volatile("" ::: "memory");
    const int c = lane & 7;
#pragma unroll
    for (int j = 0; j < 4; ++j) { const int n = (lane >> 3) + 8 * j; const LAS float* s = scr + (8 * c) * 33 + n;
        v4u o; o.x = pk2(s[0 * 33], s[1 * 33]); o.y = pk2(s[2 * 33], s[3 * 33]); o.z = pk2(s[4 * 33], s[5 * 33]); o.w = pk2(s[6 * 33], s[7 * 33]);
        *(v4u*)(WT + (size_t)(n0 + n) * K + k0 + 8 * c) = o; }
    LDS_WAIT(); asm volatile("" ::: "memory");
}

__device__ __forceinline__ void rms_row_to_bf16(const float* xrow, const float* g, bf16* orow, int lane) {
    const f32x4* xr = (const f32x4*)xrow + lane; const f32x4* gr = (const f32x4*)g + lane;
    f32x4 v[8]; float s = 0.f;
#pragma unroll
    for (int j = 0; j < 8; ++j) { v[j] = xr[64 * j]; s += (v[j].x * v[j].x + v[j].y * v[j].y) + (v[j].z * v[j].z + v[j].w * v[j].w); }
    const float rstd = rsqrtf(wave_sum(s) * (1.f / DM) + EPS);
    unsigned long long* o8 = (unsigned long long*)orow + lane;
#pragma unroll
    for (int j = 0; j < 8; ++j) { const f32x4 gg = gr[64 * j];
        o8[64 * j] = (unsigned long long)pk2(v[j].x * rstd * gg.x, v[j].y * rstd * gg.y) | ((unsigned long long)pk2(v[j].z * rstd * gg.z, v[j].w * rstd * gg.w) << 32); }
}

struct EpiNsaIn {
    static constexpr bool PERM = true, AFTER_DRAIN = false;
    bf16* O; int ldc; bf16* CPb;
    __device__ __forceinline__ void operator()(const pg8::f32x4 (&acc)[2][2][4][2], const pg8::Unit& u, int wr, int wc, int fr, int fq) const {
        const int row0 = u.pm * pg8::BM + wr * 64 + fr; const bool pl = (u.pn >= 6 && u.pn < 12);
#pragma unroll
        for (int ai = 0; ai < 2; ++ai)
#pragma unroll
            for (int m = 0; m < 4; ++m) { const size_t row = (size_t)(row0 + ai * pg8::HALF + m * 16);
#pragma unroll
                for (int bj = 0; bj < 2; ++bj) { const pg8::f32x4 v0 = acc[ai][bj][m][0], v1 = acc[ai][bj][m][1];
                    pg8::u32x4 w; w.x = pg8::cvt_pk_bf16(v0[0], v0[1]); w.y = pg8::cvt_pk_bf16(v0[2], v0[3]); w.z = pg8::cvt_pk_bf16(v1[0], v1[1]); w.w = pg8::cvt_pk_bf16(v1[2], v1[3]);
                    bf16* dst = pl ? CPb + ((size_t)((u.pn - 6) * 2 + bj)) * PLANE + row * 128 + wc * 32 + 8 * fq
                                   : O + row * ldc + u.pn * pg8::BM + bj * pg8::HALF + wc * 32 + 8 * fq;
                    *(pg8::u32x4*)dst = w; } }
    }
};

struct Args { const float* in[19]; float* out; unsigned char* ws; int ph_lo, ph_hi; };

struct Ctx {
    LAS unsigned char* lds;
    int tid, lane, wave, G, gw, NGW;
    const float *x, *mem, *ln_pre, *ln_post, *ln_mem, *w_mem_kv, *gla_w_in, *gla_w_gate, *gla_b_gate, *gla_norm, *gla_w_out;
    const float *nsa_w_in, *pe_k, *pe_v, *wk1, *wk2, *wv1, *wv2, *nsa_w_out;
    float* out; unsigned char* ws;
    bf16 *WIN0, *WIN1, *WOUT0, *WOUT1, *WMKV, *WK1T, *WV1T, *MEMKV, *KCMP, *VCMP, *XN, *P, *STATE, *MIX0, *MIX1, *OI, *CP;
    float *DEC, *HB;
};

__device__ __forceinline__ void phase_prep(Ctx& F) {
    LAS float* scr = (LAS float*)(F.lds + F.wave * 16384);
    constexpr int I_WIN = 32 * 184, I_WOUT = 32 * 64, I_MKV = 32 * 32, I_W1 = 64 * 8;
    constexpr int NITEMS = 2 * I_WIN + 2 * I_WOUT + 2 * I_MKV + 2 * I_W1;
    for (int it = F.gw; it < NITEMS; it += F.NGW) {
        int r = it;
        if (r < 2 * I_WIN) { const int layer = r / I_WIN; r -= layer * I_WIN; const int kb = r / 184, nb = r % 184;
            const int srcc = win_src_col(layer, nb * 32 + (F.lane & 31));
            transpose_item(layer ? F.nsa_w_in : F.gla_w_in, layer ? 5668 : 5648, DM, layer ? F.WIN1 : F.WIN0, nb * 32, kb * 64, srcc, scr, F.lane); continue; }
        r -= 2 * I_WIN;
        if (r < 2 * I_WOUT) { const int layer = r / I_WOUT; r -= layer * I_WOUT; const int kb = r / 64, nb = r % 64;
            transpose_item(layer ? F.nsa_w_out : F.gla_w_out, DM, DM, layer ? F.WOUT1 : F.WOUT0, nb * 32, kb * 64, nb * 32 + (F.lane & 31), scr, F.lane); continue; }
        r -= 2 * I_WOUT;
        if (r < 2 * I_MKV) { const int layer = r / I_MKV; r -= layer * I_MKV; const int kb = r / 32, nb = r % 32;
            transpose_item(F.w_mem_kv + (size_t)layer * DM * 1024, 1024, DM, F.WMKV + (size_t)layer * 1024 * DM, nb * 32, kb * 64, nb * 32 + (F.lane & 31), scr, F.lane); continue; }
        r -= 2 * I_MKV;
        { const int kv = r / I_W1; r -= kv * I_W1; const int kb = r / 8, nb = r % 8;
            transpose_item(kv ? F.wv1 : F.wk1, 256, 4096, kv ? F.WV1T : F.WK1T, nb * 32, kb * 64, nb * 32 + (F.lane & 31), scr, F.lane); }
    }
    if ((int)blockIdx.x < 64) { const int kv = blockIdx.x >> 5, s = blockIdx.x & 31; const float* pe = kv ? F.pe_v : F.pe_k; const float* w1 = kv ? F.wv1 : F.wk1;
        __syncthreads();
        LAS float* red = (LAS float*)F.lds;
        const int j = F.tid & 255, ih = F.tid >> 8; float a = 0.f;
#pragma unroll 8
        for (int i = s * 128 + ih * 64; i < s * 128 + ih * 64 + 64; ++i) a += pe[i] * w1[(size_t)i * 256 + j];
        red[F.tid] = a; __syncthreads();
        if (F.tid < 256) F.HB[(kv * 32 + s) * 256 + j] = red[j] + red[256 + j];
        __syncthreads(); }
    for (int m = F.gw; m < T; m += F.NGW) rms_row_to_bf16(F.x + (size_t)m * DM, F.ln_pre, F.XN + (size_t)m * DM, F.lane);
}

__device__ __forceinline__ void memkv_naive(Ctx& F) {
    const int gt = blockIdx.x * NTHR + F.tid, NT = F.G * NTHR;
    for (int o = gt; o < 2 * NMEM * 1024; o += NT) {
        const int layer = o >> 18, m = (o >> 10) & 255, n = o & 1023;
        const float* mr = F.mem + (size_t)m * DM; const float* g = F.ln_mem + layer * DM; const float* W = F.w_mem_kv + (size_t)layer * DM * 1024 + n;
        float ss = 0.f, acc = 0.f;
        for (int k = 0; k < DM; ++k) { const float a = mr[k]; ss += a * a; acc += a * g[k] * W[(size_t)k * 1024]; }
        const float v = acc * rsqrtf(ss * (1.f / DM) + EPS);
        const int kv = n >> 9, h = (n >> 7) & 3, d = n & 127;
        F.MEMKV[((((size_t)layer * 2 + kv) * 4 + h) * NMEM + m) * 128 + d] = f2b(v);
    }
}

__device__ __forceinline__ void cross_naive(Ctx& F, int layer, bf16* MIX) {
    const float scale = 0.08838834764831845f;
    for (int u = F.gw; u < T * 4; u += F.NGW) {
        const int t = u >> 2, h = u & 3;
        const bf16* pr = F.P + (size_t)t * NP;
        const unsigned qq = *(const unsigned*)(pr + CXQ + h * 128 + 2 * F.lane);
        const float q0 = bf2f((bf16)(qq & 0xffff)) * scale, q1 = bf2f((bf16)(qq >> 16)) * scale;
        const bf16* Kb = F.MEMKV + (((size_t)layer * 2 + 0) * 4 + h) * NMEM * 128;
        const bf16* Vb = F.MEMKV + (((size_t)layer * 2 + 1) * 4 + h) * NMEM * 128;
        float m = -1e30f, l = 0.f, o0 = 0.f, o1 = 0.f;
        for (int j = 0; j < NMEM; ++j) {
            const unsigned kk = *(const unsigned*)(Kb + j * 128 + 2 * F.lane), vv = *(const unsigned*)(Vb + j * 128 + 2 * F.lane);
            const float s = wave_sum(q0 * bf2f((bf16)(kk & 0xffff)) + q1 * bf2f((bf16)(kk >> 16)));
            const float mn = fmaxf(m, s), a = __expf(m - mn), p = __expf(s - mn);
            l = l * a + p; o0 = o0 * a + p * bf2f((bf16)(vv & 0xffff)); o1 = o1 * a + p * bf2f((bf16)(vv >> 16)); m = mn;
        }
        const unsigned gg = *(const unsigned*)(pr + CXG + h * 128 + 2 * F.lane);
        const float r0 = o0 / l * silu_f(bf2f((bf16)(gg & 0xffff))), r1 = o1 / l * silu_f(bf2f((bf16)(gg >> 16)));
        *(unsigned*)(MIX + (size_t)t * DM + 1536 + h * 128 + 2 * F.lane) = pk2(r0, r1);
    }
}

__device__ __forceinline__ void gla_g1_naive(Ctx& F) {
    LAS float* bcum = (LAS float*)(F.lds);
    LAS float* Aat = (LAS float*)(F.lds + 49152);
    LAS float* glr = (LAS float*)(F.lds + 65536);
    LAS float* blast = (LAS float*)(F.lds + 69632);
    const float qscale = 0.07216878364870323f;
    for (int u = blockIdx.x; u < 1024; u += F.G) {
        const int n = u >> 2, h = u & 3; const size_t row0 = (size_t)n * 64;
        for (int i = F.tid; i < 1024; i += NTHR) glr[i] = bf2f(F.P[(row0 + (i >> 4)) * NP + CGL + (i & 15)]);
        __syncthreads();
        if (F.tid < 192) {
            const int d = F.tid, col = h * 192 + d; float wg[16];
#pragma unroll
            for (int j = 0; j < 16; ++j) wg[j] = F.gla_w_gate[j * 768 + col];
            const float bias = F.gla_b_gate[col]; float b = 0.f;
            for (int c = 0; c < 64; ++c) { float gl = bias;
#pragma unroll
                for (int j = 0; j < 16; ++j) gl += glr[c * 16 + j] * wg[j];
                b += logsigmoid_f(gl) * (1.f / 16.f); bcum[c * 192 + d] = b; }
            blast[d] = b; F.DEC[n * 768 + col] = __expf(b);
        }
        __syncthreads();
        for (int i = 0; i < 8; ++i) { const int idx = F.tid + NTHR * i, c = idx >> 6, s = idx & 63; float a = 0.f;
            if (s <= c) { const bf16* qp = F.P + (row0 + c) * NP + GQ + h * 192; const bf16* kp = F.P + (row0 + s) * NP + GK + h * 192;
                for (int d = 0; d < 192; ++d) a += bf2f(qp[d]) * bf2f(kp[d]) * __expf(bcum[c * 192 + d] - bcum[s * 192 + d]);
                a *= qscale; }
            Aat[idx] = a; }
        __syncthreads();
        for (int i = 0; i < 48; ++i) { const int idx = F.tid + NTHR * i, c = idx / 384, e = idx % 384; float a = 0.f;
            for (int s = 0; s <= c; ++s) a += Aat[c * 64 + s] * bf2f(F.P[(row0 + s) * NP + GV + h * 384 + e]);
            F.OI[(row0 + c) * 1536 + h * 384 + e] = f2b(a); }
        for (int i = 0; i < 144; ++i) { const int idx = F.tid + NTHR * i, e = idx / 192, d = idx % 192; float a = 0.f; const float bl = blast[d];
            for (int c = 0; c < 64; ++c) a += bf2f(F.P[(row0 + c) * NP + GK + h * 192 + d]) * __expf(bl - bcum[c * 192 + d]) * bf2f(F.P[(row0 + c) * NP + GV + h * 384 + e]);
            F.STATE[((size_t)u * 384 + e) * 192 + d] = f2b(a); }
        __syncthreads();
        for (int i = 0; i < 24; ++i) { const int idx = F.tid + NTHR * i, c = idx / 192, d = idx % 192;
            bf16* qp = F.P + (row0 + c) * NP + GQ + h * 192 + d; *qp = f2b(bf2f(*qp) * qscale * __expf(bcum[c * 192 + d])); }
        __syncthreads();
    }
}

__device__ __forceinline__ void gla_scan(Ctx& F) {
    const int gt = blockIdx.x * NTHR + F.tid, NT = F.G * NTHR;
    constexpr int PER = 4 * 384 * 192;
    for (int item = gt; item < PER / 4; item += NT) {
        const int idx = item * 4, h = idx / (384 * 192), d0 = idx % 192;
        bf16* sp = F.STATE + idx; const float* dp = F.DEC + h * 192 + d0;
        float s0 = 0.f, s1 = 0.f, s2 = 0.f, s3 = 0.f;
        for (int n0 = 0; n0 < 256; n0 += 8) {
            unsigned long long u[8]; f32x4 dc[8];
#pragma unroll
            for (int j = 0; j < 8; ++j) { u[j] = *(const unsigned long long*)(sp + (size_t)(n0 + j) * PER); dc[j] = *(const f32x4*)(dp + (n0 + j) * 768); }
#pragma unroll
            for (int j = 0; j < 8; ++j) {
                const unsigned lo = (unsigned)u[j], hi = (unsigned)(u[j] >> 32);
                s0 = dc[j].x * s0 + bf2f((bf16)(lo & 0xffff)); s1 = dc[j].y * s1 + bf2f((bf16)(lo >> 16));
                s2 = dc[j].z * s2 + bf2f((bf16)(hi & 0xffff)); s3 = dc[j].w * s3 + bf2f((bf16)(hi >> 16));
                *(unsigned long long*)(sp + (size_t)(n0 + j) * PER) = (unsigned long long)pk2(s0, s1) | ((unsigned long long)pk2(s2, s3) << 32);
            }
        }
    }
}

__device__ __forceinline__ void gla_g3_naive(Ctx& F) {
    LAS float* o = (LAS float*)(F.lds);
    LAS float* rs = (LAS float*)(F.lds + 98304);
    for (int u = blockIdx.x; u < 1024; u += F.G) {
        const int n = u >> 2, h = u & 3; const size_t row0 = (size_t)n * 64;
        for (int i = 0; i < 48; ++i) { const int idx = F.tid + NTHR * i, c = idx / 384, e = idx % 384;
            float a = bf2f(F.OI[(row0 + c) * 1536 + h * 384 + e]);
            if (n > 0) { const bf16* sp = F.STATE + ((size_t)(u - 4) * 384 + e) * 192; const bf16* qp = F.P + (row0 + c) * NP + GQ + h * 192;
                for (int d = 0; d < 192; ++d) a += bf2f(qp[d]) * bf2f(sp[d]); }
            o[idx] = a; }
        __syncthreads();
        for (int c = F.wave; c < 64; c += NWAVES) { float ss = 0.f;
            for (int e = F.lane; e < 384; e += 64) { const float v = o[c * 384 + e]; ss += v * v; }
            ss = wave_sum(ss); if (F.lane == 0) rs[c] = rsqrtf(ss * (1.f / 384.f) + EPS); }
        __syncthreads();
        for (int i = 0; i < 48; ++i) { const int idx = F.tid + NTHR * i, c = idx / 384, e = idx % 384;
            const float v = o[idx] * rs[c] * F.gla_norm[e]; const float r = bf2f(F.P[(row0 + c) * NP + CR + h * 384 + e]);
            F.MIX0[(row0 + c) * DM + h * 384 + e] = f2b(v * silu_f(r)); }
        __syncthreads();
    }
}

__device__ __forceinline__ void post_rows(Ctx& F, const float* hin, const bf16* Y, const float* gpost, float* hout, const float* gpre, bf16* XNo) {
    for (int m = F.gw; m < T; m += F.NGW) {
        const v4u* yr = (const v4u*)(Y + (size_t)m * DM) + F.lane;
        float y[32]; float ss = 0.f;
#pragma unroll
        for (int j = 0; j < 4; ++j) { const v4u w = yr[64 * j];
            const unsigned ww[4] = {w.x, w.y, w.z, w.w};
#pragma unroll
            for (int q = 0; q < 4; ++q) { y[j * 8 + 2 * q] = bf2f((bf16)(ww[q] & 0xffff)); y[j * 8 + 2 * q + 1] = bf2f((bf16)(ww[q] >> 16)); } }
#pragma unroll
        for (int i = 0; i < 32; ++i) ss += y[i] * y[i];
        const float rstd = rsqrtf(wave_sum(ss) * (1.f / DM) + EPS);
        float hn[32]; float s2 = 0.f;
#pragma unroll
        for (int j = 0; j < 4; ++j) {
#pragma unroll
            for (int q = 0; q < 2; ++q) { const int col = j * 512 + F.lane * 8 + q * 4;
                const f32x4 hv = *(const f32x4*)(hin + (size_t)m * DM + col); const f32x4 gp = *(const f32x4*)(gpost + col);
                f32x4 r; r.x = hv.x + y[j * 8 + q * 4 + 0] * rstd * gp.x; r.y = hv.y + y[j * 8 + q * 4 + 1] * rstd * gp.y; r.z = hv.z + y[j * 8 + q * 4 + 2] * rstd * gp.z; r.w = hv.w + y[j * 8 + q * 4 + 3] * rstd * gp.w;
                *(f32x4*)(hout + (size_t)m * DM + col) = r;
                hn[j * 8 + q * 4 + 0] = r.x; hn[j * 8 + q * 4 + 1] = r.y; hn[j * 8 + q * 4 + 2] = r.z; hn[j * 8 + q * 4 + 3] = r.w;
                s2 += (r.x * r.x + r.y * r.y) + (r.z * r.z + r.w * r.w); } }
        if (gpre) {
            const float rstd2 = rsqrtf(wave_sum(s2) * (1.f / DM) + EPS);
#pragma unroll
            for (int j = 0; j < 4; ++j) { const int col = j * 512 + F.lane * 8;
                const f32x4 g0 = *(const f32x4*)(gpre + col), g1 = *(const f32x4*)(gpre + col + 4);
                v4u w; w.x = pk2(hn[j * 8 + 0] * rstd2 * g0.x, hn[j * 8 + 1] * rstd2 * g0.y); w.y = pk2(hn[j * 8 + 2] * rstd2 * g0.z, hn[j * 8 + 3] * rstd2 * g0.w);
                w.z = pk2(hn[j * 8 + 4] * rstd2 * g1.x, hn[j * 8 + 5] * rstd2 * g1.y); w.w = pk2(hn[j * 8 + 6] * rstd2 * g1.z, hn[j * 8 + 7] * rstd2 * g1.w);
                *((v4u*)(XNo + (size_t)m * DM) + F.lane + 64 * j) = w; }
        }
    }
}

__device__ __forceinline__ void nsa_compress_naive(Ctx& F) {
    LAS float* blk = (LAS float*)(F.lds);
    LAS float* part = (LAS float*)(F.lds + 65536);
    LAS float* hid = (LAS float*)(F.lds + 73728);
    for (int u = blockIdx.x; u < 1024; u += F.G) {
        const int kv = u & 1, g = (u >> 1) & 1, nq = u >> 2;
        const float* pe = kv ? F.pe_v : F.pe_k; const float* w1 = kv ? F.wv1 : F.wk1; const float* w2 = kv ? F.wv2 : F.wk2;
        const int colb = (kv ? NVC : NKC) + g * 128;
        for (int i = 0; i < 32; ++i) { const int idx = F.tid + NTHR * i, r = idx >> 12, i4 = idx & 4095, l = i4 >> 7, d = i4 & 127; const int n = nq * 4 + r;
            float v = 0.f; if (n < 1023) v = bf2f(F.P[(size_t)(16 * n + l) * NP + colb + d]) + pe[l * 128 + d];
            blk[idx] = v; }
        __syncthreads();
        { const int j = F.tid & 255, ih = F.tid >> 8; float a0 = 0.f, a1 = 0.f, a2 = 0.f, a3 = 0.f;
            for (int i = ih * 2048; i < ih * 2048 + 2048; ++i) { const float w = w1[(size_t)i * 256 + j];
                a0 += blk[i] * w; a1 += blk[4096 + i] * w; a2 += blk[8192 + i] * w; a3 += blk[12288 + i] * w; }
            part[(ih * 4 + 0) * 256 + j] = a0; part[(ih * 4 + 1) * 256 + j] = a1; part[(ih * 4 + 2) * 256 + j] = a2; part[(ih * 4 + 3) * 256 + j] = a3; }
        __syncthreads();
        for (int i = F.tid; i < 1024; i += NTHR) hid[i] = silu_f(part[i] + part[1024 + i]);
        __syncthreads();
        { const int d = F.tid & 127, r = F.tid >> 7; const int n = nq * 4 + r; float a = 0.f;
            for (int j = 0; j < 256; ++j) a += hid[r * 256 + j] * w2[j * 128 + d];
            if (n < 1023) (kv ? F.VCMP : F.KCMP)[((size_t)g * 1024 + n) * 128 + d] = f2b(a); }
        __syncthreads();
    }
}

__device__ __forceinline__ void nsa_main_naive(Ctx& F) {
    const float scale = 0.08838834764831845f;
    LAS float* ocs = (LAS float*)(F.lds + F.wave * 4096);
    const int lane = F.lane;
    for (int u = F.gw; u < T * 2; u += F.NGW) {
        const int t = u >> 1, g = u & 1; const bf16* pr = F.P + (size_t)t * NP;
        const int ncv = (t >= 31) ? min((t - 31) / 16 + 1, 1023) : 0;
        const bf16* Kc = F.KCMP + (size_t)g * 1024 * 128; const bf16* Vc = F.VCMP + (size_t)g * 1024 * 128;
        float imp0 = 0.f, imp1 = 0.f, imp2 = 0.f, imp3 = 0.f;
        for (int h = 0; h < 6; ++h) {
            const unsigned qq = *(const unsigned*)(pr + NQ + (g * 6 + h) * 128 + 2 * lane);
            const float q0 = bf2f((bf16)(qq & 0xffff)) * scale, q1 = bf2f((bf16)(qq >> 16)) * scale;
            float m = -1e30f, l = 0.f, o0 = 0.f, o1 = 0.f;
            for (int c = 0; c < ncv; ++c) {
                const unsigned kk = *(const unsigned*)(Kc + c * 128 + 2 * lane), vv = *(const unsigned*)(Vc + c * 128 + 2 * lane);
                const float s = wave_sum(q0 * bf2f((bf16)(kk & 0xffff)) + q1 * bf2f((bf16)(kk >> 16)));
                const float mn = fmaxf(m, s), a = __expf(m - mn), p = __expf(s - mn);
                l = l * a + p; o0 = o0 * a + p * bf2f((bf16)(vv & 0xffff)); o1 = o1 * a + p * bf2f((bf16)(vv >> 16)); m = mn;
            }
            const float gate = sigmoid_f(bf2f(pr[CGL + g * 18 + h * 3 + 0]));
            const float il = (ncv > 0) ? 1.f / l : 0.f;
            ocs[h * 128 + 2 * lane] = gate * o0 * il; ocs[h * 128 + 2 * lane + 1] = gate * o1 * il;
            for (int c = 0; c < ncv; ++c) {
                const unsigned kk = *(const unsigned*)(Kc + c * 128 + 2 * lane);
                const float s = wave_sum(q0 * bf2f((bf16)(kk & 0xffff)) + q1 * bf2f((bf16)(kk >> 16)));
                const float p = __expf(s - m) * il;
                const int ja = c >> 2, jb = (c + 1) >> 2;
                { const int jj = lane;       if (jj == ja || jj == jb) imp0 += p; }
                { const int jj = lane + 64;  if (jj == ja || jj == jb) imp1 += p; }
                { const int jj = lane + 128; if (jj == ja || jj == jb) imp2 += p; }
                { const int jj = lane + 192; if (jj == ja || jj == jb) imp3 += p; }
            }
        }
        const int cur = t >> 6;
        float iv[4] = {imp0, imp1, imp2, imp3};
#pragma unroll
        for (int i = 0; i < 4; ++i) { const int jj = lane + 64 * i; if (jj == 0 || jj == cur || jj == cur - 1) iv[i] = 1e4f; if (jj > cur) iv[i] = -1e4f; }
        int mysel = 0;
#pragma unroll
        for (int r = 0; r < 16; ++r) {
            float bv = iv[0]; int bi = lane;
#pragma unroll
            for (int i = 1; i < 4; ++i) { if (iv[i] > bv) { bv = iv[i]; bi = lane + 64 * i; } }
#pragma unroll
            for (int o = 1; o < 64; o <<= 1) { const float ov = __shfl_xor(bv, o); const int oi = __shfl_xor(bi, o); if (ov > bv || (ov == bv && oi < bi)) { bv = ov; bi = oi; } }
            mysel = (lane == r) ? bi : mysel;
#pragma unroll
            for (int i = 0; i < 4; ++i) if (lane + 64 * i == bi) iv[i] = -3e38f;
        }
        for (int h = 0; h < 6; ++h) {
            const unsigned qq = *(const unsigned*)(pr + NQ + (g * 6 + h) * 128 + 2 * lane);
            const float q0 = bf2f((bf16)(qq & 0xffff)) * scale, q1 = bf2f((bf16)(qq >> 16)) * scale;
            float m = -1e30f, l = 0.f, o0 = 0.f, o1 = 0.f;
            for (int r = 0; r < 16; ++r) { const int j = __shfl(mysel, r); if (j > cur) continue;
                const int kend = min(64, t - 64 * j + 1);
                for (int i = 0; i < kend; ++i) { const bf16* kr = F.P + (size_t)(64 * j + i) * NP;
                    const unsigned kk = *(const unsigned*)(kr + NKS + g * 128 + 2 * lane), vv = *(const unsigned*)(kr + NVS + g * 128 + 2 * lane);
                    const float s = wave_sum(q0 * bf2f((bf16)(kk & 0xffff)) + q1 * bf2f((bf16)(kk >> 16)));
                    const float mn = fmaxf(m, s), a = __expf(m - mn), p = __expf(s - mn);
                    l = l * a + p; o0 = o0 * a + p * bf2f((bf16)(vv & 0xffff)); o1 = o1 * a + p * bf2f((bf16)(vv >> 16)); m = mn; } }
            const float gs = sigmoid_f(bf2f(pr[CGL + g * 18 + h * 3 + 1]));
            float r0 = ocs[h * 128 + 2 * lane] + gs * o0 / l, r1 = ocs[h * 128 + 2 * lane + 1] + gs * o1 / l;
            m = -1e30f; l = 0.f; o0 = 0.f; o1 = 0.f;
            for (int p0 = max(0, t - 511); p0 <= t; ++p0) { const bf16* kr = F.P + (size_t)p0 * NP;
                const unsigned kk = *(const unsigned*)(kr + NKW + g * 128 + 2 * lane), vv = *(const unsigned*)(kr + NVW + g * 128 + 2 * lane);
                const float s = wave_sum(q0 * bf2f((bf16)(kk & 0xffff)) + q1 * bf2f((bf16)(kk >> 16)));
                const float mn = fmaxf(m, s), a = __expf(m - mn), p = __expf(s - mn);
                l = l * a + p; o0 = o0 * a + p * bf2f((bf16)(vv & 0xffff)); o1 = o1 * a + p * bf2f((bf16)(vv >> 16)); m = mn; }
            const float gw_ = sigmoid_f(bf2f(pr[CGL + g * 18 + h * 3 + 2]));
            r0 += gw_ * o0 / l; r1 += gw_ * o1 / l;
            const unsigned rr = *(const unsigned*)(pr + CR + (g * 6 + h) * 128 + 2 * lane);
            r0 *= silu_f(bf2f((bf16)(rr & 0xffff))); r1 *= silu_f(bf2f((bf16)(rr >> 16)));
            *(unsigned*)(F.MIX1 + (size_t)t * DM + (g * 6 + h) * 128 + 2 * lane) = pk2(r0, r1);
        }
    }
}


typedef short v4i16_t __attribute__((ext_vector_type(4)));
typedef short s16x4 __attribute__((ext_vector_type(4)));
__device__ __forceinline__ s16x4 vtr(const LAS unsigned char* p) { return __builtin_bit_cast(s16x4, __builtin_amdgcn_ds_read_tr16_b64_v4i16((LAS v4i16_t*)p)); }
constexpr int KROW = 288;
constexpr int RING = 3, TILE_K = 16384, TILE_KV = 32768;
__device__ __forceinline__ int swz_off(int row, int chunk) { return row * 256 + ((((((chunk >> 1) ^ row) & 7)) << 1) | (chunk & 1)) * 16; }
constexpr float LOG2E = 1.4426950408889634f;

struct ImpArgs { float gate0, gate1; bool hvalid; LAS float* imp; const LAS unsigned* bm; };
__device__ __forceinline__ void dma16(const char* sbase, unsigned voff, unsigned lds_dst) {
    unsigned keep;
    asm volatile("s_mov_b32 %0, m0\n\ts_mov_b32 m0, %3\n\ts_nop 0\n\tglobal_load_lds_dwordx4 %1, %2\n\ts_mov_b32 m0, %0" : "=&s"(keep) : "v"(voff), "s"(sbase), "s"(lds_dst) : "memory");
}
typedef float f32x2_t __attribute__((ext_vector_type(2)));
typedef __bf16 bf16x2_t __attribute__((ext_vector_type(2)));
__device__ __forceinline__ unsigned cvtpk(float lo, float hi) { const f32x2_t v = {lo, hi}; return __builtin_bit_cast(unsigned, __builtin_convertvector(v, bf16x2_t)); }
__device__ __forceinline__ float bperm(float x, int srclane) { return __builtin_bit_cast(float, __builtin_amdgcn_ds_bpermute(srclane << 2, __builtin_bit_cast(int, x))); }
__device__ __forceinline__ float xmax4(float x, int lane) { x = fmaxf(x, bperm(x, lane ^ 16)); return fmaxf(x, bperm(x, lane ^ 32)); }
__device__ __forceinline__ float xsum4(float x, int lane) { x += bperm(x, lane ^ 16); return x + bperm(x, lane ^ 32); }
template <int CTRL> __device__ __forceinline__ float dppf(float x) { return __builtin_bit_cast(float, __builtin_amdgcn_update_dpp(0, __builtin_bit_cast(int, x), CTRL, 0xF, 0xF, true)); }
__device__ __forceinline__ float sum8(float x) { x += dppf<0xB1>(x); x += dppf<0x4E>(x); x += dppf<0x141>(x); return x; }

template <int MODE, int RTM, bool FULL, class Mask>
__device__ __forceinline__ void attn_tile(const LAS unsigned char* Kb, const LAS unsigned char* Vb, const bf16x8 (&Q)[2][4], f32x4 (&O)[2][8], float (&m)[2], float (&l)[2],
                                          const int kt, const Mask& mask, const int tok0, const int tok1, const float sl2, const ImpArgs& ia, const bool sb0, const bool sb1,
                                          float& carry0, float& carry1, const int lane) {
    const int c16 = lane & 15, g = lane >> 4;
#pragma unroll
    for (int s32 = 0; s32 < 2; ++s32) {
        f32x4 sc[2][2];
#pragma unroll
        for (int rt = 0; rt < 2; ++rt)
#pragma unroll
            for (int st = 0; st < 2; ++st) sc[rt][st] = (f32x4){0.f, 0.f, 0.f, 0.f};
#pragma unroll
        for (int st = 0; st < 2; ++st) {
            bf16x8 kf[4];
#pragma unroll
            for (int kd = 0; kd < 4; ++kd) kf[kd] = *(const LAS bf16x8*)(Kb + swz_off(s32 * 32 + st * 16 + c16, g + 4 * kd));
#pragma unroll
            for (int kd = 0; kd < 4; ++kd) {
                if (RTM & 1) sc[0][st] = __builtin_amdgcn_mfma_f32_16x16x32_bf16(kf[kd], Q[0][kd], sc[0][st], 0, 0, 0);
                if (RTM & 2) sc[1][st] = __builtin_amdgcn_mfma_f32_16x16x32_bf16(kf[kd], Q[1][kd], sc[1][st], 0, 0, 0);
            }
        }
        bf16x8 pf[2];
#pragma unroll
        for (int rt = 0; rt < 2; ++rt) {
            if (!((RTM >> rt) & 1)) continue;
            const int tk = rt ? tok1 : tok0; const bool sb = rt ? sb1 : sb0;
            float v[8]; float mx = -3e38f;
#pragma unroll
            for (int st = 0; st < 2; ++st)
#pragma unroll
                for (int r = 0; r < 4; ++r) { const int kidx = kt + s32 * 32 + st * 16 + g * 4 + r;
                    v[st * 4 + r] = (FULL || (mask(tk, kidx) && (MODE != 3 || sb))) ? sc[rt][st][r] : -3e38f; mx = fmaxf(mx, v[st * 4 + r]); }
            if (MODE != 2) {
                const float mo = m[rt];
                bool need = (mx * sl2 - mo) > 64.f; if (MODE == 3) need = need && sb;
                if (__any(need)) {
                    const float mxa = xmax4(mx, lane); float mn = fmaxf(mo, mxa * sl2); if (MODE == 3) mn = sb ? mn : mo;
                    const float alpha = __builtin_amdgcn_exp2f(mo - mn);
                    m[rt] = mn; l[rt] = l[rt] * alpha;
                    if (MODE == 0 || MODE == 3) {
#pragma unroll
                        for (int dt = 0; dt < 8; ++dt) O[rt][dt] = O[rt][dt] * alpha;
                    }
                }
                const float mn = m[rt];
                float ps = 0.f;
#pragma unroll
                for (int i = 0; i < 8; ++i) { v[i] = __builtin_amdgcn_exp2f(fmaf(v[i], sl2, -mn)); ps += v[i]; }
                l[rt] += ps;
            } else {
                const float mn = m[rt], linv = ia.hvalid ? l[rt] : 0.f, gt = rt ? ia.gate1 : ia.gate0;
#pragma unroll
                for (int i = 0; i < 8; ++i) v[i] = __builtin_amdgcn_exp2f(fmaf(v[i], sl2, -mn)) * linv;
                const float s40 = sum8((v[0] + v[1]) + (v[2] + v[3])), s41 = sum8((v[4] + v[5]) + (v[6] + v[7])), la0 = sum8(v[3]), la1 = sum8(v[7]);
                const float pl0 = bperm(la0, (lane + 48) & 63), pl1 = bperm(la1, (lane + 48) & 63);
                const float cprev = rt ? carry1 : carry0;
                const float i0 = s40 + (g > 0 ? pl0 : cprev), i1 = s41 + (g > 0 ? pl1 : pl0);
                if (rt) carry1 = pl1; else carry0 = pl1;
                if ((lane & 7) == 0) { const int jb = (kt >> 2) + 8 * s32 + g; LAS float* ip = ia.imp + (rt * 2 + (c16 >> 3)) * 256 + jb; ip[0] = i0; ip[4] = i1; }
#pragma unroll
                for (int i = 0; i < 8; ++i) v[i] *= gt;
            }
            if (MODE != 1) { v4u pw; pw.x = cvtpk(v[0], v[1]); pw.y = cvtpk(v[2], v[3]); pw.z = cvtpk(v[4], v[5]); pw.w = cvtpk(v[6], v[7]);
                pf[rt] = __builtin_bit_cast(bf16x8, pw); }
        }
        if (MODE != 1) {
            const int vrow = s32 * 32 + g * 4 + (c16 >> 2);
            const LAS unsigned char* vb0 = Vb + vrow * 256 + ((c16 >> 1) & 1) * 16 + (c16 & 1) * 8; const int r7 = vrow & 7;
#pragma unroll
            for (int dt = 0; dt < 8; ++dt) {
                const LAS unsigned char* vp = vb0 + ((dt ^ r7) << 5);
                const s16x4 lo = vtr(vp), hi = vtr(vp + 4096);
                const bf16x8 vf = {lo[0], lo[1], lo[2], lo[3], hi[0], hi[1], hi[2], hi[3]};
                if (RTM & 1) O[0][dt] = __builtin_amdgcn_mfma_f32_16x16x32_bf16(vf, pf[0], O[0][dt], 0, 0, 0);
                if (RTM & 2) O[1][dt] = __builtin_amdgcn_mfma_f32_16x16x32_bf16(vf, pf[1], O[1][dt], 0, 0, 0);
            }
        }
    }
}

template <int MODE, class Src, class Mask>
__device__ __forceinline__ void attn_pass(Ctx& F, LAS unsigned char* base, const bf16x8 (&Q)[2][4], f32x4 (&O)[2][8], float (&m)[2], float (&l)[2],
                                          const int k0, const int nt, const Src& src, const Mask& mask, const int tok0, const int tok1, const float sl2, const ImpArgs ia = ImpArgs{0.f, 0.f, false, nullptr, nullptr}) {
    int tidv = F.wave * 64 + (int)__builtin_amdgcn_mbcnt_hi(~0u, __builtin_amdgcn_mbcnt_lo(~0u, 0u)); asm volatile("" : "+v"(tidv));
    const int lane = tidv & 63, c16 = lane & 15, g = lane >> 4;
    const int wv = F.wave;
    constexpr int NL = (MODE == 1) ? 2 : 4;
#define ATT_DMA(tj, bufi) do { const int kt_ = k0 + 64 * min((tj), nt - 1); \
        _Pragma("unroll") for (int i_ = 0; i_ < 2; ++i_) { const int pc_ = wv * 2 + i_, row_ = pc_ * 4 + g, c_ = (((((c16 >> 1) ^ row_) & 7)) << 1) | (c16 & 1); \
            const unsigned go_ = src.off(kt_ + row_) + (unsigned)(c_ * 16); \
            dma16(src.kb, go_, (unsigned)(size_t)base + (unsigned)((bufi) * TILE_KV + pc_ * 1024)); \
            if (MODE != 1) dma16(src.vb, go_, (unsigned)(size_t)base + (unsigned)((bufi) * TILE_KV + TILE_K + pc_ * 1024)); } } while (0)
    __syncthreads();
#pragma unroll
    for (int t_ = 0; t_ < RING - 1; ++t_) ATT_DMA(t_, t_);
    float carry0 = 0.f, carry1 = 0.f;
    int bcur = 0;
    for (int j = 0; j < nt; ++j) {
        if (NL == 4) asm volatile("s_waitcnt vmcnt(%0)" :: "n"((RING - 2) * 4) : "memory"); else asm volatile("s_waitcnt vmcnt(%0)" :: "n"((RING - 2) * 2) : "memory");
        __builtin_amdgcn_s_barrier();
        { const int bnext = (bcur == 0) ? RING - 1 : bcur - 1; ATT_DMA(j + RING - 1, bnext); }
        const LAS unsigned char* Kb = base + bcur * TILE_KV; const LAS unsigned char* Vb = Kb + TILE_K;
        const int kt = k0 + 64 * j;
        if (MODE == 3) {
            const int jb = kt >> 6; const unsigned w0 = ia.bm[(c16 >> 3) * 8 + (jb >> 5)], w1 = ia.bm[(2 + (c16 >> 3)) * 8 + (jb >> 5)];
            const bool sb0 = ia.hvalid && ((w0 >> (jb & 31)) & 1u), sb1 = ia.hvalid && ((w1 >> (jb & 31)) & 1u); const bool act0 = __any(sb0), act1 = __any(sb1);
            if (act0 && act1) attn_tile<MODE, 3, false>(Kb, Vb, Q, O, m, l, kt, mask, tok0, tok1, sl2, ia, sb0, sb1, carry0, carry1, lane);
            else if (act0) attn_tile<MODE, 1, false>(Kb, Vb, Q, O, m, l, kt, mask, tok0, tok1, sl2, ia, sb0, sb1, carry0, carry1, lane);
            else if (act1) attn_tile<MODE, 2, false>(Kb, Vb, Q, O, m, l, kt, mask, tok0, tok1, sl2, ia, sb0, sb1, carry0, carry1, lane);
        } else { int lj = lane; asm volatile("" : "+v"(lj));
            const bool full = __all(mask(tok0, kt) && mask(tok0, kt + 63) && mask(tok1, kt) && mask(tok1, kt + 63));
            if (full) attn_tile<MODE, 3, true>(Kb, Vb, Q, O, m, l, kt, mask, tok0, tok1, sl2, ia, true, true, carry0, carry1, lj);
            else attn_tile<MODE, 3, false>(Kb, Vb, Q, O, m, l, kt, mask, tok0, tok1, sl2, ia, true, true, carry0, carry1, lj); }
        bcur = (bcur == RING - 1) ? 0 : bcur + 1;
    }
    asm volatile("s_waitcnt vmcnt(0)" ::: "memory");
    __syncthreads();
#undef ATT_DMA
}

template <class Mask>
__device__ __forceinline__ void slc_visit1(const LAS unsigned char* Kb, const LAS unsigned char* Vb, const bf16x8 (&Qr)[4], f32x4 (&Or)[8], float& mr, float& lr,
                                           const int kt, const Mask& mask, const int tok, const float sl2, const bool sb, const int lane) {
    const int c16 = lane & 15, g = lane >> 4;
    f32x4 sc[4];
#pragma unroll
    for (int st = 0; st < 4; ++st) { sc[st] = (f32x4){0.f, 0.f, 0.f, 0.f};
#pragma unroll
        for (int kd = 0; kd < 4; ++kd) { const bf16x8 kf = *(const LAS bf16x8*)(Kb + swz_off(st * 16 + c16, g + 4 * kd));
            sc[st] = __builtin_amdgcn_mfma_f32_16x16x32_bf16(kf, Qr[kd], sc[st], 0, 0, 0); } }
    float v[16]; float mx = -3e38f;
#pragma unroll
    for (int st = 0; st < 4; ++st)
#pragma unroll
        for (int r = 0; r < 4; ++r) { const int kidx = kt + st * 16 + g * 4 + r; v[st * 4 + r] = (mask(tok, kidx) && sb) ? sc[st][r] : -3e38f; mx = fmaxf(mx, v[st * 4 + r]); }
    const float mo = mr;
    if (__any((mx * sl2 - mo) > 64.f)) {
        const float mxa = xmax4(mx, lane); const float mn = sb ? fmaxf(mo, mxa * sl2) : mo; const float alpha = __builtin_amdgcn_exp2f(mo - mn);
        mr = mn; lr *= alpha;
#pragma unroll
        for (int dt = 0; dt < 8; ++dt) Or[dt] = Or[dt] * alpha;
    }
    const float mn = mr; float ps = 0.f;
#pragma unroll
    for (int i = 0; i < 16; ++i) { v[i] = __builtin_amdgcn_exp2f(fmaf(v[i], sl2, -mn)); ps += v[i]; }
    lr += ps;
    bf16x8 pf[2];
#pragma unroll
    for (int ks = 0; ks < 2; ++ks) { v4u pw; pw.x = cvtpk(v[8 * ks + 0], v[8 * ks + 1]); pw.y = cvtpk(v[8 * ks + 2], v[8 * ks + 3]); pw.z = cvtpk(v[8 * ks + 4], v[8 * ks + 5]); pw.w = cvtpk(v[8 * ks + 6], v[8 * ks + 7]);
        pf[ks] = __builtin_bit_cast(bf16x8, pw); }
#pragma unroll
    for (int ks = 0; ks < 2; ++ks) { const int vrow = ks * 32 + g * 4 + (c16 >> 2);
        const LAS unsigned char* vb0 = Vb + vrow * 256 + ((c16 >> 1) & 1) * 16 + (c16 & 1) * 8; const int r7 = vrow & 7;
#pragma unroll
        for (int dt = 0; dt < 8; ++dt) { const LAS unsigned char* vp = vb0 + ((dt ^ r7) << 5);
            const s16x4 lo = vtr(vp), hi = vtr(vp + 4096);
            const bf16x8 vf = {lo[0], lo[1], lo[2], lo[3], hi[0], hi[1], hi[2], hi[3]};
            Or[dt] = __builtin_amdgcn_mfma_f32_16x16x32_bf16(vf, pf[ks], Or[dt], 0, 0, 0); } }
}

template <class Src, class Mask>
__device__ __forceinline__ void slc_pass(Ctx& F, LAS unsigned char* base, const bf16x8 (&Q)[2][4], f32x4 (&O)[2][8], float (&m)[2], float (&l)[2],
                                         const int nt, const Src& src, const Mask& mask, const int tok0, const int tok1, const float sl2, const ImpArgs ia) {
    int tidv = F.wave * 64 + (int)__builtin_amdgcn_mbcnt_hi(~0u, __builtin_amdgcn_mbcnt_lo(~0u, 0u)); asm volatile("" : "+v"(tidv));
    const int lane = tidv & 63, c16 = lane & 15, g = lane >> 4;
    const int wv = F.wave;
    volatile LAS unsigned* flg = (volatile LAS unsigned*)(base + RING_BYTES + 2048);
#define SLC_LOAD(tj) do { const int kt_ = 64 * (tj); \
        _Pragma("unroll 4") for (int pc_ = 0; pc_ < 16; ++pc_) { const int row_ = pc_ * 4 + g, c_ = (((((c16 >> 1) ^ row_) & 7)) << 1) | (c16 & 1); \
            const unsigned go_ = src.off(kt_ + row_) + (unsigned)(c_ * 16); \
            dma16(src.kb, go_, (unsigned)(size_t)base + (unsigned)(((tj) & 3) * TILE_KV + pc_ * 1024)); \
            dma16(src.vb, go_, (unsigned)(size_t)base + (unsigned)(((tj) & 3) * TILE_KV + TILE_K + pc_ * 1024)); } } while (0)
    __syncthreads();
    if (lane < 8) flg[16 + wv * 8 + lane] = ia.bm[lane] | ia.bm[8 + lane] | ia.bm[16 + lane] | ia.bm[24 + lane];
    if (tidv < 12) flg[tidv] = 0u;
    __syncthreads();
    int pend = -1;
    if (wv == 0) { SLC_LOAD(0); pend = 0; } else if (wv == 1 && nt > 1) { SLC_LOAD(1); pend = 1; }
    float carry0 = 0.f, carry1 = 0.f;
    unsigned myact = 0u;
    for (int j = 0; j < nt; ++j) {
        if ((j & 31) == 0) myact = (unsigned)__builtin_amdgcn_readfirstlane((int)flg[16 + wv * 8 + (j >> 5)]);
        if (pend >= 0) {
            asm volatile("s_waitcnt vmcnt(0)" ::: "memory");
            if (lane == 0) flg[8 + (pend & 3)] = (unsigned)(pend + 1);
            asm volatile("" ::: "memory"); pend = -1; }
        const int t = j + 2;
        if (t < nt) {
            const unsigned aw = flg[16 + (lane & 7) * 8 + (t >> 5)];
            const bool busy = ((aw >> (t & 31)) & 1u) || ((t & 31) && ((aw >> ((t & 31) - 1)) & 1u));
            const unsigned bb = (unsigned)(__ballot(busy) & 0xFFull);
            const unsigned rot = ((bb | (bb << 8)) >> (t & 7)) & 0xFFu;
            const int owner = ((t & 7) + ((rot == 0xFFu) ? 0 : (__builtin_ctz(~rot)))) & 7;
            if (owner == wv) {
                if (t >= 4) { const int tp = t - 4;
                    for (;;) { const unsigned av = flg[16 + (lane & 7) * 8 + (tp >> 5)], dv = flg[lane & 7], lp = flg[8 + (t & 3)];
                        const bool okv = (!((av >> (tp & 31)) & 1u) || dv >= (unsigned)(tp + 1)) && lp >= (unsigned)(tp + 1);
                        if (__all(okv)) break; __builtin_amdgcn_s_sleep(1); }
                    asm volatile("" ::: "memory"); __builtin_amdgcn_sched_barrier(0); }
                SLC_LOAD(t); pend = t; }
        }
        if ((myact >> (j & 31)) & 1u) {
            const unsigned w0 = ia.bm[(c16 >> 3) * 8 + (j >> 5)], w1 = ia.bm[(2 + (c16 >> 3)) * 8 + (j >> 5)];
            const bool sb0 = ia.hvalid && ((w0 >> (j & 31)) & 1u), sb1 = ia.hvalid && ((w1 >> (j & 31)) & 1u); const bool act0 = __any(sb0), act1 = __any(sb1);
            for (;;) { const unsigned lv = flg[8 + (j & 3)]; if (__all(lv >= (unsigned)(j + 1))) break; __builtin_amdgcn_s_sleep(1); }
            asm volatile("" ::: "memory"); __builtin_amdgcn_sched_barrier(0);
            const LAS unsigned char* Kb = base + (j & 3) * TILE_KV; const LAS unsigned char* Vb = Kb + TILE_K;
            int lj = lane; asm volatile("" : "+v"(lj));
            if (act0 && act1) attn_tile<3, 3, false>(Kb, Vb, Q, O, m, l, 64 * j, mask, tok0, tok1, sl2, ia, sb0, sb1, carry0, carry1, lj);
            else if (act0) slc_visit1(Kb, Vb, Q[0], O[0], m[0], l[0], 64 * j, mask, tok0, sl2, sb0, lj);
            else if (act1) slc_visit1(Kb, Vb, Q[1], O[1], m[1], l[1], 64 * j, mask, tok1, sl2, sb1, lj);
            asm volatile("s_waitcnt lgkmcnt(0)" ::: "memory");
        }
        asm volatile("" ::: "memory");
        if (lane == 0) flg[wv] = (unsigned)(j + 1);
        asm volatile("" ::: "memory");
    }
    asm volatile("s_waitcnt vmcnt(0)" ::: "memory");
    __syncthreads();
#undef SLC_LOAD
}

struct SrcMem { const char* kb; const char* vb;
    __device__ __forceinline__ unsigned off(int key) const { return (unsigned)min(key, NMEM - 1) * 256u; } };
struct MaskNone { __device__ __forceinline__ bool operator()(int, int) const { return true; } };

__device__ __forceinline__ void cross_fast(Ctx& F, int layer, bf16* MIX) {
    for (int u = blockIdx.x; u < 256; u += F.G) {
        int tidv = F.wave * 64 + (int)__builtin_amdgcn_mbcnt_hi(~0u, __builtin_amdgcn_mbcnt_lo(~0u, 0u)); asm volatile("" : "+v"(tidv));
        const int lane = tidv & 63, c16 = lane & 15, g = lane >> 4;
        const int h = u & 3, tb = u >> 2;
        int tok[2]; bf16x8 Q[2][4]; f32x4 O[2][8]; float m[2], l[2];
#pragma unroll
        for (int rt = 0; rt < 2; ++rt) { tok[rt] = tb * 256 + F.wave * 32 + rt * 16 + c16; m[rt] = -1e30f; l[rt] = 0.f;
#pragma unroll
            for (int kd = 0; kd < 4; ++kd) Q[rt][kd] = *(const bf16x8*)((const char*)F.P + ((unsigned)tok[rt] * (unsigned)(NP * 2) + (unsigned)((CXQ + h * 128 + g * 8 + kd * 32) * 2)));
#pragma unroll
            for (int dt = 0; dt < 8; ++dt) O[rt][dt] = (f32x4){0.f, 0.f, 0.f, 0.f}; }
        SrcMem src{(const char*)(F.MEMKV + (((size_t)layer * 2 + 0) * 4 + h) * NMEM * 128), (const char*)(F.MEMKV + (((size_t)layer * 2 + 1) * 4 + h) * NMEM * 128)};
        attn_pass<0>(F, F.lds, Q, O, m, l, 0, 4, src, MaskNone(), tok[0], tok[1], 0.08838834764831845f * LOG2E);
#pragma unroll
        for (int rt = 0; rt < 2; ++rt) {
            float lt = xsum4(l[rt], lane);
            const float inv = 1.f / lt;
#pragma unroll
            for (int dt = 0; dt < 8; ++dt) { const int d = dt * 16 + g * 4;
                const unsigned long long xg = *(const unsigned long long*)((const char*)F.P + ((unsigned)tok[rt] * (unsigned)(NP * 2) + (unsigned)((CXG + h * 128 + d) * 2)));
                const unsigned lo = (unsigned)xg, hi = (unsigned)(xg >> 32);
                const float o0 = O[rt][dt][0] * inv * silu_f(bf2f((bf16)(lo & 0xffff))), o1 = O[rt][dt][1] * inv * silu_f(bf2f((bf16)(lo >> 16)));
                const float o2 = O[rt][dt][2] * inv * silu_f(bf2f((bf16)(hi & 0xffff))), o3 = O[rt][dt][3] * inv * silu_f(bf2f((bf16)(hi >> 16)));
                *(unsigned long long*)((char*)MIX + ((unsigned)tok[rt] * (unsigned)(DM * 2) + (unsigned)((1536 + h * 128 + d) * 2))) = (unsigned long long)pk2(o0, o1) | ((unsigned long long)pk2(o2, o3) << 32); }
        }
    }
}


struct SrcRows { const char* kb; const char* vb;
    __device__ __forceinline__ unsigned off(int key) const { return (unsigned)min(max(key, 0), T - 1) * 256u; } };
struct MaskWin { __device__ __forceinline__ bool operator()(int t, int key) const { return key <= t && key > t - 512; } };
struct SrcCmp { const char* kb; const char* vb;
    __device__ __forceinline__ unsigned off(int key) const { return (unsigned)min(key, 1022) * 256u; } };
struct MaskCmp { __device__ __forceinline__ bool operator()(int t, int key) const { return 16 * key + 31 <= t; } };

struct MaskCausal { __device__ __forceinline__ bool operator()(int t, int key) const { return key <= t; } };

__device__ __forceinline__ void nsa_main_fast(Ctx& F) {
    const float sl2 = 0.08838834764831845f * LOG2E;
    LAS float* imp = (LAS float*)(F.lds + RING * TILE_KV) + F.wave * 1024;
    LAS unsigned* bm = (LAS unsigned*)(F.lds + RING_BYTES + 1024) + F.wave * 32;
    for (;;) {
        int zq = 0; asm volatile("" : "+s"(zq));
        unsigned* qctr = (unsigned*)(F.ws + WS_CTL) + 8192 + zq;
        volatile LAS int* qslot = (volatile LAS int*)(F.lds + RING_BYTES + 3072) + zq;
        __syncthreads();
        if (F.wave == 0 && __builtin_amdgcn_mbcnt_hi(~0u, __builtin_amdgcn_mbcnt_lo(~0u, 0u)) == 0) qslot[0] = (int)__hip_atomic_fetch_add(qctr, 1u, __ATOMIC_RELAXED, __HIP_MEMORY_SCOPE_AGENT);
        __syncthreads();
        const int ticket = qslot[0];
        if (ticket >= 1024) break;
        const int g = ticket & 1, tb = 511 - (ticket >> 1);
        int tidv = F.wave * 64 + (int)__builtin_amdgcn_mbcnt_hi(~0u, __builtin_amdgcn_mbcnt_lo(~0u, 0u)); asm volatile("" : "+v"(tidv));
        const int lane = tidv & 63, c16 = lane & 15, gq = lane >> 4, ts = c16 >> 3, hs = c16 & 7; const bool hv = hs < 6;
        int tok[2]; f32x4 O[2][8]; bf16x8 Q[2][4]; float m[2], l[2];
        {
            float gw[2], gc[2];
#pragma unroll
            for (int rt = 0; rt < 2; ++rt) { tok[rt] = tb * 32 + F.wave * 4 + rt * 2 + ts; m[rt] = -1e30f; l[rt] = 0.f;
                const char* Pb = (const char*)F.P; const unsigned ro = (unsigned)tok[rt] * (unsigned)(NP * 2);
#pragma unroll
                for (int kd = 0; kd < 4; ++kd) { Q[rt][kd] = (bf16x8){0, 0, 0, 0, 0, 0, 0, 0}; if (hv) Q[rt][kd] = *(const bf16x8*)(Pb + (ro + (unsigned)((NQ + (g * 6 + hs) * 128 + gq * 8 + kd * 32) * 2))); }
                gw[rt] = hv ? sigmoid_f(bf2f(*(const bf16*)(Pb + (ro + (unsigned)((CGL + g * 18 + hs * 3 + 2) * 2))))) : 0.f;
                gc[rt] = hv ? sigmoid_f(bf2f(*(const bf16*)(Pb + (ro + (unsigned)((CGL + g * 18 + hs * 3 + 0) * 2))))) : 0.f;
#pragma unroll
                for (int dt = 0; dt < 8; ++dt) O[rt][dt] = (f32x4){0.f, 0.f, 0.f, 0.f}; }
            { const int klo = max(0, tb * 32 - 511), k0 = (klo >> 6) << 6, nt = ((tb * 32 + 31 - k0) >> 6) + 1;
              attn_pass<0>(F, F.lds, Q, O, m, l, k0, nt, SrcRows{(const char*)(F.CP + (8 + g) * PLANE), (const char*)(F.CP + (10 + g) * PLANE)}, MaskWin(), tok[0], tok[1], sl2); }
#pragma unroll
            for (int rt = 0; rt < 2; ++rt) { float lt = xsum4(l[rt], lane); const float f = gw[rt] / lt;
#pragma unroll
                for (int dt = 0; dt < 8; ++dt) O[rt][dt] = O[rt][dt] * f; m[rt] = -1e30f; l[rt] = 0.f; }
            const int tlast = tb * 32 + 31, ncv = (tlast - 31) / 16 + 1, ntc = (ncv + 63) >> 6;
            SrcCmp sc_{(const char*)(F.KCMP + (size_t)g * 1024 * 128), (const char*)(F.VCMP + (size_t)g * 1024 * 128)};
            attn_pass<1>(F, F.lds, Q, O, m, l, 0, ntc, sc_, MaskCmp(), tok[0], tok[1], sl2);
#pragma unroll
            for (int rt = 0; rt < 2; ++rt) { float lt = xsum4(l[rt], lane); l[rt] = lt > 0.f ? 1.f / lt : 0.f; }
            attn_pass<2>(F, F.lds, Q, O, m, l, 0, ntc, sc_, MaskCmp(), tok[0], tok[1], sl2, ImpArgs{gc[0], gc[1], hv, imp, nullptr});
        }
        for (int s = 0; s < 4; ++s) {
            const int tt = tb * 32 + F.wave * 4 + s, cur = tt >> 6;
            unsigned key[4]; bool sel[4];
#pragma unroll
            for (int i = 0; i < 4; ++i) { const int jj = lane + 64 * i; float f = imp[s * 256 + jj]; if (jj == 0 || jj == cur || jj == cur - 1) f = 1e4f;
                key[i] = (jj > cur) ? 0u : __builtin_bit_cast(unsigned, fmaxf(f, 0.f)) + 1u; sel[i] = (jj <= cur); }
            if (cur + 1 > 16) {
                unsigned prefix = 0u;
                for (int bit = 31; bit >= 0; --bit) { const unsigned cand = prefix | (1u << bit);
                    const int cnt = __popcll(__ballot(key[0] >= cand)) + __popcll(__ballot(key[1] >= cand)) + __popcll(__ballot(key[2] >= cand)) + __popcll(__ballot(key[3] >= cand));
                    if (cnt >= 16) prefix = cand; }
                const unsigned long long g0 = __ballot(key[0] > prefix), g1 = __ballot(key[1] > prefix), g2 = __ballot(key[2] > prefix), g3 = __ballot(key[3] > prefix);
                const unsigned long long e0 = __ballot(key[0] == prefix), e1 = __ballot(key[1] == prefix), e2 = __ballot(key[2] == prefix), e3 = __ballot(key[3] == prefix);
                const int need = 16 - (__popcll(g0) + __popcll(g1) + __popcll(g2) + __popcll(g3));
                const unsigned long long lt = (1ull << lane) - 1ull;
                const int r0 = __popcll(e0 & lt), r1 = __popcll(e0) + __popcll(e1 & lt), r2 = __popcll(e0) + __popcll(e1) + __popcll(e2 & lt), r3 = __popcll(e0) + __popcll(e1) + __popcll(e2) + __popcll(e3 & lt);
                sel[0] = (key[0] > prefix) || (key[0] == prefix && r0 < need); sel[1] = (key[1] > prefix) || (key[1] == prefix && r1 < need);
                sel[2] = (key[2] > prefix) || (key[2] == prefix && r2 < need); sel[3] = (key[3] > prefix) || (key[3] == prefix && r3 < need);
            }
#pragma unroll
            for (int i = 0; i < 4; ++i) { const unsigned long long b = __ballot(sel[i]); if (lane == 0) { bm[s * 8 + 2 * i] = (unsigned)b; bm[s * 8 + 2 * i + 1] = (unsigned)(b >> 32); } }
        }
        if (hv) {
#pragma unroll
            for (int rt = 0; rt < 2; ++rt)
#pragma unroll
                for (int dt = 0; dt < 8; ++dt) { const int col = (g * 6 + hs) * 128 + dt * 16 + gq * 4;
                    *(unsigned long long*)((char*)F.MIX1 + ((unsigned)tok[rt] * (unsigned)(DM * 2) + (unsigned)(col * 2))) = (unsigned long long)cvtpk(O[rt][dt][0], O[rt][dt][1]) | ((unsigned long long)cvtpk(O[rt][dt][2], O[rt][dt][3]) << 32); }
        }
#pragma unroll
        for (int rt = 0; rt < 2; ++rt) { m[rt] = -1e30f; l[rt] = 0.f;
#pragma unroll
            for (int dt = 0; dt < 8; ++dt) O[rt][dt] = (f32x4){0.f, 0.f, 0.f, 0.f}; }
        slc_pass(F, F.lds, Q, O, m, l, ((tb * 32) >> 6) + 1, SrcRows{(const char*)(F.CP + (4 + g) * PLANE), (const char*)(F.CP + (6 + g) * PLANE)}, MaskCausal(), tok[0], tok[1], sl2, ImpArgs{0.f, 0.f, hv, nullptr, bm});
        const float lts0 = xsum4(l[0], lane), lts1 = xsum4(l[1], lane);
        if (hv) {
#pragma unroll
            for (int rt = 0; rt < 2; ++rt) {
                const float lt = rt ? lts1 : lts0;
                const float f = sigmoid_f(bf2f(*(const bf16*)((const char*)F.P + ((unsigned)tok[rt] * (unsigned)(NP * 2) + (unsigned)((CGL + g * 18 + hs * 3 + 1) * 2))))) / lt;
#pragma unroll
                for (int dt = 0; dt < 8; ++dt) { const int col = (g * 6 + hs) * 128 + dt * 16 + gq * 4;
                    char* mp = (char*)F.MIX1 + ((unsigned)tok[rt] * (unsigned)(DM * 2) + (unsigned)(col * 2));
                    const unsigned long long pp = *(const unsigned long long*)mp; const unsigned plo = (unsigned)pp, phi = (unsigned)(pp >> 32);
                    const unsigned long long rr = *(const unsigned long long*)((const char*)F.P + ((unsigned)tok[rt] * (unsigned)(NP * 2) + (unsigned)((CR + col) * 2))); const unsigned lo = (unsigned)rr, hi = (unsigned)(rr >> 32);
                    const float o0 = (O[rt][dt][0] * f + bf2f((bf16)(plo & 0xffff))) * silu_f(bf2f((bf16)(lo & 0xffff))), o1 = (O[rt][dt][1] * f + bf2f((bf16)(plo >> 16))) * silu_f(bf2f((bf16)(lo >> 16)));
                    const float o2 = (O[rt][dt][2] * f + bf2f((bf16)(phi & 0xffff))) * silu_f(bf2f((bf16)(hi & 0xffff))), o3 = (O[rt][dt][3] * f + bf2f((bf16)(phi >> 16))) * silu_f(bf2f((bf16)(hi >> 16)));
                    *(unsigned long long*)mp = (unsigned long long)cvtpk(o0, o1) | ((unsigned long long)cvtpk(o2, o3) << 32); }
            }
        }
    }
}

__device__ __forceinline__ void gla_g1_fast(Ctx& F) {
    int tidv = F.wave * 64 + (int)__builtin_amdgcn_mbcnt_hi(~0u, __builtin_amdgcn_mbcnt_lo(~0u, 0u)); asm volatile("" : "+v"(tidv));
    const int tid = tidv, lane = tidv & 63, c16 = lane & 15, gq = lane >> 4, wave = F.wave;
    constexpr int QP = 416, VP = 800;
    LAS float* bcum = (LAS float*)F.lds;
    LAS unsigned char* Vt = F.lds;
    LAS unsigned char* QT = F.lds + 51200;
    LAS unsigned char* KT = F.lds + 51200 + 26624;
    LAS float* eblast = (LAS float*)(F.lds + 104448);
    LAS float* tot0 = (LAS float*)(F.lds + 105216);
    LAS float* glr = (LAS float*)(F.lds + 105984);
    const float qscale = 0.07216878364870323f;
    for (int u = blockIdx.x; u < 1024; u += F.G) {
        const int n = u >> 2, h = u & 3; const size_t row0 = (size_t)n * 64;
        for (int i = tid; i < 1024; i += NTHR) glr[i] = bf2f(F.P[(row0 + (i >> 4)) * NP + CGL + (i & 15)]);
        __syncthreads();
        if (tid < 384) {
            const int seg = tid >= 192 ? 1 : 0, d = tid - 192 * seg, col = h * 192 + d; float wg[16];
#pragma unroll
            for (int j = 0; j < 16; ++j) wg[j] = F.gla_w_gate[j * 768 + col];
            const float bias = F.gla_b_gate[col]; float b = 0.f;
            for (int c = 32 * seg; c < 32 * seg + 32; ++c) { float gl = bias;
#pragma unroll
                for (int j = 0; j < 16; ++j) gl += glr[c * 16 + j] * wg[j];
                b += logsigmoid_f(gl) * (1.f / 16.f); bcum[c * 192 + d] = b; }
            if (seg == 0) tot0[d] = b;
        }
        __syncthreads();
        if (tid >= 192 && tid < 384) { const int d = tid - 192; const float t0 = tot0[d];
            for (int c = 32; c < 64; ++c) bcum[c * 192 + d] += t0; }
        __syncthreads();
        if (tid < 192) { const float eb = __expf(bcum[63 * 192 + tid]); eblast[tid] = eb; F.DEC[n * 768 + h * 192 + tid] = eb; }
#pragma unroll
        for (int i = 0; i < 3; ++i) { const int idx = tid + NTHR * i, c = idx / 24, d8 = (idx % 24) * 8;
            bf16* qg = F.P + (row0 + c) * NP + GQ + h * 192 + d8; const bf16* kg = F.P + (row0 + c) * NP + GK + h * 192 + d8;
            const v4u qr = *(const v4u*)qg, kr = *(const v4u*)kg;
            const unsigned qw[4] = {qr.x, qr.y, qr.z, qr.w}, kw[4] = {kr.x, kr.y, kr.z, kr.w}; unsigned qo[4], ko[4];
#pragma unroll
            for (int j = 0; j < 4; ++j) { const float b0 = bcum[c * 192 + d8 + 2 * j], b1 = bcum[c * 192 + d8 + 2 * j + 1];
                qo[j] = pk2(bf2f((bf16)(qw[j] & 0xffff)) * qscale * __expf(b0), bf2f((bf16)(qw[j] >> 16)) * qscale * __expf(b1));
                ko[j] = pk2(bf2f((bf16)(kw[j] & 0xffff)) * __expf(-b0), bf2f((bf16)(kw[j] >> 16)) * __expf(-b1)); }
            const v4u qv = {qo[0], qo[1], qo[2], qo[3]}, kv = {ko[0], ko[1], ko[2], ko[3]};
            *(LAS v4u*)(QT + c * QP + d8 * 2) = qv; *(LAS v4u*)(KT + c * QP + d8 * 2) = kv; *(v4u*)qg = qv; }
        __syncthreads();
#pragma unroll
        for (int i = 0; i < 6; ++i) { const int idx = tid + NTHR * i, r = idx / 48, ch = idx % 48;
            *(LAS v4u*)(Vt + r * VP + ch * 16) = *(const v4u*)(F.P + (row0 + r) * NP + GV + h * 384 + ch * 8); }
        __syncthreads();
        {
            bf16x8 vB[3][2];
#pragma unroll
            for (int j = 0; j < 3; ++j)
#pragma unroll
                for (int ks = 0; ks < 2; ++ks) { const LAS unsigned char* p = Vt + (32 * ks + 4 * gq + (c16 >> 2)) * VP + (16 * (3 * wave + j) + 4 * (c16 & 3)) * 2;
                    const s16x4 lo = vtr(p), hi = vtr(p + 16 * VP); vB[j][ks] = (bf16x8){lo[0], lo[1], lo[2], lo[3], hi[0], hi[1], hi[2], hi[3]}; }
            for (int dt = 0; dt < 12; ++dt) {
                bf16x8 aK[2];
#pragma unroll
                for (int ks = 0; ks < 2; ++ks) { const LAS unsigned char* p = KT + (32 * ks + 4 * gq + (c16 >> 2)) * QP + (16 * dt + 4 * (c16 & 3)) * 2;
                    const s16x4 lo = vtr(p), hi = vtr(p + 16 * QP); aK[ks] = (bf16x8){lo[0], lo[1], lo[2], lo[3], hi[0], hi[1], hi[2], hi[3]}; }
                const f32x4 eb = *(const LAS f32x4*)(eblast + 16 * dt + 4 * gq);
#pragma unroll
                for (int j = 0; j < 3; ++j) { f32x4 acc = {0.f, 0.f, 0.f, 0.f};
                    acc = __builtin_amdgcn_mfma_f32_16x16x32_bf16(aK[0], vB[j][0], acc, 0, 0, 0);
                    acc = __builtin_amdgcn_mfma_f32_16x16x32_bf16(aK[1], vB[j][1], acc, 0, 0, 0);
                    const int e = 16 * (3 * wave + j) + c16;
                    *(unsigned long long*)(F.STATE + ((size_t)u * 384 + e) * 192 + 16 * dt + 4 * gq) = (unsigned long long)pk2(acc[0] * eb[0], acc[1] * eb[1]) | ((unsigned long long)pk2(acc[2] * eb[2], acc[3] * eb[3]) << 32); }
            }
        }
        {
            const int ct = wave & 3, eh = wave >> 2;
            bf16x8 qB[6];
#pragma unroll
            for (int kd = 0; kd < 6; ++kd) qB[kd] = *(const LAS bf16x8*)(QT + (16 * ct + c16) * QP + (8 * gq + 32 * kd) * 2);
            f32x4 at[4];
#pragma unroll
            for (int st = 0; st < 4; ++st) { at[st] = (f32x4){0.f, 0.f, 0.f, 0.f};
                if (st <= ct) {
#pragma unroll
                    for (int kd = 0; kd < 6; ++kd) { const bf16x8 kA = *(const LAS bf16x8*)(KT + (16 * st + c16) * QP + (8 * gq + 32 * kd) * 2);
                        at[st] = __builtin_amdgcn_mfma_f32_16x16x32_bf16(kA, qB[kd], at[st], 0, 0, 0); }
#pragma unroll
                    for (int r = 0; r < 4; ++r) if (16 * st + 4 * gq + r > 16 * ct + c16) at[st][r] = 0.f;
                } }
            v4u pw0, pw1; pw0.x = pk2(at[0][0], at[0][1]); pw0.y = pk2(at[0][2], at[0][3]); pw0.z = pk2(at[1][0], at[1][1]); pw0.w = pk2(at[1][2], at[1][3]);
            pw1.x = pk2(at[2][0], at[2][1]); pw1.y = pk2(at[2][2], at[2][3]); pw1.z = pk2(at[3][0], at[3][1]); pw1.w = pk2(at[3][2], at[3][3]);
            const bf16x8 pA0 = __builtin_bit_cast(bf16x8, pw0), pA1 = __builtin_bit_cast(bf16x8, pw1);
            for (int j = 0; j < 12; ++j) { const int et = 12 * eh + j;
                bf16x8 vA[2];
#pragma unroll
                for (int ks = 0; ks < 2; ++ks) { const LAS unsigned char* p = Vt + (32 * ks + 4 * gq + (c16 >> 2)) * VP + (16 * et + 4 * (c16 & 3)) * 2;
                    const s16x4 lo = vtr(p), hi = vtr(p + 16 * VP); vA[ks] = (bf16x8){lo[0], lo[1], lo[2], lo[3], hi[0], hi[1], hi[2], hi[3]}; }
                f32x4 acc = {0.f, 0.f, 0.f, 0.f};
                acc = __builtin_amdgcn_mfma_f32_16x16x32_bf16(vA[0], pA0, acc, 0, 0, 0);
                acc = __builtin_amdgcn_mfma_f32_16x16x32_bf16(vA[1], pA1, acc, 0, 0, 0);
                *(unsigned long long*)(F.OI + (row0 + 16 * ct + c16) * 1536 + h * 384 + 16 * et + 4 * gq) = (unsigned long long)pk2(acc[0], acc[1]) | ((unsigned long long)pk2(acc[2], acc[3]) << 32); }
        }
        __syncthreads();
    }
}

__device__ __forceinline__ void gla_g3_fast(Ctx& F) {
    int tidv = F.wave * 64 + (int)__builtin_amdgcn_mbcnt_hi(~0u, __builtin_amdgcn_mbcnt_lo(~0u, 0u)); asm volatile("" : "+v"(tidv));
    const int lane = tidv & 63, c16 = lane & 15, gq = lane >> 4, wave = F.wave, ct = wave & 3, eh = wave >> 2;
    LAS float* ssq = (LAS float*)F.lds;
    for (int u = blockIdx.x; u < 1024; u += F.G) {
        const int n = u >> 2, h = u & 3; const size_t crow = (size_t)n * 64 + 16 * ct + c16;
        f32x4 acc[12];
#pragma unroll
        for (int j = 0; j < 12; ++j) acc[j] = (f32x4){0.f, 0.f, 0.f, 0.f};
        if (n > 0) {
            bf16x8 qB[6];
#pragma unroll
            for (int kd = 0; kd < 6; ++kd) qB[kd] = *(const bf16x8*)(F.P + crow * NP + GQ + h * 192 + 8 * gq + 32 * kd);
            const bf16* Sp = F.STATE + ((size_t)(u - 4) * 384 + 192 * eh + c16) * 192 + 8 * gq;
#pragma unroll
            for (int j = 0; j < 12; ++j)
#pragma unroll
                for (int kd = 0; kd < 6; ++kd) { const bf16x8 a = *(const bf16x8*)(Sp + (size_t)(16 * j) * 192 + 32 * kd);
                    acc[j] = __builtin_amdgcn_mfma_f32_16x16x32_bf16(a, qB[kd], acc[j], 0, 0, 0); }
        }
        float ss = 0.f;
#pragma unroll
        for (int j = 0; j < 12; ++j) { const int e0 = h * 384 + 192 * eh + 16 * j + 4 * gq;
            const unsigned long long oi = *(const unsigned long long*)(F.OI + crow * 1536 + e0); const unsigned lo = (unsigned)oi, hi = (unsigned)(oi >> 32);
            acc[j][0] += bf2f((bf16)(lo & 0xffff)); acc[j][1] += bf2f((bf16)(lo >> 16)); acc[j][2] += bf2f((bf16)(hi & 0xffff)); acc[j][3] += bf2f((bf16)(hi >> 16));
            ss += (acc[j][0] * acc[j][0] + acc[j][1] * acc[j][1]) + (acc[j][2] * acc[j][2] + acc[j][3] * acc[j][3]); }
        ss += __shfl_xor(ss, 16); ss += __shfl_xor(ss, 32);
        if (gq == 0) ssq[eh * 64 + 16 * ct + c16] = ss;
        __syncthreads();
        const float rstd = rsqrtf((ssq[16 * ct + c16] + ssq[64 + 16 * ct + c16]) * (1.f / 384.f) + EPS);
#pragma unroll
        for (int j = 0; j < 12; ++j) { const int el = 192 * eh + 16 * j + 4 * gq, e0 = h * 384 + el;
            const f32x4 gn = *(const f32x4*)(F.gla_norm + el);
            const unsigned long long rr = *(const unsigned long long*)(F.P + crow * NP + CR + e0); const unsigned lo = (unsigned)rr, hi = (unsigned)(rr >> 32);
            const float o0 = acc[j][0] * rstd * gn[0] * silu_f(bf2f((bf16)(lo & 0xffff))), o1 = acc[j][1] * rstd * gn[1] * silu_f(bf2f((bf16)(lo >> 16)));
            const float o2 = acc[j][2] * rstd * gn[2] * silu_f(bf2f((bf16)(hi & 0xffff))), o3 = acc[j][3] * rstd * gn[3] * silu_f(bf2f((bf16)(hi >> 16)));
            *(unsigned long long*)(F.MIX0 + crow * DM + e0) = (unsigned long long)pk2(o0, o1) | ((unsigned long long)pk2(o2, o3) << 32); }
        __syncthreads();
    }
}


__device__ __forceinline__ void memkv_fast(Ctx& F) {
    int tidv = F.wave * 64 + (int)__builtin_amdgcn_mbcnt_hi(~0u, __builtin_amdgcn_mbcnt_lo(~0u, 0u)); asm volatile("" : "+v"(tidv));
    const int lane = tidv & 63, c16 = lane & 15, gq = lane >> 4;
    for (int u = F.gw; u < 2048; u += F.NGW) {
        const int layer = u >> 10, mt = (u >> 6) & 15, ntile = u & 63;
        const float* ar = F.mem + (size_t)(16 * mt + c16) * DM + 8 * gq; const float* gr = F.ln_mem + layer * DM + 8 * gq;
        const bf16* br = F.WMKV + ((size_t)layer * 1024 + 16 * ntile + c16) * DM + 8 * gq;
        f32x4 acc = {0.f, 0.f, 0.f, 0.f}; float ss = 0.f;
#pragma unroll 4
        for (int ks = 0; ks < 64; ++ks) {
            const f32x4 a0 = *(const f32x4*)(ar + 32 * ks), a1 = *(const f32x4*)(ar + 32 * ks + 4), g0 = *(const f32x4*)(gr + 32 * ks), g1 = *(const f32x4*)(gr + 32 * ks + 4);
            ss += (a0.x * a0.x + a0.y * a0.y) + (a0.z * a0.z + a0.w * a0.w) + (a1.x * a1.x + a1.y * a1.y) + (a1.z * a1.z + a1.w * a1.w);
            v4u aw; aw.x = pk2(a0.x * g0.x, a0.y * g0.y); aw.y = pk2(a0.z * g0.z, a0.w * g0.w); aw.z = pk2(a1.x * g1.x, a1.y * g1.y); aw.w = pk2(a1.z * g1.z, a1.w * g1.w);
            const bf16x8 bfr = *(const bf16x8*)(br + 32 * ks);
            acc = __builtin_amdgcn_mfma_f32_16x16x32_bf16(__builtin_bit_cast(bf16x8, aw), bfr, acc, 0, 0, 0);
        }
        ss += __shfl_xor(ss, 16); ss += __shfl_xor(ss, 32);
        const float rs = rsqrtf(ss * (1.f / DM) + EPS);
        const int n = 16 * ntile + c16, kv = n >> 9, h = (n >> 7) & 3, d = n & 127;
#pragma unroll
        for (int r = 0; r < 4; ++r) { const int ml = 4 * gq + r; const float rr = __shfl(rs, ml);
            F.MEMKV[((((size_t)layer * 2 + kv) * 4 + h) * NMEM + 16 * mt + ml) * 128 + d] = f2b(acc[r] * rr); }
    }
}

__device__ __forceinline__ void nsa_compress_fast(Ctx& F) {
    int tidv = F.wave * 64 + (int)__builtin_amdgcn_mbcnt_hi(~0u, __builtin_amdgcn_mbcnt_lo(~0u, 0u)); asm volatile("" : "+v"(tidv));
    const int lane = tidv & 63, c16 = lane & 15, gq = lane >> 4, wave = F.wave;
    LAS unsigned char* hid = F.lds;
    constexpr int HP = 544;
    for (int u = blockIdx.x; u < 256; u += F.G) {
        const int kv = u & 1, g = (u >> 1) & 1, nt16 = u >> 2;
        const bf16* W1T = kv ? F.WV1T : F.WK1T; const float* w2 = kv ? F.wv2 : F.wk2; const float* hb = F.HB + kv * 32 * 256;
        const int n = min(16 * nt16 + c16, 1022);
        const bf16* ar = F.CP + (size_t)(kv * 2 + g) * PLANE + (size_t)(16 * n) * 128 + 8 * gq;
        const bf16* b0 = W1T + (size_t)(32 * wave + c16) * 4096 + 8 * gq; const bf16* b1 = b0 + (size_t)16 * 4096;
        f32x4 acc0 = {0.f, 0.f, 0.f, 0.f}, acc1 = {0.f, 0.f, 0.f, 0.f};
        for (int l = 0; l < 32; ++l) {
#pragma unroll
            for (int kd = 0; kd < 4; ++kd) { const bf16x8 a = *(const bf16x8*)(ar + l * 128 + 32 * kd);
                const bf16x8 w0 = *(const bf16x8*)(b0 + l * 128 + 32 * kd), w1 = *(const bf16x8*)(b1 + l * 128 + 32 * kd);
                acc0 = __builtin_amdgcn_mfma_f32_16x16x32_bf16(a, w0, acc0, 0, 0, 0); acc1 = __builtin_amdgcn_mfma_f32_16x16x32_bf16(a, w1, acc1, 0, 0, 0); }
        }
        { const int j0 = 32 * wave + c16; float h0 = 0.f, h1 = 0.f;
#pragma unroll 8
          for (int s = 0; s < 32; ++s) { h0 += hb[s * 256 + j0]; h1 += hb[s * 256 + j0 + 16]; }
#pragma unroll
          for (int r = 0; r < 4; ++r) { *(LAS bf16*)(hid + (4 * gq + r) * HP + j0 * 2) = f2b(silu_f(acc0[r] + h0)); *(LAS bf16*)(hid + (4 * gq + r) * HP + (j0 + 16) * 2) = f2b(silu_f(acc1[r] + h1)); } }
        __syncthreads();
        { f32x4 acc = {0.f, 0.f, 0.f, 0.f}; const int d = 16 * wave + c16;
#pragma unroll
          for (int ks = 0; ks < 8; ++ks) { const bf16x8 a = *(const LAS bf16x8*)(hid + c16 * HP + (8 * gq + 32 * ks) * 2);
              const float* wp = w2 + (size_t)(8 * gq + 32 * ks) * 128 + d;
              v4u bw; bw.x = pk2(wp[0], wp[128]); bw.y = pk2(wp[256], wp[384]); bw.z = pk2(wp[512], wp[640]); bw.w = pk2(wp[768], wp[896]);
              acc = __builtin_amdgcn_mfma_f32_16x16x32_bf16(a, __builtin_bit_cast(bf16x8, bw), acc, 0, 0, 0); }
          bf16* outp = (kv ? F.VCMP : F.KCMP) + (size_t)g * 1024 * 128;
#pragma unroll
          for (int r = 0; r < 4; ++r) { const int nn = 16 * nt16 + 4 * gq + r; if (nn < 1023) outp[(size_t)nn * 128 + d] = f2b(acc[r]); } }
        __syncthreads();
    }
}


__device__ __forceinline__ void load_ptrs(Ctx& F) {
    typedef const float* cfp;
    const volatile __attribute__((address_space(4))) cfp* ka = (const volatile __attribute__((address_space(4))) cfp*)__builtin_amdgcn_kernarg_segment_ptr();
    F.x = ka[0]; F.mem = ka[1]; F.ln_pre = ka[2]; F.ln_post = ka[3]; F.ln_mem = ka[4]; F.w_mem_kv = ka[5];
    F.gla_w_in = ka[6]; F.gla_w_gate = ka[7]; F.gla_b_gate = ka[8]; F.gla_norm = ka[9]; F.gla_w_out = ka[10];
    F.nsa_w_in = ka[11]; F.pe_k = ka[12]; F.pe_v = ka[13]; F.wk1 = ka[14]; F.wk2 = ka[15]; F.wv1 = ka[16]; F.wv2 = ka[17]; F.nsa_w_out = ka[18];
    F.out = (float*)ka[19]; F.ws = (unsigned char*)ka[20];
    unsigned char* ws = F.ws;
    F.WIN0 = (bf16*)(ws + WS_WIN0); F.WIN1 = (bf16*)(ws + WS_WIN1); F.WOUT0 = (bf16*)(ws + WS_WOUT0); F.WOUT1 = (bf16*)(ws + WS_WOUT1); F.WMKV = (bf16*)(ws + WS_WMKV);
    F.WK1T = (bf16*)(ws + WS_WK1T); F.WV1T = (bf16*)(ws + WS_WV1T); F.HB = (float*)(ws + WS_SEL);
    F.MEMKV = (bf16*)(ws + WS_MEMKV); F.DEC = (float*)(ws + WS_DEC); F.KCMP = (bf16*)(ws + WS_KCMP); F.VCMP = (bf16*)(ws + WS_VCMP);
    F.XN = (bf16*)(ws + WS_XN); F.P = (bf16*)(ws + WS_P); F.STATE = (bf16*)(ws + WS_STATE); F.MIX1 = (bf16*)(ws + WS_MIX1); F.CP = (bf16*)(ws + WS_CP);
    F.MIX0 = (bf16*)((unsigned char*)F.out + DO_MIX0); F.OI = (bf16*)((unsigned char*)F.out + DO_OI);
}
__global__ void __launch_bounds__(NTHR, 2) fwd_kernel(Args args) {
    extern __shared__ __attribute__((aligned(16))) unsigned char lds_raw[];
    Ctx F;
    F.lds = (LAS unsigned char*)lds_raw;
    F.tid = threadIdx.x; F.lane = F.tid & 63; F.wave = __builtin_amdgcn_readfirstlane(F.tid >> 6);
    F.G = gridDim.x; F.gw = blockIdx.x * NWAVES + F.wave; F.NGW = F.G * NWAVES;
    load_ptrs(F);
    unsigned char* ws = F.ws;

    volatile LAS unsigned* MISC = (volatile LAS unsigned*)(F.lds + MISC_OFF);
    for (int u = F.tid; u < (LDS_BYTES - LDSCTL_OFF) / 4; u += NTHR) ((LAS unsigned*)(F.lds + LDSCTL_OFF))[u] = 0u;
    __syncthreads();
    const int lo = args.ph_lo, hi = args.ph_hi;
    XcdBarrier bar; bar.bar = (unsigned*)(ws + WS_CTL); bar.x = 0; bar.st = nullptr;
    if (hi - lo > 1) bar = xcd_barrier_post((unsigned*)(ws + WS_CTL), MISC + 8, F.wave);
#define IN(k) (lo <= (k) && (k) < hi)
#define REFRESH() do { int t_ = F.wave * 64 + (int)__builtin_amdgcn_mbcnt_hi(~0u, __builtin_amdgcn_mbcnt_lo(~0u, 0u)); asm volatile("" : "+v"(t_)); F.tid = t_; F.lane = t_ & 63; load_ptrs(F); } while (0)
#define SEAM(k) do { if (IN(k) && IN((k) + 1)) xcd_barrier(bar, F.wave); } while (0)

    if (IN(0)) { REFRESH(); phase_prep(F); } SEAM(0);
    if (IN(1)) { REFRESH(); memkv_fast(F); REFRESH();
        pg8::Gemm g{F.XN, F.WIN0, T, NP, DM, F.wave}; pg8::StaticOrder S; S.init(T, NP, F.G, (int)blockIdx.x);
        pg8::EpiBf16<0> E{F.P, NP, nullptr, 0, 0, 1.f};
        pg8::gemm_phase<pg8::EpiBf16<0>, pg8::StaticOrder, true, true>(F.lds, g, S, E); } SEAM(1);
    if (IN(2)) { REFRESH(); gla_g1_fast(F); REFRESH(); cross_fast(F, 0, F.MIX0); } SEAM(2);
    if (IN(3)) { REFRESH(); gla_scan(F); } SEAM(3);
    if (IN(4)) { REFRESH(); gla_g3_fast(F); } SEAM(4);
    if (IN(5)) { REFRESH(); pg8::Gemm g{F.MIX0, F.WOUT0, T, DM, DM, F.wave}; pg8::StaticOrder S; S.init(T, DM, F.G, (int)blockIdx.x);
        pg8::EpiBf16<0> E{F.XN, DM, nullptr, 0, 0, 1.f};
        pg8::gemm_phase<pg8::EpiBf16<0>, pg8::StaticOrder, true, true>(F.lds, g, S, E); } SEAM(5);
    if (IN(6)) { REFRESH(); post_rows(F, F.x, F.XN, F.ln_post, F.out, F.ln_pre + DM, F.XN); } SEAM(6);
    if (IN(7)) { REFRESH(); pg8::Gemm g{F.XN, F.WIN1, T, NP, DM, F.wave}; pg8::StaticOrder S; S.init(T, NP, F.G, (int)blockIdx.x);
        EpiNsaIn E{F.P, NP, F.CP};
        pg8::gemm_phase<EpiNsaIn, pg8::StaticOrder, true, true>(F.lds, g, S, E); } SEAM(7);
    if (IN(8)) { REFRESH(); nsa_compress_fast(F); } SEAM(8);
    if (IN(9)) { REFRESH(); nsa_main_fast(F); REFRESH(); cross_fast(F, 1, F.MIX1); } SEAM(9);
    if (IN(10)) { REFRESH(); pg8::Gemm g{F.MIX1, F.WOUT1, T, DM, DM, F.wave}; pg8::StaticOrder S; S.init(T, DM, F.G, (int)blockIdx.x);
        pg8::EpiBf16<0> E{F.XN, DM, nullptr, 0, 0, 1.f};
        pg8::gemm_phase<pg8::EpiBf16<0>, pg8::StaticOrder, true, true>(F.lds, g, S, E); } SEAM(10);
    if (IN(11)) { REFRESH(); post_rows(F, F.out, F.XN, F.ln_post + DM, F.out, nullptr, nullptr); }
#undef IN
#undef SEAM
}

#ifndef N_LAUNCHES
#define N_LAUNCHES 1
#endif
extern "C" void kernel_launch(void* const* d_in, const int* in_sizes, int n_in, void* d_out, int out_size, void* d_ws, size_t ws_size, hipStream_t stream) {
    static int grid = 0;
    if (grid == 0) {
        if (n_in != 19 || out_size != T * DM || ws_size < WS_END) { fprintf(stderr, "kernel_launch: unexpected shapes (n_in %d out %d ws %zu)\n", n_in, out_size, ws_size); grid = -1; return; }
        int dev = 0, cus = 0, per_cu = 0;
        if (hipGetDevice(&dev) != hipSuccess || hipDeviceGetAttribute(&cus, hipDeviceAttributeMultiprocessorCount, dev) != hipSuccess) { grid = -1; return; }
        if (hipFuncSetAttribute((const void*)fwd_kernel, hipFuncAttributeMaxDynamicSharedMemorySize, LDS_BYTES) != hipSuccess) { fprintf(stderr, "kernel_launch: hipFuncSetAttribute failed\n"); grid = -1; return; }
        if (hipOccupancyMaxActiveBlocksPerMultiprocessor(&per_cu, (const void*)fwd_kernel, NTHR, LDS_BYTES) != hipSuccess || per_cu < 1) fprintf(stderr, "kernel_launch: occupancy query reports %d\n", per_cu);
        (void)hipGetLastError();
        grid = cus;
    }
    if (grid < 0) return;
    if (hipMemsetAsync((char*)d_ws + WS_CTL, 0, CTL_ZERO_BYTES, stream) != hipSuccess) return;
    Args a{};
    for (int i = 0; i < 19; ++i) a.in[i] = (const float*)d_in[i];
    a.out = (float*)d_out; a.ws = (unsigned char*)d_ws;
    for (int li = 0; li < N_LAUNCHES; ++li) {
        a.ph_lo = li * N_PHASES / N_LAUNCHES; a.ph_hi = (li + 1) * N_PHASES / N_LAUNCHES;
        hipLaunchKernelGGL(fwd_kernel, dim3(grid), dim3(NTHR), LDS_BYTES, stream, a);
    }
}
```

```cpp
#include <hip/hip_runtime.h>
#include <cstdio>
#include <cstdint>
namespace pg8 {
#define PG8_LAS __attribute__((address_space(3)))
typedef unsigned short bf16_t;
typedef short bf16x8 __attribute__((ext_vector_type(8)));
typedef float f32x4 __attribute__((ext_vector_type(4)));
typedef unsigned u32x4 __attribute__((ext_vector_type(4)));
constexpr int BM = 256, BK = 64, HALF = 128, HTB = HALF * BK * 2  , STAGE_BYTES = 8 * HTB, NXCD = 8, WGM = 8;

__host__ __device__ __forceinline__ int lds_byte(int r, int c) { const int st = (r >> 4) * 2 + (c >> 5), rr = r & 15, cc = c & 31, ob = rr * 64 + cc * 2; return st * 1024 + (ob ^ (((ob >> 9) & 1) << 5)); }
__host__ __device__ __forceinline__ void stage_rc(int b, int& R, int& C) { const int st = b / 1024, sb = b % 1024, swz = sb ^ (((sb >> 9) & 1) << 5); R = (st >> 1) * 16 + swz / 64; C = (st & 1) * 32 + (swz % 64) / 2; }
__host__ __device__ __forceinline__ int perm32(int rho) { const int n = rho >> 4, i = rho & 15; return 8 * (i >> 2) + 4 * n + (i & 3); }

struct Unit { int pm, pn; };
struct Gemm { const bf16_t* A; const bf16_t* Bt; int M, N, K; int wave; };

struct StaticOrder {
    int nM, nN, nwg, G, c;
    __host__ __device__ void init(int M, int N, int G_, int c_) { nM = M / BM; nN = N / BM; nwg = nM * nN; G = G_; c = c_; }
    __host__ __device__ bool next(int i, Unit& u) const {
        const long L = (long)i * G + c; if (L >= nwg) return false;
        int wgid = (int)L; { const int q = nwg / NXCD, r = nwg % NXCD, xcd = wgid % NXCD, off = wgid / NXCD; wgid = (xcd < r ? xcd * (q + 1) : r * (q + 1) + (xcd - r) * q) + off; }
        const int nig = WGM * nN, gid = wgid / nig, fm = gid * WGM, gsz = (nM - fm) < WGM ? (nM - fm) : WGM;
        u.pm = fm + ((wgid % nig) % gsz); u.pn = (wgid % nig) / gsz; return true;
    }
    __device__ __forceinline__ void a_ready(const Unit&) const {}
    __device__ __forceinline__ void done(const Unit&) const {}
};

__device__ __forceinline__ unsigned cvt_pk_bf16(float lo, float hi) { unsigned r; asm volatile("v_cvt_pk_bf16_f32 %0, %1, %2" : "=v"(r) : "v"(lo), "v"(hi)); return r; }
typedef float f32x2 __attribute__((ext_vector_type(2)));
__device__ __forceinline__ f32x2 gelu_pk(f32x2 v) {
    const f32x2 av = __builtin_elementwise_abs(v), d = av * 0.2316418882f + 1.0f;
    f32x2 t; t.x = __builtin_amdgcn_rcpf(d.x); t.y = __builtin_amdgcn_rcpf(d.y);
    f32x2 q = t * 0.5307027145f + (-0.7265760135f); q = q * t + 0.7107068705f; q = q * t + (-0.142248368f); q = q * t + 0.127414796f; q = q * t;
    const f32x2 s = (v * v) * (-0.72134752044f);
    f32x2 e; e.x = __builtin_amdgcn_exp2f(s.x); e.y = __builtin_amdgcn_exp2f(s.y);
    const f32x2 m = v * (q * e), r = v - m;
    f32x2 o; o.x = v.x < 0.f ? m.x : r.x; o.y = v.y < 0.f ? m.y : r.y; return o;
}

template <int ACT  > struct EpiBf16 {
    static constexpr bool PERM = true, AFTER_DRAIN = false; static_assert(ACT == 0 || ACT == 1, "EpiBf16: ACT is 0 (none) or 1 (gelu_pk)");
    bf16_t* O; int ldc; const float* bias; int split_cols; size_t split_stride; float scale0;
    __device__ __forceinline__ void operator()(const f32x4 (&acc)[2][2][4][2], const Unit& u, int wr, int wc, int fr, int fq) const {
        const int row0 = u.pm * BM + wr * 64 + fr; int colt = u.pn * BM; bf16_t* base = O;
        float sc = 1.f; if (split_cols) { const int t = colt / split_cols; base += (size_t)t * split_stride; colt -= t * split_cols; if (t == 0) sc = scale0; }
        const int col0 = colt + wc * 32 + 8 * fq, bcol0 = u.pn * BM + wc * 32 + 8 * fq;
        f32x4 bv[2][2];
#pragma unroll
        for (int bj = 0; bj < 2; ++bj)
#pragma unroll
            for (int n = 0; n < 2; ++n) bv[bj][n] = bias ? *(const f32x4*)(bias + bcol0 + bj * HALF + 4 * n) : (f32x4){0.f, 0.f, 0.f, 0.f};
#pragma unroll
        for (int ai = 0; ai < 2; ++ai)
#pragma unroll
            for (int m = 0; m < 4; ++m) { bf16_t* rowp = base + (size_t)(row0 + ai * HALF + m * 16) * ldc + col0;
#pragma unroll
                for (int bj = 0; bj < 2; ++bj) { f32x4 v0 = acc[ai][bj][m][0] + bv[bj][0], v1 = acc[ai][bj][m][1] + bv[bj][1];
                    if (ACT == 1) { f32x2 a = gelu_pk((f32x2){v0[0], v0[1]}), b = gelu_pk((f32x2){v0[2], v0[3]}), c = gelu_pk((f32x2){v1[0], v1[1]}), d = gelu_pk((f32x2){v1[2], v1[3]});
                        v0 = (f32x4){a.x, a.y, b.x, b.y}; v1 = (f32x4){c.x, c.y, d.x, d.y}; }
                    v0 = v0 * sc; v1 = v1 * sc; u32x4 w; w.x = cvt_pk_bf16(v0[0], v0[1]); w.y = cvt_pk_bf16(v0[2], v0[3]); w.z = cvt_pk_bf16(v1[0], v1[1]); w.w = cvt_pk_bf16(v1[2], v1[3]);
                    *(u32x4*)(rowp + bj * HALF) = w; } }
    }
};

template <class Epi, class Sched, bool ALIGN_EPI = false, bool SP2 = false>
__device__ __forceinline__ void gemm_phase(PG8_LAS unsigned char* lds, const Gemm g, const Sched& S, const Epi& E) {
    const int wid = g.wave, lane = (int)__builtin_amdgcn_mbcnt_hi(~0u, __builtin_amdgcn_mbcnt_lo(~0u, 0u)), tid = wid * 64 + lane, wr = wid >> 2, wc = wid & 3, fr = lane & 15, fq = lane >> 4;
    const int K = g.K, nt = K / BK;
    unsigned voffA[2], voffB[2];
#pragma unroll
    for (int i = 0; i < 2; ++i) { int R, C; stage_rc(tid * 16 + i * 8192, R, C); const int Rb = Epi::PERM ? ((R & ~31) + perm32(R & 31)) : R;
        voffA[i] = (unsigned)(R * K + C) * 2u; voffB[i] = (unsigned)(Rb * K + C) * 2u; }
    const size_t kstep = (size_t)(BK * 2);
    const size_t hstep = (size_t)HALF * K * 2;
    const size_t tstep = 2 * hstep;
    const unsigned ldsw = (unsigned)wid * 1024u;
    const int aoff = lds_byte(wr * 64 + fr, fq * 8), boff = lds_byte(wc * 32 + fr, fq * 8);
#define PG8_SA(b, h) (((b) * 2 + (h)) * HTB)
#define PG8_SB(b, h) ((4 + (b) * 2 + (h)) * HTB)
#define PG8_STAGE(bufoff, gbase, voff) do { _Pragma("unroll") for (int _i = 0; _i < 2; ++_i) \
        __builtin_amdgcn_global_load_lds((const unsigned*)((const char*)(gbase) + (voff)[_i]), (PG8_LAS unsigned*)(lds + (bufoff) + ldsw + _i * 8192), 16, 0, 0); } while (0)
#define PG8_LDA(dst, b, h) do { _Pragma("unroll") for (int m = 0; m < 4; ++m) _Pragma("unroll") for (int k = 0; k < 2; ++k) dst[m][k] = *(const PG8_LAS bf16x8*)(lds + PG8_SA(b, h) + aoff + m * 2048 + k * 1024); } while (0)
#define PG8_LDB(dst, b, h) do { _Pragma("unroll") for (int n = 0; n < 2; ++n) _Pragma("unroll") for (int k = 0; k < 2; ++k) dst[n][k] = *(const PG8_LAS bf16x8*)(lds + PG8_SB(b, h) + boff + n * 2048 + k * 1024); } while (0)
#define PG8_MMA(ai, bj, At, Bt) do { __builtin_amdgcn_s_setprio(1); _Pragma("unroll") for (int m = 0; m < 4; ++m) _Pragma("unroll") for (int n = 0; n < 2; ++n) _Pragma("unroll") for (int k = 0; k < 2; ++k) \
        acc[ai][bj][m][n] = __builtin_amdgcn_mfma_f32_16x16x32_bf16(Bt[n][k], At[m][k], acc[ai][bj][m][n], 0, 0, 0); __builtin_amdgcn_s_setprio(0); } while (0)
#define PG8_WAIT_V(n) asm volatile("s_waitcnt vmcnt(" #n ")" ::: "memory")
#define PG8_WAIT_L(n) asm volatile("s_waitcnt lgkmcnt(" #n ")" ::: "memory")
#define PG8_BAR __builtin_amdgcn_s_barrier()
#define PG8_SCHED __builtin_amdgcn_sched_barrier(0)
    Unit cur, nxt; int ui = 0;
    if (!S.next(0, cur)) return;
    f32x4 acc[2][2][4][2];
#pragma unroll
    for (int a = 0; a < 2; ++a)
#pragma unroll
        for (int b = 0; b < 2; ++b)
#pragma unroll
            for (int m = 0; m < 4; ++m)
#pragma unroll
                for (int n = 0; n < 2; ++n) acc[a][b][m][n] = (f32x4){0.f, 0.f, 0.f, 0.f};
    bf16x8 At[4][2], B0[2][2], B1[2][2];
    const char* cA = (const char*)g.A + (size_t)cur.pm * tstep; const char* cB = (const char*)g.Bt + (size_t)cur.pn * tstep;
    S.a_ready(cur);
    if constexpr (SP2) {
        PG8_STAGE(PG8_SB(0, 0), cB, voffB); PG8_STAGE(PG8_SB(0, 1), cB + hstep, voffB); PG8_STAGE(PG8_SA(0, 0), cA, voffA); PG8_STAGE(PG8_SA(0, 1), cA + hstep, voffA);
        if (wr == 1) PG8_BAR;
        PG8_WAIT_V(2); PG8_BAR;
        PG8_STAGE(PG8_SB(1, 0), cB + kstep, voffB); PG8_STAGE(PG8_SA(1, 0), cA + kstep, voffA); PG8_STAGE(PG8_SB(1, 1), cB + hstep + kstep, voffB);
        PG8_WAIT_V(6); PG8_BAR;
    } else {
        PG8_STAGE(PG8_SB(0, 0), cB, voffB); PG8_STAGE(PG8_SA(0, 0), cA, voffA); PG8_STAGE(PG8_SB(0, 1), cB + hstep, voffB); PG8_STAGE(PG8_SA(0, 1), cA + hstep, voffA);
        if (wr == 1) PG8_BAR;
        PG8_WAIT_V(4); PG8_BAR;
        PG8_STAGE(PG8_SB(1, 0), cB + kstep, voffB); PG8_STAGE(PG8_SA(1, 0), cA + kstep, voffA); PG8_STAGE(PG8_SB(1, 1), cB + hstep + kstep, voffB);
        PG8_WAIT_V(6); PG8_BAR;
    }
    for (;;) {
        const bool has_next = S.next(ui + 1, nxt);
        const char* nA = has_next ? (const char*)g.A + (size_t)nxt.pm * tstep : cA; const char* nB = has_next ? (const char*)g.Bt + (size_t)nxt.pn * tstep : cB;
        for (int t = 0; t < nt; t += 2) {
            const bool last = (t == nt - 2);
            const char* a1 = cA + (size_t)(t + 1) * kstep;
            const char* a2 = last ? nA : cA + (size_t)(t + 2) * kstep; const char* b2 = last ? nB : cB + (size_t)(t + 2) * kstep;
            const char* a3 = a2 + kstep; const char* b3 = b2 + kstep;
            if (last && has_next) S.a_ready(nxt);
            if constexpr (SP2) {
            PG8_LDB(B0, 0, 0); PG8_LDB(B1, 0, 1); PG8_SCHED; PG8_LDA(At, 0, 0); PG8_STAGE(PG8_SA(1, 1), a1 + hstep, voffA);
            PG8_WAIT_V(8); PG8_WAIT_L(0); PG8_BAR; PG8_MMA(0, 0, At, B0); PG8_MMA(0, 1, At, B1); PG8_BAR; PG8_SCHED;
            PG8_LDA(At, 0, 1); PG8_STAGE(PG8_SB(0, 0), b2, voffB); PG8_STAGE(PG8_SB(0, 1), b2 + hstep, voffB); PG8_STAGE(PG8_SA(0, 0), a2, voffA);
            PG8_WAIT_V(8); PG8_WAIT_L(0); PG8_BAR; PG8_MMA(1, 0, At, B0); PG8_MMA(1, 1, At, B1); PG8_BAR; PG8_SCHED;
            PG8_LDB(B0, 1, 0); PG8_LDB(B1, 1, 1); PG8_SCHED; PG8_LDA(At, 1, 0); PG8_STAGE(PG8_SA(0, 1), a2 + hstep, voffA);
            PG8_WAIT_V(8); PG8_WAIT_L(0); PG8_BAR; PG8_MMA(0, 0, At, B0); PG8_MMA(0, 1, At, B1); PG8_BAR; PG8_SCHED;
            PG8_LDA(At, 1, 1); PG8_STAGE(PG8_SB(1, 0), b3, voffB); PG8_STAGE(PG8_SB(1, 1), b3 + hstep, voffB); PG8_STAGE(PG8_SA(1, 0), a3, voffA);
            PG8_WAIT_V(8); PG8_WAIT_L(0); PG8_BAR; PG8_MMA(1, 0, At, B0); PG8_MMA(1, 1, At, B1); PG8_BAR; PG8_SCHED;
            } else {
            PG8_LDB(B0, 0, 0); PG8_SCHED; PG8_LDA(At, 0, 0); PG8_STAGE(PG8_SA(1, 1), a1 + hstep, voffA);
            PG8_WAIT_L(8); PG8_BAR; PG8_WAIT_L(0); PG8_MMA(0, 0, At, B0); PG8_BAR; PG8_SCHED;
            PG8_LDB(B1, 0, 1); PG8_STAGE(PG8_SB(0, 0), b2, voffB);
            PG8_BAR; PG8_WAIT_L(0); PG8_MMA(0, 1, At, B1); PG8_BAR;
            PG8_LDA(At, 0, 1); PG8_STAGE(PG8_SA(0, 0), a2, voffA);
            PG8_BAR; PG8_WAIT_L(0); PG8_MMA(1, 0, At, B0); PG8_BAR; PG8_SCHED;
            PG8_STAGE(PG8_SB(0, 1), b2 + hstep, voffB);
            PG8_WAIT_V(6); PG8_BAR; PG8_MMA(1, 1, At, B1); PG8_BAR;
            PG8_LDB(B0, 1, 0); PG8_SCHED; PG8_LDA(At, 1, 0); PG8_STAGE(PG8_SA(0, 1), a2 + hstep, voffA);
            PG8_WAIT_L(8); PG8_BAR; PG8_WAIT_L(0); PG8_MMA(0, 0, At, B0); PG8_BAR; PG8_SCHED;
            PG8_LDB(B1, 1, 1); PG8_STAGE(PG8_SB(1, 0), b3, voffB);
            PG8_BAR; PG8_WAIT_L(0); PG8_MMA(0, 1, At, B1); PG8_BAR;
            PG8_LDA(At, 1, 1); PG8_STAGE(PG8_SA(1, 0), a3, voffA);
            PG8_BAR; PG8_WAIT_L(0); PG8_MMA(1, 0, At, B0); PG8_BAR; PG8_SCHED;
            PG8_STAGE(PG8_SB(1, 1), b3 + hstep, voffB);
            PG8_WAIT_V(6); PG8_BAR; PG8_MMA(1, 1, At, B1); PG8_BAR;
            }
        }
        if constexpr (ALIGN_EPI) { if (wr == 0) PG8_BAR; }
        if constexpr (!Epi::AFTER_DRAIN) { E(acc, cur, wr, wc, fr, fq); S.done(cur); }
        if (!has_next) break;
#pragma unroll
        for (int a = 0; a < 2; ++a)
#pragma unroll
            for (int b = 0; b < 2; ++b)
#pragma unroll
                for (int m = 0; m < 4; ++m)
#pragma unroll
                    for (int n = 0; n < 2; ++n) acc[a][b][m][n] = (f32x4){0.f, 0.f, 0.f, 0.f};
        cur = nxt; cA = nA; cB = nB; ++ui;
        if constexpr (ALIGN_EPI) { if (wr == 1) PG8_BAR; }
    }
    PG8_WAIT_V(0);
    if constexpr (!ALIGN_EPI) { if (wr == 0) PG8_BAR; }
    PG8_BAR;
    if constexpr (Epi::AFTER_DRAIN) { E.fused(acc, cur, wr, wc, fr, fq, lds, wid, lane); S.done(cur); }
#undef PG8_SA
#undef PG8_SB
#undef PG8_STAGE
#undef PG8_LDA
#undef PG8_LDB
#undef PG8_MMA
#undef PG8_WAIT_V
#undef PG8_WAIT_L
#undef PG8_BAR
#undef PG8_SCHED
}
}
#define GAS __attribute__((address_space(1)))
#define LAS __attribute__((address_space(3)))
typedef unsigned short bf16;
typedef unsigned v4u __attribute__((ext_vector_type(4)));
typedef float f32x4 __attribute__((ext_vector_type(4)));
typedef short bf16x8 __attribute__((ext_vector_type(8)));
typedef GAS unsigned gu32;
typedef GAS unsigned long long gu64;
#define RLX_AGENT __ATOMIC_RELAXED, __HIP_MEMORY_SCOPE_AGENT
#define LDS_WAIT() asm volatile("s_waitcnt lgkmcnt(0)" ::: "memory")
#define VM_WAIT() asm volatile("s_waitcnt vmcnt(0)" ::: "memory")
__device__ __forceinline__ unsigned long long rt() { return __builtin_amdgcn_s_memrealtime(); }
__device__ __forceinline__ unsigned f2bf(float f) { unsigned u = __builtin_bit_cast(unsigned, f); return (u + 0x7fffu + ((u >> 16) & 1u)) >> 16; }
__device__ __forceinline__ unsigned pk2(float lo, float hi) { return f2bf(lo) | (f2bf(hi) << 16); }

#define XB_TMO      128
#define XB_XCNT(j)  (256  + 64 * (j))
#define XB_XSUB(j)  (1280 + 64 * (j))
#define XB_XGEN(j)  (2304 + 64 * (j))
#define XB_TOP      3328
#define XB_TOPGEN   3392
#define XCD_BAR_WORDS 3456
#define XB_SPIN_CAP (1u << 18)

__device__ __forceinline__ unsigned xb_ld(unsigned* p)              { return __hip_atomic_load(p, __ATOMIC_RELAXED, __HIP_MEMORY_SCOPE_AGENT); }
__device__ __forceinline__ unsigned xb_add(unsigned* p, unsigned v) { return __hip_atomic_fetch_add(p, v, __ATOMIC_RELAXED, __HIP_MEMORY_SCOPE_AGENT); }
__device__ __forceinline__ unsigned xb_xcc_id() { return (unsigned)__builtin_amdgcn_s_getreg((3 << 11) | 20) & 0xFu; }
#define XB_SPIN(cond, bar) do { unsigned _sp = 0; while (cond) { __builtin_amdgcn_s_sleep(1); \
    if ((++_sp & 255u) == 0u) { if (xb_ld(&(bar)[XB_TMO])) break; if (_sp > XB_SPIN_CAP) { atomicAdd(&(bar)[XB_TMO], 1u); break; } } } } while (0)

static __device__ __forceinline__ bool xb_t0_impl(int wave) { return wave == 0 && __builtin_amdgcn_mbcnt_hi(~0u, __builtin_amdgcn_mbcnt_lo(~0u, 0u)) == 0u; }
#define xb_t0() xb_t0_impl(xb_wave)
struct XcdBarrier {
    unsigned* bar; unsigned x;
    volatile LAS unsigned* st;
};

__device__ __forceinline__ XcdBarrier xcd_barrier_post(unsigned* bar, volatile LAS unsigned* st, const int xb_wave) {
    XcdBarrier b; b.bar = bar; b.x = xb_xcc_id(); b.st = st;
    if (xb_t0()) (void)xb_add(&bar[XB_XCNT(b.x)], 1u);
    return b;
}
__device__ __forceinline__ void xcd_barrier_complete(unsigned* bar, unsigned x, unsigned& nloc, unsigned& nx) {
    const unsigned G = gridDim.x * gridDim.y * gridDim.z;
    unsigned sum, cnt, mine, sp = 0u;
    for (;;) {
        sum = 0u; cnt = 0u; mine = 0u;
#pragma unroll
        for (unsigned j = 0; j < 16; ++j) { const unsigned c = xb_ld(&bar[XB_XCNT(j)]); sum += c; cnt += (c > 0u) ? 1u : 0u; mine = (j == x) ? c : mine; }
        if (sum == G) break;
        __builtin_amdgcn_s_sleep(1);
        if ((++sp & 255u) == 0u) { if (xb_ld(&bar[XB_TMO])) break; if (sp > XB_SPIN_CAP) { atomicAdd(&bar[XB_TMO], 1u); break; } }
    }
    nloc = mine > 0u ? mine : 1u; nx = cnt > 0u ? cnt : 1u;
}

__device__ __forceinline__ void xcd_barrier(const XcdBarrier& b, const int xb_wave) {
    asm volatile("s_waitcnt vmcnt(0)" ::: "memory");
    __syncthreads();
    if (xb_t0()) {
        unsigned* bar = b.bar;
        __builtin_amdgcn_s_waitcnt(0);
        unsigned nloc = b.st[0], nx = b.st[1];
        if (nloc == 0u) { xcd_barrier_complete(bar, b.x, nloc, nx); b.st[0] = nloc; b.st[1] = nx; }
        const unsigned old = xb_add(&bar[XB_XSUB(b.x)], 1u);
        const unsigned gen = old / nloc;
        if (old + 1u == (gen + 1u) * nloc) {
            __builtin_amdgcn_fence(__ATOMIC_RELEASE, "agent");
            asm volatile("s_waitcnt vmcnt(0)" ::: "memory");
            const unsigned og = xb_add(&bar[XB_TOP], 1u);
            const unsigned tg = og / nx;
            if (og + 1u == (tg + 1u) * nx) xb_add(&bar[XB_TOPGEN], 1u);
            else XB_SPIN(xb_ld(&bar[XB_TOPGEN]) == tg, bar);
            __builtin_amdgcn_fence(__ATOMIC_ACQUIRE, "agent");
            xb_add(&bar[XB_XGEN(b.x)], 1u);
            asm volatile("s_waitcnt vmcnt(0)" ::: "memory");
        } else {
            XB_SPIN(xb_ld(&bar[XB_XGEN(b.x)]) == gen, bar);
            __builtin_amdgcn_fence(__ATOMIC_ACQUIRE, "agent");
            asm volatile("s_waitcnt vmcnt(0)" ::: "memory");
        }
    }
    __syncthreads();
}

constexpr int T = 16384, DM = 2048, NP = 5888, NMEM = 256;
constexpr int NWAVES = 8, NTHR = 512;
constexpr float EPS = 1e-6f;
constexpr size_t MiB = 1u << 20;
constexpr size_t WS_CTL = 0, CTL_ZERO_BYTES = 65536;
constexpr size_t WS_WIN0 = 1 * MiB, WS_WIN1 = 24 * MiB, WS_WOUT0 = 47 * MiB, WS_WOUT1 = 55 * MiB, WS_WMKV = 63 * MiB, WS_WK1T = 71 * MiB, WS_WV1T = 73 * MiB;
constexpr size_t WS_MEMKV = 75 * MiB, WS_DEC = 76 * MiB, WS_KCMP = 77 * MiB, WS_VCMP = 77 * MiB + 512 * 1024, WS_SEL = 78 * MiB;
constexpr size_t WS_XN = 80 * MiB, WS_P = 144 * MiB, WS_STATE = 328 * MiB, WS_END = 472 * MiB;
constexpr size_t WS_MIX1 = WS_STATE;
constexpr size_t WS_CP = WS_STATE + 64 * MiB;
constexpr size_t PLANE = (size_t)T * 128;
constexpr size_t DO_MIX0 = 0, DO_OI = 64 * MiB;
constexpr int CR = 3072, CXQ = 4608, CXG = 5120, CGL = 5632;
constexpr int GQ = 0, GK = 768, GV = 1536;
constexpr int NQ = 0, NKC = 1536, NVC = 1792, NKS = 2048, NVS = 2304, NKW = 2560, NVW = 2816;
constexpr int RING_BYTES = 131072, LDSCTL_OFF = RING_BYTES, MISC_OFF = LDSCTL_OFF + 320, LDS_BYTES = 147456;
constexpr int N_PHASES = 12;

__device__ __forceinline__ float bf2f(bf16 v) { return __builtin_bit_cast(float, (unsigned)v << 16); }
__device__ __forceinline__ bf16 f2b(float f) { return (bf16)f2bf(f); }
__device__ __forceinline__ float wave_sum(float v) {
#pragma unroll
    for (int o = 1; o < 64; o <<= 1) v += __shfl_xor(v, o);
    return v;
}
__device__ __forceinline__ float silu_f(float x) { return x / (1.f + __expf(-x)); }
__device__ __forceinline__ float sigmoid_f(float x) { return 1.f / (1.f + __expf(-x)); }
__device__ __forceinline__ float logsigmoid_f(float x) { return fminf(x, 0.f) - log1pf(__expf(-fabsf(x))); }

__device__ __forceinline__ int win_src_col(int layer, int c) {
    const int ex = layer ? 36 : 16;
    if (c < 3072) return c;
    if (c < 5632) return c + ex;
    if (c < 5632 + ex) return c - 5632 + 3072;
    return -1;
}

__device__ __forceinline__ void transpose_item(const float* W, int ldw, int K, bf16* WT, int n0, int k0, int srcc, LAS float* scr, int lane) {
#pragma unroll 8
    for (int i = 0; i < 32; ++i) { const int kk = 2 * i + (lane >> 5); scr[kk * 33 + (lane & 31)] = (srcc >= 0) ? W[(size_t)(k0 + kk) * ldw + srcc] : 0.f; }
    LDS_WAIT(); asm volatile("" ::: "memory");
    const int c = lane & 7;
#pragma unroll
    for (int j = 0; j < 4; ++j) { const int n = (lane >> 3) + 8 * j; const LAS float* s = scr + (8 * c) * 33 + n;
        v4u o; o.x = pk2(s[0 * 33], s[1 * 33]); o.y = pk2(s[2 * 33], s[3 * 33]); o.z = pk2(s[4 * 33], s[5 * 33]); o.w = pk2(s[6 * 33], s[7 * 33]);
        *(v4u*)(WT + (size_t)(n0 + n) * K + k0 + 8 * c) = o; }
    LDS_WAIT(); asm volatile("" ::: "memory");
}

__device__ __forceinline__ void rms_row_to_bf16(const float* xrow, const float* g, bf16* orow, int lane) {
    const f32x4* xr = (const f32x4*)xrow + lane; const f32x4* gr = (const f32x4*)g + lane;
    f32x4 v[8]; float s = 0.f;
#pragma unroll
    for (int j = 0; j < 8; ++j) { v[j] = xr[64 * j]; s += (v[j].x * v[j].x + v[j].y * v[j].y) + (v[j].z * v[j].z + v[j].w * v[j].w); }
    const float rstd = rsqrtf(wave_sum(s) * (1.f / DM) + EPS);
    unsigned long long* o8 = (unsigned long long*)orow + lane;
#pragma unroll
    for (int j = 0; j < 8; ++j) { const f32x4 gg = gr[64 * j];
        o8[64 * j] = (unsigned long long)pk2(v[j].x * rstd * gg.x, v[j].y * rstd * gg.y) | ((unsigned long long)pk2(v[j].z * rstd * gg.z, v[j].w * rstd * gg.w) << 32); }
}

struct EpiNsaIn {
    static constexpr bool PERM = true, AFTER_DRAIN = false;
    bf16* O; int ldc; bf16* CPb;
    __device__ __forceinline__ void operator()(const pg8::f32x4 (&acc)[2][2][4][2], const pg8::Unit& u, int wr, int wc, int fr, int fq) const {
        const int row0 = u.pm * pg8::BM + wr * 64 + fr; const bool pl = (u.pn >= 6 && u.pn < 12);
#pragma unroll
        for (int ai = 0; ai < 2; ++ai)
#pragma unroll
            for (int m = 0; m < 4; ++m) { const size_t row = (size_t)(row0 + ai * pg8::HALF + m * 16);
#pragma unroll
                for (int bj = 0; bj < 2; ++bj) { const pg8::f32x4 v0 = acc[ai][bj][m][0], v1 = acc[ai][bj][m][1];
                    pg8::u32x4 w; w.x = pg8::cvt_pk_bf16(v0[0], v0[1]); w.y = pg8::cvt_pk_bf16(v0[2], v0[3]); w.z = pg8::cvt_pk_bf16(v1[0], v1[1]); w.w = pg8::cvt_pk_bf16(v1[2], v1[3]);
                    bf16* dst = pl ? CPb + ((size_t)((u.pn - 6) * 2 + bj)) * PLANE + row * 128 + wc * 32 + 8 * fq
                                   : O + row * ldc + u.pn * pg8::BM + bj * pg8::HALF + wc * 32 + 8 * fq;
                    *(pg8::u32x4*)dst = w; } }
    }
};

struct Args { const float* in[19]; float* out; unsigned char* ws; int ph_lo, ph_hi; };

struct Ctx {
    LAS unsigned char* lds;
    int tid, lane, wave, G, gw, NGW;
    const float *x, *mem, *ln_pre, *ln_post, *ln_mem, *w_mem_kv, *gla_w_in, *gla_w_gate, *gla_b_gate, *gla_norm, *gla_w_out;
    const float *nsa_w_in, *pe_k, *pe_v, *wk1, *wk2, *wv1, *wv2, *nsa_w_out;
    float* out; unsigned char* ws;
    bf16 *WIN0, *WIN1, *WOUT0, *WOUT1, *WMKV, *WK1T, *WV1T, *MEMKV, *KCMP, *VCMP, *XN, *P, *STATE, *MIX0, *MIX1, *OI, *CP;
    float *DEC, *HB;
};

__device__ __forceinline__ void phase_prep(Ctx& F) {
    LAS float* scr = (LAS float*)(F.lds + F.wave * 16384);
    constexpr int I_WIN = 32 * 184, I_WOUT = 32 * 64, I_MKV = 32 * 32, I_W1 = 64 * 8;
    constexpr int NITEMS = 2 * I_WIN + 2 * I_WOUT + 2 * I_MKV + 2 * I_W1;
    for (int it = F.gw; it < NITEMS; it += F.NGW) {
        int r = it;
        if (r < 2 * I_WIN) { const int layer = r / I_WIN; r -= layer * I_WIN; const int kb = r / 184, nb = r % 184;
            const int srcc = win_src_col(layer, nb * 32 + (F.lane & 31));
            transpose_item(layer ? F.nsa_w_in : F.gla_w_in, layer ? 5668 : 5648, DM, layer ? F.WIN1 : F.WIN0, nb * 32, kb * 64, srcc, scr, F.lane); continue; }
        r -= 2 * I_WIN;
        if (r < 2 * I_WOUT) { const int layer = r / I_WOUT; r -= layer * I_WOUT; const int kb = r / 64, nb = r % 64;
            transpose_item(layer ? F.nsa_w_out : F.gla_w_out, DM, DM, layer ? F.WOUT1 : F.WOUT0, nb * 32, kb * 64, nb * 32 + (F.lane & 31), scr, F.lane); continue; }
        r -= 2 * I_WOUT;
        if (r < 2 * I_MKV) { const int layer = r / I_MKV; r -= layer * I_MKV; const int kb = r / 32, nb = r % 32;
            transpose_item(F.w_mem_kv + (size_t)layer * DM * 1024, 1024, DM, F.WMKV + (size_t)layer * 1024 * DM, nb * 32, kb * 64, nb * 32 + (F.lane & 31), scr, F.lane); continue; }
        r -= 2 * I_MKV;
        { const int kv = r / I_W1; r -= kv * I_W1; const int kb = r / 8, nb = r % 8;
            transpose_item(kv ? F.wv1 : F.wk1, 256, 4096, kv ? F.WV1T : F.WK1T, nb * 32, kb * 64, nb * 32 + (F.lane & 31), scr, F.lane); }
    }
    if ((int)blockIdx.x < 64) { const int kv = blockIdx.x >> 5, s = blockIdx.x & 31; const float* pe = kv ? F.pe_v : F.pe_k; const float* w1 = kv ? F.wv1 : F.wk1;
        __syncthreads();
        LAS float* red = (LAS float*)F.lds;
        const int j = F.tid & 255, ih = F.tid >> 8; float a = 0.f;
#pragma unroll 8
        for (int i = s * 128 + ih * 64; i < s * 128 + ih * 64 + 64; ++i) a += pe[i] * w1[(size_t)i * 256 + j];
        red[F.tid] = a; __syncthreads();
        if (F.tid < 256) F.HB[(kv * 32 + s) * 256 + j] = red[j] + red[256 + j];
        __syncthreads(); }
    for (int m = F.gw; m < T; m += F.NGW) rms_row_to_bf16(F.x + (size_t)m * DM, F.ln_pre, F.XN + (size_t)m * DM, F.lane);
}

__device__ __forceinline__ void gla_scan(Ctx& F) {
    const int gt = blockIdx.x * NTHR + F.tid, NT = F.G * NTHR;
    constexpr int PER = 4 * 384 * 192;
    for (int item = gt; item < PER / 4; item += NT) {
        const int idx = item * 4, h = idx / (384 * 192), d0 = idx % 192;
        bf16* sp = F.STATE + idx; const float* dp = F.DEC + h * 192 + d0;
        float s0 = 0.f, s1 = 0.f, s2 = 0.f, s3 = 0.f;
        for (int n0 = 0; n0 < 256; n0 += 8) {
            unsigned long long u[8]; f32x4 dc[8];
#pragma unroll
            for (int j = 0; j < 8; ++j) { u[j] = *(const unsigned long long*)(sp + (size_t)(n0 + j) * PER); dc[j] = *(const f32x4*)(dp + (n0 + j) * 768); }
#pragma unroll
            for (int j = 0; j < 8; ++j) {
                const unsigned lo = (unsigned)u[j], hi = (unsigned)(u[j] >> 32);
                s0 = dc[j].x * s0 + bf2f((bf16)(lo & 0xffff)); s1 = dc[j].y * s1 + bf2f((bf16)(lo >> 16));
                s2 = dc[j].z * s2 + bf2f((bf16)(hi & 0xffff)); s3 = dc[j].w * s3 + bf2f((bf16)(hi >> 16));
                *(unsigned long long*)(sp + (size_t)(n0 + j) * PER) = (unsigned long long)pk2(s0, s1) | ((unsigned long long)pk2(s2, s3) << 32);
            }
        }
    }
}

__device__ __forceinline__ void post_rows(Ctx& F, const float* hin, const bf16* Y, const float* gpost, float* hout, const float* gpre, bf16* XNo) {
    for (int m = F.gw; m < T; m += F.NGW) {
        const v4u* yr = (const v4u*)(Y + (size_t)m * DM) + F.lane;
        float y[32]; float ss = 0.f;
#pragma unroll
        for (int j = 0; j < 4; ++j) { const v4u w = yr[64 * j];
            const unsigned ww[4] = {w.x, w.y, w.z, w.w};
#pragma unroll
            for (int q = 0; q < 4; ++q) { y[j * 8 + 2 * q] = bf2f((bf16)(ww[q] & 0xffff)); y[j * 8 + 2 * q + 1] = bf2f((bf16)(ww[q] >> 16)); } }
#pragma unroll
        for (int i = 0; i < 32; ++i) ss += y[i] * y[i];
        const float rstd = rsqrtf(wave_sum(ss) * (1.f / DM) + EPS);
        float hn[32]; float s2 = 0.f;
#pragma unroll
        for (int j = 0; j < 4; ++j) {
#pragma unroll
            for (int q = 0; q < 2; ++q) { const int col = j * 512 + F.lane * 8 + q * 4;
                const f32x4 hv = *(const f32x4*)(hin + (size_t)m * DM + col); const f32x4 gp = *(const f32x4*)(gpost + col);
                f32x4 r; r.x = hv.x + y[j * 8 + q * 4 + 0] * rstd * gp.x; r.y = hv.y + y[j * 8 + q * 4 + 1] * rstd * gp.y; r.z = hv.z + y[j * 8 + q * 4 + 2] * rstd * gp.z; r.w = hv.w + y[j * 8 + q * 4 + 3] * rstd * gp.w;
                *(f32x4*)(hout + (size_t)m * DM + col) = r;
                hn[j * 8 + q * 4 + 0] = r.x; hn[j * 8 + q * 4 + 1] = r.y; hn[j * 8 + q * 4 + 2] = r.z; hn[j * 8 + q * 4 + 3] = r.w;
                s2 += (r.x * r.x + r.y * r.y) + (r.z * r.z + r.w * r.w); } }
        if (gpre) {
            const float rstd2 = rsqrtf(wave_sum(s2) * (1.f / DM) + EPS);
#pragma unroll
            for (int j = 0; j < 4; ++j) { const int col = j * 512 + F.lane * 8;
                const f32x4 g0 = *(const f32x4*)(gpre + col), g1 = *(const f32x4*)(gpre + col + 4);
                v4u w; w.x = pk2(hn[j * 8 + 0] * rstd2 * g0.x, hn[j * 8 + 1] * rstd2 * g0.y); w.y = pk2(hn[j * 8 + 2] * rstd2 * g0.z, hn[j * 8 + 3] * rstd2 * g0.w);
                w.z = pk2(hn[j * 8 + 4] * rstd2 * g1.x, hn[j * 8 + 5] * rstd2 * g1.y); w.w = pk2(hn[j * 8 + 6] * rstd2 * g1.z, hn[j * 8 + 7] * rstd2 * g1.w);
                *((v4u*)(XNo + (size_t)m * DM) + F.lane + 64 * j) = w; }
        }
    }
}

typedef short v4i16_t __attribute__((ext_vector_type(4)));
typedef short s16x4 __attribute__((ext_vector_type(4)));
__device__ __forceinline__ s16x4 vtr(const LAS unsigned char* p) { return __builtin_bit_cast(s16x4, __builtin_amdgcn_ds_read_tr16_b64_v4i16((LAS v4i16_t*)p)); }
constexpr int KROW = 288;
constexpr int RING = 3, TILE_K = 16384, TILE_KV = 32768;
__device__ __forceinline__ int swz_off(int row, int chunk) { return row * 256 + ((((((chunk >> 1) ^ row) & 7)) << 1) | (chunk & 1)) * 16; }
constexpr float LOG2E = 1.4426950408889634f;

struct ImpArgs { float gate0, gate1; bool hvalid; LAS float* imp; const LAS unsigned* bm; };
__device__ __forceinline__ void dma16(const char* sbase, unsigned voff, unsigned lds_dst) {
    unsigned keep;
    asm volatile("s_mov_b32 %0, m0\n\ts_mov_b32 m0, %3\n\ts_nop 0\n\tglobal_load_lds_dwordx4 %1, %2\n\ts_mov_b32 m0, %0" : "=&s"(keep) : "v"(voff), "s"(sbase), "s"(lds_dst) : "memory");
}
typedef float f32x2_t __attribute__((ext_vector_type(2)));
typedef __bf16 bf16x2_t __attribute__((ext_vector_type(2)));
__device__ __forceinline__ unsigned cvtpk(float lo, float hi) { const f32x2_t v = {lo, hi}; return __builtin_bit_cast(unsigned, __builtin_convertvector(v, bf16x2_t)); }
__device__ __forceinline__ float bperm(float x, int srclane) { return __builtin_bit_cast(float, __builtin_amdgcn_ds_bpermute(srclane << 2, __builtin_bit_cast(int, x))); }
__device__ __forceinline__ float xmax4(float x, int lane) { x = fmaxf(x, bperm(x, lane ^ 16)); return fmaxf(x, bperm(x, lane ^ 32)); }
__device__ __forceinline__ float xsum4(float x, int lane) { x += bperm(x, lane ^ 16); return x + bperm(x, lane ^ 32); }
template <int CTRL> __device__ __forceinline__ float dppf(float x) { return __builtin_bit_cast(float, __builtin_amdgcn_update_dpp(0, __builtin_bit_cast(int, x), CTRL, 0xF, 0xF, true)); }
__device__ __forceinline__ float sum8(float x) { x += dppf<0xB1>(x); x += dppf<0x4E>(x); x += dppf<0x141>(x); return x; }

template <int MODE, int RTM, bool FULL, class Mask>
__device__ __forceinline__ void attn_tile(const LAS unsigned char* Kb, const LAS unsigned char* Vb, const bf16x8 (&Q)[2][4], f32x4 (&O)[2][8], float (&m)[2], float (&l)[2],
                                          const int kt, const Mask& mask, const int tok0, const int tok1, const float sl2, const ImpArgs& ia, const bool sb0, const bool sb1,
                                          float& carry0, float& carry1, const int lane) {
    const int c16 = lane & 15, g = lane >> 4;
#pragma unroll
    for (int s32 = 0; s32 < 2; ++s32) {
        f32x4 sc[2][2];
#pragma unroll
        for (int rt = 0; rt < 2; ++rt)
#pragma unroll
            for (int st = 0; st < 2; ++st) sc[rt][st] = (f32x4){0.f, 0.f, 0.f, 0.f};
#pragma unroll
        for (int st = 0; st < 2; ++st) {
            bf16x8 kf[4];
#pragma unroll
            for (int kd = 0; kd < 4; ++kd) kf[kd] = *(const LAS bf16x8*)(Kb + swz_off(s32 * 32 + st * 16 + c16, g + 4 * kd));
#pragma unroll
            for (int kd = 0; kd < 4; ++kd) {
                if (RTM & 1) sc[0][st] = __builtin_amdgcn_mfma_f32_16x16x32_bf16(kf[kd], Q[0][kd], sc[0][st], 0, 0, 0);
                if (RTM & 2) sc[1][st] = __builtin_amdgcn_mfma_f32_16x16x32_bf16(kf[kd], Q[1][kd], sc[1][st], 0, 0, 0);
            }
        }
        bf16x8 pf[2];
#pragma unroll
        for (int rt = 0; rt < 2; ++rt) {
            if (!((RTM >> rt) & 1)) continue;
            const int tk = rt ? tok1 : tok0; const bool sb = rt ? sb1 : sb0;
            float v[8]; float mx = -3e38f;
#pragma unroll
            for (int st = 0; st < 2; ++st)
#pragma unroll
                for (int r = 0; r < 4; ++r) { const int kidx = kt + s32 * 32 + st * 16 + g * 4 + r;
                    v[st * 4 + r] = (FULL || (mask(tk, kidx) && (MODE != 3 || sb))) ? sc[rt][st][r] : -3e38f; mx = fmaxf(mx, v[st * 4 + r]); }
            if (MODE != 2) {
                const float mo = m[rt];
                bool need = (mx * sl2 - mo) > 64.f; if (MODE == 3) need = need && sb;
                if (__any(need)) {
                    const float mxa = xmax4(mx, lane); float mn = fmaxf(mo, mxa * sl2); if (MODE == 3) mn = sb ? mn : mo;
                    const float alpha = __builtin_amdgcn_exp2f(mo - mn);
                    m[rt] = mn; l[rt] = l[rt] * alpha;
                    if (MODE == 0 || MODE == 3) {
#pragma unroll
                        for (int dt = 0; dt < 8; ++dt) O[rt][dt] = O[rt][dt] * alpha;
                    }
                }
                const float mn = m[rt];
                float ps = 0.f;
#pragma unroll
                for (int i = 0; i < 8; ++i) { v[i] = __builtin_amdgcn_exp2f(fmaf(v[i], sl2, -mn)); ps += v[i]; }
                l[rt] += ps;
            } else {
                const float mn = m[rt], linv = ia.hvalid ? l[rt] : 0.f, gt = rt ? ia.gate1 : ia.gate0;
#pragma unroll
                for (int i = 0; i < 8; ++i) v[i] = __builtin_amdgcn_exp2f(fmaf(v[i], sl2, -mn)) * linv;
                const float s40 = sum8((v[0] + v[1]) + (v[2] + v[3])), s41 = sum8((v[4] + v[5]) + (v[6] + v[7])), la0 = sum8(v[3]), la1 = sum8(v[7]);
                const float pl0 = bperm(la0, (lane + 48) & 63), pl1 = bperm(la1, (lane + 48) & 63);
                const float cprev = rt ? carry1 : carry0;
                const float i0 = s40 + (g > 0 ? pl0 : cprev), i1 = s41 + (g > 0 ? pl1 : pl0);
                if (rt) carry1 = pl1; else carry0 = pl1;
                if ((lane & 7) == 0) { const int jb = (kt >> 2) + 8 * s32 + g; LAS float* ip = ia.imp + (rt * 2 + (c16 >> 3)) * 256 + jb; ip[0] = i0; ip[4] = i1; }
#pragma unroll
                for (int i = 0; i < 8; ++i) v[i] *= gt;
            }
            if (MODE != 1) { v4u pw; pw.x = cvtpk(v[0], v[1]); pw.y = cvtpk(v[2], v[3]); pw.z = cvtpk(v[4], v[5]); pw.w = cvtpk(v[6], v[7]);
                pf[rt] = __builtin_bit_cast(bf16x8, pw); }
        }
        if (MODE != 1) {
            const int vrow = s32 * 32 + g * 4 + (c16 >> 2);
            const LAS unsigned char* vb0 = Vb + vrow * 256 + ((c16 >> 1) & 1) * 16 + (c16 & 1) * 8; const int r7 = vrow & 7;
#pragma unroll
            for (int dt = 0; dt < 8; ++dt) {
                const LAS unsigned char* vp = vb0 + ((dt ^ r7) << 5);
                const s16x4 lo = vtr(vp), hi = vtr(vp + 4096);
                const bf16x8 vf = {lo[0], lo[1], lo[2], lo[3], hi[0], hi[1], hi[2], hi[3]};
                if (RTM & 1) O[0][dt] = __builtin_amdgcn_mfma_f32_16x16x32_bf16(vf, pf[0], O[0][dt], 0, 0, 0);
                if (RTM & 2) O[1][dt] = __builtin_amdgcn_mfma_f32_16x16x32_bf16(vf, pf[1], O[1][dt], 0, 0, 0);
            }
        }
    }
}

template <int MODE, class Src, class Mask>
__device__ __forceinline__ void attn_pass(Ctx& F, LAS unsigned char* base, const bf16x8 (&Q)[2][4], f32x4 (&O)[2][8], float (&m)[2], float (&l)[2],
                                          const int k0, const int nt, const Src& src, const Mask& mask, const int tok0, const int tok1, const float sl2, const ImpArgs ia = ImpArgs{0.f, 0.f, false, nullptr, nullptr}) {
    int tidv = F.wave * 64 + (int)__builtin_amdgcn_mbcnt_hi(~0u, __builtin_amdgcn_mbcnt_lo(~0u, 0u)); asm volatile("" : "+v"(tidv));
    const int lane = tidv & 63, c16 = lane & 15, g = lane >> 4;
    const int wv = F.wave;
    constexpr int NL = (MODE == 1) ? 2 : 4;
#define ATT_DMA(tj, bufi) do { const int kt_ = k0 + 64 * min((tj), nt - 1); \
        _Pragma("unroll") for (int i_ = 0; i_ < 2; ++i_) { const int pc_ = wv * 2 + i_, row_ = pc_ * 4 + g, c_ = (((((c16 >> 1) ^ row_) & 7)) << 1) | (c16 & 1); \
            const unsigned go_ = src.off(kt_ + row_) + (unsigned)(c_ * 16); \
            dma16(src.kb, go_, (unsigned)(size_t)base + (unsigned)((bufi) * TILE_KV + pc_ * 1024)); \
            if (MODE != 1) dma16(src.vb, go_, (unsigned)(size_t)base + (unsigned)((bufi) * TILE_KV + TILE_K + pc_ * 1024)); } } while (0)
    __syncthreads();
#pragma unroll
    for (int t_ = 0; t_ < RING - 1; ++t_) ATT_DMA(t_, t_);
    float carry0 = 0.f, carry1 = 0.f;
    int bcur = 0;
    for (int j = 0; j < nt; ++j) {
        if (NL == 4) asm volatile("s_waitcnt vmcnt(%0)" :: "n"((RING - 2) * 4) : "memory"); else asm volatile("s_waitcnt vmcnt(%0)" :: "n"((RING - 2) * 2) : "memory");
        __builtin_amdgcn_s_barrier();
        { const int bnext = (bcur == 0) ? RING - 1 : bcur - 1; ATT_DMA(j + RING - 1, bnext); }
        const LAS unsigned char* Kb = base + bcur * TILE_KV; const LAS unsigned char* Vb = Kb + TILE_K;
        const int kt = k0 + 64 * j;
        if (MODE == 3) {
            const int jb = kt >> 6; const unsigned w0 = ia.bm[(c16 >> 3) * 8 + (jb >> 5)], w1 = ia.bm[(2 + (c16 >> 3)) * 8 + (jb >> 5)];
            const bool sb0 = ia.hvalid && ((w0 >> (jb & 31)) & 1u), sb1 = ia.hvalid && ((w1 >> (jb & 31)) & 1u); const bool act0 = __any(sb0), act1 = __any(sb1);
            if (act0 && act1) attn_tile<MODE, 3, false>(Kb, Vb, Q, O, m, l, kt, mask, tok0, tok1, sl2, ia, sb0, sb1, carry0, carry1, lane);
            else if (act0) attn_tile<MODE, 1, false>(Kb, Vb, Q, O, m, l, kt, mask, tok0, tok1, sl2, ia, sb0, sb1, carry0, carry1, lane);
            else if (act1) attn_tile<MODE, 2, false>(Kb, Vb, Q, O, m, l, kt, mask, tok0, tok1, sl2, ia, sb0, sb1, carry0, carry1, lane);
        } else { int lj = lane; asm volatile("" : "+v"(lj));
            const bool full = __all(mask(tok0, kt) && mask(tok0, kt + 63) && mask(tok1, kt) && mask(tok1, kt + 63));
            if (full) attn_tile<MODE, 3, true>(Kb, Vb, Q, O, m, l, kt, mask, tok0, tok1, sl2, ia, true, true, carry0, carry1, lj);
            else attn_tile<MODE, 3, false>(Kb, Vb, Q, O, m, l, kt, mask, tok0, tok1, sl2, ia, true, true, carry0, carry1, lj); }
        bcur = (bcur == RING - 1) ? 0 : bcur + 1;
    }
    asm volatile("s_waitcnt vmcnt(0)" ::: "memory");
    __syncthreads();
#undef ATT_DMA
}

template <class Mask>
__device__ __forceinline__ void slc_visit1(const LAS unsigned char* Kb, const LAS unsigned char* Vb, const bf16x8 (&Qr)[4], f32x4 (&Or)[8], float& mr, float& lr,
                                           const int kt, const Mask& mask, const int tok, const float sl2, const bool sb, const int lane) {
    const int c16 = lane & 15, g = lane >> 4;
    f32x4 sc[4];
#pragma unroll
    for (int st = 0; st < 4; ++st) { sc[st] = (f32x4){0.f, 0.f, 0.f, 0.f};
#pragma unroll
        for (int kd = 0; kd < 4; ++kd) { const bf16x8 kf = *(const LAS bf16x8*)(Kb + swz_off(st * 16 + c16, g + 4 * kd));
            sc[st] = __builtin_amdgcn_mfma_f32_16x16x32_bf16(kf, Qr[kd], sc[st], 0, 0, 0); } }
    float v[16]; float mx = -3e38f;
#pragma unroll
    for (int st = 0; st < 4; ++st)
#pragma unroll
        for (int r = 0; r < 4; ++r) { const int kidx = kt + st * 16 + g * 4 + r; v[st * 4 + r] = (mask(tok, kidx) && sb) ? sc[st][r] : -3e38f; mx = fmaxf(mx, v[st * 4 + r]); }
    const float mo = mr;
    if (__any((mx * sl2 - mo) > 64.f)) {
        const float mxa = xmax4(mx, lane); const float mn = sb ? fmaxf(mo, mxa * sl2) : mo; const float alpha = __builtin_amdgcn_exp2f(mo - mn);
        mr = mn; lr *= alpha;
#pragma unroll
        for (int dt = 0; dt < 8; ++dt) Or[dt] = Or[dt] * alpha;
    }
    const float mn = mr; float ps = 0.f;
#pragma unroll
    for (int i = 0; i < 16; ++i) { v[i] = __builtin_amdgcn_exp2f(fmaf(v[i], sl2, -mn)); ps += v[i]; }
    lr += ps;
    bf16x8 pf[2];
#pragma unroll
    for (int ks = 0; ks < 2; ++ks) { v4u pw; pw.x = cvtpk(v[8 * ks + 0], v[8 * ks + 1]); pw.y = cvtpk(v[8 * ks + 2], v[8 * ks + 3]); pw.z = cvtpk(v[8 * ks + 4], v[8 * ks + 5]); pw.w = cvtpk(v[8 * ks + 6], v[8 * ks + 7]);
        pf[ks] = __builtin_bit_cast(bf16x8, pw); }
#pragma unroll
    for (int ks = 0; ks < 2; ++ks) { const int vrow = ks * 32 + g * 4 + (c16 >> 2);
        const LAS unsigned char* vb0 = Vb + vrow * 256 + ((c16 >> 1) & 1) * 16 + (c16 & 1) * 8; const int r7 = vrow & 7;
#pragma unroll
        for (int dt = 0; dt < 8; ++dt) { const LAS unsigned char* vp = vb0 + ((dt ^ r7) << 5);
            const s16x4 lo = vtr(vp), hi = vtr(vp + 4096);
            const bf16x8 vf = {lo[0], lo[1], lo[2], lo[3], hi[0], hi[1], hi[2], hi[3]};
            Or[dt] = __builtin_amdgcn_mfma_f32_16x16x32_bf16(vf, pf[ks], Or[dt], 0, 0, 0); } }
}

template <class Src, class Mask>
__device__ __forceinline__ void slc_pass(Ctx& F, LAS unsigned char* base, const bf16x8 (&Q)[2][4], f32x4 (&O)[2][8], float (&m)[2], float (&l)[2],
                                         const int nt, const Src& src, const Mask& mask, const int tok0, const int tok1, const float sl2, const ImpArgs ia) {
    int tidv = F.wave * 64 + (int)__builtin_amdgcn_mbcnt_hi(~0u, __builtin_amdgcn_mbcnt_lo(~0u, 0u)); asm volatile("" : "+v"(tidv));
    const int lane = tidv & 63, c16 = lane & 15, g = lane >> 4;
    const int wv = F.wave;
    volatile LAS unsigned* flg = (volatile LAS unsigned*)(base + RING_BYTES + 2048);
#define SLC_LOAD(tj) do { const int kt_ = 64 * (tj); \
        _Pragma("unroll 4") for (int pc_ = 0; pc_ < 16; ++pc_) { const int row_ = pc_ * 4 + g, c_ = (((((c16 >> 1) ^ row_) & 7)) << 1) | (c16 & 1); \
            const unsigned go_ = src.off(kt_ + row_) + (unsigned)(c_ * 16); \
            dma16(src.kb, go_, (unsigned)(size_t)base + (unsigned)(((tj) & 3) * TILE_KV + pc_ * 1024)); \
            dma16(src.vb, go_, (unsigned)(size_t)base + (unsigned)(((tj) & 3) * TILE_KV + TILE_K + pc_ * 1024)); } } while (0)
    __syncthreads();
    if (lane < 8) flg[16 + wv * 8 + lane] = ia.bm[lane] | ia.bm[8 + lane] | ia.bm[16 + lane] | ia.bm[24 + lane];
    if (tidv < 12) flg[tidv] = 0u;
    __syncthreads();
    int pend = -1;
    if (wv == 0) { SLC_LOAD(0); pend = 0; } else if (wv == 1 && nt > 1) { SLC_LOAD(1); pend = 1; }
    float carry0 = 0.f, carry1 = 0.f;
    unsigned myact = 0u;
    for (int j = 0; j < nt; ++j) {
        if ((j & 31) == 0) myact = (unsigned)__builtin_amdgcn_readfirstlane((int)flg[16 + wv * 8 + (j >> 5)]);
        if (pend >= 0) {
            asm volatile("s_waitcnt vmcnt(0)" ::: "memory");
            if (lane == 0) flg[8 + (pend & 3)] = (unsigned)(pend + 1);
            asm volatile("" ::: "memory"); pend = -1; }
        const int t = j + 2;
        if (t < nt) {
            const unsigned aw = flg[16 + (lane & 7) * 8 + (t >> 5)];
            const bool busy = ((aw >> (t & 31)) & 1u) || ((t & 31) && ((aw >> ((t & 31) - 1)) & 1u));
            const unsigned bb = (unsigned)(__ballot(busy) & 0xFFull);
            const unsigned rot = ((bb | (bb << 8)) >> (t & 7)) & 0xFFu;
            const int owner = ((t & 7) + ((rot == 0xFFu) ? 0 : (__builtin_ctz(~rot)))) & 7;
            if (owner == wv) {
                if (t >= 4) { const int tp = t - 4;
                    for (;;) { const unsigned av = flg[16 + (lane & 7) * 8 + (tp >> 5)], dv = flg[lane & 7], lp = flg[8 + (t & 3)];
                        const bool okv = (!((av >> (tp & 31)) & 1u) || dv >= (unsigned)(tp + 1)) && lp >= (unsigned)(tp + 1);
                        if (__all(okv)) break; __builtin_amdgcn_s_sleep(1); }
                    asm volatile("" ::: "memory"); __builtin_amdgcn_sched_barrier(0); }
                SLC_LOAD(t); pend = t; }
        }
        if ((myact >> (j & 31)) & 1u) {
            const unsigned w0 = ia.bm[(c16 >> 3) * 8 + (j >> 5)], w1 = ia.bm[(2 + (c16 >> 3)) * 8 + (j >> 5)];
            const bool sb0 = ia.hvalid && ((w0 >> (j & 31)) & 1u), sb1 = ia.hvalid && ((w1 >> (j & 31)) & 1u); const bool act0 = __any(sb0), act1 = __any(sb1);
            for (;;) { const unsigned lv = flg[8 + (j & 3)]; if (__all(lv >= (unsigned)(j + 1))) break; __builtin_amdgcn_s_sleep(1); }
            asm volatile("" ::: "memory"); __builtin_amdgcn_sched_barrier(0);
            const LAS unsigned char* Kb = base + (j & 3) * TILE_KV; const LAS unsigned char* Vb = Kb + TILE_K;
            int lj = lane; asm volatile("" : "+v"(lj));
            if (act0 && act1) attn_tile<3, 3, false>(Kb, Vb, Q, O, m, l, 64 * j, mask, tok0, tok1, sl2, ia, sb0, sb1, carry0, carry1, lj);
            else if (act0) slc_visit1(Kb, Vb, Q[0], O[0], m[0], l[0], 64 * j, mask, tok0, sl2, sb0, lj);
            else if (act1) slc_visit1(Kb, Vb, Q[1], O[1], m[1], l[1], 64 * j, mask, tok1, sl2, sb1, lj);
            asm volatile("s_waitcnt lgkmcnt(0)" ::: "memory");
        }
        asm volatile("" ::: "memory");
        if (lane == 0) flg[wv] = (unsigned)(j + 1);
        asm volatile("" ::: "memory");
    }
    asm volatile("s_waitcnt vmcnt(0)" ::: "memory");
    __syncthreads();
#undef SLC_LOAD
}

struct SrcMem { const char* kb; const char* vb;
    __device__ __forceinline__ unsigned off(int key) const { return (unsigned)min(key, NMEM - 1) * 256u; } };
struct MaskNone { __device__ __forceinline__ bool operator()(int, int) const { return true; } };

__device__ __forceinline__ void cross_fast(Ctx& F, int layer, bf16* MIX) {
    for (int u = blockIdx.x; u < 256; u += F.G) {
        int tidv = F.wave * 64 + (int)__builtin_amdgcn_mbcnt_hi(~0u, __builtin_amdgcn_mbcnt_lo(~0u, 0u)); asm volatile("" : "+v"(tidv));
        const int lane = tidv & 63, c16 = lane & 15, g = lane >> 4;
        const int h = u & 3, tb = u >> 2;
        int tok[2]; bf16x8 Q[2][4]; f32x4 O[2][8]; float m[2], l[2];
#pragma unroll
        for (int rt = 0; rt < 2; ++rt) { tok[rt] = tb * 256 + F.wave * 32 + rt * 16 + c16; m[rt] = -1e30f; l[rt] = 0.f;
#pragma unroll
            for (int kd = 0; kd < 4; ++kd) Q[rt][kd] = *(const bf16x8*)((const char*)F.P + ((unsigned)tok[rt] * (unsigned)(NP * 2) + (unsigned)((CXQ + h * 128 + g * 8 + kd * 32) * 2)));
#pragma unroll
            for (int dt = 0; dt < 8; ++dt) O[rt][dt] = (f32x4){0.f, 0.f, 0.f, 0.f}; }
        SrcMem src{(const char*)(F.MEMKV + (((size_t)layer * 2 + 0) * 4 + h) * NMEM * 128), (const char*)(F.MEMKV + (((size_t)layer * 2 + 1) * 4 + h) * NMEM * 128)};
        attn_pass<0>(F, F.lds, Q, O, m, l, 0, 4, src, MaskNone(), tok[0], tok[1], 0.08838834764831845f * LOG2E);
#pragma unroll
        for (int rt = 0; rt < 2; ++rt) {
            float lt = xsum4(l[rt], lane);
            const float inv = 1.f / lt;
#pragma unroll
            for (int dt = 0; dt < 8; ++dt) { const int d = dt * 16 + g * 4;
                const unsigned long long xg = *(const unsigned long long*)((const char*)F.P + ((unsigned)tok[rt] * (unsigned)(NP * 2) + (unsigned)((CXG + h * 128 + d) * 2)));
                const unsigned lo = (unsigned)xg, hi = (unsigned)(xg >> 32);
                const float o0 = O[rt][dt][0] * inv * silu_f(bf2f((bf16)(lo & 0xffff))), o1 = O[rt][dt][1] * inv * silu_f(bf2f((bf16)(lo >> 16)));
                const float o2 = O[rt][dt][2] * inv * silu_f(bf2f((bf16)(hi & 0xffff))), o3 = O[rt][dt][3] * inv * silu_f(bf2f((bf16)(hi >> 16)));
                *(unsigned long long*)((char*)MIX + ((unsigned)tok[rt] * (unsigned)(DM * 2) + (unsigned)((1536 + h * 128 + d) * 2))) = (unsigned long long)pk2(o0, o1) | ((unsigned long long)pk2(o2, o3) << 32); }
        }
    }
}


struct SrcRows { const char* kb; const char* vb;
    __device__ __forceinline__ unsigned off(int key) const { return (unsigned)min(max(key, 0), T - 1) * 256u; } };
struct MaskWin { __device__ __forceinline__ bool operator()(int t, int key) const { return key <= t && key > t - 512; } };
struct SrcCmp { const char* kb; const char* vb;
    __device__ __forceinline__ unsigned off(int key) const { return (unsigned)min(key, 1022) * 256u; } };
struct MaskCmp { __device__ __forceinline__ bool operator()(int t, int key) const { return 16 * key + 31 <= t; } };

struct MaskCausal { __device__ __forceinline__ bool operator()(int t, int key) const { return key <= t; } };

__device__ __forceinline__ void nsa_main_fast(Ctx& F) {
    const float sl2 = 0.08838834764831845f * LOG2E;
    LAS float* imp = (LAS float*)(F.lds + RING * TILE_KV) + F.wave * 1024;
    LAS unsigned* bm = (LAS unsigned*)(F.lds + RING_BYTES + 1024) + F.wave * 32;
    for (;;) {
        int zq = 0; asm volatile("" : "+s"(zq));
        unsigned* qctr = (unsigned*)(F.ws + WS_CTL) + 8192 + zq;
        volatile LAS int* qslot = (volatile LAS int*)(F.lds + RING_BYTES + 3072) + zq;
        __syncthreads();
        if (F.wave == 0 && __builtin_amdgcn_mbcnt_hi(~0u, __builtin_amdgcn_mbcnt_lo(~0u, 0u)) == 0) qslot[0] = (int)__hip_atomic_fetch_add(qctr, 1u, __ATOMIC_RELAXED, __HIP_MEMORY_SCOPE_AGENT);
        __syncthreads();
        const int ticket = qslot[0];
        if (ticket >= 1024) break;
        const int g = ticket & 1, tb = 511 - (ticket >> 1);
        int tidv = F.wave * 64 + (int)__builtin_amdgcn_mbcnt_hi(~0u, __builtin_amdgcn_mbcnt_lo(~0u, 0u)); asm volatile("" : "+v"(tidv));
        const int lane = tidv & 63, c16 = lane & 15, gq = lane >> 4, ts = c16 >> 3, hs = c16 & 7; const bool hv = hs < 6;
        int tok[2]; f32x4 O[2][8]; bf16x8 Q[2][4]; float m[2], l[2];
        {
            float gw[2], gc[2];
#pragma unroll
            for (int rt = 0; rt < 2; ++rt) { tok[rt] = tb * 32 + F.wave * 4 + rt * 2 + ts; m[rt] = -1e30f; l[rt] = 0.f;
                const char* Pb = (const char*)F.P; const unsigned ro = (unsigned)tok[rt] * (unsigned)(NP * 2);
#pragma unroll
                for (int kd = 0; kd < 4; ++kd) { Q[rt][kd] = (bf16x8){0, 0, 0, 0, 0, 0, 0, 0}; if (hv) Q[rt][kd] = *(const bf16x8*)(Pb + (ro + (unsigned)((NQ + (g * 6 + hs) * 128 + gq * 8 + kd * 32) * 2))); }
                gw[rt] = hv ? sigmoid_f(bf2f(*(const bf16*)(Pb + (ro + (unsigned)((CGL + g * 18 + hs * 3 + 2) * 2))))) : 0.f;
                gc[rt] = hv ? sigmoid_f(bf2f(*(const bf16*)(Pb + (ro + (unsigned)((CGL + g * 18 + hs * 3 + 0) * 2))))) : 0.f;
#pragma unroll
                for (int dt = 0; dt < 8; ++dt) O[rt][dt] = (f32x4){0.f, 0.f, 0.f, 0.f}; }
            { const int klo = max(0, tb * 32 - 511), k0 = (klo >> 6) << 6, nt = ((tb * 32 + 31 - k0) >> 6) + 1;
              attn_pass<0>(F, F.lds, Q, O, m, l, k0, nt, SrcRows{(const char*)(F.CP + (8 + g) * PLANE), (const char*)(F.CP + (10 + g) * PLANE)}, MaskWin(), tok[0], tok[1], sl2); }
#pragma unroll
            for (int rt = 0; rt < 2; ++rt) { float lt = xsum4(l[rt], lane); const float f = gw[rt] / lt;
#pragma unroll
                for (int dt = 0; dt < 8; ++dt) O[rt][dt] = O[rt][dt] * f; m[rt] = -1e30f; l[rt] = 0.f; }
            const int tlast = tb * 32 + 31, ncv = (tlast - 31) / 16 + 1, ntc = (ncv + 63) >> 6;
            SrcCmp sc_{(const char*)(F.KCMP + (size_t)g * 1024 * 128), (const char*)(F.VCMP + (size_t)g * 1024 * 128)};
            attn_pass<1>(F, F.lds, Q, O, m, l, 0, ntc, sc_, MaskCmp(), tok[0], tok[1], sl2);
#pragma unroll
            for (int rt = 0; rt < 2; ++rt) { float lt = xsum4(l[rt], lane); l[rt] = lt > 0.f ? 1.f / lt : 0.f; }
            attn_pass<2>(F, F.lds, Q, O, m, l, 0, ntc, sc_, MaskCmp(), tok[0], tok[1], sl2, ImpArgs{gc[0], gc[1], hv, imp, nullptr});
        }
        for (int s = 0; s < 4; ++s) {
            const int tt = tb * 32 + F.wave * 4 + s, cur = tt >> 6;
            unsigned key[4]; bool sel[4];
#pragma unroll
            for (int i = 0; i < 4; ++i) { const int jj = lane + 64 * i; float f = imp[s * 256 + jj]; if (jj == 0 || jj == cur || jj == cur - 1) f = 1e4f;
                key[i] = (jj > cur) ? 0u : __builtin_bit_cast(unsigned, fmaxf(f, 0.f)) + 1u; sel[i] = (jj <= cur); }
            if (cur + 1 > 16) {
                unsigned prefix = 0u;
                for (int bit = 31; bit >= 0; --bit) { const unsigned cand = prefix | (1u << bit);
                    const int cnt = __popcll(__ballot(key[0] >= cand)) + __popcll(__ballot(key[1] >= cand)) + __popcll(__ballot(key[2] >= cand)) + __popcll(__ballot(key[3] >= cand));
                    if (cnt >= 16) prefix = cand; }
                const unsigned long long g0 = __ballot(key[0] > prefix), g1 = __ballot(key[1] > prefix), g2 = __ballot(key[2] > prefix), g3 = __ballot(key[3] > prefix);
                const unsigned long long e0 = __ballot(key[0] == prefix), e1 = __ballot(key[1] == prefix), e2 = __ballot(key[2] == prefix), e3 = __ballot(key[3] == prefix);
                const int need = 16 - (__popcll(g0) + __popcll(g1) + __popcll(g2) + __popcll(g3));
                const unsigned long long lt = (1ull << lane) - 1ull;
                const int r0 = __popcll(e0 & lt), r1 = __popcll(e0) + __popcll(e1 & lt), r2 = __popcll(e0) + __popcll(e1) + __popcll(e2 & lt), r3 = __popcll(e0) + __popcll(e1) + __popcll(e2) + __popcll(e3 & lt);
                sel[0] = (key[0] > prefix) || (key[0] == prefix && r0 < need); sel[1] = (key[1] > prefix) || (key[1] == prefix && r1 < need);
                sel[2] = (key[2] > prefix) || (key[2] == prefix && r2 < need); sel[3] = (key[3] > prefix) || (key[3] == prefix && r3 < need);
            }
#pragma unroll
            for (int i = 0; i < 4; ++i) { const unsigned long long b = __ballot(sel[i]); if (lane == 0) { bm[s * 8 + 2 * i] = (unsigned)b; bm[s * 8 + 2 * i + 1] = (unsigned)(b >> 32); } }
        }
        if (hv) {
#pragma unroll
            for (int rt = 0; rt < 2; ++rt)
#pragma unroll
                for (int dt = 0; dt < 8; ++dt) { const int col = (g * 6 + hs) * 128 + dt * 16 + gq * 4;
                    *(unsigned long long*)((char*)F.MIX1 + ((unsigned)tok[rt] * (unsigned)(DM * 2) + (unsigned)(col * 2))) = (unsigned long long)cvtpk(O[rt][dt][0], O[rt][dt][1]) | ((unsigned long long)cvtpk(O[rt][dt][2], O[rt][dt][3]) << 32); }
        }
#pragma unroll
        for (int rt = 0; rt < 2; ++rt) { m[rt] = -1e30f; l[rt] = 0.f;
#pragma unroll
            for (int dt = 0; dt < 8; ++dt) O[rt][dt] = (f32x4){0.f, 0.f, 0.f, 0.f}; }
        slc_pass(F, F.lds, Q, O, m, l, ((tb * 32) >> 6) + 1, SrcRows{(const char*)(F.CP + (4 + g) * PLANE), (const char*)(F.CP + (6 + g) * PLANE)}, MaskCausal(), tok[0], tok[1], sl2, ImpArgs{0.f, 0.f, hv, nullptr, bm});
        const float lts0 = xsum4(l[0], lane), lts1 = xsum4(l[1], lane);
        if (hv) {
#pragma unroll
            for (int rt = 0; rt < 2; ++rt) {
                const float lt = rt ? lts1 : lts0;
                const float f = sigmoid_f(bf2f(*(const bf16*)((const char*)F.P + ((unsigned)tok[rt] * (unsigned)(NP * 2) + (unsigned)((CGL + g * 18 + hs * 3 + 1) * 2))))) / lt;
#pragma unroll
                for (int dt = 0; dt < 8; ++dt) { const int col = (g * 6 + hs) * 128 + dt * 16 + gq * 4;
                    char* mp = (char*)F.MIX1 + ((unsigned)tok[rt] * (unsigned)(DM * 2) + (unsigned)(col * 2));
                    const unsigned long long pp = *(const unsigned long long*)mp; const unsigned plo = (unsigned)pp, phi = (unsigned)(pp >> 32);
                    const unsigned long long rr = *(const unsigned long long*)((const char*)F.P + ((unsigned)tok[rt] * (unsigned)(NP * 2) + (unsigned)((CR + col) * 2))); const unsigned lo = (unsigned)rr, hi = (unsigned)(rr >> 32);
                    const float o0 = (O[rt][dt][0] * f + bf2f((bf16)(plo & 0xffff))) * silu_f(bf2f((bf16)(lo & 0xffff))), o1 = (O[rt][dt][1] * f + bf2f((bf16)(plo >> 16))) * silu_f(bf2f((bf16)(lo >> 16)));
                    const float o2 = (O[rt][dt][2] * f + bf2f((bf16)(phi & 0xffff))) * silu_f(bf2f((bf16)(hi & 0xffff))), o3 = (O[rt][dt][3] * f + bf2f((bf16)(phi >> 16))) * silu_f(bf2f((bf16)(hi >> 16)));
                    *(unsigned long long*)mp = (unsigned long long)cvtpk(o0, o1) | ((unsigned long long)cvtpk(o2, o3) << 32); }
            }
        }
    }
}

__device__ __forceinline__ void gla_g1_fast(Ctx& F) {
    int tidv = F.wave * 64 + (int)__builtin_amdgcn_mbcnt_hi(~0u, __builtin_amdgcn_mbcnt_lo(~0u, 0u)); asm volatile("" : "+v"(tidv));
    const int tid = tidv, lane = tidv & 63, c16 = lane & 15, gq = lane >> 4, wave = F.wave;
    constexpr int QP = 416, VP = 800;
    LAS float* bcum = (LAS float*)F.lds;
    LAS unsigned char* Vt = F.lds;
    LAS unsigned char* QT = F.lds + 51200;
    LAS unsigned char* KT = F.lds + 51200 + 26624;
    LAS float* eblast = (LAS float*)(F.lds + 104448);
    LAS float* tot0 = (LAS float*)(F.lds + 105216);
    LAS float* glr = (LAS float*)(F.lds + 105984);
    const float qscale = 0.07216878364870323f;
    for (int u = blockIdx.x; u < 1024; u += F.G) {
        const int n = u >> 2, h = u & 3; const size_t row0 = (size_t)n * 64;
        for (int i = tid; i < 1024; i += NTHR) glr[i] = bf2f(F.P[(row0 + (i >> 4)) * NP + CGL + (i & 15)]);
        __syncthreads();
        if (tid < 384) {
            const int seg = tid >= 192 ? 1 : 0, d = tid - 192 * seg, col = h * 192 + d; float wg[16];
#pragma unroll
            for (int j = 0; j < 16; ++j) wg[j] = F.gla_w_gate[j * 768 + col];
            const float bias = F.gla_b_gate[col]; float b = 0.f;
            for (int c = 32 * seg; c < 32 * seg + 32; ++c) { float gl = bias;
#pragma unroll
                for (int j = 0; j < 16; ++j) gl += glr[c * 16 + j] * wg[j];
                b += logsigmoid_f(gl) * (1.f / 16.f); bcum[c * 192 + d] = b; }
            if (seg == 0) tot0[d] = b;
        }
        __syncthreads();
        if (tid >= 192 && tid < 384) { const int d = tid - 192; const float t0 = tot0[d];
            for (int c = 32; c < 64; ++c) bcum[c * 192 + d] += t0; }
        __syncthreads();
        if (tid < 192) { const float eb = __expf(bcum[63 * 192 + tid]); eblast[tid] = eb; F.DEC[n * 768 + h * 192 + tid] = eb; }
#pragma unroll
        for (int i = 0; i < 3; ++i) { const int idx = tid + NTHR * i, c = idx / 24, d8 = (idx % 24) * 8;
            bf16* qg = F.P + (row0 + c) * NP + GQ + h * 192 + d8; const bf16* kg = F.P + (row0 + c) * NP + GK + h * 192 + d8;
            const v4u qr = *(const v4u*)qg, kr = *(const v4u*)kg;
            const unsigned qw[4] = {qr.x, qr.y, qr.z, qr.w}, kw[4] = {kr.x, kr.y, kr.z, kr.w}; unsigned qo[4], ko[4];
#pragma unroll
            for (int j = 0; j < 4; ++j) { const float b0 = bcum[c * 192 + d8 + 2 * j], b1 = bcum[c * 192 + d8 + 2 * j + 1];
                qo[j] = pk2(bf2f((bf16)(qw[j] & 0xffff)) * qscale * __expf(b0), bf2f((bf16)(qw[j] >> 16)) * qscale * __expf(b1));
                ko[j] = pk2(bf2f((bf16)(kw[j] & 0xffff)) * __expf(-b0), bf2f((bf16)(kw[j] >> 16)) * __expf(-b1)); }
            const v4u qv = {qo[0], qo[1], qo[2], qo[3]}, kv = {ko[0], ko[1], ko[2], ko[3]};
            *(LAS v4u*)(QT + c * QP + d8 * 2) = qv; *(LAS v4u*)(KT + c * QP + d8 * 2) = kv; *(v4u*)qg = qv; }
        __syncthreads();
#pragma unroll
        for (int i = 0; i < 6; ++i) { const int idx = tid + NTHR * i, r = idx / 48, ch = idx % 48;
            *(LAS v4u*)(Vt + r * VP + ch * 16) = *(const v4u*)(F.P + (row0 + r) * NP + GV + h * 384 + ch * 8); }
        __syncthreads();
        {
            bf16x8 vB[3][2];
#pragma unroll
            for (int j = 0; j < 3; ++j)
#pragma unroll
                for (int ks = 0; ks < 2; ++ks) { const LAS unsigned char* p = Vt + (32 * ks + 4 * gq + (c16 >> 2)) * VP + (16 * (3 * wave + j) + 4 * (c16 & 3)) * 2;
                    const s16x4 lo = vtr(p), hi = vtr(p + 16 * VP); vB[j][ks] = (bf16x8){lo[0], lo[1], lo[2], lo[3], hi[0], hi[1], hi[2], hi[3]}; }
            for (int dt = 0; dt < 12; ++dt) {
                bf16x8 aK[2];
#pragma unroll
                for (int ks = 0; ks < 2; ++ks) { const LAS unsigned char* p = KT + (32 * ks + 4 * gq + (c16 >> 2)) * QP + (16 * dt + 4 * (c16 & 3)) * 2;
                    const s16x4 lo = vtr(p), hi = vtr(p + 16 * QP); aK[ks] = (bf16x8){lo[0], lo[1], lo[2], lo[3], hi[0], hi[1], hi[2], hi[3]}; }
                const f32x4 eb = *(const LAS f32x4*)(eblast + 16 * dt + 4 * gq);
#pragma unroll
                for (int j = 0; j < 3; ++j) { f32x4 acc = {0.f, 0.f, 0.f, 0.f};
                    acc = __builtin_amdgcn_mfma_f32_16x16x32_bf16(aK[0], vB[j][0], acc, 0, 0, 0);
                    acc = __builtin_amdgcn_mfma_f32_16x16x32_bf16(aK[1], vB[j][1], acc, 0, 0, 0);
                    const int e = 16 * (3 * wave + j) + c16;
                    *(unsigned long long*)(F.STATE + ((size_t)u * 384 + e) * 192 + 16 * dt + 4 * gq) = (unsigned long long)pk2(acc[0] * eb[0], acc[1] * eb[1]) | ((unsigned long long)pk2(acc[2] * eb[2], acc[3] * eb[3]) << 32); }
            }
        }
        {
            const int ct = wave & 3, eh = wave >> 2;
            bf16x8 qB[6];
#pragma unroll
            for (int kd = 0; kd < 6; ++kd) qB[kd] = *(const LAS bf16x8*)(QT + (16 * ct + c16) * QP + (8 * gq + 32 * kd) * 2);
            f32x4 at[4];
#pragma unroll
            for (int st = 0; st < 4; ++st) { at[st] = (f32x4){0.f, 0.f, 0.f, 0.f};
                if (st <= ct) {
#pragma unroll
                    for (int kd = 0; kd < 6; ++kd) { const bf16x8 kA = *(const LAS bf16x8*)(KT + (16 * st + c16) * QP + (8 * gq + 32 * kd) * 2);
                        at[st] = __builtin_amdgcn_mfma_f32_16x16x32_bf16(kA, qB[kd], at[st], 0, 0, 0); }
#pragma unroll
                    for (int r = 0; r < 4; ++r) if (16 * st + 4 * gq + r > 16 * ct + c16) at[st][r] = 0.f;
                } }
            v4u pw0, pw1; pw0.x = pk2(at[0][0], at[0][1]); pw0.y = pk2(at[0][2], at[0][3]); pw0.z = pk2(at[1][0], at[1][1]); pw0.w = pk2(at[1][2], at[1][3]);
            pw1.x = pk2(at[2][0], at[2][1]); pw1.y = pk2(at[2][2], at[2][3]); pw1.z = pk2(at[3][0], at[3][1]); pw1.w = pk2(at[3][2], at[3][3]);
            const bf16x8 pA0 = __builtin_bit_cast(bf16x8, pw0), pA1 = __builtin_bit_cast(bf16x8, pw1);
            for (int j = 0; j < 12; ++j) { const int et = 12 * eh + j;
                bf16x8 vA[2];
#pragma unroll
                for (int ks = 0; ks < 2; ++ks) { const LAS unsigned char* p = Vt + (32 * ks + 4 * gq + (c16 >> 2)) * VP + (16 * et + 4 * (c16 & 3)) * 2;
                    const s16x4 lo = vtr(p), hi = vtr(p + 16 * VP); vA[ks] = (bf16x8){lo[0], lo[1], lo[2], lo[3], hi[0], hi[1], hi[2], hi[3]}; }
                f32x4 acc = {0.f, 0.f, 0.f, 0.f};
                acc = __builtin_amdgcn_mfma_f32_16x16x32_bf16(vA[0], pA0, acc, 0, 0, 0);
                acc = __builtin_amdgcn_mfma_f32_16x16x32_bf16(vA[1], pA1, acc, 0, 0, 0);
                *(unsigned long long*)(F.OI + (row0 + 16 * ct + c16) * 1536 + h * 384 + 16 * et + 4 * gq) = (unsigned long long)pk2(acc[0], acc[1]) | ((unsigned long long)pk2(acc[2], acc[3]) << 32); }
        }
        __syncthreads();
    }
}

__device__ __forceinline__ void gla_g3_fast(Ctx& F) {
    int tidv = F.wave * 64 + (int)__builtin_amdgcn_mbcnt_hi(~0u, __builtin_amdgcn_mbcnt_lo(~0u, 0u)); asm volatile("" : "+v"(tidv));
    const int lane = tidv & 63, c16 = lane & 15, gq = lane >> 4, wave = F.wave, ct = wave & 3, eh = wave >> 2;
    LAS float* ssq = (LAS float*)F.lds;
    for (int u = blockIdx.x; u < 1024; u += F.G) {
        const int n = u >> 2, h = u & 3; const size_t crow = (size_t)n * 64 + 16 * ct + c16;
        f32x4 acc[12];
#pragma unroll
        for (int j = 0; j < 12; ++j) acc[j] = (f32x4){0.f, 0.f, 0.f, 0.f};
        if (n > 0) {
            bf16x8 qB[6];
#pragma unroll
            for (int kd = 0; kd < 6; ++kd) qB[kd] = *(const bf16x8*)(F.P + crow * NP + GQ + h * 192 + 8 * gq + 32 * kd);
            const bf16* Sp = F.STATE + ((size_t)(u - 4) * 384 + 192 * eh + c16) * 192 + 8 * gq;
#pragma unroll
            for (int j = 0; j < 12; ++j)
#pragma unroll
                for (int kd = 0; kd < 6; ++kd) { const bf16x8 a = *(const bf16x8*)(Sp + (size_t)(16 * j) * 192 + 32 * kd);
                    acc[j] = __builtin_amdgcn_mfma_f32_16x16x32_bf16(a, qB[kd], acc[j], 0, 0, 0); }
        }
        float ss = 0.f;
#pragma unroll
        for (int j = 0; j < 12; ++j) { const int e0 = h * 384 + 192 * eh + 16 * j + 4 * gq;
            const unsigned long long oi = *(const unsigned long long*)(F.OI + crow * 1536 + e0); const unsigned lo = (unsigned)oi, hi = (unsigned)(oi >> 32);
            acc[j][0] += bf2f((bf16)(lo & 0xffff)); acc[j][1] += bf2f((bf16)(lo >> 16)); acc[j][2] += bf2f((bf16)(hi & 0xffff)); acc[j][3] += bf2f((bf16)(hi >> 16));
            ss += (acc[j][0] * acc[j][0] + acc[j][1] * acc[j][1]) + (acc[j][2] * acc[j][2] + acc[j][3] * acc[j][3]); }
        ss += __shfl_xor(ss, 16); ss += __shfl_xor(ss, 32);
        if (gq == 0) ssq[eh * 64 + 16 * ct + c16] = ss;
        __syncthreads();
        const float rstd = rsqrtf((ssq[16 * ct + c16] + ssq[64 + 16 * ct + c16]) * (1.f / 384.f) + EPS);
#pragma unroll
        for (int j = 0; j < 12; ++j) { const int el = 192 * eh + 16 * j + 4 * gq, e0 = h * 384 + el;
            const f32x4 gn = *(const f32x4*)(F.gla_norm + el);
            const unsigned long long rr = *(const unsigned long long*)(F.P + crow * NP + CR + e0); const unsigned lo = (unsigned)rr, hi = (unsigned)(rr >> 32);
            const float o0 = acc[j][0] * rstd * gn[0] * silu_f(bf2f((bf16)(lo & 0xffff))), o1 = acc[j][1] * rstd * gn[1] * silu_f(bf2f((bf16)(lo >> 16)));
            const float o2 = acc[j][2] * rstd * gn[2] * silu_f(bf2f((bf16)(hi & 0xffff))), o3 = acc[j][3] * rstd * gn[3] * silu_f(bf2f((bf16)(hi >> 16)));
            *(unsigned long long*)(F.MIX0 + crow * DM + e0) = (unsigned long long)pk2(o0, o1) | ((unsigned long long)pk2(o2, o3) << 32); }
        __syncthreads();
    }
}


__device__ __forceinline__ void memkv_fast(Ctx& F) {
    int tidv = F.wave * 64 + (int)__builtin_amdgcn_mbcnt_hi(~0u, __builtin_amdgcn_mbcnt_lo(~0u, 0u)); asm volatile("" : "+v"(tidv));
    const int lane = tidv & 63, c16 = lane & 15, gq = lane >> 4;
    for (int u = F.gw; u < 2048; u += F.NGW) {
        const int layer = u >> 10, mt = (u >> 6) & 15, ntile = u & 63;
        const float* ar = F.mem + (size_t)(16 * mt + c16) * DM + 8 * gq; const float* gr = F.ln_mem + layer * DM + 8 * gq;
        const bf16* br = F.WMKV + ((size_t)layer * 1024 + 16 * ntile + c16) * DM + 8 * gq;
        f32x4 acc = {0.f, 0.f, 0.f, 0.f}; float ss = 0.f;
#pragma unroll 4
        for (int ks = 0; ks < 64; ++ks) {
            const f32x4 a0 = *(const f32x4*)(ar + 32 * ks), a1 = *(const f32x4*)(ar + 32 * ks + 4), g0 = *(const f32x4*)(gr + 32 * ks), g1 = *(const f32x4*)(gr + 32 * ks + 4);
            ss += (a0.x * a0.x + a0.y * a0.y) + (a0.z * a0.z + a0.w * a0.w) + (a1.x * a1.x + a1.y * a1.y) + (a1.z * a1.z + a1.w * a1.w);
            v4u aw; aw.x = pk2(a0.x * g0.x, a0.y * g0.y); aw.y = pk2(a0.z * g0.z, a0.w * g0.w); aw.z = pk2(a1.x * g1.x, a1.y * g1.y); aw.w = pk2(a1.z * g1.z, a1.w * g1.w);
            const bf16x8 bfr = *(const bf16x8*)(br + 32 * ks);
            acc = __builtin_amdgcn_mfma_f32_16x16x32_bf16(__builtin_bit_cast(bf16x8, aw), bfr, acc, 0, 0, 0);
        }
        ss += __shfl_xor(ss, 16); ss += __shfl_xor(ss, 32);
        const float rs = rsqrtf(ss * (1.f / DM) + EPS);
        const int n = 16 * ntile + c16, kv = n >> 9, h = (n >> 7) & 3, d = n & 127;
#pragma unroll
        for (int r = 0; r < 4; ++r) { const int ml = 4 * gq + r; const float rr = __shfl(rs, ml);
            F.MEMKV[((((size_t)layer * 2 + kv) * 4 + h) * NMEM + 16 * mt + ml) * 128 + d] = f2b(acc[r] * rr); }
    }
}

__device__ __forceinline__ void nsa_compress_fast(Ctx& F) {
    int tidv = F.wave * 64 + (int)__builtin_amdgcn_mbcnt_hi(~0u, __builtin_amdgcn_mbcnt_lo(~0u, 0u)); asm volatile("" : "+v"(tidv));
    const int lane = tidv & 63, c16 = lane & 15, gq = lane >> 4, wave = F.wave;
    LAS unsigned char* hid = F.lds;
    constexpr int HP = 544;
    for (int u = blockIdx.x; u < 256; u += F.G) {
        const int kv = u & 1, g = (u >> 1) & 1, nt16 = u >> 2;
        const bf16* W1T = kv ? F.WV1T : F.WK1T; const float* w2 = kv ? F.wv2 : F.wk2; const float* hb = F.HB + kv * 32 * 256;
        const int n = min(16 * nt16 + c16, 1022);
        const bf16* ar = F.CP + (size_t)(kv * 2 + g) * PLANE + (size_t)(16 * n) * 128 + 8 * gq;
        const bf16* b0 = W1T + (size_t)(32 * wave + c16) * 4096 + 8 * gq; const bf16* b1 = b0 + (size_t)16 * 4096;
        f32x4 acc0 = {0.f, 0.f, 0.f, 0.f}, acc1 = {0.f, 0.f, 0.f, 0.f};
        for (int l = 0; l < 32; ++l) {
#pragma unroll
            for (int kd = 0; kd < 4; ++kd) { const bf16x8 a = *(const bf16x8*)(ar + l * 128 + 32 * kd);
                const bf16x8 w0 = *(const bf16x8*)(b0 + l * 128 + 32 * kd), w1 = *(const bf16x8*)(b1 + l * 128 + 32 * kd);
                acc0 = __builtin_amdgcn_mfma_f32_16x16x32_bf16(a, w0, acc0, 0, 0, 0); acc1 = __builtin_amdgcn_mfma_f32_16x16x32_bf16(a, w1, acc1, 0, 0, 0); }
        }
        { const int j0 = 32 * wave + c16; float h0 = 0.f, h1 = 0.f;
#pragma unroll 8
          for (int s = 0; s < 32; ++s) { h0 += hb[s * 256 + j0]; h1 += hb[s * 256 + j0 + 16]; }
#pragma unroll
          for (int r = 0; r < 4; ++r) { *(LAS bf16*)(hid + (4 * gq + r) * HP + j0 * 2) = f2b(silu_f(acc0[r] + h0)); *(LAS bf16*)(hid + (4 * gq + r) * HP + (j0 + 16) * 2) = f2b(silu_f(acc1[r] + h1)); } }
        __syncthreads();
        { f32x4 acc = {0.f, 0.f, 0.f, 0.f}; const int d = 16 * wave + c16;
#pragma unroll
          for (int ks = 0; ks < 8; ++ks) { const bf16x8 a = *(const LAS bf16x8*)(hid + c16 * HP + (8 * gq + 32 * ks) * 2);
              const float* wp = w2 + (size_t)(8 * gq + 32 * ks) * 128 + d;
              v4u bw; bw.x = pk2(wp[0], wp[128]); bw.y = pk2(wp[256], wp[384]); bw.z = pk2(wp[512], wp[640]); bw.w = pk2(wp[768], wp[896]);
              acc = __builtin_amdgcn_mfma_f32_16x16x32_bf16(a, __builtin_bit_cast(bf16x8, bw), acc, 0, 0, 0); }
          bf16* outp = (kv ? F.VCMP : F.KCMP) + (size_t)g * 1024 * 128;
#pragma unroll
          for (int r = 0; r < 4; ++r) { const int nn = 16 * nt16 + 4 * gq + r; if (nn < 1023) outp[(size_t)nn * 128 + d] = f2b(acc[r]); } }
        __syncthreads();
    }
}


__device__ __forceinline__ void load_ptrs(Ctx& F) {
    typedef const float* cfp;
    const volatile __attribute__((address_space(4))) cfp* ka = (const volatile __attribute__((address_space(4))) cfp*)__builtin_amdgcn_kernarg_segment_ptr();
    F.x = ka[0]; F.mem = ka[1]; F.ln_pre = ka[2]; F.ln_post = ka[3]; F.ln_mem = ka[4]; F.w_mem_kv = ka[5];
    F.gla_w_in = ka[6]; F.gla_w_gate = ka[7]; F.gla_b_gate = ka[8]; F.gla_norm = ka[9]; F.gla_w_out = ka[10];
    F.nsa_w_in = ka[11]; F.pe_k = ka[12]; F.pe_v = ka[13]; F.wk1 = ka[14]; F.wk2 = ka[15]; F.wv1 = ka[16]; F.wv2 = ka[17]; F.nsa_w_out = ka[18];
    F.out = (float*)ka[19]; F.ws = (unsigned char*)ka[20];
    unsigned char* ws = F.ws;
    F.WIN0 = (bf16*)(ws + WS_WIN0); F.WIN1 = (bf16*)(ws + WS_WIN1); F.WOUT0 = (bf16*)(ws + WS_WOUT0); F.WOUT1 = (bf16*)(ws + WS_WOUT1); F.WMKV = (bf16*)(ws + WS_WMKV);
    F.WK1T = (bf16*)(ws + WS_WK1T); F.WV1T = (bf16*)(ws + WS_WV1T); F.HB = (float*)(ws + WS_SEL);
    F.MEMKV = (bf16*)(ws + WS_MEMKV); F.DEC = (float*)(ws + WS_DEC); F.KCMP = (bf16*)(ws + WS_KCMP); F.VCMP = (bf16*)(ws + WS_VCMP);
    F.XN = (bf16*)(ws + WS_XN); F.P = (bf16*)(ws + WS_P); F.STATE = (bf16*)(ws + WS_STATE); F.MIX1 = (bf16*)(ws + WS_MIX1); F.CP = (bf16*)(ws + WS_CP);
    F.MIX0 = (bf16*)((unsigned char*)F.out + DO_MIX0); F.OI = (bf16*)((unsigned char*)F.out + DO_OI);
}
__global__ void __launch_bounds__(NTHR, 2) fwd_kernel(Args args) {
    extern __shared__ __attribute__((aligned(16))) unsigned char lds_raw[];
    Ctx F;
    F.lds = (LAS unsigned char*)lds_raw;
    F.tid = threadIdx.x; F.lane = F.tid & 63; F.wave = __builtin_amdgcn_readfirstlane(F.tid >> 6);
    F.G = gridDim.x; F.gw = blockIdx.x * NWAVES + F.wave; F.NGW = F.G * NWAVES;
    load_ptrs(F);
    unsigned char* ws = F.ws;

    volatile LAS unsigned* MISC = (volatile LAS unsigned*)(F.lds + MISC_OFF);
    for (int u = F.tid; u < (LDS_BYTES - LDSCTL_OFF) / 4; u += NTHR) ((LAS unsigned*)(F.lds + LDSCTL_OFF))[u] = 0u;
    __syncthreads();
    const int lo = args.ph_lo, hi = args.ph_hi;
    XcdBarrier bar; bar.bar = (unsigned*)(ws + WS_CTL); bar.x = 0; bar.st = nullptr;
    if (hi - lo > 1) bar = xcd_barrier_post((unsigned*)(ws + WS_CTL), MISC + 8, F.wave);
#define IN(k) (lo <= (k) && (k) < hi)
#define REFRESH() do { int t_ = F.wave * 64 + (int)__builtin_amdgcn_mbcnt_hi(~0u, __builtin_amdgcn_mbcnt_lo(~0u, 0u)); asm volatile("" : "+v"(t_)); F.tid = t_; F.lane = t_ & 63; load_ptrs(F); } while (0)
#define SEAM(k) do { if (IN(k) && IN((k) + 1)) xcd_barrier(bar, F.wave); } while (0)

    if (IN(0)) { REFRESH(); phase_prep(F); } SEAM(0);
    if (IN(1)) { REFRESH(); memkv_fast(F); REFRESH();
        pg8::Gemm g{F.XN, F.WIN0, T, NP, DM, F.wave}; pg8::StaticOrder S; S.init(T, NP, F.G, (int)blockIdx.x);
        pg8::EpiBf16<0> E{F.P, NP, nullptr, 0, 0, 1.f};
        pg8::gemm_phase<pg8::EpiBf16<0>, pg8::StaticOrder, true, true>(F.lds, g, S, E); } SEAM(1);
    if (IN(2)) { REFRESH(); gla_g1_fast(F); REFRESH(); cross_fast(F, 0, F.MIX0); } SEAM(2);
    if (IN(3)) { REFRESH(); gla_scan(F); } SEAM(3);
    if (IN(4)) { REFRESH(); gla_g3_fast(F); } SEAM(4);
    if (IN(5)) { REFRESH(); pg8::Gemm g{F.MIX0, F.WOUT0, T, DM, DM, F.wave}; pg8::StaticOrder S; S.init(T, DM, F.G, (int)blockIdx.x);
        pg8::EpiBf16<0> E{F.XN, DM, nullptr, 0, 0, 1.f};
        pg8::gemm_phase<pg8::EpiBf16<0>, pg8::StaticOrder, true, true>(F.lds, g, S, E); } SEAM(5);
    if (IN(6)) { REFRESH(); post_rows(F, F.x, F.XN, F.ln_post, F.out, F.ln_pre + DM, F.XN); } SEAM(6);
    if (IN(7)) { REFRESH(); pg8::Gemm g{F.XN, F.WIN1, T, NP, DM, F.wave}; pg8::StaticOrder S; S.init(T, NP, F.G, (int)blockIdx.x);
        EpiNsaIn E{F.P, NP, F.CP};
        pg8::gemm_phase<EpiNsaIn, pg8::StaticOrder, true, true>(F.lds, g, S, E); } SEAM(7);
    if (IN(8)) { REFRESH(); nsa_compress_fast(F); } SEAM(8);
    if (IN(9)) { REFRESH(); nsa_main_fast(F); REFRESH(); cross_fast(F, 1, F.MIX1); } SEAM(9);
    if (IN(10)) { REFRESH(); pg8::Gemm g{F.MIX1, F.WOUT1, T, DM, DM, F.wave}; pg8::StaticOrder S; S.init(T, DM, F.G, (int)blockIdx.x);
        pg8::EpiBf16<0> E{F.XN, DM, nullptr, 0, 0, 1.f};
        pg8::gemm_phase<pg8::EpiBf16<0>, pg8::StaticOrder, true, true>(F.lds, g, S, E); } SEAM(10);
    if (IN(11)) { REFRESH(); post_rows(F, F.out, F.XN, F.ln_post + DM, F.out, nullptr, nullptr); }
#undef IN
#undef SEAM
}

#ifndef N_LAUNCHES
#define N_LAUNCHES 1
#endif
extern "C" void kernel_launch(void* const* d_in, const int* in_sizes, int n_in, void* d_out, int out_size, void* d_ws, size_t ws_size, hipStream_t stream) {
    static int grid = 0;
    if (grid == 0) {
        if (n_in != 19 || out_size != T * DM || ws_size < WS_END) { fprintf(stderr, "kernel_launch: unexpected shapes (n_in %d out %d ws %zu)\n", n_in, out_size, ws_size); grid = -1; return; }
        int dev = 0, cus = 0, per_cu = 0;
        if (hipGetDevice(&dev) != hipSuccess || hipDeviceGetAttribute(&cus, hipDeviceAttributeMultiprocessorCount, dev) != hipSuccess) { grid = -1; return; }
        if (hipFuncSetAttribute((const void*)fwd_kernel, hipFuncAttributeMaxDynamicSharedMemorySize, LDS_BYTES) != hipSuccess) { fprintf(stderr, "kernel_launch: hipFuncSetAttribute failed\n"); grid = -1; return; }
        if (hipOccupancyMaxActiveBlocksPerMultiprocessor(&per_cu, (const void*)fwd_kernel, NTHR, LDS_BYTES) != hipSuccess || per_cu < 1) fprintf(stderr, "kernel_launch: occupancy query reports %d\n", per_cu);
        (void)hipGetLastError();
        grid = cus;
    }
    if (grid < 0) return;
    if (hipMemsetAsync((char*)d_ws + WS_CTL, 0, CTL_ZERO_BYTES, stream) != hipSuccess) return;
    Args a{};
    for (int i = 0; i < 19; ++i) a.in[i] = (const float*)d_in[i];
    a.out = (float*)d_out; a.ws = (unsigned char*)d_ws;
    for (int li = 0; li < N_LAUNCHES; ++li) {
        a.ph_lo = li * N_PHASES / N_LAUNCHES; a.ph_hi = (li + 1) * N_PHASES / N_LAUNCHES;
        hipLaunchKernelGGL(fwd_kernel, dim3(grid), dim3(NTHR), LDS_BYTES, stream, a);
    }
}
```

```cpp
#include <hip/hip_runtime.h>
#include <cstdio>
#include <cstdint>
namespace pg8 {
#define PG8_LAS __attribute__((address_space(3)))
typedef unsigned short bf16_t;
typedef short bf16x8 __attribute__((ext_vector_type(8)));
typedef float f32x4 __attribute__((ext_vector_type(4)));
typedef unsigned u32x4 __attribute__((ext_vector_type(4)));
constexpr int BM = 256, BK = 64, HALF = 128, HTB = HALF * BK * 2  , STAGE_BYTES = 8 * HTB, NXCD = 8, WGM = 8;

__host__ __device__ __forceinline__ int lds_byte(int r, int c) { const int st = (r >> 4) * 2 + (c >> 5), rr = r & 15, cc = c & 31, ob = rr * 64 + cc * 2; return st * 1024 + (ob ^ (((ob >> 9) & 1) << 5)); }
__host__ __device__ __forceinline__ void stage_rc(int b, int& R, int& C) { const int st = b / 1024, sb = b % 1024, swz = sb ^ (((sb >> 9) & 1) << 5); R = (st >> 1) * 16 + swz / 64; C = (st & 1) * 32 + (swz % 64) / 2; }
__host__ __device__ __forceinline__ int perm32(int rho) { const int n = rho >> 4, i = rho & 15; return 8 * (i >> 2) + 4 * n + (i & 3); }

struct Unit { int pm, pn; };
struct Gemm { const bf16_t* A; const bf16_t* Bt; int M, N, K; int wave; };

struct StaticOrder {
    int nM, nN, nwg, G, c;
    __host__ __device__ void init(int M, int N, int G_, int c_) { nM = M / BM; nN = N / BM; nwg = nM * nN; G = G_; c = c_; }
    __host__ __device__ bool next(int i, Unit& u) const {
        const long L = (long)i * G + c; if (L >= nwg) return false;
        int wgid = (int)L; { const int q = nwg / NXCD, r = nwg % NXCD, xcd = wgid % NXCD, off = wgid / NXCD; wgid = (xcd < r ? xcd * (q + 1) : r * (q + 1) + (xcd - r) * q) + off; }
        const int nig = WGM * nN, gid = wgid / nig, fm = gid * WGM, gsz = (nM - fm) < WGM ? (nM - fm) : WGM;
        u.pm = fm + ((wgid % nig) % gsz); u.pn = (wgid % nig) / gsz; return true;
    }
    __device__ __forceinline__ void a_ready(const Unit&) const {}
    __device__ __forceinline__ void done(const Unit&) const {}
};

__device__ __forceinline__ unsigned cvt_pk_bf16(float lo, float hi) { unsigned r; asm volatile("v_cvt_pk_bf16_f32 %0, %1, %2" : "=v"(r) : "v"(lo), "v"(hi)); return r; }
typedef float f32x2 __attribute__((ext_vector_type(2)));
__device__ __forceinline__ f32x2 gelu_pk(f32x2 v) {
    const f32x2 av = __builtin_elementwise_abs(v), d = av * 0.2316418882f + 1.0f;
    f32x2 t; t.x = __builtin_amdgcn_rcpf(d.x); t.y = __builtin_amdgcn_rcpf(d.y);
    f32x2 q = t * 0.5307027145f + (-0.7265760135f); q = q * t + 0.7107068705f; q = q * t + (-0.142248368f); q = q * t + 0.127414796f; q = q * t;
    const f32x2 s = (v * v) * (-0.72134752044f);
    f32x2 e; e.x = __builtin_amdgcn_exp2f(s.x); e.y = __builtin_amdgcn_exp2f(s.y);
    const f32x2 m = v * (q * e), r = v - m;
    f32x2 o; o.x = v.x < 0.f ? m.x : r.x; o.y = v.y < 0.f ? m.y : r.y; return o;
}

template <int ACT  > struct EpiBf16 {
    static constexpr bool PERM = true, AFTER_DRAIN = false; static_assert(ACT == 0 || ACT == 1, "EpiBf16: ACT is 0 (none) or 1 (gelu_pk)");
    bf16_t* O; int ldc; const float* bias; int split_cols; size_t split_stride; float scale0;
    __device__ __forceinline__ void operator()(const f32x4 (&acc)[2][2][4][2], const Unit& u, int wr, int wc, int fr, int fq) const {
        const int row0 = u.pm * BM + wr * 64 + fr; int colt = u.pn * BM; bf16_t* base = O;
        float sc = 1.f; if (split_cols) { const int t = colt / split_cols; base += (size_t)t * split_stride; colt -= t * split_cols; if (t == 0) sc = scale0; }
        const int col0 = colt + wc * 32 + 8 * fq, bcol0 = u.pn * BM + wc * 32 + 8 * fq;
        f32x4 bv[2][2];
#pragma unroll
        for (int bj = 0; bj < 2; ++bj)
#pragma unroll
            for (int n = 0; n < 2; ++n) bv[bj][n] = bias ? *(const f32x4*)(bias + bcol0 + bj * HALF + 4 * n) : (f32x4){0.f, 0.f, 0.f, 0.f};
#pragma unroll
        for (int ai = 0; ai < 2; ++ai)
#pragma unroll
            for (int m = 0; m < 4; ++m) { bf16_t* rowp = base + (size_t)(row0 + ai * HALF + m * 16) * ldc + col0;
#pragma unroll
                for (int bj = 0; bj < 2; ++bj) { f32x4 v0 = acc[ai][bj][m][0] + bv[bj][0], v1 = acc[ai][bj][m][1] + bv[bj][1];
                    if (ACT == 1) { f32x2 a = gelu_pk((f32x2){v0[0], v0[1]}), b = gelu_pk((f32x2){v0[2], v0[3]}), c = gelu_pk((f32x2){v1[0], v1[1]}), d = gelu_pk((f32x2){v1[2], v1[3]});
                        v0 = (f32x4){a.x, a.y, b.x, b.y}; v1 = (f32x4){c.x, c.y, d.x, d.y}; }
                    v0 = v0 * sc; v1 = v1 * sc; u32x4 w; w.x = cvt_pk_bf16(v0[0], v0[1]); w.y = cvt_pk_bf16(v0[2], v0[3]); w.z = cvt_pk_bf16(v1[0], v1[1]); w.w = cvt_pk_bf16(v1[2], v1[3]);
                    *(u32x4*)(rowp + bj * HALF) = w; } }
    }
};

template <class Epi, class Sched, bool ALIGN_EPI = false, bool SP2 = false>
__device__ __forceinline__ void gemm_phase(PG8_LAS unsigned char* lds, const Gemm g, const Sched& S, const Epi& E) {
    const int wid = g.wave, lane = (int)__builtin_amdgcn_mbcnt_hi(~0u, __builtin_amdgcn_mbcnt_lo(~0u, 0u)), tid = wid * 64 + lane, wr = wid >> 2, wc = wid & 3, fr = lane & 15, fq = lane >> 4;
    const int K = g.K, nt = K / BK;
    unsigned voffA[2], voffB[2];
#pragma unroll
    for (int i = 0; i < 2; ++i) { int R, C; stage_rc(tid * 16 + i * 8192, R, C); const int Rb = Epi::PERM ? ((R & ~31) + perm32(R & 31)) : R;
        voffA[i] = (unsigned)(R * K + C) * 2u; voffB[i] = (unsigned)(Rb * K + C) * 2u; }
    const size_t kstep = (size_t)(BK * 2);
    const size_t hstep = (size_t)HALF * K * 2;
    const size_t tstep = 2 * hstep;
    const unsigned ldsw = (unsigned)wid * 1024u;
    const int aoff = lds_byte(wr * 64 + fr, fq * 8), boff = lds_byte(wc * 32 + fr, fq * 8);
#define PG8_SA(b, h) (((b) * 2 + (h)) * HTB)
#define PG8_SB(b, h) ((4 + (b) * 2 + (h)) * HTB)
#define PG8_STAGE(bufoff, gbase, voff) do { _Pragma("unroll") for (int _i = 0; _i < 2; ++_i) \
        __builtin_amdgcn_global_load_lds((const unsigned*)((const char*)(gbase) + (voff)[_i]), (PG8_LAS unsigned*)(lds + (bufoff) + ldsw + _i * 8192), 16, 0, 0); } while (0)
#define PG8_LDA(dst, b, h) do { _Pragma("unroll") for (int m = 0; m < 4; ++m) _Pragma("unroll") for (int k = 0; k < 2; ++k) dst[m][k] = *(const PG8_LAS bf16x8*)(lds + PG8_SA(b, h) + aoff + m * 2048 + k * 1024); } while (0)
#define PG8_LDB(dst, b, h) do { _Pragma("unroll") for (int n = 0; n < 2; ++n) _Pragma("unroll") for (int k = 0; k < 2; ++k) dst[n][k] = *(const PG8_LAS bf16x8*)(lds + PG8_SB(b, h) + boff + n * 2048 + k * 1024); } while (0)
#define PG8_MMA(ai, bj, At, Bt) do { __builtin_amdgcn_s_setprio(1); _Pragma("unroll") for (int m = 0; m < 4; ++m) _Pragma("unroll") for (int n = 0; n < 2; ++n) _Pragma("unroll") for (int k = 0; k < 2; ++k) \
        acc[ai][bj][m][n] = __builtin_amdgcn_mfma_f32_16x16x32_bf16(Bt[n][k], At[m][k], acc[ai][bj][m][n], 0, 0, 0); __builtin_amdgcn_s_setprio(0); } while (0)
#define PG8_WAIT_V(n) asm volatile("s_waitcnt vmcnt(" #n ")" ::: "memory")
#define PG8_WAIT_L(n) asm volatile("s_waitcnt lgkmcnt(" #n ")" ::: "memory")
#define PG8_BAR __builtin_amdgcn_s_barrier()
#define PG8_SCHED __builtin_amdgcn_sched_barrier(0)
    Unit cur, nxt; int ui = 0;
    if (!S.next(0, cur)) return;
    f32x4 acc[2][2][4][2];
#pragma unroll
    for (int a = 0; a < 2; ++a)
#pragma unroll
        for (int b = 0; b < 2; ++b)
#pragma unroll
            for (int m = 0; m < 4; ++m)
#pragma unroll
                for (int n = 0; n < 2; ++n) acc[a][b][m][n] = (f32x4){0.f, 0.f, 0.f, 0.f};
    bf16x8 At[4][2], B0[2][2], B1[2][2];
    const char* cA = (const char*)g.A + (size_t)cur.pm * tstep; const char* cB = (const char*)g.Bt + (size_t)cur.pn * tstep;
    S.a_ready(cur);
    if constexpr (SP2) {
        PG8_STAGE(PG8_SB(0, 0), cB, voffB); PG8_STAGE(PG8_SB(0, 1), cB + hstep, voffB); PG8_STAGE(PG8_SA(0, 0), cA, voffA); PG8_STAGE(PG8_SA(0, 1), cA + hstep, voffA);
        if (wr == 1) PG8_BAR;
        PG8_WAIT_V(2); PG8_BAR;
        PG8_STAGE(PG8_SB(1, 0), cB + kstep, voffB); PG8_STAGE(PG8_SA(1, 0), cA + kstep, voffA); PG8_STAGE(PG8_SB(1, 1), cB + hstep + kstep, voffB);
        PG8_WAIT_V(6); PG8_BAR;
    } else {
        PG8_STAGE(PG8_SB(0, 0), cB, voffB); PG8_STAGE(PG8_SA(0, 0), cA, voffA); PG8_STAGE(PG8_SB(0, 1), cB + hstep, voffB); PG8_STAGE(PG8_SA(0, 1), cA + hstep, voffA);
        if (wr == 1) PG8_BAR;
        PG8_WAIT_V(4); PG8_BAR;
        PG8_STAGE(PG8_SB(1, 0), cB + kstep, voffB); PG8_STAGE(PG8_SA(1, 0), cA + kstep, voffA); PG8_STAGE(PG8_SB(1, 1), cB + hstep + kstep, voffB);
        PG8_WAIT_V(6); PG8_BAR;
    }
    for (;;) {
        const bool has_next = S.next(ui + 1, nxt);
        const char* nA = has_next ? (const char*)g.A + (size_t)nxt.pm * tstep : cA; const char* nB = has_next ? (const char*)g.Bt + (size_t)nxt.pn * tstep : cB;
        for (int t = 0; t < nt; t += 2) {
            const bool last = (t == nt - 2);
            const char* a1 = cA + (size_t)(t + 1) * kstep;
            const char* a2 = last ? nA : cA + (size_t)(t + 2) * kstep; const char* b2 = last ? nB : cB + (size_t)(t + 2) * kstep;
            const char* a3 = a2 + kstep; const char* b3 = b2 + kstep;
            if (last && has_next) S.a_ready(nxt);
            if constexpr (SP2) {
            PG8_LDB(B0, 0, 0); PG8_LDB(B1, 0, 1); PG8_SCHED; PG8_LDA(At, 0, 0); PG8_STAGE(PG8_SA(1, 1), a1 + hstep, voffA);
            PG8_WAIT_V(8); PG8_WAIT_L(0); PG8_BAR; PG8_MMA(0, 0, At, B0); PG8_MMA(0, 1, At, B1); PG8_BAR; PG8_SCHED;
            PG8_LDA(At, 0, 1); PG8_STAGE(PG8_SB(0, 0), b2, voffB); PG8_STAGE(PG8_SB(0, 1), b2 + hstep, voffB); PG8_STAGE(PG8_SA(0, 0), a2, voffA);
            PG8_WAIT_V(8); PG8_WAIT_L(0); PG8_BAR; PG8_MMA(1, 0, At, B0); PG8_MMA(1, 1, At, B1); PG8_BAR; PG8_SCHED;
            PG8_LDB(B0, 1, 0); PG8_LDB(B1, 1, 1); PG8_SCHED; PG8_LDA(At, 1, 0); PG8_STAGE(PG8_SA(0, 1), a2 + hstep, voffA);
            PG8_WAIT_V(8); PG8_WAIT_L(0); PG8_BAR; PG8_MMA(0, 0, At, B0); PG8_MMA(0, 1, At, B1); PG8_BAR; PG8_SCHED;
            PG8_LDA(At, 1, 1); PG8_STAGE(PG8_SB(1, 0), b3, voffB); PG8_STAGE(PG8_SB(1, 1), b3 + hstep, voffB); PG8_STAGE(PG8_SA(1, 0), a3, voffA);
            PG8_WAIT_V(8); PG8_WAIT_L(0); PG8_BAR; PG8_MMA(1, 0, At, B0); PG8_MMA(1, 1, At, B1); PG8_BAR; PG8_SCHED;
            } else {
            PG8_LDB(B0, 0, 0); PG8_SCHED; PG8_LDA(At, 0, 0); PG8_STAGE(PG8_SA(1, 1), a1 + hstep, voffA);
            PG8_WAIT_L(8); PG8_BAR; PG8_WAIT_L(0); PG8_MMA(0, 0, At, B0); PG8_BAR; PG8_SCHED;
            PG8_LDB(B1, 0, 1); PG8_STAGE(PG8_SB(0, 0), b2, voffB);
            PG8_BAR; PG8_WAIT_L(0); PG8_MMA(0, 1, At, B1); PG8_BAR;
            PG8_LDA(At, 0, 1); PG8_STAGE(PG8_SA(0, 0), a2, voffA);
            PG8_BAR; PG8_WAIT_L(0); PG8_MMA(1, 0, At, B0); PG8_BAR; PG8_SCHED;
            PG8_STAGE(PG8_SB(0, 1), b2 + hstep, voffB);
            PG8_WAIT_V(6); PG8_BAR; PG8_MMA(1, 1, At, B1); PG8_BAR;
            PG8_LDB(B0, 1, 0); PG8_SCHED; PG8_LDA(At, 1, 0); PG8_STAGE(PG8_SA(0, 1), a2 + hstep, voffA);
            PG8_WAIT_L(8); PG8_BAR; PG8_WAIT_L(0); PG8_MMA(0, 0, At, B0); PG8_BAR; PG8_SCHED;
            PG8_LDB(B1, 1, 1); PG8_STAGE(PG8_SB(1, 0), b3, voffB);
            PG8_BAR; PG8_WAIT_L(0); PG8_MMA(0, 1, At, B1); PG8_BAR;
            PG8_LDA(At, 1, 1); PG8_STAGE(PG8_SA(1, 0), a3, voffA);
            PG8_BAR; PG8_WAIT_L(0); PG8_MMA(1, 0, At, B0); PG8_BAR; PG8_SCHED;
            PG8_STAGE(PG8_SB(1, 1), b3 + hstep, voffB);
            PG8_WAIT_V(6); PG8_BAR; PG8_MMA(1, 1, At, B1); PG8_BAR;
            }
        }
        if constexpr (ALIGN_EPI) { if (wr == 0) PG8_BAR; }
        if constexpr (!Epi::AFTER_DRAIN) { E(acc, cur, wr, wc, fr, fq); S.done(cur); }
        if (!has_next) break;
#pragma unroll
        for (int a = 0; a < 2; ++a)
#pragma unroll
            for (int b = 0; b < 2; ++b)
#pragma unroll
                for (int m = 0; m < 4; ++m)
#pragma unroll
                    for (int n = 0; n < 2; ++n) acc[a][b][m][n] = (f32x4){0.f, 0.f, 0.f, 0.f};
        cur = nxt; cA = nA; cB = nB; ++ui;
        if constexpr (ALIGN_EPI) { if (wr == 1) PG8_BAR; }
    }
    PG8_WAIT_V(0);
    if constexpr (!ALIGN_EPI) { if (wr == 0) PG8_BAR; }
    PG8_BAR;
    if constexpr (Epi::AFTER_DRAIN) { E.fused(acc, cur, wr, wc, fr, fq, lds, wid, lane); S.done(cur); }
#undef PG8_SA
#undef PG8_SB
#undef PG8_STAGE
#undef PG8_LDA
#undef PG8_LDB
#undef PG8_MMA
#undef PG8_WAIT_V
#undef PG8_WAIT_L
#undef PG8_BAR
#undef PG8_SCHED
}
}
#define GAS __attribute__((address_space(1)))
#define LAS __attribute__((address_space(3)))
typedef unsigned short bf16;
typedef unsigned v4u __attribute__((ext_vector_type(4)));
typedef float f32x4 __attribute__((ext_vector_type(4)));
typedef short bf16x8 __attribute__((ext_vector_type(8)));
typedef GAS unsigned gu32;
typedef GAS unsigned long long gu64;
#define RLX_AGENT __ATOMIC_RELAXED, __HIP_MEMORY_SCOPE_AGENT
#define LDS_WAIT() asm volatile("s_waitcnt lgkmcnt(0)" ::: "memory")
#define VM_WAIT() asm volatile("s_waitcnt vmcnt(0)" ::: "memory")
__device__ __forceinline__ unsigned long long rt() { return __builtin_amdgcn_s_memrealtime(); }
__device__ __forceinline__ unsigned f2bf(float f) { unsigned u = __builtin_bit_cast(unsigned, f); return (u + 0x7fffu + ((u >> 16) & 1u)) >> 16; }
__device__ __forceinline__ unsigned pk2(float lo, float hi) { return f2bf(lo) | (f2bf(hi) << 16); }

#define XB_TMO      128
#define XB_XCNT(j)  (256  + 64 * (j))
#define XB_XSUB(j)  (1280 + 64 * (j))
#define XB_XGEN(j)  (2304 + 64 * (j))
#define XB_TOP      3328
#define XB_TOPGEN   3392
#define XCD_BAR_WORDS 3456
#define XB_SPIN_CAP (1u << 18)

__device__ __forceinline__ unsigned xb_ld(unsigned* p)              { return __hip_atomic_load(p, __ATOMIC_RELAXED, __HIP_MEMORY_SCOPE_AGENT); }
__device__ __forceinline__ unsigned xb_add(unsigned* p, unsigned v) { return __hip_atomic_fetch_add(p, v, __ATOMIC_RELAXED, __HIP_MEMORY_SCOPE_AGENT); }
__device__ __forceinline__ unsigned xb_xcc_id() { return (unsigned)__builtin_amdgcn_s_getreg((3 << 11) | 20) & 0xFu; }
#define XB_SPIN(cond, bar) do { unsigned _sp = 0; while (cond) { __builtin_amdgcn_s_sleep(1); \
    if ((++_sp & 255u) == 0u) { if (xb_ld(&(bar)[XB_TMO])) break; if (_sp > XB_SPIN_CAP) { atomicAdd(&(bar)[XB_TMO], 1u); break; } } } } while (0)

static __device__ __forceinline__ bool xb_t0_impl(int wave) { return wave == 0 && __builtin_amdgcn_mbcnt_hi(~0u, __builtin_amdgcn_mbcnt_lo(~0u, 0u)) == 0u; }
#define xb_t0() xb_t0_impl(xb_wave)
struct XcdBarrier {
    unsigned* bar; unsigned x;
    volatile LAS unsigned* st;
};

__device__ __forceinline__ XcdBarrier xcd_barrier_post(unsigned* bar, volatile LAS unsigned* st, const int xb_wave) {
    XcdBarrier b; b.bar = bar; b.x = xb_xcc_id(); b.st = st;
    if (xb_t0()) (void)xb_add(&bar[XB_XCNT(b.x)], 1u);
    return b;
}
__device__ __forceinline__ void xcd_barrier_complete(unsigned* bar, unsigned x, unsigned& nloc, unsigned& nx) {
    const unsigned G = gridDim.x * gridDim.y * gridDim.z;
    unsigned sum, cnt, mine, sp = 0u;
    for (;;) {
        sum = 0u; cnt = 0u; mine = 0u;
#pragma unroll
        for (unsigned j = 0; j < 16; ++j) { const unsigned c = xb_ld(&bar[XB_XCNT(j)]); sum += c; cnt += (c > 0u) ? 1u : 0u; mine = (j == x) ? c : mine; }
        if (sum == G) break;
        __builtin_amdgcn_s_sleep(1);
        if ((++sp & 255u) == 0u) { if (xb_ld(&bar[XB_TMO])) break; if (sp > XB_SPIN_CAP) { atomicAdd(&bar[XB_TMO], 1u); break; } }
    }
    nloc = mine > 0u ? mine : 1u; nx = cnt > 0u ? cnt : 1u;
}

__device__ __forceinline__ void xcd_barrier(const XcdBarrier& b, const int xb_wave) {
    asm volatile("s_waitcnt vmcnt(0)" ::: "memory");
    __syncthreads();
    if (xb_t0()) {
        unsigned* bar = b.bar;
        __builtin_amdgcn_s_waitcnt(0);
        unsigned nloc = b.st[0], nx = b.st[1];
        if (nloc == 0u) { xcd_barrier_complete(bar, b.x, nloc, nx); b.st[0] = nloc; b.st[1] = nx; }
        const unsigned old = xb_add(&bar[XB_XSUB(b.x)], 1u);
        const unsigned gen = old / nloc;
        if (old + 1u == (gen + 1u) * nloc) {
            __builtin_amdgcn_fence(__ATOMIC_RELEASE, "agent");
            asm volatile("s_waitcnt vmcnt(0)" ::: "memory");
            const unsigned og = xb_add(&bar[XB_TOP], 1u);
            const unsigned tg = og / nx;
            if (og + 1u == (tg + 1u) * nx) xb_add(&bar[XB_TOPGEN], 1u);
            else XB_SPIN(xb_ld(&bar[XB_TOPGEN]) == tg, bar);
            __builtin_amdgcn_fence(__ATOMIC_ACQUIRE, "agent");
            xb_add(&bar[XB_XGEN(b.x)], 1u);
            asm volatile("s_waitcnt vmcnt(0)" ::: "memory");
        } else {
            XB_SPIN(xb_ld(&bar[XB_XGEN(b.x)]) == gen, bar);
            __builtin_amdgcn_fence(__ATOMIC_ACQUIRE, "agent");
            asm volatile("s_waitcnt vmcnt(0)" ::: "memory");
        }
    }
    __syncthreads();
}

constexpr int T = 16384, DM = 2048, NP = 5888, NMEM = 256;
constexpr int NWAVES = 8, NTHR = 512;
constexpr float EPS = 1e-6f;
constexpr size_t MiB = 1u << 20;
constexpr size_t WS_CTL = 0, CTL_ZERO_BYTES = 65536;
constexpr size_t WS_WIN0 = 1 * MiB, WS_WIN1 = 24 * MiB, WS_WOUT0 = 47 * MiB, WS_WOUT1 = 55 * MiB, WS_WMKV = 63 * MiB, WS_WK1T = 71 * MiB, WS_WV1T = 73 * MiB;
constexpr size_t WS_MEMKV = 75 * MiB, WS_DEC = 76 * MiB, WS_KCMP = 77 * MiB, WS_VCMP = 77 * MiB + 512 * 1024, WS_SEL = 78 * MiB;
constexpr size_t WS_XN = 80 * MiB, WS_P = 144 * MiB, WS_STATE = 328 * MiB, WS_END = 472 * MiB;
constexpr size_t WS_MIX1 = WS_STATE;
constexpr size_t WS_CP = WS_STATE + 64 * MiB;
constexpr size_t PLANE = (size_t)T * 128;
constexpr size_t DO_MIX0 = 0, DO_OI = 64 * MiB;
constexpr int CR = 3072, CXQ = 4608, CXG = 5120, CGL = 5632;
constexpr int GQ = 0, GK = 768, GV = 1536;
constexpr int NQ = 0, NKC = 1536, NVC = 1792, NKS = 2048, NVS = 2304, NKW = 2560, NVW = 2816;
constexpr int RING_BYTES = 131072, LDSCTL_OFF = RING_BYTES, MISC_OFF = LDSCTL_OFF + 320, LDS_BYTES = 147456;
constexpr int N_PHASES = 12;

__device__ __forceinline__ float bf2f(bf16 v) { return __builtin_bit_cast(float, (unsigned)v << 16); }
__device__ __forceinline__ bf16 f2b(float f) { return (bf16)f2bf(f); }
__device__ __forceinline__ float wave_sum(float v) {
#pragma unroll
    for (int o = 1; o < 64; o <<= 1) v += __shfl_xor(v, o);
    return v;
}
__device__ __forceinline__ float silu_f(float x) { return x / (1.f + __expf(-x)); }
__device__ __forceinline__ float sigmoid_f(float x) { return 1.f / (1.f + __expf(-x)); }
__device__ __forceinline__ float logsigmoid_f(float x) { return fminf(x, 0.f) - 0.6931471805599453f * __builtin_amdgcn_logf(1.f + __builtin_amdgcn_exp2f(-1.4426950408889634f * fabsf(x))); }

__device__ __forceinline__ int win_src_col(int layer, int c) {
    const int ex = layer ? 36 : 16;
    if (c < 3072) return c;
    if (c < 5632) return c + ex;
    if (c < 5632 + ex) return c - 5632 + 3072;
    return -1;
}

__device__ __forceinline__ void transpose_item(const float* W, int ldw, int K, bf16* WT, int n0, int k0, int srcc4, LAS float* scr, int lane) {
#pragma unroll
    for (int i = 0; i < 8; ++i) { const int kk = 8 * i + (lane >> 3);
        f32x4 v = {0.f, 0.f, 0.f, 0.f}; if (srcc4 >= 0) v = *(const f32x4*)(W + (size_t)(k0 + kk) * ldw + srcc4);
        LAS float* d = scr + kk * 33 + 4 * (lane & 7); d[0] = v.x; d[1] = v.y; d[2] = v.z; d[3] = v.w; }
    LDS_WAIT(); asm volatile("" ::: "memory");
    const int c = lane & 7;
#pragma unroll
    for (int j = 0; j < 4; ++j) { const int n = (lane >> 3) + 8 * j; const LAS float* s = scr + (8 * c) * 33 + n;
        v4u o; o.x = pk2(s[0 * 33], s[1 * 33]); o.y = pk2(s[2 * 33], s[3 * 33]); o.z = pk2(s[4 * 33], s[5 * 33]); o.w = pk2(s[6 * 33], s[7 * 33]);
        *(v4u*)(WT + (size_t)(n0 + n) * K + k0 + 8 * c) = o; }
    LDS_WAIT(); asm volatile("" ::: "memory");
}

__device__ __forceinline__ void rms_row_to_bf16(const float* xrow, const float* g, bf16* orow, int lane) {
    f32x4 v[8]; float s = 0.f;
#pragma unroll
    for (int j = 0; j < 4; ++j) { v[2 * j] = *(const f32x4*)(xrow + j * 512 + lane * 8); v[2 * j + 1] = *(const f32x4*)(xrow + j * 512 + lane * 8 + 4);
        s += (v[2 * j].x * v[2 * j].x + v[2 * j].y * v[2 * j].y) + (v[2 * j].z * v[2 * j].z + v[2 * j].w * v[2 * j].w) + (v[2 * j + 1].x * v[2 * j + 1].x + v[2 * j + 1].y * v[2 * j + 1].y) + (v[2 * j + 1].z * v[2 * j + 1].z + v[2 * j + 1].w * v[2 * j + 1].w); }
    const float rstd = rsqrtf(wave_sum(s) * (1.f / DM) + EPS);
#pragma unroll
    for (int j = 0; j < 4; ++j) { const f32x4 g0 = *(const f32x4*)(g + j * 512 + lane * 8), g1 = *(const f32x4*)(g + j * 512 + lane * 8 + 4);
        v4u w; w.x = pk2(v[2 * j].x * rstd * g0.x, v[2 * j].y * rstd * g0.y); w.y = pk2(v[2 * j].z * rstd * g0.z, v[2 * j].w * rstd * g0.w);
        w.z = pk2(v[2 * j + 1].x * rstd * g1.x, v[2 * j + 1].y * rstd * g1.y); w.w = pk2(v[2 * j + 1].z * rstd * g1.z, v[2 * j + 1].w * rstd * g1.w);
        *(v4u*)(orow + j * 512 + lane * 8) = w; }
}

struct EpiNsaIn {
    static constexpr bool PERM = true, AFTER_DRAIN = false;
    bf16* O; int ldc; bf16* CPb;
    __device__ __forceinline__ void operator()(const pg8::f32x4 (&acc)[2][2][4][2], const pg8::Unit& u, int wr, int wc, int fr, int fq) const {
        const int row0 = u.pm * pg8::BM + wr * 64 + fr; const bool pl = (u.pn >= 6 && u.pn < 12);
#pragma unroll
        for (int ai = 0; ai < 2; ++ai)
#pragma unroll
            for (int m = 0; m < 4; ++m) { const size_t row = (size_t)(row0 + ai * pg8::HALF + m * 16);
#pragma unroll
                for (int bj = 0; bj < 2; ++bj) { const pg8::f32x4 v0 = acc[ai][bj][m][0], v1 = acc[ai][bj][m][1];
                    pg8::u32x4 w; w.x = pg8::cvt_pk_bf16(v0[0], v0[1]); w.y = pg8::cvt_pk_bf16(v0[2], v0[3]); w.z = pg8::cvt_pk_bf16(v1[0], v1[1]); w.w = pg8::cvt_pk_bf16(v1[2], v1[3]);
                    bf16* dst = pl ? CPb + ((size_t)((u.pn - 6) * 2 + bj)) * PLANE + row * 128 + wc * 32 + 8 * fq
                                   : O + row * ldc + u.pn * pg8::BM + bj * pg8::HALF + wc * 32 + 8 * fq;
                    *(pg8::u32x4*)dst = w; } }
    }
};

struct Args { const float* in[19]; float* out; unsigned char* ws; int ph_lo, ph_hi; };

struct Ctx {
    LAS unsigned char* lds;
    int tid, lane, wave, G, gw, NGW;
    const float *x, *mem, *ln_pre, *ln_post, *ln_mem, *w_mem_kv, *gla_w_in, *gla_w_gate, *gla_b_gate, *gla_norm, *gla_w_out;
    const float *nsa_w_in, *pe_k, *pe_v, *wk1, *wk2, *wv1, *wv2, *nsa_w_out;
    float* out; unsigned char* ws;
    bf16 *WIN0, *WIN1, *WOUT0, *WOUT1, *WMKV, *WK1T, *WV1T, *MEMKV, *KCMP, *VCMP, *XN, *P, *STATE, *MIX0, *MIX1, *OI, *CP;
    float *DEC, *HB;
};

__device__ __forceinline__ void phase_prep(Ctx& F) {
    LAS float* scr = (LAS float*)(F.lds + F.wave * 16384);
    constexpr int I_WIN = 32 * 184, I_WOUT = 32 * 64, I_MKV = 32 * 32, I_W1 = 64 * 8;
    constexpr int NITEMS = 2 * I_WIN + 2 * I_WOUT + 2 * I_MKV + 2 * I_W1;
    for (int it = F.gw; it < NITEMS; it += F.NGW) {
        int r = it;
        if (r < 2 * I_WIN) { const int layer = r / I_WIN; r -= layer * I_WIN; const int kb = r / 184, nb = r % 184;
            const int srcc = win_src_col(layer, nb * 32 + 4 * (F.lane & 7));
            transpose_item(layer ? F.nsa_w_in : F.gla_w_in, layer ? 5668 : 5648, DM, layer ? F.WIN1 : F.WIN0, nb * 32, kb * 64, srcc, scr, F.lane); continue; }
        r -= 2 * I_WIN;
        if (r < 2 * I_WOUT) { const int layer = r / I_WOUT; r -= layer * I_WOUT; const int kb = r / 64, nb = r % 64;
            transpose_item(layer ? F.nsa_w_out : F.gla_w_out, DM, DM, layer ? F.WOUT1 : F.WOUT0, nb * 32, kb * 64, nb * 32 + 4 * (F.lane & 7), scr, F.lane); continue; }
        r -= 2 * I_WOUT;
        if (r < 2 * I_MKV) { const int layer = r / I_MKV; r -= layer * I_MKV; const int kb = r / 32, nb = r % 32;
            transpose_item(F.w_mem_kv + (size_t)layer * DM * 1024, 1024, DM, F.WMKV + (size_t)layer * 1024 * DM, nb * 32, kb * 64, nb * 32 + 4 * (F.lane & 7), scr, F.lane); continue; }
        r -= 2 * I_MKV;
        { const int kv = r / I_W1; r -= kv * I_W1; const int kb = r / 8, nb = r % 8;
            transpose_item(kv ? F.wv1 : F.wk1, 256, 4096, kv ? F.WV1T : F.WK1T, nb * 32, kb * 64, nb * 32 + 4 * (F.lane & 7), scr, F.lane); }
    }
    if ((int)blockIdx.x < 64) { const int kv = blockIdx.x >> 5, s = blockIdx.x & 31; const float* pe = kv ? F.pe_v : F.pe_k; const float* w1 = kv ? F.wv1 : F.wk1;
        __syncthreads();
        LAS float* red = (LAS float*)F.lds;
        const int j = F.tid & 255, ih = F.tid >> 8; float a = 0.f;
#pragma unroll 8
        for (int i = s * 128 + ih * 64; i < s * 128 + ih * 64 + 64; ++i) a += pe[i] * w1[(size_t)i * 256 + j];
        red[F.tid] = a; __syncthreads();
        if (F.tid < 256) F.HB[(kv * 32 + s) * 256 + j] = red[j] + red[256 + j];
        __syncthreads(); }
    for (int m = F.gw; m < T; m += F.NGW) rms_row_to_bf16(F.x + (size_t)m * DM, F.ln_pre, F.XN + (size_t)m * DM, F.lane);
}

__device__ __forceinline__ void gla_scan(Ctx& F) {
    const int gt = blockIdx.x * NTHR + F.tid, NT = F.G * NTHR;
    constexpr int PER = 4 * 384 * 192;
    for (int item = gt; item < PER / 4; item += NT) {
        const int idx = item * 4, h = idx / (384 * 192), d0 = idx % 192;
        bf16* sp = F.STATE + idx; const float* dp = F.DEC + h * 192 + d0;
        float s0 = 0.f, s1 = 0.f, s2 = 0.f, s3 = 0.f;
        for (int n0 = 0; n0 < 256; n0 += 8) {
            unsigned long long u[8]; f32x4 dc[8];
#pragma unroll
            for (int j = 0; j < 8; ++j) { u[j] = *(const unsigned long long*)(sp + (size_t)(n0 + j) * PER); dc[j] = *(const f32x4*)(dp + (n0 + j) * 768); }
#pragma unroll
            for (int j = 0; j < 8; ++j) {
                const unsigned lo = (unsigned)u[j], hi = (unsigned)(u[j] >> 32);
                s0 = dc[j].x * s0 + bf2f((bf16)(lo & 0xffff)); s1 = dc[j].y * s1 + bf2f((bf16)(lo >> 16));
                s2 = dc[j].z * s2 + bf2f((bf16)(hi & 0xffff)); s3 = dc[j].w * s3 + bf2f((bf16)(hi >> 16));
                *(unsigned long long*)(sp + (size_t)(n0 + j) * PER) = (unsigned long long)pk2(s0, s1) | ((unsigned long long)pk2(s2, s3) << 32);
            }
        }
    }
}

__device__ __forceinline__ void post_rows(Ctx& F, const float* hin, const bf16* Y, const float* gpost, float* hout, const float* gpre, bf16* XNo) {
    for (int m = F.gw; m < T; m += F.NGW) {
        const v4u* yr = (const v4u*)(Y + (size_t)m * DM) + F.lane;
        float y[32]; float ss = 0.f;
#pragma unroll
        for (int j = 0; j < 4; ++j) { const v4u w = yr[64 * j];
            const unsigned ww[4] = {w.x, w.y, w.z, w.w};
#pragma unroll
            for (int q = 0; q < 4; ++q) { y[j * 8 + 2 * q] = bf2f((bf16)(ww[q] & 0xffff)); y[j * 8 + 2 * q + 1] = bf2f((bf16)(ww[q] >> 16)); } }
#pragma unroll
        for (int i = 0; i < 32; ++i) ss += y[i] * y[i];
        const float rstd = rsqrtf(wave_sum(ss) * (1.f / DM) + EPS);
        float hn[32]; float s2 = 0.f;
#pragma unroll
        for (int j = 0; j < 4; ++j) {
#pragma unroll
            for (int q = 0; q < 2; ++q) { const int col = j * 512 + F.lane * 8 + q * 4;
                const f32x4 hv = *(const f32x4*)(hin + (size_t)m * DM + col); const f32x4 gp = *(const f32x4*)(gpost + col);
                f32x4 r; r.x = hv.x + y[j * 8 + q * 4 + 0] * rstd * gp.x; r.y = hv.y + y[j * 8 + q * 4 + 1] * rstd * gp.y; r.z = hv.z + y[j * 8 + q * 4 + 2] * rstd * gp.z; r.w = hv.w + y[j * 8 + q * 4 + 3] * rstd * gp.w;
                *(f32x4*)(hout + (size_t)m * DM + col) = r;
                hn[j * 8 + q * 4 + 0] = r.x; hn[j * 8 + q * 4 + 1] = r.y; hn[j * 8 + q * 4 + 2] = r.z; hn[j * 8 + q * 4 + 3] = r.w;
                s2 += (r.x * r.x + r.y * r.y) + (r.z * r.z + r.w * r.w); } }
        if (gpre) {
            const float rstd2 = rsqrtf(wave_sum(s2) * (1.f / DM) + EPS);
#pragma unroll
            for (int j = 0; j < 4; ++j) { const int col = j * 512 + F.lane * 8;
                const f32x4 g0 = *(const f32x4*)(gpre + col), g1 = *(const f32x4*)(gpre + col + 4);
                v4u w; w.x = pk2(hn[j * 8 + 0] * rstd2 * g0.x, hn[j * 8 + 1] * rstd2 * g0.y); w.y = pk2(hn[j * 8 + 2] * rstd2 * g0.z, hn[j * 8 + 3] * rstd2 * g0.w);
                w.z = pk2(hn[j * 8 + 4] * rstd2 * g1.x, hn[j * 8 + 5] * rstd2 * g1.y); w.w = pk2(hn[j * 8 + 6] * rstd2 * g1.z, hn[j * 8 + 7] * rstd2 * g1.w);
                *((v4u*)(XNo + (size_t)m * DM) + F.lane + 64 * j) = w; }
        }
    }
}

typedef short v4i16_t __attribute__((ext_vector_type(4)));
typedef short s16x4 __attribute__((ext_vector_type(4)));
__device__ __forceinline__ s16x4 vtr(const LAS unsigned char* p) { return __builtin_bit_cast(s16x4, __builtin_amdgcn_ds_read_tr16_b64_v4i16((LAS v4i16_t*)p)); }
constexpr int KROW = 288;
constexpr int RING = 3, TILE_K = 16384, TILE_KV = 32768;
__device__ __forceinline__ int swz_off(int row, int chunk) { return row * 256 + ((((((chunk >> 1) ^ row) & 7)) << 1) | (chunk & 1)) * 16; }
constexpr float LOG2E = 1.4426950408889634f;

struct ImpArgs { float gate0, gate1; bool hvalid; LAS float* imp; const LAS unsigned* bm; };
__device__ __forceinline__ void dma16(const char* sbase, unsigned voff, unsigned lds_dst) {
    unsigned keep;
    asm volatile("s_mov_b32 %0, m0\n\ts_mov_b32 m0, %3\n\ts_nop 0\n\tglobal_load_lds_dwordx4 %1, %2\n\ts_mov_b32 m0, %0" : "=&s"(keep) : "v"(voff), "s"(sbase), "s"(lds_dst) : "memory");
}
typedef float f32x2_t __attribute__((ext_vector_type(2)));
typedef __bf16 bf16x2_t __attribute__((ext_vector_type(2)));
__device__ __forceinline__ unsigned cvtpk(float lo, float hi) { const f32x2_t v = {lo, hi}; return __builtin_bit_cast(unsigned, __builtin_convertvector(v, bf16x2_t)); }
__device__ __forceinline__ float bperm(float x, int srclane) { return __builtin_bit_cast(float, __builtin_amdgcn_ds_bpermute(srclane << 2, __builtin_bit_cast(int, x))); }
__device__ __forceinline__ float xmax4(float x, int lane) { x = fmaxf(x, bperm(x, lane ^ 16)); return fmaxf(x, bperm(x, lane ^ 32)); }
__device__ __forceinline__ float xsum4(float x, int lane) { x += bperm(x, lane ^ 16); return x + bperm(x, lane ^ 32); }
template <int CTRL> __device__ __forceinline__ float dppf(float x) { return __builtin_bit_cast(float, __builtin_amdgcn_update_dpp(0, __builtin_bit_cast(int, x), CTRL, 0xF, 0xF, true)); }
__device__ __forceinline__ float sum8(float x) { x += dppf<0xB1>(x); x += dppf<0x4E>(x); x += dppf<0x141>(x); return x; }

template <int MODE, int RTM, bool FULL, class Mask>
__device__ __forceinline__ void attn_tile(const LAS unsigned char* Kb, const LAS unsigned char* Vb, const bf16x8 (&Q)[2][4], f32x4 (&O)[2][8], float (&m)[2], float (&l)[2],
                                          const int kt, const Mask& mask, const int tok0, const int tok1, const float sl2, const ImpArgs& ia, const bool sb0, const bool sb1,
                                          float& carry0, float& carry1, const int lane) {
    const int c16 = lane & 15, g = lane >> 4;
#pragma unroll
    for (int s32 = 0; s32 < 2; ++s32) {
        f32x4 sc[2][2];
#pragma unroll
        for (int rt = 0; rt < 2; ++rt)
#pragma unroll
            for (int st = 0; st < 2; ++st) sc[rt][st] = (f32x4){0.f, 0.f, 0.f, 0.f};
#pragma unroll
        for (int st = 0; st < 2; ++st) {
            bf16x8 kf[4];
#pragma unroll
            for (int kd = 0; kd < 4; ++kd) kf[kd] = *(const LAS bf16x8*)(Kb + swz_off(s32 * 32 + st * 16 + c16, g + 4 * kd));
#pragma unroll
            for (int kd = 0; kd < 4; ++kd) {
                if (RTM & 1) sc[0][st] = __builtin_amdgcn_mfma_f32_16x16x32_bf16(kf[kd], Q[0][kd], sc[0][st], 0, 0, 0);
                if (RTM & 2) sc[1][st] = __builtin_amdgcn_mfma_f32_16x16x32_bf16(kf[kd], Q[1][kd], sc[1][st], 0, 0, 0);
            }
        }
        bf16x8 pf[2];
#pragma unroll
        for (int rt = 0; rt < 2; ++rt) {
            if (!((RTM >> rt) & 1)) continue;
            const int tk = rt ? tok1 : tok0; const bool sb = rt ? sb1 : sb0;
            float v[8]; float mx = -3e38f;
#pragma unroll
            for (int st = 0; st < 2; ++st)
#pragma unroll
                for (int r = 0; r < 4; ++r) { const int kidx = kt + s32 * 32 + st * 16 + g * 4 + r;
                    v[st * 4 + r] = (FULL || (mask(tk, kidx) && (MODE != 3 || sb))) ? sc[rt][st][r] : -3e38f; mx = fmaxf(mx, v[st * 4 + r]); }
            if (MODE != 2) {
                const float mo = m[rt];
                bool need = (mx * sl2 - mo) > 64.f; if (MODE == 3) need = need && sb;
                if (__any(need)) {
                    const float mxa = xmax4(mx, lane); float mn = fmaxf(mo, mxa * sl2); if (MODE == 3) mn = sb ? mn : mo;
                    const float alpha = __builtin_amdgcn_exp2f(mo - mn);
                    m[rt] = mn; l[rt] = l[rt] * alpha;
                    if (MODE == 0 || MODE == 3) {
#pragma unroll
                        for (int dt = 0; dt < 8; ++dt) O[rt][dt] = O[rt][dt] * alpha;
                    }
                }
                const float mn = m[rt];
                float ps = 0.f;
#pragma unroll
                for (int i = 0; i < 8; ++i) { v[i] = __builtin_amdgcn_exp2f(fmaf(v[i], sl2, -mn)); ps += v[i]; }
                l[rt] += ps;
            } else {
                const float mn = m[rt], linv = ia.hvalid ? l[rt] : 0.f, gt = rt ? ia.gate1 : ia.gate0;
#pragma unroll
                for (int i = 0; i < 8; ++i) v[i] = __builtin_amdgcn_exp2f(fmaf(v[i], sl2, -mn)) * linv;
                const float s40 = sum8((v[0] + v[1]) + (v[2] + v[3])), s41 = sum8((v[4] + v[5]) + (v[6] + v[7])), la0 = sum8(v[3]), la1 = sum8(v[7]);
                const float pl0 = bperm(la0, (lane + 48) & 63), pl1 = bperm(la1, (lane + 48) & 63);
                const float cprev = rt ? carry1 : carry0;
                const float i0 = s40 + (g > 0 ? pl0 : cprev), i1 = s41 + (g > 0 ? pl1 : pl0);
                if (rt) carry1 = pl1; else carry0 = pl1;
                if ((lane & 7) == 0) { const int jb = (kt >> 2) + 8 * s32 + g; LAS float* ip = ia.imp + (rt * 2 + (c16 >> 3)) * 256 + jb; ip[0] = i0; ip[4] = i1; }
#pragma unroll
                for (int i = 0; i < 8; ++i) v[i] *= gt;
            }
            if (MODE != 1) { v4u pw; pw.x = cvtpk(v[0], v[1]); pw.y = cvtpk(v[2], v[3]); pw.z = cvtpk(v[4], v[5]); pw.w = cvtpk(v[6], v[7]);
                pf[rt] = __builtin_bit_cast(bf16x8, pw); }
        }
        if (MODE != 1) {
            const int vrow = s32 * 32 + g * 4 + (c16 >> 2);
            const LAS unsigned char* vb0 = Vb + vrow * 256 + ((c16 >> 1) & 1) * 16 + (c16 & 1) * 8; const int r7 = vrow & 7;
#pragma unroll
            for (int dt = 0; dt < 8; ++dt) {
                const LAS unsigned char* vp = vb0 + ((dt ^ r7) << 5);
                const s16x4 lo = vtr(vp), hi = vtr(vp + 4096);
                const bf16x8 vf = {lo[0], lo[1], lo[2], lo[3], hi[0], hi[1], hi[2], hi[3]};
                if (RTM & 1) O[0][dt] = __builtin_amdgcn_mfma_f32_16x16x32_bf16(vf, pf[0], O[0][dt], 0, 0, 0);
                if (RTM & 2) O[1][dt] = __builtin_amdgcn_mfma_f32_16x16x32_bf16(vf, pf[1], O[1][dt], 0, 0, 0);
            }
        }
    }
}

template <int MODE, class Src, class Mask>
__device__ __forceinline__ void attn_pass(Ctx& F, LAS unsigned char* base, const bf16x8 (&Q)[2][4], f32x4 (&O)[2][8], float (&m)[2], float (&l)[2],
                                          const int k0, const int nt, const Src& src, const Mask& mask, const int tok0, const int tok1, const float sl2, const ImpArgs ia = ImpArgs{0.f, 0.f, false, nullptr, nullptr}) {
    int tidv = F.wave * 64 + (int)__builtin_amdgcn_mbcnt_hi(~0u, __builtin_amdgcn_mbcnt_lo(~0u, 0u)); asm volatile("" : "+v"(tidv));
    const int lane = tidv & 63, c16 = lane & 15, g = lane >> 4;
    const int wv = F.wave;
    constexpr int NL = (MODE == 1) ? 2 : 4;
#define ATT_DMA(tj, bufi) do { const int kt_ = k0 + 64 * min((tj), nt - 1); \
        _Pragma("unroll") for (int i_ = 0; i_ < 2; ++i_) { const int pc_ = wv * 2 + i_, row_ = pc_ * 4 + g, c_ = (((((c16 >> 1) ^ row_) & 7)) << 1) | (c16 & 1); \
            const unsigned go_ = src.off(kt_ + row_) + (unsigned)(c_ * 16); \
            dma16(src.kb, go_, (unsigned)(size_t)base + (unsigned)((bufi) * TILE_KV + pc_ * 1024)); \
            if (MODE != 1) dma16(src.vb, go_, (unsigned)(size_t)base + (unsigned)((bufi) * TILE_KV + TILE_K + pc_ * 1024)); } } while (0)
    __syncthreads();
#pragma unroll
    for (int t_ = 0; t_ < RING - 1; ++t_) ATT_DMA(t_, t_);
    float carry0 = 0.f, carry1 = 0.f;
    int bcur = 0;
    for (int j = 0; j < nt; ++j) {
        if (NL == 4) asm volatile("s_waitcnt vmcnt(%0)" :: "n"((RING - 2) * 4) : "memory"); else asm volatile("s_waitcnt vmcnt(%0)" :: "n"((RING - 2) * 2) : "memory");
        __builtin_amdgcn_s_barrier();
        { const int bnext = (bcur == 0) ? RING - 1 : bcur - 1; ATT_DMA(j + RING - 1, bnext); }
        const LAS unsigned char* Kb = base + bcur * TILE_KV; const LAS unsigned char* Vb = Kb + TILE_K;
        const int kt = k0 + 64 * j;
        if (MODE == 3) {
            const int jb = kt >> 6; const unsigned w0 = ia.bm[(c16 >> 3) * 8 + (jb >> 5)], w1 = ia.bm[(2 + (c16 >> 3)) * 8 + (jb >> 5)];
            const bool sb0 = ia.hvalid && ((w0 >> (jb & 31)) & 1u), sb1 = ia.hvalid && ((w1 >> (jb & 31)) & 1u); const bool act0 = __any(sb0), act1 = __any(sb1);
            if (act0 && act1) attn_tile<MODE, 3, false>(Kb, Vb, Q, O, m, l, kt, mask, tok0, tok1, sl2, ia, sb0, sb1, carry0, carry1, lane);
            else if (act0) attn_tile<MODE, 1, false>(Kb, Vb, Q, O, m, l, kt, mask, tok0, tok1, sl2, ia, sb0, sb1, carry0, carry1, lane);
            else if (act1) attn_tile<MODE, 2, false>(Kb, Vb, Q, O, m, l, kt, mask, tok0, tok1, sl2, ia, sb0, sb1, carry0, carry1, lane);
        } else { int lj = lane; asm volatile("" : "+v"(lj));
            const bool full = __all(mask(tok0, kt) && mask(tok0, kt + 63) && mask(tok1, kt) && mask(tok1, kt + 63));
            if (full) attn_tile<MODE, 3, true>(Kb, Vb, Q, O, m, l, kt, mask, tok0, tok1, sl2, ia, true, true, carry0, carry1, lj);
            else attn_tile<MODE, 3, false>(Kb, Vb, Q, O, m, l, kt, mask, tok0, tok1, sl2, ia, true, true, carry0, carry1, lj); }
        bcur = (bcur == RING - 1) ? 0 : bcur + 1;
    }
    asm volatile("s_waitcnt vmcnt(0)" ::: "memory");
    __syncthreads();
#undef ATT_DMA
}

template <class Mask>
__device__ __forceinline__ void slc_visit1(const LAS unsigned char* Kb, const LAS unsigned char* Vb, const bf16x8 (&Qr)[4], f32x4 (&Or)[8], float& mr, float& lr,
                                           const int kt, const Mask& mask, const int tok, const float sl2, const bool sb, const int lane) {
    const int c16 = lane & 15, g = lane >> 4;
    f32x4 sc[4];
#pragma unroll
    for (int st = 0; st < 4; ++st) { sc[st] = (f32x4){0.f, 0.f, 0.f, 0.f};
#pragma unroll
        for (int kd = 0; kd < 4; ++kd) { const bf16x8 kf = *(const LAS bf16x8*)(Kb + swz_off(st * 16 + c16, g + 4 * kd));
            sc[st] = __builtin_amdgcn_mfma_f32_16x16x32_bf16(kf, Qr[kd], sc[st], 0, 0, 0); } }
    float v[16]; float mx = -3e38f;
#pragma unroll
    for (int st = 0; st < 4; ++st)
#pragma unroll
        for (int r = 0; r < 4; ++r) { const int kidx = kt + st * 16 + g * 4 + r; v[st * 4 + r] = (mask(tok, kidx) && sb) ? sc[st][r] : -3e38f; mx = fmaxf(mx, v[st * 4 + r]); }
    const float mo = mr;
    if (__any((mx * sl2 - mo) > 64.f)) {
        const float mxa = xmax4(mx, lane); const float mn = sb ? fmaxf(mo, mxa * sl2) : mo; const float alpha = __builtin_amdgcn_exp2f(mo - mn);
        mr = mn; lr *= alpha;
#pragma unroll
        for (int dt = 0; dt < 8; ++dt) Or[dt] = Or[dt] * alpha;
    }
    const float mn = mr; float ps = 0.f;
#pragma unroll
    for (int i = 0; i < 16; ++i) { v[i] = __builtin_amdgcn_exp2f(fmaf(v[i], sl2, -mn)); ps += v[i]; }
    lr += ps;
    bf16x8 pf[2];
#pragma unroll
    for (int ks = 0; ks < 2; ++ks) { v4u pw; pw.x = cvtpk(v[8 * ks + 0], v[8 * ks + 1]); pw.y = cvtpk(v[8 * ks + 2], v[8 * ks + 3]); pw.z = cvtpk(v[8 * ks + 4], v[8 * ks + 5]); pw.w = cvtpk(v[8 * ks + 6], v[8 * ks + 7]);
        pf[ks] = __builtin_bit_cast(bf16x8, pw); }
#pragma unroll
    for (int ks = 0; ks < 2; ++ks) { const int vrow = ks * 32 + g * 4 + (c16 >> 2);
        const LAS unsigned char* vb0 = Vb + vrow * 256 + ((c16 >> 1) & 1) * 16 + (c16 & 1) * 8; const int r7 = vrow & 7;
#pragma unroll
        for (int dt = 0; dt < 8; ++dt) { const LAS unsigned char* vp = vb0 + ((dt ^ r7) << 5);
            const s16x4 lo = vtr(vp), hi = vtr(vp + 4096);
            const bf16x8 vf = {lo[0], lo[1], lo[2], lo[3], hi[0], hi[1], hi[2], hi[3]};
            Or[dt] = __builtin_amdgcn_mfma_f32_16x16x32_bf16(vf, pf[ks], Or[dt], 0, 0, 0); } }
}

template <class Src, class Mask>
__device__ __forceinline__ void slc_pass(Ctx& F, LAS unsigned char* base, const bf16x8 (&Q)[2][4], f32x4 (&O)[2][8], float (&m)[2], float (&l)[2],
                                         const int nt, const Src& src, const Mask& mask, const int tok0, const int tok1, const float sl2, const ImpArgs ia) {
    int tidv = F.wave * 64 + (int)__builtin_amdgcn_mbcnt_hi(~0u, __builtin_amdgcn_mbcnt_lo(~0u, 0u)); asm volatile("" : "+v"(tidv));
    const int lane = tidv & 63, c16 = lane & 15, g = lane >> 4;
    const int wv = F.wave;
    volatile LAS unsigned* flg = (volatile LAS unsigned*)(base + RING_BYTES + 2048);
#define SLC_LOAD(tj) do { const int kt_ = 64 * (tj); \
        _Pragma("unroll 4") for (int pc_ = 0; pc_ < 16; ++pc_) { const int row_ = pc_ * 4 + g, c_ = (((((c16 >> 1) ^ row_) & 7)) << 1) | (c16 & 1); \
            const unsigned go_ = src.off(kt_ + row_) + (unsigned)(c_ * 16); \
            dma16(src.kb, go_, (unsigned)(size_t)base + (unsigned)(((tj) & 3) * TILE_KV + pc_ * 1024)); \
            dma16(src.vb, go_, (unsigned)(size_t)base + (unsigned)(((tj) & 3) * TILE_KV + TILE_K + pc_ * 1024)); } } while (0)
    __syncthreads();
    if (lane < 8) flg[16 + wv * 8 + lane] = ia.bm[lane] | ia.bm[8 + lane] | ia.bm[16 + lane] | ia.bm[24 + lane];
    if (tidv < 12) flg[tidv] = 0u;
    __syncthreads();
    int pend = -1;
    if (wv == 0) { SLC_LOAD(0); pend = 0; } else if (wv == 1 && nt > 1) { SLC_LOAD(1); pend = 1; }
    float carry0 = 0.f, carry1 = 0.f;
    unsigned myact = 0u;
    for (int j = 0; j < nt; ++j) {
        if ((j & 31) == 0) myact = (unsigned)__builtin_amdgcn_readfirstlane((int)flg[16 + wv * 8 + (j >> 5)]);
        if (pend >= 0) {
            asm volatile("s_waitcnt vmcnt(0)" ::: "memory");
            if (lane == 0) flg[8 + (pend & 3)] = (unsigned)(pend + 1);
            asm volatile("" ::: "memory"); pend = -1; }
        const int t = j + 2;
        if (t < nt) {
            const unsigned aw = flg[16 + (lane & 7) * 8 + (t >> 5)];
            const bool busy = ((aw >> (t & 31)) & 1u) || ((t & 31) && ((aw >> ((t & 31) - 1)) & 1u));
            const unsigned bb = (unsigned)(__ballot(busy) & 0xFFull);
            const unsigned rot = ((bb | (bb << 8)) >> (t & 7)) & 0xFFu;
            const int owner = ((t & 7) + ((rot == 0xFFu) ? 0 : (__builtin_ctz(~rot)))) & 7;
            if (owner == wv) {
                if (t >= 4) { const int tp = t - 4;
                    for (;;) { const unsigned av = flg[16 + (lane & 7) * 8 + (tp >> 5)], dv = flg[lane & 7], lp = flg[8 + (t & 3)];
                        const bool okv = (!((av >> (tp & 31)) & 1u) || dv >= (unsigned)(tp + 1)) && lp >= (unsigned)(tp + 1);
                        if (__all(okv)) break; __builtin_amdgcn_s_sleep(1); }
                    asm volatile("" ::: "memory"); __builtin_amdgcn_sched_barrier(0); }
                SLC_LOAD(t); pend = t; }
        }
        if ((myact >> (j & 31)) & 1u) {
            const unsigned w0 = ia.bm[(c16 >> 3) * 8 + (j >> 5)], w1 = ia.bm[(2 + (c16 >> 3)) * 8 + (j >> 5)];
            const bool sb0 = ia.hvalid && ((w0 >> (j & 31)) & 1u), sb1 = ia.hvalid && ((w1 >> (j & 31)) & 1u); const bool act0 = __any(sb0), act1 = __any(sb1);
            for (;;) { const unsigned lv = flg[8 + (j & 3)]; if (__all(lv >= (unsigned)(j + 1))) break; __builtin_amdgcn_s_sleep(1); }
            asm volatile("" ::: "memory"); __builtin_amdgcn_sched_barrier(0);
            const LAS unsigned char* Kb = base + (j & 3) * TILE_KV; const LAS unsigned char* Vb = Kb + TILE_K;
            int lj = lane; asm volatile("" : "+v"(lj));
            if (act0 && act1) attn_tile<3, 3, false>(Kb, Vb, Q, O, m, l, 64 * j, mask, tok0, tok1, sl2, ia, sb0, sb1, carry0, carry1, lj);
            else if (act0) slc_visit1(Kb, Vb, Q[0], O[0], m[0], l[0], 64 * j, mask, tok0, sl2, sb0, lj);
            else if (act1) slc_visit1(Kb, Vb, Q[1], O[1], m[1], l[1], 64 * j, mask, tok1, sl2, sb1, lj);
            asm volatile("s_waitcnt lgkmcnt(0)" ::: "memory");
        }
        asm volatile("" ::: "memory");
        if (lane == 0) flg[wv] = (unsigned)(j + 1);
        asm volatile("" ::: "memory");
    }
    asm volatile("s_waitcnt vmcnt(0)" ::: "memory");
    __syncthreads();
#undef SLC_LOAD
}

struct SrcMem { const char* kb; const char* vb;
    __device__ __forceinline__ unsigned off(int key) const { return (unsigned)min(key, NMEM - 1) * 256u; } };
struct MaskNone { __device__ __forceinline__ bool operator()(int, int) const { return true; } };

__device__ __forceinline__ void cross_fast(Ctx& F, int layer, bf16* MIX) {
    for (int u = blockIdx.x; u < 256; u += F.G) {
        int tidv = F.wave * 64 + (int)__builtin_amdgcn_mbcnt_hi(~0u, __builtin_amdgcn_mbcnt_lo(~0u, 0u)); asm volatile("" : "+v"(tidv));
        const int lane = tidv & 63, c16 = lane & 15, g = lane >> 4;
        const int h = u & 3, tb = u >> 2;
        int tok[2]; bf16x8 Q[2][4]; f32x4 O[2][8]; float m[2], l[2];
#pragma unroll
        for (int rt = 0; rt < 2; ++rt) { tok[rt] = tb * 256 + F.wave * 32 + rt * 16 + c16; m[rt] = -1e30f; l[rt] = 0.f;
#pragma unroll
            for (int kd = 0; kd < 4; ++kd) Q[rt][kd] = *(const bf16x8*)((const char*)F.P + ((unsigned)tok[rt] * (unsigned)(NP * 2) + (unsigned)((CXQ + h * 128 + g * 8 + kd * 32) * 2)));
#pragma unroll
            for (int dt = 0; dt < 8; ++dt) O[rt][dt] = (f32x4){0.f, 0.f, 0.f, 0.f}; }
        SrcMem src{(const char*)(F.MEMKV + (((size_t)layer * 2 + 0) * 4 + h) * NMEM * 128), (const char*)(F.MEMKV + (((size_t)layer * 2 + 1) * 4 + h) * NMEM * 128)};
        attn_pass<0>(F, F.lds, Q, O, m, l, 0, 4, src, MaskNone(), tok[0], tok[1], 0.08838834764831845f * LOG2E);
#pragma unroll
        for (int rt = 0; rt < 2; ++rt) {
            float lt = xsum4(l[rt], lane);
            const float inv = 1.f / lt;
#pragma unroll
            for (int dt = 0; dt < 8; ++dt) { const int d = dt * 16 + g * 4;
                const unsigned long long xg = *(const unsigned long long*)((const char*)F.P + ((unsigned)tok[rt] * (unsigned)(NP * 2) + (unsigned)((CXG + h * 128 + d) * 2)));
                const unsigned lo = (unsigned)xg, hi = (unsigned)(xg >> 32);
                const float o0 = O[rt][dt][0] * inv * silu_f(bf2f((bf16)(lo & 0xffff))), o1 = O[rt][dt][1] * inv * silu_f(bf2f((bf16)(lo >> 16)));
                const float o2 = O[rt][dt][2] * inv * silu_f(bf2f((bf16)(hi & 0xffff))), o3 = O[rt][dt][3] * inv * silu_f(bf2f((bf16)(hi >> 16)));
                *(unsigned long long*)((char*)MIX + ((unsigned)tok[rt] * (unsigned)(DM * 2) + (unsigned)((1536 + h * 128 + d) * 2))) = (unsigned long long)pk2(o0, o1) | ((unsigned long long)pk2(o2, o3) << 32); }
        }
    }
}


struct SrcRows { const char* kb; const char* vb;
    __device__ __forceinline__ unsigned off(int key) const { return (unsigned)min(max(key, 0), T - 1) * 256u; } };
struct MaskWin { __device__ __forceinline__ bool operator()(int t, int key) const { return key <= t && key > t - 512; } };
struct SrcCmp { const char* kb; const char* vb;
    __device__ __forceinline__ unsigned off(int key) const { return (unsigned)min(key, 1022) * 256u; } };
struct MaskCmp { __device__ __forceinline__ bool operator()(int t, int key) const { return 16 * key + 31 <= t; } };

struct MaskCausal { __device__ __forceinline__ bool operator()(int t, int key) const { return key <= t; } };

__device__ __forceinline__ void nsa_main_fast(Ctx& F) {
    const float sl2 = 0.08838834764831845f * LOG2E;
    LAS float* imp = (LAS float*)(F.lds + RING * TILE_KV) + F.wave * 1024;
    LAS unsigned* bm = (LAS unsigned*)(F.lds + RING_BYTES + 1024) + F.wave * 32;
    for (;;) {
        int zq = 0; asm volatile("" : "+s"(zq));
        unsigned* qctr = (unsigned*)(F.ws + WS_CTL) + 8192 + zq;
        volatile LAS int* qslot = (volatile LAS int*)(F.lds + RING_BYTES + 3072) + zq;
        __syncthreads();
        if (F.wave == 0 && __builtin_amdgcn_mbcnt_hi(~0u, __builtin_amdgcn_mbcnt_lo(~0u, 0u)) == 0) qslot[0] = (int)__hip_atomic_fetch_add(qctr, 1u, __ATOMIC_RELAXED, __HIP_MEMORY_SCOPE_AGENT);
        __syncthreads();
        const int ticket = qslot[0];
        if (ticket >= 1024) break;
        const int g = ticket & 1, tb = 511 - (ticket >> 1);
        int tidv = F.wave * 64 + (int)__builtin_amdgcn_mbcnt_hi(~0u, __builtin_amdgcn_mbcnt_lo(~0u, 0u)); asm volatile("" : "+v"(tidv));
        const int lane = tidv & 63, c16 = lane & 15, gq = lane >> 4, ts = c16 >> 3, hs = c16 & 7; const bool hv = hs < 6;
        int tok[2]; f32x4 O[2][8]; bf16x8 Q[2][4]; float m[2], l[2];
        {
#pragma unroll
            for (int rt = 0; rt < 2; ++rt) { tok[rt] = tb * 32 + F.wave * 4 + rt * 2 + ts; m[rt] = -1e30f; l[rt] = 0.f;
                const char* Pb = (const char*)F.P; const unsigned ro = (unsigned)tok[rt] * (unsigned)(NP * 2);
#pragma unroll
                for (int kd = 0; kd < 4; ++kd) { Q[rt][kd] = (bf16x8){0, 0, 0, 0, 0, 0, 0, 0}; if (hv) Q[rt][kd] = *(const bf16x8*)(Pb + (ro + (unsigned)((NQ + (g * 6 + hs) * 128 + gq * 8 + kd * 32) * 2))); }
#pragma unroll
                for (int dt = 0; dt < 8; ++dt) O[rt][dt] = (f32x4){0.f, 0.f, 0.f, 0.f}; }
            { const int klo = max(0, tb * 32 - 511), k0 = (klo >> 6) << 6, nt = ((tb * 32 + 31 - k0) >> 6) + 1;
              attn_pass<0>(F, F.lds, Q, O, m, l, k0, nt, SrcRows{(const char*)(F.CP + (8 + g) * PLANE), (const char*)(F.CP + (10 + g) * PLANE)}, MaskWin(), tok[0], tok[1], sl2); }
#pragma unroll
            for (int rt = 0; rt < 2; ++rt) { float lt = xsum4(l[rt], lane);
                const float gwv = hv ? sigmoid_f(bf2f(*(const bf16*)((const char*)F.P + ((unsigned)tok[rt] * (unsigned)(NP * 2) + (unsigned)((CGL + g * 18 + hs * 3 + 2) * 2))))) : 0.f;
                const float f = gwv / lt;
#pragma unroll
                for (int dt = 0; dt < 8; ++dt) O[rt][dt] = O[rt][dt] * f; m[rt] = -1e30f; l[rt] = 0.f; }
            const int tlast = tb * 32 + 31, ncv = (tlast - 31) / 16 + 1, ntc = (ncv + 63) >> 6;
            SrcCmp sc_{(const char*)(F.KCMP + (size_t)g * 1024 * 128), (const char*)(F.VCMP + (size_t)g * 1024 * 128)};
            attn_pass<1>(F, F.lds, Q, O, m, l, 0, ntc, sc_, MaskCmp(), tok[0], tok[1], sl2);
#pragma unroll
            for (int rt = 0; rt < 2; ++rt) { float lt = xsum4(l[rt], lane); l[rt] = lt > 0.f ? 1.f / lt : 0.f; }
            float gc[2];
#pragma unroll
            for (int rt = 0; rt < 2; ++rt) gc[rt] = hv ? sigmoid_f(bf2f(*(const bf16*)((const char*)F.P + ((unsigned)tok[rt] * (unsigned)(NP * 2) + (unsigned)((CGL + g * 18 + hs * 3 + 0) * 2))))) : 0.f;
            attn_pass<2>(F, F.lds, Q, O, m, l, 0, ntc, sc_, MaskCmp(), tok[0], tok[1], sl2, ImpArgs{gc[0], gc[1], hv, imp, nullptr});
        }
        for (int s = 0; s < 4; ++s) {
            const int tt = tb * 32 + F.wave * 4 + s, cur = tt >> 6;
            unsigned key[4]; bool sel[4];
#pragma unroll
            for (int i = 0; i < 4; ++i) { const int jj = lane + 64 * i; float f = imp[s * 256 + jj]; if (jj == 0 || jj == cur || jj == cur - 1) f = 1e4f;
                key[i] = (jj > cur) ? 0u : __builtin_bit_cast(unsigned, fmaxf(f, 0.f)) + 1u; sel[i] = (jj <= cur); }
            if (cur + 1 > 16) {
                unsigned prefix = 0u;
                for (int bit = 31; bit >= 0; --bit) { const unsigned cand = prefix | (1u << bit);
                    const int cnt = __popcll(__ballot(key[0] >= cand)) + __popcll(__ballot(key[1] >= cand)) + __popcll(__ballot(key[2] >= cand)) + __popcll(__ballot(key[3] >= cand));
                    if (cnt >= 16) prefix = cand; }
                const unsigned long long g0 = __ballot(key[0] > prefix), g1 = __ballot(key[1] > prefix), g2 = __ballot(key[2] > prefix), g3 = __ballot(key[3] > prefix);
                const unsigned long long e0 = __ballot(key[0] == prefix), e1 = __ballot(key[1] == prefix), e2 = __ballot(key[2] == prefix), e3 = __ballot(key[3] == prefix);
                const int need = 16 - (__popcll(g0) + __popcll(g1) + __popcll(g2) + __popcll(g3));
                const unsigned long long lt = (1ull << lane) - 1ull;
                const int r0 = __popcll(e0 & lt), r1 = __popcll(e0) + __popcll(e1 & lt), r2 = __popcll(e0) + __popcll(e1) + __popcll(e2 & lt), r3 = __popcll(e0) + __popcll(e1) + __popcll(e2) + __popcll(e3 & lt);
                sel[0] = (key[0] > prefix) || (key[0] == prefix && r0 < need); sel[1] = (key[1] > prefix) || (key[1] == prefix && r1 < need);
                sel[2] = (key[2] > prefix) || (key[2] == prefix && r2 < need); sel[3] = (key[3] > prefix) || (key[3] == prefix && r3 < need);
            }
#pragma unroll
            for (int i = 0; i < 4; ++i) { const unsigned long long b = __ballot(sel[i]); if (lane == 0) { bm[s * 8 + 2 * i] = (unsigned)b; bm[s * 8 + 2 * i + 1] = (unsigned)(b >> 32); } }
        }
        if (hv) {
#pragma unroll
            for (int rt = 0; rt < 2; ++rt)
#pragma unroll
                for (int dt = 0; dt < 8; ++dt) { const int col = (g * 6 + hs) * 128 + dt * 16 + gq * 4;
                    *(unsigned long long*)((char*)F.MIX1 + ((unsigned)tok[rt] * (unsigned)(DM * 2) + (unsigned)(col * 2))) = (unsigned long long)cvtpk(O[rt][dt][0], O[rt][dt][1]) | ((unsigned long long)cvtpk(O[rt][dt][2], O[rt][dt][3]) << 32); }
        }
#pragma unroll
        for (int rt = 0; rt < 2; ++rt) { m[rt] = -1e30f; l[rt] = 0.f;
#pragma unroll
            for (int dt = 0; dt < 8; ++dt) O[rt][dt] = (f32x4){0.f, 0.f, 0.f, 0.f}; }
        slc_pass(F, F.lds, Q, O, m, l, ((tb * 32) >> 6) + 1, SrcRows{(const char*)(F.CP + (4 + g) * PLANE), (const char*)(F.CP + (6 + g) * PLANE)}, MaskCausal(), tok[0], tok[1], sl2, ImpArgs{0.f, 0.f, hv, nullptr, bm});
        const float lts0 = xsum4(l[0], lane), lts1 = xsum4(l[1], lane);
        if (hv) {
#pragma unroll
            for (int rt = 0; rt < 2; ++rt) {
                const float lt = rt ? lts1 : lts0;
                const float f = sigmoid_f(bf2f(*(const bf16*)((const char*)F.P + ((unsigned)tok[rt] * (unsigned)(NP * 2) + (unsigned)((CGL + g * 18 + hs * 3 + 1) * 2))))) / lt;
#pragma unroll
                for (int dt = 0; dt < 8; ++dt) { const int col = (g * 6 + hs) * 128 + dt * 16 + gq * 4;
                    char* mp = (char*)F.MIX1 + ((unsigned)tok[rt] * (unsigned)(DM * 2) + (unsigned)(col * 2));
                    const unsigned long long pp = *(const unsigned long long*)mp; const unsigned plo = (unsigned)pp, phi = (unsigned)(pp >> 32);
                    const unsigned long long rr = *(const unsigned long long*)((const char*)F.P + ((unsigned)tok[rt] * (unsigned)(NP * 2) + (unsigned)((CR + col) * 2))); const unsigned lo = (unsigned)rr, hi = (unsigned)(rr >> 32);
                    const float o0 = (O[rt][dt][0] * f + bf2f((bf16)(plo & 0xffff))) * silu_f(bf2f((bf16)(lo & 0xffff))), o1 = (O[rt][dt][1] * f + bf2f((bf16)(plo >> 16))) * silu_f(bf2f((bf16)(lo >> 16)));
                    const float o2 = (O[rt][dt][2] * f + bf2f((bf16)(phi & 0xffff))) * silu_f(bf2f((bf16)(hi & 0xffff))), o3 = (O[rt][dt][3] * f + bf2f((bf16)(phi >> 16))) * silu_f(bf2f((bf16)(hi >> 16)));
                    *(unsigned long long*)mp = (unsigned long long)cvtpk(o0, o1) | ((unsigned long long)cvtpk(o2, o3) << 32); }
            }
        }
    }
}

__device__ __forceinline__ void gla_g1_fast(Ctx& F) {
    int tidv = F.wave * 64 + (int)__builtin_amdgcn_mbcnt_hi(~0u, __builtin_amdgcn_mbcnt_lo(~0u, 0u)); asm volatile("" : "+v"(tidv));
    const int tid = tidv, lane = tidv & 63, c16 = lane & 15, gq = lane >> 4, wave = F.wave;
    constexpr int QP = 416, VP = 800;
    LAS float* bcum = (LAS float*)F.lds;
    LAS unsigned char* Vt = F.lds;
    LAS unsigned char* QT = F.lds + 51200;
    LAS unsigned char* KT = F.lds + 51200 + 26624;
    LAS float* eblast = (LAS float*)(F.lds + 104448);
    LAS float* tot0 = (LAS float*)(F.lds + 105216);
    LAS float* glr = (LAS float*)(F.lds + 105984);
    const float qscale = 0.07216878364870323f;
    for (int u = blockIdx.x; u < 1024; u += F.G) {
        const int n = u >> 2, h = u & 3; const size_t row0 = (size_t)n * 64;
        for (int i = tid; i < 1024; i += NTHR) glr[i] = bf2f(F.P[(row0 + (i >> 4)) * NP + CGL + (i & 15)]);
        __syncthreads();
        if (tid < 384) {
            const int seg = tid >= 192 ? 1 : 0, d = tid - 192 * seg, col = h * 192 + d; float wg[16];
#pragma unroll
            for (int j = 0; j < 16; ++j) wg[j] = F.gla_w_gate[j * 768 + col];
            const float bias = F.gla_b_gate[col]; float b = 0.f;
            for (int c = 32 * seg; c < 32 * seg + 32; ++c) { float gl = bias;
#pragma unroll
                for (int j = 0; j < 16; ++j) gl += glr[c * 16 + j] * wg[j];
                b += logsigmoid_f(gl) * (1.f / 16.f); bcum[c * 192 + d] = b; }
            if (seg == 0) tot0[d] = b;
        }
        __syncthreads();
        if (tid >= 192 && tid < 384) { const int d = tid - 192; const float t0 = tot0[d];
            for (int c = 32; c < 64; ++c) bcum[c * 192 + d] += t0; }
        __syncthreads();
        if (tid < 192) { const float eb = __expf(bcum[63 * 192 + tid]); eblast[tid] = eb; F.DEC[n * 768 + h * 192 + tid] = eb; }
#pragma unroll
        for (int i = 0; i < 3; ++i) { const int idx = tid + NTHR * i, c = idx / 24, d8 = (idx % 24) * 8;
            bf16* qg = F.P + (row0 + c) * NP + GQ + h * 192 + d8; const bf16* kg = F.P + (row0 + c) * NP + GK + h * 192 + d8;
            const v4u qr = *(const v4u*)qg, kr = *(const v4u*)kg;
            const unsigned qw[4] = {qr.x, qr.y, qr.z, qr.w}, kw[4] = {kr.x, kr.y, kr.z, kr.w}; unsigned qo[4], ko[4];
#pragma unroll
            for (int j = 0; j < 4; ++j) { const float b0 = bcum[c * 192 + d8 + 2 * j], b1 = bcum[c * 192 + d8 + 2 * j + 1];
                qo[j] = pk2(bf2f((bf16)(qw[j] & 0xffff)) * qscale * __expf(b0), bf2f((bf16)(qw[j] >> 16)) * qscale * __expf(b1));
                ko[j] = pk2(bf2f((bf16)(kw[j] & 0xffff)) * __expf(-b0), bf2f((bf16)(kw[j] >> 16)) * __expf(-b1)); }
            const v4u qv = {qo[0], qo[1], qo[2], qo[3]}, kv = {ko[0], ko[1], ko[2], ko[3]};
            *(LAS v4u*)(QT + c * QP + d8 * 2) = qv; *(LAS v4u*)(KT + c * QP + d8 * 2) = kv; *(v4u*)qg = qv; }
        __syncthreads();
#pragma unroll
        for (int i = 0; i < 6; ++i) { const int idx = tid + NTHR * i, r = idx / 48, ch = idx % 48;
            *(LAS v4u*)(Vt + r * VP + ch * 16) = *(const v4u*)(F.P + (row0 + r) * NP + GV + h * 384 + ch * 8); }
        __syncthreads();
        {
            bf16x8 vB[3][2];
#pragma unroll
            for (int j = 0; j < 3; ++j)
#pragma unroll
                for (int ks = 0; ks < 2; ++ks) { const LAS unsigned char* p = Vt + (32 * ks + 4 * gq + (c16 >> 2)) * VP + (16 * (3 * wave + j) + 4 * (c16 & 3)) * 2;
                    const s16x4 lo = vtr(p), hi = vtr(p + 16 * VP); vB[j][ks] = (bf16x8){lo[0], lo[1], lo[2], lo[3], hi[0], hi[1], hi[2], hi[3]}; }
            for (int dt = 0; dt < 12; ++dt) {
                bf16x8 aK[2];
#pragma unroll
                for (int ks = 0; ks < 2; ++ks) { const LAS unsigned char* p = KT + (32 * ks + 4 * gq + (c16 >> 2)) * QP + (16 * dt + 4 * (c16 & 3)) * 2;
                    const s16x4 lo = vtr(p), hi = vtr(p + 16 * QP); aK[ks] = (bf16x8){lo[0], lo[1], lo[2], lo[3], hi[0], hi[1], hi[2], hi[3]}; }
                const f32x4 eb = *(const LAS f32x4*)(eblast + 16 * dt + 4 * gq);
#pragma unroll
                for (int j = 0; j < 3; ++j) { f32x4 acc = {0.f, 0.f, 0.f, 0.f};
                    acc = __builtin_amdgcn_mfma_f32_16x16x32_bf16(aK[0], vB[j][0], acc, 0, 0, 0);
                    acc = __builtin_amdgcn_mfma_f32_16x16x32_bf16(aK[1], vB[j][1], acc, 0, 0, 0);
                    const int e = 16 * (3 * wave + j) + c16;
                    *(unsigned long long*)(F.STATE + ((size_t)u * 384 + e) * 192 + 16 * dt + 4 * gq) = (unsigned long long)pk2(acc[0] * eb[0], acc[1] * eb[1]) | ((unsigned long long)pk2(acc[2] * eb[2], acc[3] * eb[3]) << 32); }
            }
        }
        {
            const int ct = wave & 3, eh = wave >> 2;
            bf16x8 qB[6];
#pragma unroll
            for (int kd = 0; kd < 6; ++kd) qB[kd] = *(const LAS bf16x8*)(QT + (16 * ct + c16) * QP + (8 * gq + 32 * kd) * 2);
            f32x4 at[4];
#pragma unroll
            for (int st = 0; st < 4; ++st) { at[st] = (f32x4){0.f, 0.f, 0.f, 0.f};
                if (st <= ct) {
#pragma unroll
                    for (int kd = 0; kd < 6; ++kd) { const bf16x8 kA = *(const LAS bf16x8*)(KT + (16 * st + c16) * QP + (8 * gq + 32 * kd) * 2);
                        at[st] = __builtin_amdgcn_mfma_f32_16x16x32_bf16(kA, qB[kd], at[st], 0, 0, 0); }
#pragma unroll
                    for (int r = 0; r < 4; ++r) if (16 * st + 4 * gq + r > 16 * ct + c16) at[st][r] = 0.f;
                } }
            v4u pw0, pw1; pw0.x = pk2(at[0][0], at[0][1]); pw0.y = pk2(at[0][2], at[0][3]); pw0.z = pk2(at[1][0], at[1][1]); pw0.w = pk2(at[1][2], at[1][3]);
            pw1.x = pk2(at[2][0], at[2][1]); pw1.y = pk2(at[2][2], at[2][3]); pw1.z = pk2(at[3][0], at[3][1]); pw1.w = pk2(at[3][2], at[3][3]);
            const bf16x8 pA0 = __builtin_bit_cast(bf16x8, pw0), pA1 = __builtin_bit_cast(bf16x8, pw1);
            for (int j = 0; j < 12; ++j) { const int et = 12 * eh + j;
                bf16x8 vA[2];
#pragma unroll
                for (int ks = 0; ks < 2; ++ks) { const LAS unsigned char* p = Vt + (32 * ks + 4 * gq + (c16 >> 2)) * VP + (16 * et + 4 * (c16 & 3)) * 2;
                    const s16x4 lo = vtr(p), hi = vtr(p + 16 * VP); vA[ks] = (bf16x8){lo[0], lo[1], lo[2], lo[3], hi[0], hi[1], hi[2], hi[3]}; }
                f32x4 acc = {0.f, 0.f, 0.f, 0.f};
                acc = __builtin_amdgcn_mfma_f32_16x16x32_bf16(vA[0], pA0, acc, 0, 0, 0);
                acc = __builtin_amdgcn_mfma_f32_16x16x32_bf16(vA[1], pA1, acc, 0, 0, 0);
                *(unsigned long long*)(F.OI + (row0 + 16 * ct + c16) * 1536 + h * 384 + 16 * et + 4 * gq) = (unsigned long long)pk2(acc[0], acc[1]) | ((unsigned long long)pk2(acc[2], acc[3]) << 32); }
        }
        __syncthreads();
    }
}

__device__ __forceinline__ void gla_g3_fast(Ctx& F) {
    int tidv = F.wave * 64 + (int)__builtin_amdgcn_mbcnt_hi(~0u, __builtin_amdgcn_mbcnt_lo(~0u, 0u)); asm volatile("" : "+v"(tidv));
    const int lane = tidv & 63, c16 = lane & 15, gq = lane >> 4, wave = F.wave, ct = wave & 3, eh = wave >> 2;
    LAS float* ssq = (LAS float*)F.lds;
    for (int u = blockIdx.x; u < 1024; u += F.G) {
        const int n = u >> 2, h = u & 3; const size_t crow = (size_t)n * 64 + 16 * ct + c16;
        f32x4 acc[12];
#pragma unroll
        for (int j = 0; j < 12; ++j) acc[j] = (f32x4){0.f, 0.f, 0.f, 0.f};
        if (n > 0) {
            bf16x8 qB[6];
#pragma unroll
            for (int kd = 0; kd < 6; ++kd) qB[kd] = *(const bf16x8*)(F.P + crow * NP + GQ + h * 192 + 8 * gq + 32 * kd);
            const bf16* Sp = F.STATE + ((size_t)(u - 4) * 384 + 192 * eh + c16) * 192 + 8 * gq;
#pragma unroll
            for (int j = 0; j < 12; ++j)
#pragma unroll
                for (int kd = 0; kd < 6; ++kd) { const bf16x8 a = *(const bf16x8*)(Sp + (size_t)(16 * j) * 192 + 32 * kd);
                    acc[j] = __builtin_amdgcn_mfma_f32_16x16x32_bf16(a, qB[kd], acc[j], 0, 0, 0); }
        }
        float ss = 0.f;
#pragma unroll
        for (int j = 0; j < 12; ++j) { const int e0 = h * 384 + 192 * eh + 16 * j + 4 * gq;
            const unsigned long long oi = *(const unsigned long long*)(F.OI + crow * 1536 + e0); const unsigned lo = (unsigned)oi, hi = (unsigned)(oi >> 32);
            acc[j][0] += bf2f((bf16)(lo & 0xffff)); acc[j][1] += bf2f((bf16)(lo >> 16)); acc[j][2] += bf2f((bf16)(hi & 0xffff)); acc[j][3] += bf2f((bf16)(hi >> 16));
            ss += (acc[j][0] * acc[j][0] + acc[j][1] * acc[j][1]) + (acc[j][2] * acc[j][2] + acc[j][3] * acc[j][3]); }
        ss += __shfl_xor(ss, 16); ss += __shfl_xor(ss, 32);
        if (gq == 0) ssq[eh * 64 + 16 * ct + c16] = ss;
        __syncthreads();
        const float rstd = rsqrtf((ssq[16 * ct + c16] + ssq[64 + 16 * ct + c16]) * (1.f / 384.f) + EPS);
#pragma unroll
        for (int j = 0; j < 12; ++j) { const int el = 192 * eh + 16 * j + 4 * gq, e0 = h * 384 + el;
            const f32x4 gn = *(const f32x4*)(F.gla_norm + el);
            const unsigned long long rr = *(const unsigned long long*)(F.P + crow * NP + CR + e0); const unsigned lo = (unsigned)rr, hi = (unsigned)(rr >> 32);
            const float o0 = acc[j][0] * rstd * gn[0] * silu_f(bf2f((bf16)(lo & 0xffff))), o1 = acc[j][1] * rstd * gn[1] * silu_f(bf2f((bf16)(lo >> 16)));
            const float o2 = acc[j][2] * rstd * gn[2] * silu_f(bf2f((bf16)(hi & 0xffff))), o3 = acc[j][3] * rstd * gn[3] * silu_f(bf2f((bf16)(hi >> 16)));
            *(unsigned long long*)(F.MIX0 + crow * DM + e0) = (unsigned long long)pk2(o0, o1) | ((unsigned long long)pk2(o2, o3) << 32); }
        __syncthreads();
    }
}


__device__ __forceinline__ void memkv_fast(Ctx& F) {
    int tidv = F.wave * 64 + (int)__builtin_amdgcn_mbcnt_hi(~0u, __builtin_amdgcn_mbcnt_lo(~0u, 0u)); asm volatile("" : "+v"(tidv));
    const int lane = tidv & 63, c16 = lane & 15, gq = lane >> 4;
    for (int u = F.gw; u < 2048; u += F.NGW) {
        const int layer = u >> 10, mt = (u >> 6) & 15, ntile = u & 63;
        const float* ar = F.mem + (size_t)(16 * mt + c16) * DM + 8 * gq; const float* gr = F.ln_mem + layer * DM + 8 * gq;
        const bf16* br = F.WMKV + ((size_t)layer * 1024 + 16 * ntile + c16) * DM + 8 * gq;
        f32x4 acc = {0.f, 0.f, 0.f, 0.f}; float ss = 0.f;
#pragma unroll 4
        for (int ks = 0; ks < 64; ++ks) {
            const f32x4 a0 = *(const f32x4*)(ar + 32 * ks), a1 = *(const f32x4*)(ar + 32 * ks + 4), g0 = *(const f32x4*)(gr + 32 * ks), g1 = *(const f32x4*)(gr + 32 * ks + 4);
            ss += (a0.x * a0.x + a0.y * a0.y) + (a0.z * a0.z + a0.w * a0.w) + (a1.x * a1.x + a1.y * a1.y) + (a1.z * a1.z + a1.w * a1.w);
            v4u aw; aw.x = pk2(a0.x * g0.x, a0.y * g0.y); aw.y = pk2(a0.z * g0.z, a0.w * g0.w); aw.z = pk2(a1.x * g1.x, a1.y * g1.y); aw.w = pk2(a1.z * g1.z, a1.w * g1.w);
            const bf16x8 bfr = *(const bf16x8*)(br + 32 * ks);
            acc = __builtin_amdgcn_mfma_f32_16x16x32_bf16(__builtin_bit_cast(bf16x8, aw), bfr, acc, 0, 0, 0);
        }
        ss += __shfl_xor(ss, 16); ss += __shfl_xor(ss, 32);
        const float rs = rsqrtf(ss * (1.f / DM) + EPS);
        const int n = 16 * ntile + c16, kv = n >> 9, h = (n >> 7) & 3, d = n & 127;
#pragma unroll
        for (int r = 0; r < 4; ++r) { const int ml = 4 * gq + r; const float rr = __shfl(rs, ml);
            F.MEMKV[((((size_t)layer * 2 + kv) * 4 + h) * NMEM + 16 * mt + ml) * 128 + d] = f2b(acc[r] * rr); }
    }
}

__device__ __forceinline__ void nsa_compress_fast(Ctx& F) {
    int tidv = F.wave * 64 + (int)__builtin_amdgcn_mbcnt_hi(~0u, __builtin_amdgcn_mbcnt_lo(~0u, 0u)); asm volatile("" : "+v"(tidv));
    const int lane = tidv & 63, c16 = lane & 15, gq = lane >> 4, wave = F.wave;
    LAS unsigned char* hid = F.lds;
    constexpr int HP = 544;
    for (int u = blockIdx.x; u < 256; u += F.G) {
        const int kv = u & 1, g = (u >> 1) & 1, nt16 = u >> 2;
        const bf16* W1T = kv ? F.WV1T : F.WK1T; const float* w2 = kv ? F.wv2 : F.wk2; const float* hb = F.HB + kv * 32 * 256;
        const int n = min(16 * nt16 + c16, 1022);
        const bf16* ar = F.CP + (size_t)(kv * 2 + g) * PLANE + (size_t)(16 * n) * 128 + 8 * gq;
        const bf16* b0 = W1T + (size_t)(32 * wave + c16) * 4096 + 8 * gq; const bf16* b1 = b0 + (size_t)16 * 4096;
        f32x4 acc0 = {0.f, 0.f, 0.f, 0.f}, acc1 = {0.f, 0.f, 0.f, 0.f};
        for (int l = 0; l < 32; ++l) {
#pragma unroll
            for (int kd = 0; kd < 4; ++kd) { const bf16x8 a = *(const bf16x8*)(ar + l * 128 + 32 * kd);
                const bf16x8 w0 = *(const bf16x8*)(b0 + l * 128 + 32 * kd), w1 = *(const bf16x8*)(b1 + l * 128 + 32 * kd);
                acc0 = __builtin_amdgcn_mfma_f32_16x16x32_bf16(a, w0, acc0, 0, 0, 0); acc1 = __builtin_amdgcn_mfma_f32_16x16x32_bf16(a, w1, acc1, 0, 0, 0); }
        }
        { const int j0 = 32 * wave + c16; float h0 = 0.f, h1 = 0.f;
#pragma unroll 8
          for (int s = 0; s < 32; ++s) { h0 += hb[s * 256 + j0]; h1 += hb[s * 256 + j0 + 16]; }
#pragma unroll
          for (int r = 0; r < 4; ++r) { *(LAS bf16*)(hid + (4 * gq + r) * HP + j0 * 2) = f2b(silu_f(acc0[r] + h0)); *(LAS bf16*)(hid + (4 * gq + r) * HP + (j0 + 16) * 2) = f2b(silu_f(acc1[r] + h1)); } }
        __syncthreads();
        { f32x4 acc = {0.f, 0.f, 0.f, 0.f}; const int d = 16 * wave + c16;
#pragma unroll
          for (int ks = 0; ks < 8; ++ks) { const bf16x8 a = *(const LAS bf16x8*)(hid + c16 * HP + (8 * gq + 32 * ks) * 2);
              const float* wp = w2 + (size_t)(8 * gq + 32 * ks) * 128 + d;
              v4u bw; bw.x = pk2(wp[0], wp[128]); bw.y = pk2(wp[256], wp[384]); bw.z = pk2(wp[512], wp[640]); bw.w = pk2(wp[768], wp[896]);
              acc = __builtin_amdgcn_mfma_f32_16x16x32_bf16(a, __builtin_bit_cast(bf16x8, bw), acc, 0, 0, 0); }
          bf16* outp = (kv ? F.VCMP : F.KCMP) + (size_t)g * 1024 * 128;
#pragma unroll
          for (int r = 0; r < 4; ++r) { const int nn = 16 * nt16 + 4 * gq + r; if (nn < 1023) outp[(size_t)nn * 128 + d] = f2b(acc[r]); } }
        __syncthreads();
    }
}


__device__ __forceinline__ void load_ptrs(Ctx& F) {
    typedef const float* cfp;
    const volatile __attribute__((address_space(4))) cfp* ka = (const volatile __attribute__((address_space(4))) cfp*)__builtin_amdgcn_kernarg_segment_ptr();
    F.x = ka[0]; F.mem = ka[1]; F.ln_pre = ka[2]; F.ln_post = ka[3]; F.ln_mem = ka[4]; F.w_mem_kv = ka[5];
    F.gla_w_in = ka[6]; F.gla_w_gate = ka[7]; F.gla_b_gate = ka[8]; F.gla_norm = ka[9]; F.gla_w_out = ka[10];
    F.nsa_w_in = ka[11]; F.pe_k = ka[12]; F.pe_v = ka[13]; F.wk1 = ka[14]; F.wk2 = ka[15]; F.wv1 = ka[16]; F.wv2 = ka[17]; F.nsa_w_out = ka[18];
    F.out = (float*)ka[19]; F.ws = (unsigned char*)ka[20];
    unsigned char* ws = F.ws;
    F.WIN0 = (bf16*)(ws + WS_WIN0); F.WIN1 = (bf16*)(ws + WS_WIN1); F.WOUT0 = (bf16*)(ws + WS_WOUT0); F.WOUT1 = (bf16*)(ws + WS_WOUT1); F.WMKV = (bf16*)(ws + WS_WMKV);
    F.WK1T = (bf16*)(ws + WS_WK1T); F.WV1T = (bf16*)(ws + WS_WV1T); F.HB = (float*)(ws + WS_SEL);
    F.MEMKV = (bf16*)(ws + WS_MEMKV); F.DEC = (float*)(ws + WS_DEC); F.KCMP = (bf16*)(ws + WS_KCMP); F.VCMP = (bf16*)(ws + WS_VCMP);
    F.XN = (bf16*)(ws + WS_XN); F.P = (bf16*)(ws + WS_P); F.STATE = (bf16*)(ws + WS_STATE); F.MIX1 = (bf16*)(ws + WS_MIX1); F.CP = (bf16*)(ws + WS_CP);
    F.MIX0 = (bf16*)((unsigned char*)F.out + DO_MIX0); F.OI = (bf16*)((unsigned char*)F.out + DO_OI);
}
__global__ void __launch_bounds__(NTHR, 2) fwd_kernel(Args args) {
    extern __shared__ __attribute__((aligned(16))) unsigned char lds_raw[];
    Ctx F;
    F.lds = (LAS unsigned char*)lds_raw;
    F.tid = threadIdx.x; F.lane = F.tid & 63; F.wave = __builtin_amdgcn_readfirstlane(F.tid >> 6);
    F.G = gridDim.x; F.gw = blockIdx.x * NWAVES + F.wave; F.NGW = F.G * NWAVES;
    load_ptrs(F);
    unsigned char* ws = F.ws;

    volatile LAS unsigned* MISC = (volatile LAS unsigned*)(F.lds + MISC_OFF);
    for (int u = F.tid; u < (LDS_BYTES - LDSCTL_OFF) / 4; u += NTHR) ((LAS unsigned*)(F.lds + LDSCTL_OFF))[u] = 0u;
    __syncthreads();
    const int lo = args.ph_lo, hi = args.ph_hi;
    XcdBarrier bar; bar.bar = (unsigned*)(ws + WS_CTL); bar.x = 0; bar.st = nullptr;
    if (hi - lo > 1) bar = xcd_barrier_post((unsigned*)(ws + WS_CTL), MISC + 8, F.wave);
#define IN(k) (lo <= (k) && (k) < hi)
#define REFRESH() do { int t_ = F.wave * 64 + (int)__builtin_amdgcn_mbcnt_hi(~0u, __builtin_amdgcn_mbcnt_lo(~0u, 0u)); asm volatile("" : "+v"(t_)); F.tid = t_; F.lane = t_ & 63; load_ptrs(F); } while (0)
#define SEAM(k) do { if (IN(k) && IN((k) + 1)) xcd_barrier(bar, F.wave); } while (0)

    if (IN(0)) { REFRESH(); phase_prep(F); } SEAM(0);
    if (IN(1)) { REFRESH(); memkv_fast(F); REFRESH();
        pg8::Gemm g{F.XN, F.WIN0, T, NP, DM, F.wave}; pg8::StaticOrder S; S.init(T, NP, F.G, (int)blockIdx.x);
        pg8::EpiBf16<0> E{F.P, NP, nullptr, 0, 0, 1.f};
        pg8::gemm_phase<pg8::EpiBf16<0>, pg8::StaticOrder, true, true>(F.lds, g, S, E); } SEAM(1);
    if (IN(2)) { REFRESH(); gla_g1_fast(F); REFRESH(); cross_fast(F, 0, F.MIX0); } SEAM(2);
    if (IN(3)) { REFRESH(); gla_scan(F); } SEAM(3);
    if (IN(4)) { REFRESH(); gla_g3_fast(F); } SEAM(4);
    if (IN(5)) { REFRESH(); pg8::Gemm g{F.MIX0, F.WOUT0, T, DM, DM, F.wave}; pg8::StaticOrder S; S.init(T, DM, F.G, (int)blockIdx.x);
        pg8::EpiBf16<0> E{F.XN, DM, nullptr, 0, 0, 1.f};
        pg8::gemm_phase<pg8::EpiBf16<0>, pg8::StaticOrder, true, true>(F.lds, g, S, E); } SEAM(5);
    if (IN(6)) { REFRESH(); post_rows(F, F.x, F.XN, F.ln_post, F.out, F.ln_pre + DM, F.XN); } SEAM(6);
    if (IN(7)) { REFRESH(); pg8::Gemm g{F.XN, F.WIN1, T, NP, DM, F.wave}; pg8::StaticOrder S; S.init(T, NP, F.G, (int)blockIdx.x);
        EpiNsaIn E{F.P, NP, F.CP};
        pg8::gemm_phase<EpiNsaIn, pg8::StaticOrder, true, true>(F.lds, g, S, E); } SEAM(7);
    if (IN(8)) { REFRESH(); nsa_compress_fast(F); } SEAM(8);
    if (IN(9)) { REFRESH(); nsa_main_fast(F); REFRESH(); cross_fast(F, 1, F.MIX1); } SEAM(9);
    if (IN(10)) { REFRESH(); pg8::Gemm g{F.MIX1, F.WOUT1, T, DM, DM, F.wave}; pg8::StaticOrder S; S.init(T, DM, F.G, (int)blockIdx.x);
        pg8::EpiBf16<0> E{F.XN, DM, nullptr, 0, 0, 1.f};
        pg8::gemm_phase<pg8::EpiBf16<0>, pg8::StaticOrder, true, true>(F.lds, g, S, E); } SEAM(10);
    if (IN(11)) { REFRESH(); post_rows(F, F.out, F.XN, F.ln_post + DM, F.out, nullptr, nullptr); }
#undef IN
#undef SEAM
}

#ifndef N_LAUNCHES
#define N_LAUNCHES 1
#endif
extern "C" void kernel_launch(void* const* d_in, const int* in_sizes, int n_in, void* d_out, int out_size, void* d_ws, size_t ws_size, hipStream_t stream) {
    static int grid = 0;
    if (grid == 0) {
        if (n_in != 19 || out_size != T * DM || ws_size < WS_END) { fprintf(stderr, "kernel_launch: unexpected shapes (n_in %d out %d ws %zu)\n", n_in, out_size, ws_size); grid = -1; return; }
        int dev = 0, cus = 0, per_cu = 0;
        if (hipGetDevice(&dev) != hipSuccess || hipDeviceGetAttribute(&cus, hipDeviceAttributeMultiprocessorCount, dev) != hipSuccess) { grid = -1; return; }
        if (hipFuncSetAttribute((const void*)fwd_kernel, hipFuncAttributeMaxDynamicSharedMemorySize, LDS_BYTES) != hipSuccess) { fprintf(stderr, "kernel_launch: hipFuncSetAttribute failed\n"); grid = -1; return; }
        if (hipOccupancyMaxActiveBlocksPerMultiprocessor(&per_cu, (const void*)fwd_kernel, NTHR, LDS_BYTES) != hipSuccess || per_cu < 1) fprintf(stderr, "kernel_launch: occupancy query reports %d\n", per_cu);
        (void)hipGetLastError();
        grid = cus;
    }
    if (grid < 0) return;
    if (hipMemsetAsync((char*)d_ws + WS_CTL, 0, CTL_ZERO_BYTES, stream) != hipSuccess) return;
    Args a{};
    for (int i = 0; i < 19; ++i) a.in[i] = (const float*)d_in[i];
    a.out = (float*)d_out; a.ws = (unsigned char*)d_ws;
    for (int li = 0; li < N_LAUNCHES; ++li) {
        a.ph_lo = li * N_PHASES / N_LAUNCHES; a.ph_hi = (li + 1) * N_PHASES / N_LAUNCHES;
        hipLaunchKernelGGL(fwd_kernel, dim3(grid), dim3(NTHR), LDS_BYTES, stream, a);
    }
}
```
